# Optimizing an MI355X kernel written in HIP

```python
import jax, jax.numpy as jnp
from jax import lax
import numpy as np

D_MODEL = 2048
BATCH = 4
SEQ = 4096
DEPTH = 4

CHUNK = 64
N_A_LAYERS = DEPTH // 2
N_B_LAYERS = DEPTH - N_A_LAYERS
RMS_EPS = 1e-6
POOL_WINDOWS = (2, 4, 8, 16)
N_POOL_GROUPS = len(POOL_WINDOWS)
POOL_GROUP = D_MODEL // N_POOL_GROUPS
MLA_HEADS = 16
Q_RANK = D_MODEL // 4
KV_RANK = D_MODEL // 4
NOPE_DIM = 128
ROPE_DIM = 64
V_DIM = 128
ROPE_THETA = 10000.0
Q_BLOCK = 128
MEM_TOKENS = 256
MEM_HEADS = 4
MEM_HEAD_DIM = 128
MEM_INNER = MEM_HEADS * MEM_HEAD_DIM
N_GROUPS = 4
EXPERTS_PER_GROUP = 8
N_EXPERTS = N_GROUPS * EXPERTS_PER_GROUP
TOP_K = 2
EXPERT_FF = D_MODEL // 4
MOE_BLOCK = 256

kernel_name = "yoco_pool_mla_hier_moe_trunk"


def rmsnorm(x, g):
    xf = x.astype(jnp.float32)
    y = xf * lax.rsqrt(jnp.mean(xf * xf, axis=-1, keepdims=True) + RMS_EPS)
    return (y * g.astype(jnp.float32)).astype(x.dtype)


def rope_tables(positions):
    half = ROPE_DIM // 2
    inv = 1.0 / (ROPE_THETA ** (jnp.arange(half, dtype=jnp.float32) / half))
    ang = positions.astype(jnp.float32)[..., None] * inv
    return jnp.cos(ang), jnp.sin(ang)


def apply_rope(x, cos, sin):
    if x.ndim == 4:
        cos, sin = cos[:, :, None, :], sin[:, :, None, :]
    half = ROPE_DIM // 2
    x1 = x[..., :half].astype(jnp.float32)
    x2 = x[..., half:].astype(jnp.float32)
    return jnp.concatenate([x1 * cos - x2 * sin, x2 * cos + x1 * sin], axis=-1).astype(x.dtype)


def pool_mixer(h, w_pool, scale):
    bsz, s, d = h.shape
    hf = h.astype(jnp.float32)
    cs = jnp.concatenate([jnp.zeros((bsz, 1, d), jnp.float32), jnp.cumsum(hf, axis=1)], axis=1)
    t = np.arange(s)
    means = []
    for g, w in enumerate(POOL_WINDOWS):
        sl = slice(g * POOL_GROUP, (g + 1) * POOL_GROUP)
        lo = np.maximum(t + 1 - w, 0)
        cnt = np.minimum(t + 1, w).astype(np.float32)
        means.append((cs[:, 1:, sl] - cs[:, lo, sl]) / cnt[None, :, None])
    u = (jnp.concatenate(means, axis=-1) - hf).astype(h.dtype)
    u = u.reshape(bsz, s, N_POOL_GROUPS, POOL_GROUP)
    y = jnp.einsum('bsgc,gcd->bsgd', u, w_pool).reshape(bsz, s, d)
    return y * scale


def mem_attention(h, m, wq, wk, wv, wo):
    bsz, s, _ = h.shape
    q = (h @ wq).reshape(bsz, s, MEM_HEADS, MEM_HEAD_DIM)
    k = (m @ wk).reshape(bsz, -1, MEM_HEADS, MEM_HEAD_DIM)
    v = (m @ wv).reshape(bsz, -1, MEM_HEADS, MEM_HEAD_DIM)
    sc = jnp.einsum('bshd,bmhd->bhsm', q, k).astype(jnp.float32) * (MEM_HEAD_DIM ** -0.5)
    p = jax.nn.softmax(sc, axis=-1).astype(v.dtype)
    o = jnp.einsum('bhsm,bmhd->bshd', p, v).reshape(bsz, s, MEM_INNER)
    return o @ wo


def mla_shared_kv(h, cos, sin, kv_in_norm, w_dkv, kv_latent_norm, w_kr, w_uk, w_uv):
    bsz, s, _ = h.shape
    hn = rmsnorm(h, kv_in_norm)
    c_kv = rmsnorm(hn @ w_dkv, kv_latent_norm)
    k_rope = apply_rope(hn @ w_kr, cos, sin)
    k_nope = (c_kv @ w_uk).reshape(bsz, s, MLA_HEADS, NOPE_DIM)
    v = (c_kv @ w_uv).reshape(bsz, s, MLA_HEADS, V_DIM)
    return k_nope, k_rope, v


def mla_attention(hn, cos, sin, k_nope, k_rope, v, w_dq, q_latent_norm, w_uq, w_qr, w_o):
    bsz, s, _ = hn.shape
    c_q = rmsnorm(hn @ w_dq, q_latent_norm)
    q_nope = (c_q @ w_uq).reshape(bsz, s, MLA_HEADS, NOPE_DIM)
    q_rope = apply_rope((c_q @ w_qr).reshape(bsz, s, MLA_HEADS, ROPE_DIM), cos, sin)
    nb = s // Q_BLOCK
    qn = q_nope.reshape(bsz, nb, Q_BLOCK, MLA_HEADS, NOPE_DIM).transpose(1, 0, 2, 3, 4)
    qr = q_rope.reshape(bsz, nb, Q_BLOCK, MLA_HEADS, ROPE_DIM).transpose(1, 0, 2, 3, 4)
    key_chunk = jnp.arange(s) // CHUNK
    scale = (NOPE_DIM + ROPE_DIM) ** -0.5

    def attend(args):
        qn_b, qr_b, b = args
        sc = (jnp.einsum('bqhd,bkhd->bhqk', qn_b, k_nope)
              + jnp.einsum('bqhr,bkr->bhqk', qr_b, k_rope)).astype(jnp.float32) * scale
        q_chunk = (b * Q_BLOCK + jnp.arange(Q_BLOCK)) // CHUNK
        allowed = key_chunk[None, :] <= q_chunk[:, None]
        sc = jnp.where(allowed[None, None], sc, -jnp.inf)
        p = jax.nn.softmax(sc, axis=-1).astype(v.dtype)
        return jnp.einsum('bhqk,bkhd->bqhd', p, v)

    o = lax.map(attend, (qn, qr, jnp.arange(nb)))
    o = o.transpose(1, 0, 2, 3, 4).reshape(bsz, s, MLA_HEADS * V_DIM)
    return o @ w_o


def hier_moe(h, rg_w, rg_b, re_w, re_b, w_gate, w_up, w_down):
    bsz, s, d = h.shape
    t_tok = bsz * s
    xt = h.reshape(t_tok, d)
    rows = jnp.arange(t_tok)
    g_logits = (xt @ rg_w + rg_b).astype(jnp.float32)
    g_sel = jnp.argmax(g_logits, axis=-1)
    g_p = jax.nn.softmax(g_logits, axis=-1)[rows, g_sel][:, None]
    e_logits = (xt @ re_w + re_b).astype(jnp.float32).reshape(t_tok, N_GROUPS, EXPERTS_PER_GROUP)
    e_p = jax.nn.softmax(e_logits[rows, g_sel], axis=-1)
    top_p, top_i = lax.top_k(e_p, TOP_K)
    gate = g_p * top_p / jnp.sum(top_p, axis=-1, keepdims=True)
    expert = (g_sel[:, None] * EXPERTS_PER_GROUP + top_i).astype(jnp.int32)
    n_assign = t_tok * TOP_K
    e_flat = expert.reshape(n_assign)
    tok_flat = jnp.arange(n_assign, dtype=jnp.int32) // TOP_K
    w_flat = gate.reshape(n_assign)
    order = jnp.argsort(e_flat)
    e_sorted = e_flat[order]
    counts = jnp.bincount(e_flat, length=N_EXPERTS)
    starts = jnp.cumsum(counts) - counts
    padded = (counts + MOE_BLOCK - 1) // MOE_BLOCK * MOE_BLOCK
    pends = jnp.cumsum(padded)
    dest = (pends - padded)[e_sorted] + jnp.arange(n_assign) - starts[e_sorted]
    n_rows = -(-(n_assign + N_EXPERTS * MOE_BLOCK) // MOE_BLOCK) * MOE_BLOCK
    n_blocks = n_rows // MOE_BLOCK
    row_tok = jnp.full((n_rows,), t_tok, jnp.int32).at[dest].set(tok_flat[order])
    row_w = jnp.zeros((n_rows,), jnp.float32).at[dest].set(w_flat[order])
    block_e = jnp.minimum(jnp.searchsorted(pends, jnp.arange(n_blocks) * MOE_BLOCK, side='right'), N_EXPERTS - 1)
    x_rows = jnp.concatenate([xt, jnp.zeros((1, d), xt.dtype)], axis=0)[row_tok]
    x_rows = x_rows.reshape(n_blocks, MOE_BLOCK, d)

    def expert_block(args):
        xb, e = args
        return (jax.nn.silu(xb @ w_gate[e]) * (xb @ w_up[e])) @ w_down[e]

    y_rows = lax.map(expert_block, (x_rows, block_e)).reshape(n_rows, d)
    y = jax.ops.segment_sum(y_rows * row_w[:, None], row_tok, num_segments=t_tok + 1)[:t_tok]
    return y.astype(h.dtype).reshape(bsz, s, d)


def setup_inputs(seed: int = 0) -> dict:
    key = jax.random.key(seed)
    k = jax.random.split(key, 32)
    f32 = jnp.float32

    def w(i, shape, fan_in):
        return jax.random.normal(k[i], shape, f32) * (fan_in ** -0.5)

    def gain(i, shape):
        return 1.0 + 0.05 * jax.random.normal(k[i], shape, f32)

    positions = (jax.random.randint(k[2], (BATCH, 1), 0, 4096, dtype=jnp.int32)
                 + jnp.arange(SEQ, dtype=jnp.int32)[None, :])
    return {
        'x': jax.random.normal(k[0], (BATCH, SEQ, D_MODEL), f32),
        'mem': jax.random.normal(k[1], (BATCH, MEM_TOKENS, D_MODEL), f32),
        'positions': positions,
        'norm_mix': gain(3, (DEPTH, D_MODEL)),
        'norm_mem': gain(4, (DEPTH, D_MODEL)),
        'norm_memtok': gain(5, (DEPTH, D_MODEL)),
        'norm_ffn': gain(6, (DEPTH, D_MODEL)),
        'pool_w': w(7, (N_A_LAYERS, N_POOL_GROUPS, POOL_GROUP, POOL_GROUP), POOL_GROUP),
        'pool_scale': gain(8, (N_A_LAYERS, D_MODEL)),
        'kv_in_norm': gain(9, (D_MODEL,)),
        'w_dkv': w(10, (D_MODEL, KV_RANK), D_MODEL),
        'kv_latent_norm': gain(11, (KV_RANK,)),
        'w_kr': w(12, (D_MODEL, ROPE_DIM), D_MODEL),
        'w_uk': w(13, (KV_RANK, MLA_HEADS * NOPE_DIM), KV_RANK),
        'w_uv': w(14, (KV_RANK, MLA_HEADS * V_DIM), KV_RANK),
        'w_dq': w(15, (N_B_LAYERS, D_MODEL, Q_RANK), D_MODEL),
        'q_latent_norm': gain(16, (N_B_LAYERS, Q_RANK)),
        'w_uq': w(17, (N_B_LAYERS, Q_RANK, MLA_HEADS * NOPE_DIM), Q_RANK),
        'w_qr': w(18, (N_B_LAYERS, Q_RANK, MLA_HEADS * ROPE_DIM), Q_RANK),
        'w_o': w(19, (N_B_LAYERS, MLA_HEADS * V_DIM, D_MODEL), MLA_HEADS * V_DIM),
        'mem_wq': w(20, (DEPTH, D_MODEL, MEM_INNER), D_MODEL),
        'mem_wk': w(21, (DEPTH, D_MODEL, MEM_INNER), D_MODEL),
        'mem_wv': w(22, (DEPTH, D_MODEL, MEM_INNER), D_MODEL),
        'mem_wo': w(23, (DEPTH, MEM_INNER, D_MODEL), MEM_INNER),
        'rg_w': w(24, (DEPTH, D_MODEL, N_GROUPS), D_MODEL),
        'rg_b': 0.01 * jax.random.normal(k[25], (DEPTH, N_GROUPS), f32),
        're_w': w(26, (DEPTH, D_MODEL, N_EXPERTS), D_MODEL),
        're_b': 0.01 * jax.random.normal(k[27], (DEPTH, N_EXPERTS), f32),
        'w_gate': w(28, (DEPTH, N_EXPERTS, D_MODEL, EXPERT_FF), D_MODEL),
        'w_up': w(29, (DEPTH, N_EXPERTS, D_MODEL, EXPERT_FF), D_MODEL),
        'w_down': w(30, (DEPTH, N_EXPERTS, EXPERT_FF, D_MODEL), EXPERT_FF),
        'final_norm': gain(31, (D_MODEL,)),
    }


def reference(x, mem, positions, norm_mix, norm_mem, norm_memtok, norm_ffn,
              pool_w, pool_scale, kv_in_norm, w_dkv, kv_latent_norm, w_kr, w_uk, w_uv,
              w_dq, q_latent_norm, w_uq, w_qr, w_o, mem_wq, mem_wk, mem_wv, mem_wo,
              rg_w, rg_b, re_w, re_b, w_gate, w_up, w_down, final_norm):
    cos, sin = rope_tables(positions)
    h = x
    for l in range(DEPTH):
        if l < N_A_LAYERS:
            h = h + pool_mixer(rmsnorm(h, norm_mix[l]), pool_w[l], pool_scale[l])
        else:
            if l == N_A_LAYERS:
                k_nope, k_rope, v_sh = mla_shared_kv(h, cos, sin, kv_in_norm, w_dkv,
                                                     kv_latent_norm, w_kr, w_uk, w_uv)
            j = l - N_A_LAYERS
            h = h + mla_attention(rmsnorm(h, norm_mix[l]), cos, sin, k_nope, k_rope, v_sh,
                                  w_dq[j], q_latent_norm[j], w_uq[j], w_qr[j], w_o[j])
        h = h + mem_attention(rmsnorm(h, norm_mem[l]), rmsnorm(mem, norm_memtok[l]),
                              mem_wq[l], mem_wk[l], mem_wv[l], mem_wo[l])
        h = h + hier_moe(rmsnorm(h, norm_ffn[l]), rg_w[l], rg_b[l], re_w[l], re_b[l],
                         w_gate[l], w_up[l], w_down[l])
    return rmsnorm(h, final_norm)
```

```cpp
#include <hip/hip_runtime.h>
#include <cstdio>
#include <cstdint>
#include <cstring>

typedef unsigned short bf16_t;
typedef float f32x4 __attribute__((ext_vector_type(4)));
typedef unsigned u32x4 __attribute__((ext_vector_type(4)));
typedef unsigned u32x2 __attribute__((ext_vector_type(2)));
#define DI __device__ __forceinline__

constexpr int D = 2048, NB = 4, S = 4096, T = NB * S, DEPTH = 4, NA = 2;
constexpr int CHUNK = 64;
constexpr int PG = 512;
constexpr int HEADS = 16, QR = 512, KVR = 512, NOPE = 128, ROPE = 64, VD = 128, QKD = NOPE + ROPE;
constexpr int MEMT = 256, MH = 4, MHD = 128, MI = 512;
constexpr int NG = 4, EPG = 8, NE = 32, EFF = 512;
constexpr float EPS = 1e-6f;
constexpr int CAP = T;
constexpr int MAXROWS = 2 * T + NE * 256;
constexpr int NQ = HEADS * QKD;
constexpr int NDQ0 = 1280;

constexpr size_t al(size_t x) { return (x + 255) & ~(size_t)255; }
constexpr size_t WS_CTL = 0, CTL_BYTES = 1u << 20;
constexpr size_t OFF_CNT = 65536;
constexpr size_t WS_WPOOL = WS_CTL + CTL_BYTES;
constexpr size_t WS_WMQ = WS_WPOOL + (size_t)NA * D * PG * 2;
constexpr size_t WS_WMK = WS_WMQ + (size_t)DEPTH * MI * D * 2;
constexpr size_t WS_WMV = WS_WMK + (size_t)DEPTH * MI * D * 2;
constexpr size_t WS_WMO = WS_WMV + (size_t)DEPTH * MI * D * 2;
constexpr size_t WS_WDQ0 = WS_WMO + (size_t)DEPTH * D * MI * 2;
constexpr size_t WS_WDQ1 = WS_WDQ0 + (size_t)NDQ0 * D * 2;
constexpr size_t WS_WUQ = WS_WDQ1 + (size_t)QR * D * 2;
constexpr size_t WS_WUKV = WS_WUQ + (size_t)2 * NQ * QR * 2;
constexpr size_t WS_WO = WS_WUKV + (size_t)4096 * KVR * 2;
constexpr size_t WS_RWT = WS_WO + (size_t)2 * D * D * 2;
constexpr size_t WS_WGU = al(WS_RWT + (size_t)DEPTH * 36 * D * 4);
constexpr size_t WS_WD = WS_WGU + (size_t)DEPTH * NE * 1024 * D * 2;
constexpr size_t WS_H = WS_WD + (size_t)DEPTH * NE * D * EFF * 2;
constexpr size_t WS_HB = WS_H + (size_t)T * D * 4;
constexpr size_t WS_Y = WS_HB + (size_t)T * D * 2;
constexpr size_t WS_HH = WS_Y + (size_t)2 * T * D * 2;
constexpr size_t WS_KN = WS_HH + (size_t)MAXROWS * EFF * 2;
constexpr size_t WS_V = WS_KN + (size_t)T * D * 2;
constexpr size_t WS_Q = WS_V + (size_t)T * D * 2;
constexpr size_t WS_HN = WS_Q;
constexpr size_t WS_U = WS_Q + (size_t)T * D * 2;
constexpr size_t WS_AO = WS_Q + (size_t)T * NQ * 2;
constexpr size_t WS_MQ = WS_AO + (size_t)T * D * 2;
constexpr size_t WS_MO = WS_MQ + (size_t)T * MI * 2;
constexpr size_t WS_CQ = WS_MO + (size_t)T * MI * 2;
constexpr size_t WS_CKV = WS_CQ + (size_t)T * QR * 2;
constexpr size_t WS_KR = WS_CKV + (size_t)T * KVR * 2;
constexpr size_t WS_MEMB = WS_KR + (size_t)T * ROPE * 2;
constexpr size_t WS_MK = WS_MEMB + (size_t)NB * MEMT * D * 2;
constexpr size_t WS_MV = WS_MK + (size_t)DEPTH * NB * MEMT * MI * 2;
constexpr size_t WS_SSP = WS_MV + (size_t)DEPTH * NB * MEMT * MI * 2;
constexpr size_t WS_LSQ = WS_SSP + (size_t)T * 32 * 4;
constexpr size_t WS_LSKV = WS_LSQ + (size_t)T * 8 * 4;
constexpr size_t WS_RS0 = WS_LSKV + (size_t)T * 8 * 4;
constexpr size_t WS_RS2 = WS_RS0 + (size_t)T * 4;
constexpr size_t WS_MEMRS = WS_RS2 + (size_t)T * 4;
constexpr size_t WS_COS = WS_MEMRS + 4096;
constexpr size_t WS_SIN = WS_COS + (size_t)T * 32 * 4;
constexpr size_t WS_GW = WS_SIN + (size_t)T * 32 * 4;
constexpr size_t WS_LIST = WS_GW + (size_t)2 * T * 4;
constexpr size_t WS_END = WS_LIST + (size_t)NE * CAP * 4;
static_assert(WS_U + (size_t)T * D * 2 <= WS_MQ, "U overlay inside Q|AO");

DI float bf2f(bf16_t b) { return __uint_as_float(((unsigned)b) << 16); }
DI unsigned f2bf(float f) { unsigned u = __float_as_uint(f); return (u + 0x7fffu + ((u >> 16) & 1u)) >> 16; }
DI unsigned pk2(float lo, float hi) { return f2bf(lo) | (f2bf(hi) << 16); }
DI float wave_sum(float v) {
#pragma unroll
    for (int o = 1; o < 64; o <<= 1) v += __shfl_xor(v, o);
    return v;
}
DI float silu(float x) { return x / (1.0f + __expf(-x)); }

DI int permrow(int perm, int n) {
    switch (perm) {
        case 1: return (n >> 7) * QKD + (n & 127);
        case 2: { const int h = n >> 6, r = n & 63; return h * QKD + NOPE + 2 * (r & 31) + (r >> 5); }
        case 3: return (n >> 7) * 256 + (n & 127);
        case 4: return (n >> 7) * 256 + 128 + (n & 127);
        case 5: return 2 * (n & 31) + (n >> 5);
        default: return n;
    }
}
struct WtJob { const float* W; bf16_t* WT; const float* kgain; const float* ngain; long wstride, tstride; int K, N, perm, row_off; float scale; int pad; };
__global__ __launch_bounds__(256) void k_wt(WtJob j) {
    __shared__ float scr_all[4][64 * 33];
    const int wave = threadIdx.x >> 6, lane = threadIdx.x & 63;
    float* scr = scr_all[wave];
    const int nblk = j.N / 32, kblk = j.K / 64, item = blockIdx.x * 4 + wave;
    if (item >= nblk * kblk) return;
    const float* W = j.W + (long)blockIdx.y * j.wstride; bf16_t* WT = j.WT + (long)blockIdx.y * j.tstride;
    const int kb = item / nblk, nb = item % nblk, k0 = 64 * kb, n0 = 32 * nb;
    const float ng = (j.ngain ? j.ngain[n0 + (lane & 31)] : 1.0f) * j.scale;
#pragma unroll 8
    for (int i = 0; i < 32; ++i) { const int kk = 2 * i + (lane >> 5);
        float v = W[(size_t)(k0 + kk) * j.N + n0 + (lane & 31)] * ng; if (j.kgain) v *= j.kgain[k0 + kk];
        scr[kk * 33 + (lane & 31)] = v; }
    asm volatile("s_waitcnt lgkmcnt(0)" ::: "memory");
    const int c = lane & 7;
#pragma unroll
    for (int q = 0; q < 4; ++q) { const int n = (lane >> 3) + 8 * q; const float* s = scr + (8 * c) * 33 + n;
        u32x4 o; o.x = pk2(s[0 * 33], s[1 * 33]); o.y = pk2(s[2 * 33], s[3 * 33]); o.z = pk2(s[4 * 33], s[5 * 33]); o.w = pk2(s[6 * 33], s[7 * 33]);
        *(u32x4*)(WT + (size_t)(j.row_off + permrow(j.perm, n0 + n)) * j.K + k0 + 8 * c) = o; }
}
__global__ void k_rwt(const float* rg_w, const float* re_w, const float* gain, float* RWT) {
    const int idx = blockIdx.x * 256 + threadIdx.x; if (idx >= DEPTH * 36 * D) return;
    const int l = idx / (36 * D), n = (idx / D) % 36, k = idx % D;
    const float w = n < 4 ? rg_w[((size_t)l * D + k) * 4 + n] : re_w[((size_t)l * D + k) * 32 + (n - 4)];
    RWT[idx] = w * gain[l * D + k];
}
__global__ void k_zero(unsigned* p, long n) { for (long i = blockIdx.x * 256L + threadIdx.x; i < n; i += gridDim.x * 256L) p[i] = 0u; }
__global__ void k_rope(const int* pos, float* COS, float* SIN) {
    const int idx = blockIdx.x * 256 + threadIdx.x; if (idx >= T * 32) return;
    const int t = idx >> 5, i = idx & 31;
    const float inv = (float)(1.0 / pow(10000.0, (double)i / 32.0));
    const float ang = (float)pos[t] * inv;
    const double rev = (double)ang * 0.15915494309189533577; const float fr = (float)(rev - rint(rev));
    COS[idx] = __builtin_amdgcn_cosf(fr); SIN[idx] = __builtin_amdgcn_sinf(fr);
}
__global__ __launch_bounds__(256) void k_memprep(const float* mem, bf16_t* MEMB, float* MEMRS) {
    const int r = blockIdx.x * 4 + (threadIdx.x >> 6), lane = threadIdx.x & 63;
    const f32x4* x = (const f32x4*)(mem + (size_t)r * D) + lane; float ss = 0.f;
#pragma unroll
    for (int j = 0; j < 8; ++j) { const f32x4 v = x[64 * j]; ss += (v.x * v.x + v.y * v.y) + (v.z * v.z + v.w * v.w);
        u32x2 o; o.x = pk2(v.x, v.y); o.y = pk2(v.z, v.w); *((u32x2*)(MEMB + (size_t)r * D) + lane + 64 * j) = o; }
    ss = wave_sum(ss); if (lane == 0) MEMRS[r] = rsqrtf(ss * (1.0f / D) + EPS);
}
__global__ __launch_bounds__(256) void k_combine(const float* src, const bf16_t* Y, float* H, bf16_t* HB, float* RS0, const float* gain, bf16_t* HN, float* out) {
    const int t = blockIdx.x * 4 + (threadIdx.x >> 6), lane = threadIdx.x & 63;
    const f32x4* x = (const f32x4*)(src + (size_t)t * D) + lane; f32x4 v[8]; float ss = 0.f;
#pragma unroll
    for (int j = 0; j < 8; ++j) { v[j] = x[64 * j];
        if (Y) { const u32x2 a = *((const u32x2*)(Y + (size_t)(2 * t) * D) + lane + 64 * j), b = *((const u32x2*)(Y + (size_t)(2 * t + 1) * D) + lane + 64 * j);
            v[j].x = (v[j].x + __uint_as_float(a.x << 16)) + __uint_as_float(b.x << 16); v[j].y = (v[j].y + __uint_as_float(a.x & 0xffff0000u)) + __uint_as_float(b.x & 0xffff0000u);
            v[j].z = (v[j].z + __uint_as_float(a.y << 16)) + __uint_as_float(b.y << 16); v[j].w = (v[j].w + __uint_as_float(a.y & 0xffff0000u)) + __uint_as_float(b.y & 0xffff0000u); }
        ss += (v[j].x * v[j].x + v[j].y * v[j].y) + (v[j].z * v[j].z + v[j].w * v[j].w); }
    ss = wave_sum(ss); const float rs = rsqrtf(ss * (1.0f / D) + EPS);
    if (lane == 0 && RS0) RS0[t] = rs;
#pragma unroll
    for (int j = 0; j < 8; ++j) {
        if (H) *((f32x4*)(H + (size_t)t * D) + lane + 64 * j) = v[j];
        if (HB) { u32x2 o; o.x = pk2(v[j].x, v[j].y); o.y = pk2(v[j].z, v[j].w); *((u32x2*)(HB + (size_t)t * D) + lane + 64 * j) = o; }
        if (gain) { const f32x4 g = *((const f32x4*)gain + lane + 64 * j); const f32x4 n = v[j] * g * rs;
            if (HN) { u32x2 o; o.x = pk2(n.x, n.y); o.y = pk2(n.z, n.w); *((u32x2*)(HN + (size_t)t * D) + lane + 64 * j) = o; }
            if (out) *((f32x4*)(out + (size_t)t * D) + lane + 64 * j) = n; }
    }
}
__global__ __launch_bounds__(256) void k_pool(const bf16_t* HN, bf16_t* U) {
    const int t = blockIdx.x, c = threadIdx.x * 8, s = t & (S - 1), w = 2 << (c >> 9);
    const int n = (s + 1 < w) ? s + 1 : w;
    float acc[8] = {0.f, 0.f, 0.f, 0.f, 0.f, 0.f, 0.f, 0.f}, self[8];
    for (int i = 0; i < n; ++i) { const u32x4 v = *(const u32x4*)(HN + (size_t)(t - i) * D + c);
        const float f[8] = {__uint_as_float(v.x << 16), __uint_as_float(v.x & 0xffff0000u), __uint_as_float(v.y << 16), __uint_as_float(v.y & 0xffff0000u),
                            __uint_as_float(v.z << 16), __uint_as_float(v.z & 0xffff0000u), __uint_as_float(v.w << 16), __uint_as_float(v.w & 0xffff0000u)};
#pragma unroll
        for (int q = 0; q < 8; ++q) { acc[q] += f[q]; if (i == 0) self[q] = f[q]; } }
    const float inv = 1.0f / (float)n; u32x4 o;
    o.x = pk2(acc[0] * inv - self[0], acc[1] * inv - self[1]); o.y = pk2(acc[2] * inv - self[2], acc[3] * inv - self[3]);
    o.z = pk2(acc[4] * inv - self[4], acc[5] * inv - self[5]); o.w = pk2(acc[6] * inv - self[6], acc[7] * inv - self[7]);
    *(u32x4*)(U + (size_t)t * D + c) = o;
}
__global__ __launch_bounds__(256) void k_rowstats_f32(const float* X, int ncol, float* P, int np) {
    const int t = blockIdx.x * 4 + (threadIdx.x >> 6), lane = threadIdx.x & 63; float ss = 0.f;
    for (int c = lane * 4; c < ncol; c += 256) { const f32x4 v = *(const f32x4*)(X + (size_t)t * ncol + c); ss += (v.x * v.x + v.y * v.y) + (v.z * v.z + v.w * v.w); }
    ss = wave_sum(ss); if (lane < np) P[(size_t)t * np + lane] = lane == 0 ? ss : 0.f;
}
__global__ __launch_bounds__(256) void k_rowstats_bf16(const bf16_t* X, int ncol, float* P, int np) {
    const int t = blockIdx.x * 4 + (threadIdx.x >> 6), lane = threadIdx.x & 63; float ss = 0.f;
    for (int c = lane * 4; c < ncol; c += 256) { const u32x2 v = *(const u32x2*)(X + (size_t)t * ncol + c);
        const float a = __uint_as_float(v.x << 16), b = __uint_as_float(v.x & 0xffff0000u), cc = __uint_as_float(v.y << 16), d = __uint_as_float(v.y & 0xffff0000u); ss += (a * a + b * b) + (cc * cc + d * d); }
    ss = wave_sum(ss); if (lane < np) P[(size_t)t * np + lane] = lane == 0 ? ss : 0.f;
}

enum { K_BF16RS = 0, K_RES = 1, K_DQ = 2, K_UQ = 3, K_UKV = 4, K_MOE1 = 5, K_MOE2 = 6 };
struct GArgs {
    const bf16_t* A; const bf16_t* Bt; float* H; bf16_t* HB; bf16_t* O1; bf16_t* O2; bf16_t* O3;
    const float* rs; const float* part;
    const float* COS; const float* SIN;
    const int* cnt; const int* list; const float* gw; long estride;
    int lda, K, kind, pool, ldo, np; float pdiv; int pad;
};
DI float rowscale(const GArgs& g, int r) {
    if (g.rs) return g.rs[r];
    if (g.part) { float s = 0.f; for (int p = 0; p < g.np; ++p) s += g.part[(size_t)r * g.np + p]; return rsqrtf(s / g.pdiv + EPS); }
    return 1.0f;
}
template <bool DUAL>
__global__ __launch_bounds__(256) void k_gemm(GArgs g) {
    __shared__ __attribute__((aligned(16))) float As[16][132];
    __shared__ __attribute__((aligned(16))) float Bs[DUAL ? 2 : 1][16][132];
    const int tid = threadIdx.x, tx = tid & 15, ty = tid >> 4, lr = tid >> 1, lk = (tid & 1) * 8;
    const int n0 = blockIdx.x * 128, m0 = blockIdx.y * 128;
    int e = 0, rie0 = 0, ecnt = 0;
    if (g.cnt) { const int tile256 = blockIdx.y >> 1; int acc = 0; bool found = false;
        for (int i = 0; i < NE; ++i) { const int c = g.cnt[i], nt = (c + 255) >> 8; if (!found && tile256 < acc + nt) { found = true; e = i; ecnt = c; rie0 = (tile256 - acc) * 256 + (blockIdx.y & 1) * 128; } acc += nt; }
        if (!found) return; }
    const bf16_t* ap; const bf16_t* bp; const bf16_t* bp2 = nullptr;
    if (g.kind == K_MOE1) { const int ri = rie0 + lr; ap = ri < ecnt ? g.A + (size_t)(g.list[(size_t)e * CAP + ri] >> 1) * g.lda : nullptr;
        bp = g.Bt + (size_t)e * g.estride + (size_t)(blockIdx.x * 256 + lr) * g.K; bp2 = bp + (size_t)128 * g.K; }
    else if (g.kind == K_MOE2) { ap = g.A + (size_t)(m0 + lr) * g.lda; bp = g.Bt + (size_t)e * g.estride + (size_t)(n0 + lr) * g.K; }
    else { ap = g.A + (size_t)(m0 + lr) * g.lda + (g.pool ? (n0 / 512) * 512 : 0); bp = g.Bt + (size_t)(n0 + lr) * g.K; }
    float acc[8][8], acc2[DUAL ? 8 : 1][8];
#pragma unroll
    for (int i = 0; i < 8; ++i)
#pragma unroll
        for (int j = 0; j < 8; ++j) { acc[i][j] = 0.f; if (DUAL) acc2[i][j] = 0.f; }
    for (int k0 = 0; k0 < g.K; k0 += 16) {
        u32x4 av = {0u, 0u, 0u, 0u}, bv, bv2 = {0u, 0u, 0u, 0u};
        if (ap) av = *(const u32x4*)(ap + k0 + lk);
        bv = *(const u32x4*)(bp + k0 + lk);
        if (DUAL) bv2 = *(const u32x4*)(bp2 + k0 + lk);
        __syncthreads();
        const unsigned aw[4] = {av.x, av.y, av.z, av.w}, bw[4] = {bv.x, bv.y, bv.z, bv.w}, bw2[4] = {bv2.x, bv2.y, bv2.z, bv2.w};
#pragma unroll
        for (int q = 0; q < 4; ++q) {
            As[lk + 2 * q][lr] = __uint_as_float(aw[q] << 16); As[lk + 2 * q + 1][lr] = __uint_as_float(aw[q] & 0xffff0000u);
            Bs[0][lk + 2 * q][lr] = __uint_as_float(bw[q] << 16); Bs[0][lk + 2 * q + 1][lr] = __uint_as_float(bw[q] & 0xffff0000u);
            if (DUAL) { Bs[DUAL ? 1 : 0][lk + 2 * q][lr] = __uint_as_float(bw2[q] << 16); Bs[DUAL ? 1 : 0][lk + 2 * q + 1][lr] = __uint_as_float(bw2[q] & 0xffff0000u); }
        }
        __syncthreads();
#pragma unroll
        for (int kk = 0; kk < 16; ++kk) {
            const f32x4 a0 = *(const f32x4*)&As[kk][ty * 8], a1 = *(const f32x4*)&As[kk][ty * 8 + 4];
            const f32x4 b0 = *(const f32x4*)&Bs[0][kk][tx * 8], b1 = *(const f32x4*)&Bs[0][kk][tx * 8 + 4];
            const float a[8] = {a0.x, a0.y, a0.z, a0.w, a1.x, a1.y, a1.z, a1.w}, b[8] = {b0.x, b0.y, b0.z, b0.w, b1.x, b1.y, b1.z, b1.w};
#pragma unroll
            for (int i = 0; i < 8; ++i)
#pragma unroll
                for (int j = 0; j < 8; ++j) acc[i][j] += a[i] * b[j];
            if (DUAL) { const f32x4 c0 = *(const f32x4*)&Bs[DUAL ? 1 : 0][kk][tx * 8], c1 = *(const f32x4*)&Bs[DUAL ? 1 : 0][kk][tx * 8 + 4];
                const float c[8] = {c0.x, c0.y, c0.z, c0.w, c1.x, c1.y, c1.z, c1.w};
#pragma unroll
                for (int i = 0; i < 8; ++i)
#pragma unroll
                    for (int j = 0; j < 8; ++j) acc2[i][j] += a[i] * c[j]; }
        }
    }
#pragma unroll
    for (int i = 0; i < 8; ++i) {
        const int r = m0 + ty * 8 + i, n = n0 + tx * 8;
        float v[8];
#pragma unroll
        for (int j = 0; j < 8; ++j) v[j] = acc[i][j];
        if (g.kind == K_BF16RS) { const float sc = rowscale(g, r); u32x4 o; o.x = pk2(v[0] * sc, v[1] * sc); o.y = pk2(v[2] * sc, v[3] * sc); o.z = pk2(v[4] * sc, v[5] * sc); o.w = pk2(v[6] * sc, v[7] * sc);
            *(u32x4*)(g.O1 + (size_t)r * g.ldo + n) = o; }
        else if (g.kind == K_RES) { float* hp = g.H + (size_t)r * D + n; f32x4 h0 = *(f32x4*)hp, h1 = *(f32x4*)(hp + 4);
            h0.x += v[0]; h0.y += v[1]; h0.z += v[2]; h0.w += v[3]; h1.x += v[4]; h1.y += v[5]; h1.z += v[6]; h1.w += v[7];
            *(f32x4*)hp = h0; *(f32x4*)(hp + 4) = h1;
            u32x4 o; o.x = pk2(h0.x, h0.y); o.y = pk2(h0.z, h0.w); o.z = pk2(h1.x, h1.y); o.w = pk2(h1.z, h1.w); *(u32x4*)(g.HB + (size_t)r * D + n) = o; }
        else if (g.kind == K_DQ) { const float sc = rowscale(g, r);
#pragma unroll
            for (int j = 0; j < 8; ++j) v[j] *= sc;
            if (n >= 1024 && n < 1088) { const int i0 = (n - 1024) >> 1;
#pragma unroll
                for (int p = 0; p < 4; ++p) { const float c = g.COS[(size_t)r * 32 + i0 + p], s = g.SIN[(size_t)r * 32 + i0 + p], x1 = v[2 * p], x2 = v[2 * p + 1]; v[2 * p] = x1 * c - x2 * s; v[2 * p + 1] = x2 * c + x1 * s; } }
            u32x4 o; o.x = pk2(v[0], v[1]); o.y = pk2(v[2], v[3]); o.z = pk2(v[4], v[5]); o.w = pk2(v[6], v[7]);
            if (n < 512) *(u32x4*)(g.O1 + (size_t)r * 512 + n) = o;
            else if (n < 1024) { if (g.O2) *(u32x4*)(g.O2 + (size_t)r * 512 + (n - 512)) = o; }
            else if (n < 1088) { if (g.O3) *(u32x4*)(g.O3 + (size_t)r * 64 + (n - 1024)) = o; } }
        else if (g.kind == K_UQ) { const float sc = rowscale(g, r); const int hc = n % QKD;
#pragma unroll
            for (int j = 0; j < 8; ++j) v[j] *= sc;
            if (hc >= NOPE) { const int i0 = (hc - NOPE) >> 1;
#pragma unroll
                for (int p = 0; p < 4; ++p) { const float c = g.COS[(size_t)r * 32 + i0 + p], s = g.SIN[(size_t)r * 32 + i0 + p], x1 = v[2 * p], x2 = v[2 * p + 1]; v[2 * p] = x1 * c - x2 * s; v[2 * p + 1] = x2 * c + x1 * s; } }
            u32x4 o; o.x = pk2(v[0], v[1]); o.y = pk2(v[2], v[3]); o.z = pk2(v[4], v[5]); o.w = pk2(v[6], v[7]); *(u32x4*)(g.O1 + (size_t)r * NQ + n) = o; }
        else if (g.kind == K_UKV) { const float sc = rowscale(g, r); u32x4 o; o.x = pk2(v[0] * sc, v[1] * sc); o.y = pk2(v[2] * sc, v[3] * sc); o.z = pk2(v[4] * sc, v[5] * sc); o.w = pk2(v[6] * sc, v[7] * sc);
            if (n < 2048) *(u32x4*)(g.O1 + (size_t)r * D + n) = o; else *(u32x4*)(g.O2 + (size_t)r * D + (n - 2048)) = o; }
        else if (g.kind == K_MOE1) { const int ri = rie0 + ty * 8 + i;
            if (ri < ecnt) { const float sc = g.rs[g.list[(size_t)e * CAP + ri] >> 1]; float hv[8];
#pragma unroll
                for (int j = 0; j < 8; ++j) hv[j] = silu(v[j] * sc) * (acc2[DUAL ? i : 0][j] * sc);
                u32x4 o; o.x = pk2(hv[0], hv[1]); o.y = pk2(hv[2], hv[3]); o.z = pk2(hv[4], hv[5]); o.w = pk2(hv[6], hv[7]);
                *(u32x4*)(g.O1 + (size_t)r * EFF + blockIdx.x * 128 + tx * 8) = o; } }
        else if (g.kind == K_MOE2) { const int ri = rie0 + ty * 8 + i;
            if (ri < ecnt) { const int a = g.list[(size_t)e * CAP + ri]; const float sc = g.gw[a];
                u32x4 o; o.x = pk2(v[0] * sc, v[1] * sc); o.y = pk2(v[2] * sc, v[3] * sc); o.z = pk2(v[4] * sc, v[5] * sc); o.w = pk2(v[6] * sc, v[7] * sc);
                *(u32x4*)(g.O1 + (size_t)a * D + n) = o; } }
    }
}

struct AArgs { const bf16_t* Q; const bf16_t* K1; const bf16_t* K2; const bf16_t* V; bf16_t* O; int ldq, qhs, ldk1, k1hs, ldk2, ldv, vhs, ldo, ohs, nq, nk, pad; };
template <int DQK, bool CAUSAL>
__global__ __launch_bounds__(256) void k_attn(AArgs a) {
    extern __shared__ __attribute__((aligned(16))) float sm[];
    constexpr int LQ = DQK + 1;
    float* Qs = sm; float* Ks = Qs + 64 * LQ; float* Vs = Ks + 64 * LQ; float* Ps = Vs + 64 * 132;
    const int tid = threadIdx.x, tx = tid & 15, ty = tid >> 4, qc = blockIdx.x, h = blockIdx.y, b = blockIdx.z;
    const size_t qrow0 = (size_t)b * a.nq + (size_t)qc * 64, krow0 = (size_t)b * a.nk;
    for (int i = tid; i < 64 * DQK / 8; i += 256) { const int r = i / (DQK / 8), c = (i % (DQK / 8)) * 8;
        const u32x4 v = *(const u32x4*)(a.Q + (qrow0 + r) * a.ldq + h * a.qhs + c); const unsigned w[4] = {v.x, v.y, v.z, v.w};
#pragma unroll
        for (int q = 0; q < 4; ++q) { Qs[r * LQ + c + 2 * q] = __uint_as_float(w[q] << 16); Qs[r * LQ + c + 2 * q + 1] = __uint_as_float(w[q] & 0xffff0000u); } }
    float m[4], l[4], o[4][8];
#pragma unroll
    for (int i = 0; i < 4; ++i) { m[i] = -1e30f; l[i] = 0.f;
#pragma unroll
        for (int j = 0; j < 8; ++j) o[i][j] = 0.f; }
    const int ntile = CAUSAL ? qc + 1 : a.nk / 64;
    for (int kt = 0; kt < ntile; ++kt) {
        __syncthreads();
        for (int i = tid; i < 64 * DQK / 8; i += 256) { const int r = i / (DQK / 8), c = (i % (DQK / 8)) * 8; const size_t kr = krow0 + kt * 64 + r;
            const u32x4 v = (c < 128) ? *(const u32x4*)(a.K1 + kr * a.ldk1 + h * a.k1hs + c) : *(const u32x4*)(a.K2 + kr * a.ldk2 + (c - 128));
            const unsigned w[4] = {v.x, v.y, v.z, v.w};
#pragma unroll
            for (int q = 0; q < 4; ++q) { Ks[r * LQ + c + 2 * q] = __uint_as_float(w[q] << 16); Ks[r * LQ + c + 2 * q + 1] = __uint_as_float(w[q] & 0xffff0000u); } }
        for (int i = tid; i < 64 * 16; i += 256) { const int r = i >> 4, c = (i & 15) * 8; const size_t kr = krow0 + kt * 64 + r;
            const u32x4 v = *(const u32x4*)(a.V + kr * a.ldv + h * a.vhs + c); const unsigned w[4] = {v.x, v.y, v.z, v.w};
#pragma unroll
            for (int q = 0; q < 4; ++q) { Vs[r * 132 + c + 2 * q] = __uint_as_float(w[q] << 16); Vs[r * 132 + c + 2 * q + 1] = __uint_as_float(w[q] & 0xffff0000u); } }
        __syncthreads();
        float s[4][4];
#pragma unroll
        for (int i = 0; i < 4; ++i)
#pragma unroll
            for (int j = 0; j < 4; ++j) s[i][j] = 0.f;
        for (int d = 0; d < DQK; ++d) { float qv[4], kv[4];
#pragma unroll
            for (int i = 0; i < 4; ++i) { qv[i] = Qs[(ty * 4 + i) * LQ + d]; kv[i] = Ks[(tx * 4 + i) * LQ + d]; }
#pragma unroll
            for (int i = 0; i < 4; ++i)
#pragma unroll
                for (int j = 0; j < 4; ++j) s[i][j] += qv[i] * kv[j]; }
#pragma unroll
        for (int i = 0; i < 4; ++i) {
            float mx = fmaxf(fmaxf(s[i][0], s[i][1]), fmaxf(s[i][2], s[i][3]));
#pragma unroll
            for (int x = 1; x < 16; x <<= 1) mx = fmaxf(mx, __shfl_xor(mx, x));
            const float mn = fmaxf(m[i], mx), alpha = __expf(m[i] - mn); m[i] = mn; float ps = 0.f;
#pragma unroll
            for (int j = 0; j < 4; ++j) { const float p = __expf(s[i][j] - mn); ps += p; Ps[(ty * 4 + i) * 65 + tx * 4 + j] = p; }
#pragma unroll
            for (int x = 1; x < 16; x <<= 1) ps += __shfl_xor(ps, x);
            l[i] = l[i] * alpha + ps;
#pragma unroll
            for (int j = 0; j < 8; ++j) o[i][j] *= alpha;
        }
        __syncthreads();
        for (int c = 0; c < 64; ++c) { const f32x4 v0 = *(const f32x4*)&Vs[c * 132 + tx * 8], v1 = *(const f32x4*)&Vs[c * 132 + tx * 8 + 4];
            const float vv[8] = {v0.x, v0.y, v0.z, v0.w, v1.x, v1.y, v1.z, v1.w};
#pragma unroll
            for (int i = 0; i < 4; ++i) { const float p = Ps[(ty * 4 + i) * 65 + c];
#pragma unroll
                for (int j = 0; j < 8; ++j) o[i][j] += p * vv[j]; } }
    }
#pragma unroll
    for (int i = 0; i < 4; ++i) { const float il = 1.0f / l[i]; u32x4 w; w.x = pk2(o[i][0] * il, o[i][1] * il); w.y = pk2(o[i][2] * il, o[i][3] * il); w.z = pk2(o[i][4] * il, o[i][5] * il); w.w = pk2(o[i][6] * il, o[i][7] * il);
        *(u32x4*)(a.O + (qrow0 + ty * 4 + i) * a.ldo + h * a.ohs + tx * 8) = w; }
}

__global__ __launch_bounds__(256) void k_router(const float* H, const float* RWT, const float* rg_b, const float* re_b, float* RS2, int* cnt, int* list, float* gw) {
    const int t = blockIdx.x * 4 + (threadIdx.x >> 6), lane = threadIdx.x & 63;
    const f32x4* x = (const f32x4*)(H + (size_t)t * D) + lane; f32x4 v[8]; float ss = 0.f;
#pragma unroll
    for (int j = 0; j < 8; ++j) { v[j] = x[64 * j]; ss += (v[j].x * v[j].x + v[j].y * v[j].y) + (v[j].z * v[j].z + v[j].w * v[j].w); }
    ss = wave_sum(ss); const float rs = rsqrtf(ss * (1.0f / D) + EPS);
    float mine = 0.f;
    for (int n = 0; n < 36; ++n) { const f32x4* w = (const f32x4*)(RWT + (size_t)n * D) + lane; float p = 0.f;
#pragma unroll
        for (int j = 0; j < 8; ++j) { const f32x4 ww = w[64 * j]; p += (v[j].x * ww.x + v[j].y * ww.y) + (v[j].z * ww.z + v[j].w * ww.w); }
        p = wave_sum(p); const float bias = n < 4 ? rg_b[n] : re_b[n - 4]; if (lane == n) mine = p * rs + bias; }
    const float g0 = __shfl(mine, 0), g1 = __shfl(mine, 1), g2 = __shfl(mine, 2), g3 = __shfl(mine, 3);
    int gs = 0; float gm = g0; if (g1 > gm) { gm = g1; gs = 1; } if (g2 > gm) { gm = g2; gs = 2; } if (g3 > gm) { gm = g3; gs = 3; }
    const float gp = 1.0f / (__expf(g0 - gm) + __expf(g1 - gm) + __expf(g2 - gm) + __expf(g3 - gm));
    float ev[8];
#pragma unroll
    for (int i = 0; i < 8; ++i) ev[i] = __shfl(mine, 4 + gs * 8 + i);
    int i0 = 0; float m0 = ev[0];
#pragma unroll
    for (int i = 1; i < 8; ++i) if (ev[i] > m0) { m0 = ev[i]; i0 = i; }
    int i1 = -1; float m1 = -3.0e38f;
#pragma unroll
    for (int i = 0; i < 8; ++i) if (i != i0 && ev[i] > m1) { m1 = ev[i]; i1 = i; }
    const float e1 = __expf(m1 - m0), w0 = gp / (1.0f + e1), w1 = gp * e1 / (1.0f + e1);
    if (lane == 0) { RS2[t] = rs;
        const int ea = gs * 8 + i0, eb = gs * 8 + i1;
        const int pa = atomicAdd(&cnt[ea], 1); list[(size_t)ea * CAP + pa] = 2 * t; gw[2 * t] = w0;
        const int pb = atomicAdd(&cnt[eb], 1); list[(size_t)eb * CAP + pb] = 2 * t + 1; gw[2 * t + 1] = w1; }
}

static void wt(hipStream_t st, const float* W, bf16_t* WT, const float* kg, const float* ng, int K, int N, int perm, int row_off, float scale, int nb = 1, long ws = 0, long ts = 0) {
    WtJob j; memset(&j, 0, sizeof(j)); j.W = W; j.WT = WT; j.kgain = kg; j.ngain = ng; j.wstride = ws; j.tstride = ts; j.K = K; j.N = N; j.perm = perm; j.row_off = row_off; j.scale = scale;
    const int items = (N / 32) * (K / 64);
    hipLaunchKernelGGL(k_wt, dim3((items + 3) / 4, nb), dim3(256), 0, st, j);
}
extern "C" void kernel_launch(void* const* d_in, const int* in_sizes, int n_in, void* d_out, int out_size, void* d_ws, size_t ws_size, hipStream_t stream) {
    static int ok = 0;
    constexpr int SM_MLA = (64 * 193 * 2 + 64 * 132 + 64 * 65) * 4, SM_MEM = (64 * 129 * 2 + 64 * 132 + 64 * 65) * 4;
    if (ok == 0) {
        if (n_in != 32 || in_sizes[0] != T * D || out_size != T * D || ws_size < WS_END) { fprintf(stderr, "kernel_launch: shape/ws mismatch (ws %zu need %zu)\n", ws_size, (size_t)WS_END); ok = -1; return; }
        if (hipFuncSetAttribute((const void*)k_attn<192, true>, hipFuncAttributeMaxDynamicSharedMemorySize, SM_MLA) != hipSuccess ||
            hipFuncSetAttribute((const void*)k_attn<128, false>, hipFuncAttributeMaxDynamicSharedMemorySize, SM_MEM) != hipSuccess) { fprintf(stderr, "kernel_launch: hipFuncSetAttribute failed\n"); ok = -1; return; }
        ok = 1;
    }
    if (ok < 0) return;
    hipStream_t st = stream;
    char* ws = (char*)d_ws;
#define IN(i) ((const float*)d_in[i])
    const float *x = IN(0), *mem = IN(1); const int* pos = (const int*)d_in[2];
    const float *norm_mix = IN(3), *norm_mem = IN(4), *norm_memtok = IN(5), *norm_ffn = IN(6), *pool_w = IN(7), *pool_scale = IN(8), *kv_in_norm = IN(9), *w_dkv = IN(10), *kv_latent_norm = IN(11),
                *w_kr = IN(12), *w_uk = IN(13), *w_uv = IN(14), *w_dq = IN(15), *q_latent_norm = IN(16), *w_uq = IN(17), *w_qr = IN(18), *w_o = IN(19), *mem_wq = IN(20), *mem_wk = IN(21), *mem_wv = IN(22),
                *mem_wo = IN(23), *rg_w = IN(24), *rg_b = IN(25), *re_w = IN(26), *re_b = IN(27), *w_gate = IN(28), *w_up = IN(29), *w_down = IN(30), *final_norm = IN(31);
    bf16_t *WPOOL = (bf16_t*)(ws + WS_WPOOL), *WMQ = (bf16_t*)(ws + WS_WMQ), *WMK = (bf16_t*)(ws + WS_WMK), *WMV = (bf16_t*)(ws + WS_WMV), *WMO = (bf16_t*)(ws + WS_WMO), *WDQ0 = (bf16_t*)(ws + WS_WDQ0),
           *WDQ1 = (bf16_t*)(ws + WS_WDQ1), *WUQ = (bf16_t*)(ws + WS_WUQ), *WUKV = (bf16_t*)(ws + WS_WUKV), *WO = (bf16_t*)(ws + WS_WO), *WGU = (bf16_t*)(ws + WS_WGU), *WD = (bf16_t*)(ws + WS_WD);
    float* RWT = (float*)(ws + WS_RWT);
    float *H = (float*)(ws + WS_H), *SSP = (float*)(ws + WS_SSP), *LSQ = (float*)(ws + WS_LSQ), *LSKV = (float*)(ws + WS_LSKV), *RS0 = (float*)(ws + WS_RS0), *RS2 = (float*)(ws + WS_RS2), *MEMRS = (float*)(ws + WS_MEMRS),
          *COS = (float*)(ws + WS_COS), *SIN = (float*)(ws + WS_SIN), *GW = (float*)(ws + WS_GW);
    bf16_t *HB = (bf16_t*)(ws + WS_HB), *Y = (bf16_t*)(ws + WS_Y), *HH = (bf16_t*)(ws + WS_HH), *KN = (bf16_t*)(ws + WS_KN), *V = (bf16_t*)(ws + WS_V), *Q = (bf16_t*)(ws + WS_Q), *HN = (bf16_t*)(ws + WS_HN), *U = (bf16_t*)(ws + WS_U),
           *AO = (bf16_t*)(ws + WS_AO), *MQ = (bf16_t*)(ws + WS_MQ), *MO = (bf16_t*)(ws + WS_MO), *CQ = (bf16_t*)(ws + WS_CQ), *CKV = (bf16_t*)(ws + WS_CKV), *KR = (bf16_t*)(ws + WS_KR), *MEMB = (bf16_t*)(ws + WS_MEMB),
           *MK = (bf16_t*)(ws + WS_MK), *MV = (bf16_t*)(ws + WS_MV);
    int* CNT = (int*)(ws + WS_CTL + OFF_CNT); int* LIST = (int*)(ws + WS_LIST);
    hipMemsetAsync(ws + WS_CTL, 0, CTL_BYTES, st);

    const float SC_MEM = 0.08838834764831845f  , SC_MLA = 0.07216878364870323f  ;
    for (int l = 0; l < NA; ++l) for (int g = 0; g < 4; ++g)
        wt(st, pool_w + ((size_t)l * 4 + g) * PG * PG, WPOOL + (size_t)l * D * PG, nullptr, pool_scale + l * D + g * PG, PG, PG, 0, g * PG, 1.f);
    for (int l = 0; l < DEPTH; ++l) {
        wt(st, mem_wq + (size_t)l * D * MI, WMQ + (size_t)l * MI * D, norm_mem + l * D, nullptr, D, MI, 0, 0, SC_MEM);
        wt(st, mem_wk + (size_t)l * D * MI, WMK + (size_t)l * MI * D, norm_memtok + l * D, nullptr, D, MI, 0, 0, 1.f);
        wt(st, mem_wv + (size_t)l * D * MI, WMV + (size_t)l * MI * D, norm_memtok + l * D, nullptr, D, MI, 0, 0, 1.f);
        wt(st, mem_wo + (size_t)l * MI * D, WMO + (size_t)l * D * MI, nullptr, nullptr, MI, D, 0, 0, 1.f);
        wt(st, w_gate + (size_t)l * NE * D * EFF, WGU + (size_t)l * NE * 1024 * D, norm_ffn + l * D, nullptr, D, EFF, 3, 0, 1.f, NE, (long)D * EFF, (long)1024 * D);
        wt(st, w_up + (size_t)l * NE * D * EFF, WGU + (size_t)l * NE * 1024 * D, norm_ffn + l * D, nullptr, D, EFF, 4, 0, 1.f, NE, (long)D * EFF, (long)1024 * D);
        wt(st, w_down + (size_t)l * NE * EFF * D, WD + (size_t)l * NE * D * EFF, nullptr, nullptr, EFF, D, 0, 0, 1.f, NE, (long)EFF * D, (long)D * EFF);
    }
    hipLaunchKernelGGL(k_zero, dim3(256), dim3(256), 0, st, (unsigned*)(WDQ0 + (size_t)1088 * D), (long)(NDQ0 - 1088) * D / 2);
    wt(st, w_dq, WDQ0, norm_mix + 2 * D, nullptr, D, QR, 0, 0, 1.f);
    wt(st, w_dkv, WDQ0, kv_in_norm, nullptr, D, KVR, 0, 512, 1.f);
    wt(st, w_kr, WDQ0, kv_in_norm, nullptr, D, ROPE, 5, 1024, 1.f);
    wt(st, w_dq + (size_t)D * QR, WDQ1, norm_mix + 3 * D, nullptr, D, QR, 0, 0, 1.f);
    for (int j = 0; j < 2; ++j) {
        wt(st, w_uq + (size_t)j * QR * D, WUQ + (size_t)j * NQ * QR, q_latent_norm + j * QR, nullptr, QR, HEADS * NOPE, 1, 0, SC_MLA);
        wt(st, w_qr + (size_t)j * QR * HEADS * ROPE, WUQ + (size_t)j * NQ * QR, q_latent_norm + j * QR, nullptr, QR, HEADS * ROPE, 2, 0, SC_MLA);
        wt(st, w_o + (size_t)j * D * D, WO + (size_t)j * D * D, nullptr, nullptr, D, D, 0, 0, 1.f);
    }
    wt(st, w_uk, WUKV, kv_latent_norm, nullptr, KVR, D, 0, 0, 1.f);
    wt(st, w_uv, WUKV, kv_latent_norm, nullptr, KVR, D, 0, 2048, 1.f);
    hipLaunchKernelGGL(k_rwt, dim3((DEPTH * 36 * D + 255) / 256), dim3(256), 0, st, rg_w, re_w, norm_ffn, RWT);
    hipLaunchKernelGGL(k_rope, dim3(T * 32 / 256), dim3(256), 0, st, pos, COS, SIN);
    hipLaunchKernelGGL(k_memprep, dim3(NB * MEMT / 4), dim3(256), 0, st, mem, MEMB, MEMRS);
    for (int l = 0; l < DEPTH; ++l) for (int kv = 0; kv < 2; ++kv) {
        GArgs g; memset(&g, 0, sizeof(g)); g.A = MEMB; g.lda = D; g.K = D; g.Bt = (kv ? WMV : WMK) + (size_t)l * MI * D; g.kind = K_BF16RS; g.O1 = (kv ? MV : MK) + (size_t)l * NB * MEMT * MI; g.ldo = MI; g.rs = MEMRS;
        hipLaunchKernelGGL(k_gemm<false>, dim3(MI / 128, NB * MEMT / 128), dim3(256), 0, st, g);
    }
    for (int l = 0; l < DEPTH; ++l) {
        const bool isA = l < NA;
        hipLaunchKernelGGL(k_combine, dim3(T / 4), dim3(256), 0, st, l == 0 ? x : (const float*)H, l == 0 ? (const bf16_t*)nullptr : (const bf16_t*)Y, H, HB, RS0, isA ? norm_mix + l * D : (const float*)nullptr, isA ? HN : (bf16_t*)nullptr, (float*)nullptr);
        if (isA) {
            hipLaunchKernelGGL(k_pool, dim3(T), dim3(256), 0, st, (const bf16_t*)HN, U);
            GArgs g; memset(&g, 0, sizeof(g)); g.A = U; g.lda = D; g.K = PG; g.Bt = WPOOL + (size_t)l * D * PG; g.kind = K_RES; g.pool = 1; g.H = H; g.HB = HB;
            hipLaunchKernelGGL(k_gemm<false>, dim3(D / 128, T / 128), dim3(256), 0, st, g);
        } else {
            const int j = l - NA;
            { GArgs g; memset(&g, 0, sizeof(g)); g.A = HB; g.lda = D; g.K = D; g.Bt = j == 0 ? WDQ0 : WDQ1; g.kind = K_DQ; g.O1 = CQ; g.O2 = j == 0 ? CKV : nullptr; g.O3 = j == 0 ? KR : nullptr; g.rs = RS0; g.COS = COS; g.SIN = SIN;
              hipLaunchKernelGGL(k_gemm<false>, dim3((j == 0 ? NDQ0 : QR) / 128, T / 128), dim3(256), 0, st, g); }
            hipLaunchKernelGGL(k_rowstats_bf16, dim3(T / 4), dim3(256), 0, st, (const bf16_t*)CQ, QR, LSQ, 8);
            { GArgs g; memset(&g, 0, sizeof(g)); g.A = CQ; g.lda = QR; g.K = QR; g.Bt = WUQ + (size_t)j * NQ * QR; g.kind = K_UQ; g.O1 = Q; g.part = LSQ; g.np = 8; g.pdiv = (float)QR; g.COS = COS; g.SIN = SIN;
              hipLaunchKernelGGL(k_gemm<false>, dim3(NQ / 128, T / 128), dim3(256), 0, st, g); }
            if (j == 0) {
                hipLaunchKernelGGL(k_rowstats_bf16, dim3(T / 4), dim3(256), 0, st, (const bf16_t*)CKV, KVR, LSKV, 8);
                GArgs g; memset(&g, 0, sizeof(g)); g.A = CKV; g.lda = KVR; g.K = KVR; g.Bt = WUKV; g.kind = K_UKV; g.O1 = KN; g.O2 = V; g.part = LSKV; g.np = 8; g.pdiv = (float)KVR;
                hipLaunchKernelGGL(k_gemm<false>, dim3(4096 / 128, T / 128), dim3(256), 0, st, g);
            }
            { AArgs a; memset(&a, 0, sizeof(a)); a.Q = Q; a.ldq = NQ; a.qhs = QKD; a.K1 = KN; a.ldk1 = D; a.k1hs = NOPE; a.K2 = KR; a.ldk2 = ROPE; a.V = V; a.ldv = D; a.vhs = VD; a.O = AO; a.ldo = D; a.ohs = VD; a.nq = S; a.nk = S;
              hipLaunchKernelGGL((k_attn<192, true>), dim3(S / 64, HEADS, NB), dim3(256), SM_MLA, st, a); }
            { GArgs g; memset(&g, 0, sizeof(g)); g.A = AO; g.lda = D; g.K = D; g.Bt = WO + (size_t)j * D * D; g.kind = K_RES; g.H = H; g.HB = HB;
              hipLaunchKernelGGL(k_gemm<false>, dim3(D / 128, T / 128), dim3(256), 0, st, g); }
        }
        hipLaunchKernelGGL(k_rowstats_f32, dim3(T / 4), dim3(256), 0, st, (const float*)H, D, SSP, 32);
        { GArgs g; memset(&g, 0, sizeof(g)); g.A = HB; g.lda = D; g.K = D; g.Bt = WMQ + (size_t)l * MI * D; g.kind = K_BF16RS; g.O1 = MQ; g.ldo = MI; g.part = SSP; g.np = 32; g.pdiv = (float)D;
          hipLaunchKernelGGL(k_gemm<false>, dim3(MI / 128, T / 128), dim3(256), 0, st, g); }
        { AArgs a; memset(&a, 0, sizeof(a)); a.Q = MQ; a.ldq = MI; a.qhs = MHD; a.K1 = MK + (size_t)l * NB * MEMT * MI; a.ldk1 = MI; a.k1hs = MHD; a.V = MV + (size_t)l * NB * MEMT * MI; a.ldv = MI; a.vhs = MHD; a.O = MO; a.ldo = MI; a.ohs = MHD; a.nq = S; a.nk = MEMT;
          hipLaunchKernelGGL((k_attn<128, false>), dim3(S / 64, MH, NB), dim3(256), SM_MEM, st, a); }
        { GArgs g; memset(&g, 0, sizeof(g)); g.A = MO; g.lda = MI; g.K = MI; g.Bt = WMO + (size_t)l * D * MI; g.kind = K_RES; g.H = H; g.HB = HB;
          hipLaunchKernelGGL(k_gemm<false>, dim3(D / 128, T / 128), dim3(256), 0, st, g); }
        hipLaunchKernelGGL(k_router, dim3(T / 4), dim3(256), 0, st, (const float*)H, (const float*)(RWT + (size_t)l * 36 * D), rg_b + l * NG, re_b + l * NE, RS2, CNT + l * NE, LIST, GW);
        { GArgs g; memset(&g, 0, sizeof(g)); g.A = HB; g.lda = D; g.K = D; g.Bt = WGU + (size_t)l * NE * 1024 * D; g.kind = K_MOE1; g.O1 = HH; g.rs = RS2; g.cnt = CNT + l * NE; g.list = LIST; g.estride = (long)1024 * D;
          hipLaunchKernelGGL(k_gemm<true>, dim3(EFF / 128, MAXROWS / 128), dim3(256), 0, st, g); }
        { GArgs g; memset(&g, 0, sizeof(g)); g.A = HH; g.lda = EFF; g.K = EFF; g.Bt = WD + (size_t)l * NE * D * EFF; g.kind = K_MOE2; g.O1 = Y; g.cnt = CNT + l * NE; g.list = LIST; g.gw = GW; g.estride = (long)D * EFF;
          hipLaunchKernelGGL(k_gemm<false>, dim3(D / 128, MAXROWS / 128), dim3(256), 0, st, g); }
    }
    hipLaunchKernelGGL(k_combine, dim3(T / 4), dim3(256), 0, st, (const float*)H, (const bf16_t*)Y, (float*)nullptr, (bf16_t*)nullptr, (float*)nullptr, final_norm, (bf16_t*)nullptr, (float*)d_out);
    const hipError_t le = hipPeekAtLastError();
    if (le != hipSuccess) fprintf(stderr, "kernel_launch: launch failed: %s\n", hipGetErrorName(le));
#undef IN
}
```

```cpp
#include <hip/hip_runtime.h>
#include <cstdio>
#include <cstdint>
#include <cstring>

typedef unsigned short bf16_t;
typedef float f32x4 __attribute__((ext_vector_type(4)));
typedef unsigned u32x4 __attribute__((ext_vector_type(4)));
typedef unsigned u32x2 __attribute__((ext_vector_type(2)));
#define DI __device__ __forceinline__

constexpr int D = 2048, NB = 4, S = 4096, T = NB * S, DEPTH = 4, NA = 2;
constexpr int CHUNK = 64;
constexpr int PG = 512;
constexpr int HEADS = 16, QR = 512, KVR = 512, NOPE = 128, ROPE = 64, VD = 128, QKD = NOPE + ROPE;
constexpr int MEMT = 256, MH = 4, MHD = 128, MI = 512;
constexpr int NG = 4, EPG = 8, NE = 32, EFF = 512;
constexpr float EPS = 1e-6f;
constexpr int CAP = T;
constexpr int MAXROWS = 2 * T + NE * 256;
constexpr int NQ = HEADS * QKD;
constexpr int NDQ0 = 1280;

constexpr size_t al(size_t x) { return (x + 255) & ~(size_t)255; }
constexpr size_t WS_CTL = 0, CTL_BYTES = 1u << 20;
constexpr size_t OFF_CNT = 65536;
constexpr size_t WS_WPOOL = WS_CTL + CTL_BYTES;
constexpr size_t WS_WMQ = WS_WPOOL + (size_t)NA * D * PG * 2;
constexpr size_t WS_WMK = WS_WMQ + (size_t)DEPTH * MI * D * 2;
constexpr size_t WS_WMV = WS_WMK + (size_t)DEPTH * MI * D * 2;
constexpr size_t WS_WMO = WS_WMV + (size_t)DEPTH * MI * D * 2;
constexpr size_t WS_WDQ0 = WS_WMO + (size_t)DEPTH * D * MI * 2;
constexpr size_t WS_WDQ1 = WS_WDQ0 + (size_t)NDQ0 * D * 2;
constexpr size_t WS_WUQ = WS_WDQ1 + (size_t)QR * D * 2;
constexpr size_t WS_WUKV = WS_WUQ + (size_t)2 * NQ * QR * 2;
constexpr size_t WS_WO = WS_WUKV + (size_t)4096 * KVR * 2;
constexpr size_t WS_RWT = WS_WO + (size_t)2 * D * D * 2;
constexpr size_t WS_WGU = al(WS_RWT + (size_t)DEPTH * 36 * D * 4);
constexpr size_t WS_WD = WS_WGU + (size_t)DEPTH * NE * 1024 * D * 2;
constexpr size_t WS_H = WS_WD + (size_t)DEPTH * NE * D * EFF * 2;
constexpr size_t WS_HB = WS_H + (size_t)T * D * 4;
constexpr size_t WS_Y = WS_HB + (size_t)T * D * 2;
constexpr size_t WS_HH = WS_Y + (size_t)2 * T * D * 2;
constexpr size_t WS_KN = WS_HH + (size_t)MAXROWS * EFF * 2;
constexpr size_t WS_V = WS_KN + (size_t)T * D * 2;
constexpr size_t WS_Q = WS_V + (size_t)T * D * 2;
constexpr size_t WS_HN = WS_Q;
constexpr size_t WS_U = WS_Q + (size_t)T * D * 2;
constexpr size_t WS_AO = WS_Q + (size_t)T * NQ * 2;
constexpr size_t WS_MQ = WS_AO + (size_t)T * D * 2;
constexpr size_t WS_MO = WS_MQ + (size_t)T * MI * 2;
constexpr size_t WS_CQ = WS_MO + (size_t)T * MI * 2;
constexpr size_t WS_CKV = WS_CQ + (size_t)T * QR * 2;
constexpr size_t WS_KR = WS_CKV + (size_t)T * KVR * 2;
constexpr size_t WS_MEMB = WS_KR + (size_t)T * ROPE * 2;
constexpr size_t WS_MK = WS_MEMB + (size_t)NB * MEMT * D * 2;
constexpr size_t WS_MV = WS_MK + (size_t)DEPTH * NB * MEMT * MI * 2;
constexpr size_t WS_SSP = WS_MV + (size_t)DEPTH * NB * MEMT * MI * 2;
constexpr size_t WS_LSQ = WS_SSP + (size_t)T * 32 * 4;
constexpr size_t WS_LSKV = WS_LSQ + (size_t)T * 8 * 4;
constexpr size_t WS_RS0 = WS_LSKV + (size_t)T * 8 * 4;
constexpr size_t WS_RS2 = WS_RS0 + (size_t)T * 4;
constexpr size_t WS_MEMRS = WS_RS2 + (size_t)T * 4;
constexpr size_t WS_COS = WS_MEMRS + 4096;
constexpr size_t WS_SIN = WS_COS + (size_t)T * 32 * 4;
constexpr size_t WS_GW = WS_SIN + (size_t)T * 32 * 4;
constexpr size_t WS_LIST = WS_GW + (size_t)2 * T * 4;
constexpr size_t WS_END = WS_LIST + (size_t)NE * CAP * 4;
static_assert(WS_U + (size_t)T * D * 2 <= WS_MQ, "U overlay inside Q|AO");

DI float bf2f(bf16_t b) { return __uint_as_float(((unsigned)b) << 16); }
DI unsigned f2bf(float f) { unsigned u = __float_as_uint(f); return (u + 0x7fffu + ((u >> 16) & 1u)) >> 16; }
DI unsigned pk2(float lo, float hi) { return f2bf(lo) | (f2bf(hi) << 16); }
DI float wave_sum(float v) {
#pragma unroll
    for (int o = 1; o < 64; o <<= 1) v += __shfl_xor(v, o);
    return v;
}
DI float silu(float x) { return x / (1.0f + __expf(-x)); }

DI int permrow(int perm, int n) {
    switch (perm) {
        case 1: return (n >> 7) * QKD + (n & 127);
        case 2: { const int h = n >> 6, r = n & 63; return h * QKD + NOPE + 2 * (r & 31) + (r >> 5); }
        case 3: return (n >> 7) * 256 + (n & 127);
        case 4: return (n >> 7) * 256 + 128 + (n & 127);
        case 5: return 2 * (n & 31) + (n >> 5);
        default: return n;
    }
}
struct WtJob { const float* W; bf16_t* WT; const float* kgain; const float* ngain; long wstride, tstride; int K, N, perm, row_off; float scale; int pad; };
__global__ __launch_bounds__(256) void k_wt(WtJob j) {
    __shared__ float scr_all[4][64 * 33];
    const int wave = threadIdx.x >> 6, lane = threadIdx.x & 63;
    float* scr = scr_all[wave];
    const int nblk = j.N / 32, kblk = j.K / 64, item = blockIdx.x * 4 + wave;
    if (item >= nblk * kblk) return;
    const float* W = j.W + (long)blockIdx.y * j.wstride; bf16_t* WT = j.WT + (long)blockIdx.y * j.tstride;
    const int kb = item / nblk, nb = item % nblk, k0 = 64 * kb, n0 = 32 * nb;
    const float ng = (j.ngain ? j.ngain[n0 + (lane & 31)] : 1.0f) * j.scale;
#pragma unroll 8
    for (int i = 0; i < 32; ++i) { const int kk = 2 * i + (lane >> 5);
        float v = W[(size_t)(k0 + kk) * j.N + n0 + (lane & 31)] * ng; if (j.kgain) v *= j.kgain[k0 + kk];
        scr[kk * 33 + (lane & 31)] = v; }
    asm volatile("s_waitcnt lgkmcnt(0)" ::: "memory");
    const int c = lane & 7;
#pragma unroll
    for (int q = 0; q < 4; ++q) { const int n = (lane >> 3) + 8 * q; const float* s = scr + (8 * c) * 33 + n;
        u32x4 o; o.x = pk2(s[0 * 33], s[1 * 33]); o.y = pk2(s[2 * 33], s[3 * 33]); o.z = pk2(s[4 * 33], s[5 * 33]); o.w = pk2(s[6 * 33], s[7 * 33]);
        *(u32x4*)(WT + (size_t)(j.row_off + permrow(j.perm, n0 + n)) * j.K + k0 + 8 * c) = o; }
}
__global__ void k_rwt(const float* rg_w, const float* re_w, const float* gain, float* RWT) {
    const int idx = blockIdx.x * 256 + threadIdx.x; if (idx >= DEPTH * 36 * D) return;
    const int l = idx / (36 * D), n = (idx / D) % 36, k = idx % D;
    const float w = n < 4 ? rg_w[((size_t)l * D + k) * 4 + n] : re_w[((size_t)l * D + k) * 32 + (n - 4)];
    RWT[idx] = w * gain[l * D + k];
}
__global__ void k_zero(unsigned* p, long n) { for (long i = blockIdx.x * 256L + threadIdx.x; i < n; i += gridDim.x * 256L) p[i] = 0u; }
__global__ void k_rope(const int* pos, float* COS, float* SIN) {
    const int idx = blockIdx.x * 256 + threadIdx.x; if (idx >= T * 32) return;
    const int t = idx >> 5, i = idx & 31;
    const float inv = (float)(1.0 / pow(10000.0, (double)i / 32.0));
    const float ang = (float)pos[t] * inv;
    const double rev = (double)ang * 0.15915494309189533577; const float fr = (float)(rev - rint(rev));
    COS[idx] = __builtin_amdgcn_cosf(fr); SIN[idx] = __builtin_amdgcn_sinf(fr);
}
__global__ __launch_bounds__(256) void k_memprep(const float* mem, bf16_t* MEMB, float* MEMRS) {
    const int r = blockIdx.x * 4 + (threadIdx.x >> 6), lane = threadIdx.x & 63;
    const f32x4* x = (const f32x4*)(mem + (size_t)r * D) + lane; float ss = 0.f;
#pragma unroll
    for (int j = 0; j < 8; ++j) { const f32x4 v = x[64 * j]; ss += (v.x * v.x + v.y * v.y) + (v.z * v.z + v.w * v.w);
        u32x2 o; o.x = pk2(v.x, v.y); o.y = pk2(v.z, v.w); *((u32x2*)(MEMB + (size_t)r * D) + lane + 64 * j) = o; }
    ss = wave_sum(ss); if (lane == 0) MEMRS[r] = rsqrtf(ss * (1.0f / D) + EPS);
}
__global__ __launch_bounds__(256) void k_combine(const float* src, const bf16_t* Y, float* H, bf16_t* HB, float* RS0, const float* gain, bf16_t* HN, float* out) {
    const int t = blockIdx.x * 4 + (threadIdx.x >> 6), lane = threadIdx.x & 63;
    const f32x4* x = (const f32x4*)(src + (size_t)t * D) + lane; f32x4 v[8]; float ss = 0.f;
#pragma unroll
    for (int j = 0; j < 8; ++j) { v[j] = x[64 * j];
        if (Y) { const u32x2 a = *((const u32x2*)(Y + (size_t)(2 * t) * D) + lane + 64 * j), b = *((const u32x2*)(Y + (size_t)(2 * t + 1) * D) + lane + 64 * j);
            v[j].x = (v[j].x + __uint_as_float(a.x << 16)) + __uint_as_float(b.x << 16); v[j].y = (v[j].y + __uint_as_float(a.x & 0xffff0000u)) + __uint_as_float(b.x & 0xffff0000u);
            v[j].z = (v[j].z + __uint_as_float(a.y << 16)) + __uint_as_float(b.y << 16); v[j].w = (v[j].w + __uint_as_float(a.y & 0xffff0000u)) + __uint_as_float(b.y & 0xffff0000u); }
        ss += (v[j].x * v[j].x + v[j].y * v[j].y) + (v[j].z * v[j].z + v[j].w * v[j].w); }
    ss = wave_sum(ss); const float rs = rsqrtf(ss * (1.0f / D) + EPS);
    if (lane == 0 && RS0) RS0[t] = rs;
#pragma unroll
    for (int j = 0; j < 8; ++j) {
        if (H) *((f32x4*)(H + (size_t)t * D) + lane + 64 * j) = v[j];
        if (HB) { u32x2 o; o.x = pk2(v[j].x, v[j].y); o.y = pk2(v[j].z, v[j].w); *((u32x2*)(HB + (size_t)t * D) + lane + 64 * j) = o; }
        if (gain) { const f32x4 g = *((const f32x4*)gain + lane + 64 * j); const f32x4 n = v[j] * g * rs;
            if (HN) { u32x2 o; o.x = pk2(n.x, n.y); o.y = pk2(n.z, n.w); *((u32x2*)(HN + (size_t)t * D) + lane + 64 * j) = o; }
            if (out) *((f32x4*)(out + (size_t)t * D) + lane + 64 * j) = n; }
    }
}
__global__ __launch_bounds__(256) void k_pool(const bf16_t* HN, bf16_t* U) {
    const int t = blockIdx.x, c = threadIdx.x * 8, s = t & (S - 1), w = 2 << (c >> 9);
    const int n = (s + 1 < w) ? s + 1 : w;
    float acc[8] = {0.f, 0.f, 0.f, 0.f, 0.f, 0.f, 0.f, 0.f}, self[8];
    for (int i = 0; i < n; ++i) { const u32x4 v = *(const u32x4*)(HN + (size_t)(t - i) * D + c);
        const float f[8] = {__uint_as_float(v.x << 16), __uint_as_float(v.x & 0xffff0000u), __uint_as_float(v.y << 16), __uint_as_float(v.y & 0xffff0000u),
                            __uint_as_float(v.z << 16), __uint_as_float(v.z & 0xffff0000u), __uint_as_float(v.w << 16), __uint_as_float(v.w & 0xffff0000u)};
#pragma unroll
        for (int q = 0; q < 8; ++q) { acc[q] += f[q]; if (i == 0) self[q] = f[q]; } }
    const float inv = 1.0f / (float)n; u32x4 o;
    o.x = pk2(acc[0] * inv - self[0], acc[1] * inv - self[1]); o.y = pk2(acc[2] * inv - self[2], acc[3] * inv - self[3]);
    o.z = pk2(acc[4] * inv - self[4], acc[5] * inv - self[5]); o.w = pk2(acc[6] * inv - self[6], acc[7] * inv - self[7]);
    *(u32x4*)(U + (size_t)t * D + c) = o;
}
__global__ __launch_bounds__(256) void k_rowstats_f32(const float* X, int ncol, float* P, int np) {
    const int t = blockIdx.x * 4 + (threadIdx.x >> 6), lane = threadIdx.x & 63; float ss = 0.f;
    for (int c = lane * 4; c < ncol; c += 256) { const f32x4 v = *(const f32x4*)(X + (size_t)t * ncol + c); ss += (v.x * v.x + v.y * v.y) + (v.z * v.z + v.w * v.w); }
    ss = wave_sum(ss); if (lane < np) P[(size_t)t * np + lane] = lane == 0 ? ss : 0.f;
}
__global__ __launch_bounds__(256) void k_rowstats_bf16(const bf16_t* X, int ncol, float* P, int np) {
    const int t = blockIdx.x * 4 + (threadIdx.x >> 6), lane = threadIdx.x & 63; float ss = 0.f;
    for (int c = lane * 4; c < ncol; c += 256) { const u32x2 v = *(const u32x2*)(X + (size_t)t * ncol + c);
        const float a = __uint_as_float(v.x << 16), b = __uint_as_float(v.x & 0xffff0000u), cc = __uint_as_float(v.y << 16), d = __uint_as_float(v.y & 0xffff0000u); ss += (a * a + b * b) + (cc * cc + d * d); }
    ss = wave_sum(ss); if (lane < np) P[(size_t)t * np + lane] = lane == 0 ? ss : 0.f;
}

enum { K_BF16RS = 0, K_RES = 1, K_DQ = 2, K_UQ = 3, K_UKV = 4, K_MOE1 = 5, K_MOE2 = 6 };
struct GArgs {
    const bf16_t* A; const bf16_t* Bt; float* H; bf16_t* HB; bf16_t* O1; bf16_t* O2; bf16_t* O3;
    const float* rs; const float* part;
    const float* COS; const float* SIN;
    const int* cnt; const int* list; const float* gw; long estride;
    int lda, K, kind, pool, ldo, np; float pdiv; int pad;
};
DI float rowscale(const GArgs& g, int r) {
    if (g.rs) return g.rs[r];
    if (g.part) { float s = 0.f; for (int p = 0; p < g.np; ++p) s += g.part[(size_t)r * g.np + p]; return rsqrtf(s / g.pdiv + EPS); }
    return 1.0f;
}
template <bool DUAL>
__global__ __launch_bounds__(256) void k_gemm(GArgs g) {
    __shared__ __attribute__((aligned(16))) float As[16][132];
    __shared__ __attribute__((aligned(16))) float Bs[DUAL ? 2 : 1][16][132];
    const int tid = threadIdx.x, tx = tid & 15, ty = tid >> 4, lr = tid >> 1, lk = (tid & 1) * 8;
    const int n0 = blockIdx.x * 128, m0 = blockIdx.y * 128;
    int e = 0, rie0 = 0, ecnt = 0;
    if (g.cnt) { const int tile256 = blockIdx.y >> 1; int acc = 0; bool found = false;
        for (int i = 0; i < NE; ++i) { const int c = g.cnt[i], nt = (c + 255) >> 8; if (!found && tile256 < acc + nt) { found = true; e = i; ecnt = c; rie0 = (tile256 - acc) * 256 + (blockIdx.y & 1) * 128; } acc += nt; }
        if (!found) return; }
    const bf16_t* ap; const bf16_t* bp; const bf16_t* bp2 = nullptr;
    if (g.kind == K_MOE1) { const int ri = rie0 + lr; ap = ri < ecnt ? g.A + (size_t)(g.list[(size_t)e * CAP + ri] >> 1) * g.lda : nullptr;
        bp = g.Bt + (size_t)e * g.estride + (size_t)(blockIdx.x * 256 + lr) * g.K; bp2 = bp + (size_t)128 * g.K; }
    else if (g.kind == K_MOE2) { ap = g.A + (size_t)(m0 + lr) * g.lda; bp = g.Bt + (size_t)e * g.estride + (size_t)(n0 + lr) * g.K; }
    else { ap = g.A + (size_t)(m0 + lr) * g.lda + (g.pool ? (n0 / 512) * 512 : 0); bp = g.Bt + (size_t)(n0 + lr) * g.K; }
    float acc[8][8], acc2[DUAL ? 8 : 1][8];
#pragma unroll
    for (int i = 0; i < 8; ++i)
#pragma unroll
        for (int j = 0; j < 8; ++j) { acc[i][j] = 0.f; if (DUAL) acc2[i][j] = 0.f; }
    for (int k0 = 0; k0 < g.K; k0 += 16) {
        u32x4 av = {0u, 0u, 0u, 0u}, bv, bv2 = {0u, 0u, 0u, 0u};
        if (ap) av = *(const u32x4*)(ap + k0 + lk);
        bv = *(const u32x4*)(bp + k0 + lk);
        if (DUAL) bv2 = *(const u32x4*)(bp2 + k0 + lk);
        __syncthreads();
        const unsigned aw[4] = {av.x, av.y, av.z, av.w}, bw[4] = {bv.x, bv.y, bv.z, bv.w}, bw2[4] = {bv2.x, bv2.y, bv2.z, bv2.w};
#pragma unroll
        for (int q = 0; q < 4; ++q) {
            As[lk + 2 * q][lr] = __uint_as_float(aw[q] << 16); As[lk + 2 * q + 1][lr] = __uint_as_float(aw[q] & 0xffff0000u);
            Bs[0][lk + 2 * q][lr] = __uint_as_float(bw[q] << 16); Bs[0][lk + 2 * q + 1][lr] = __uint_as_float(bw[q] & 0xffff0000u);
            if (DUAL) { Bs[DUAL ? 1 : 0][lk + 2 * q][lr] = __uint_as_float(bw2[q] << 16); Bs[DUAL ? 1 : 0][lk + 2 * q + 1][lr] = __uint_as_float(bw2[q] & 0xffff0000u); }
        }
        __syncthreads();
#pragma unroll
        for (int kk = 0; kk < 16; ++kk) {
            const f32x4 a0 = *(const f32x4*)&As[kk][ty * 8], a1 = *(const f32x4*)&As[kk][ty * 8 + 4];
            const f32x4 b0 = *(const f32x4*)&Bs[0][kk][tx * 8], b1 = *(const f32x4*)&Bs[0][kk][tx * 8 + 4];
            const float a[8] = {a0.x, a0.y, a0.z, a0.w, a1.x, a1.y, a1.z, a1.w}, b[8] = {b0.x, b0.y, b0.z, b0.w, b1.x, b1.y, b1.z, b1.w};
#pragma unroll
            for (int i = 0; i < 8; ++i)
#pragma unroll
                for (int j = 0; j < 8; ++j) acc[i][j] += a[i] * b[j];
            if (DUAL) { const f32x4 c0 = *(const f32x4*)&Bs[DUAL ? 1 : 0][kk][tx * 8], c1 = *(const f32x4*)&Bs[DUAL ? 1 : 0][kk][tx * 8 + 4];
                const float c[8] = {c0.x, c0.y, c0.z, c0.w, c1.x, c1.y, c1.z, c1.w};
#pragma unroll
                for (int i = 0; i < 8; ++i)
#pragma unroll
                    for (int j = 0; j < 8; ++j) acc2[i][j] += a[i] * c[j]; }
        }
    }
#pragma unroll
    for (int i = 0; i < 8; ++i) {
        const int r = m0 + ty * 8 + i, n = n0 + tx * 8;
        float v[8];
#pragma unroll
        for (int j = 0; j < 8; ++j) v[j] = acc[i][j];
        if (g.kind == K_BF16RS) { const float sc = rowscale(g, r); u32x4 o; o.x = pk2(v[0] * sc, v[1] * sc); o.y = pk2(v[2] * sc, v[3] * sc); o.z = pk2(v[4] * sc, v[5] * sc); o.w = pk2(v[6] * sc, v[7] * sc);
            *(u32x4*)(g.O1 + (size_t)r * g.ldo + n) = o; }
        else if (g.kind == K_RES) { float* hp = g.H + (size_t)r * D + n; f32x4 h0 = *(f32x4*)hp, h1 = *(f32x4*)(hp + 4);
            h0.x += v[0]; h0.y += v[1]; h0.z += v[2]; h0.w += v[3]; h1.x += v[4]; h1.y += v[5]; h1.z += v[6]; h1.w += v[7];
            *(f32x4*)hp = h0; *(f32x4*)(hp + 4) = h1;
            u32x4 o; o.x = pk2(h0.x, h0.y); o.y = pk2(h0.z, h0.w); o.z = pk2(h1.x, h1.y); o.w = pk2(h1.z, h1.w); *(u32x4*)(g.HB + (size_t)r * D + n) = o; }
        else if (g.kind == K_DQ) { const float sc = rowscale(g, r);
#pragma unroll
            for (int j = 0; j < 8; ++j) v[j] *= sc;
            if (n >= 1024 && n < 1088) { const int i0 = (n - 1024) >> 1;
#pragma unroll
                for (int p = 0; p < 4; ++p) { const float c = g.COS[(size_t)r * 32 + i0 + p], s = g.SIN[(size_t)r * 32 + i0 + p], x1 = v[2 * p], x2 = v[2 * p + 1]; v[2 * p] = x1 * c - x2 * s; v[2 * p + 1] = x2 * c + x1 * s; } }
            u32x4 o; o.x = pk2(v[0], v[1]); o.y = pk2(v[2], v[3]); o.z = pk2(v[4], v[5]); o.w = pk2(v[6], v[7]);
            if (n < 512) *(u32x4*)(g.O1 + (size_t)r * 512 + n) = o;
            else if (n < 1024) { if (g.O2) *(u32x4*)(g.O2 + (size_t)r * 512 + (n - 512)) = o; }
            else if (n < 1088) { if (g.O3) *(u32x4*)(g.O3 + (size_t)r * 64 + (n - 1024)) = o; } }
        else if (g.kind == K_UQ) { const float sc = rowscale(g, r); const int hc = n % QKD;
#pragma unroll
            for (int j = 0; j < 8; ++j) v[j] *= sc;
            if (hc >= NOPE) { const int i0 = (hc - NOPE) >> 1;
#pragma unroll
                for (int p = 0; p < 4; ++p) { const float c = g.COS[(size_t)r * 32 + i0 + p], s = g.SIN[(size_t)r * 32 + i0 + p], x1 = v[2 * p], x2 = v[2 * p + 1]; v[2 * p] = x1 * c - x2 * s; v[2 * p + 1] = x2 * c + x1 * s; } }
            u32x4 o; o.x = pk2(v[0], v[1]); o.y = pk2(v[2], v[3]); o.z = pk2(v[4], v[5]); o.w = pk2(v[6], v[7]); *(u32x4*)(g.O1 + (size_t)r * NQ + n) = o; }
        else if (g.kind == K_UKV) { const float sc = rowscale(g, r); u32x4 o; o.x = pk2(v[0] * sc, v[1] * sc); o.y = pk2(v[2] * sc, v[3] * sc); o.z = pk2(v[4] * sc, v[5] * sc); o.w = pk2(v[6] * sc, v[7] * sc);
            if (n < 2048) *(u32x4*)(g.O1 + (size_t)r * D + n) = o; else *(u32x4*)(g.O2 + (size_t)r * D + (n - 2048)) = o; }
        else if (g.kind == K_MOE1) { const int ri = rie0 + ty * 8 + i;
            if (ri < ecnt) { const float sc = g.rs[g.list[(size_t)e * CAP + ri] >> 1]; float hv[8];
#pragma unroll
                for (int j = 0; j < 8; ++j) hv[j] = silu(v[j] * sc) * (acc2[DUAL ? i : 0][j] * sc);
                u32x4 o; o.x = pk2(hv[0], hv[1]); o.y = pk2(hv[2], hv[3]); o.z = pk2(hv[4], hv[5]); o.w = pk2(hv[6], hv[7]);
                *(u32x4*)(g.O1 + (size_t)r * EFF + blockIdx.x * 128 + tx * 8) = o; } }
        else if (g.kind == K_MOE2) { const int ri = rie0 + ty * 8 + i;
            if (ri < ecnt) { const int a = g.list[(size_t)e * CAP + ri]; const float sc = g.gw[a];
                u32x4 o; o.x = pk2(v[0] * sc, v[1] * sc); o.y = pk2(v[2] * sc, v[3] * sc); o.z = pk2(v[4] * sc, v[5] * sc); o.w = pk2(v[6] * sc, v[7] * sc);
                *(u32x4*)(g.O1 + (size_t)a * D + n) = o; } }
    }
}

struct AArgs { const bf16_t* Q; const bf16_t* K1; const bf16_t* K2; const bf16_t* V; bf16_t* O; int ldq, qhs, ldk1, k1hs, ldk2, ldv, vhs, ldo, ohs, nq, nk, pad; };
template <int DQK, bool CAUSAL>
__global__ __launch_bounds__(256) void k_attn(AArgs a) {
    extern __shared__ __attribute__((aligned(16))) float sm[];
    constexpr int LQ = DQK + 1;
    float* Qs = sm; float* Ks = Qs + 64 * LQ; float* Vs = Ks + 64 * LQ; float* Ps = Vs + 64 * 132;
    const int tid = threadIdx.x, tx = tid & 15, ty = tid >> 4, qc = blockIdx.x, h = blockIdx.y, b = blockIdx.z;
    const size_t qrow0 = (size_t)b * a.nq + (size_t)qc * 64, krow0 = (size_t)b * a.nk;
    for (int i = tid; i < 64 * DQK / 8; i += 256) { const int r = i / (DQK / 8), c = (i % (DQK / 8)) * 8;
        const u32x4 v = *(const u32x4*)(a.Q + (qrow0 + r) * a.ldq + h * a.qhs + c); const unsigned w[4] = {v.x, v.y, v.z, v.w};
#pragma unroll
        for (int q = 0; q < 4; ++q) { Qs[r * LQ + c + 2 * q] = __uint_as_float(w[q] << 16); Qs[r * LQ + c + 2 * q + 1] = __uint_as_float(w[q] & 0xffff0000u); } }
    float m[4], l[4], o[4][8];
#pragma unroll
    for (int i = 0; i < 4; ++i) { m[i] = -1e30f; l[i] = 0.f;
#pragma unroll
        for (int j = 0; j < 8; ++j) o[i][j] = 0.f; }
    const int ntile = CAUSAL ? qc + 1 : a.nk / 64;
    for (int kt = 0; kt < ntile; ++kt) {
        __syncthreads();
        for (int i = tid; i < 64 * DQK / 8; i += 256) { const int r = i / (DQK / 8), c = (i % (DQK / 8)) * 8; const size_t kr = krow0 + kt * 64 + r;
            const u32x4 v = (c < 128) ? *(const u32x4*)(a.K1 + kr * a.ldk1 + h * a.k1hs + c) : *(const u32x4*)(a.K2 + kr * a.ldk2 + (c - 128));
            const unsigned w[4] = {v.x, v.y, v.z, v.w};
#pragma unroll
            for (int q = 0; q < 4; ++q) { Ks[r * LQ + c + 2 * q] = __uint_as_float(w[q] << 16); Ks[r * LQ + c + 2 * q + 1] = __uint_as_float(w[q] & 0xffff0000u); } }
        for (int i = tid; i < 64 * 16; i += 256) { const int r = i >> 4, c = (i & 15) * 8; const size_t kr = krow0 + kt * 64 + r;
            const u32x4 v = *(const u32x4*)(a.V + kr * a.ldv + h * a.vhs + c); const unsigned w[4] = {v.x, v.y, v.z, v.w};
#pragma unroll
            for (int q = 0; q < 4; ++q) { Vs[r * 132 + c + 2 * q] = __uint_as_float(w[q] << 16); Vs[r * 132 + c + 2 * q + 1] = __uint_as_float(w[q] & 0xffff0000u); } }
        __syncthreads();
        float s[4][4];
#pragma unroll
        for (int i = 0; i < 4; ++i)
#pragma unroll
            for (int j = 0; j < 4; ++j) s[i][j] = 0.f;
        for (int d = 0; d < DQK; ++d) { float qv[4], kv[4];
#pragma unroll
            for (int i = 0; i < 4; ++i) { qv[i] = Qs[(ty * 4 + i) * LQ + d]; kv[i] = Ks[(tx * 4 + i) * LQ + d]; }
#pragma unroll
            for (int i = 0; i < 4; ++i)
#pragma unroll
                for (int j = 0; j < 4; ++j) s[i][j] += qv[i] * kv[j]; }
#pragma unroll
        for (int i = 0; i < 4; ++i) {
            float mx = fmaxf(fmaxf(s[i][0], s[i][1]), fmaxf(s[i][2], s[i][3]));
#pragma unroll
            for (int x = 1; x < 16; x <<= 1) mx = fmaxf(mx, __shfl_xor(mx, x));
            const float mn = fmaxf(m[i], mx), alpha = __expf(m[i] - mn); m[i] = mn; float ps = 0.f;
#pragma unroll
            for (int j = 0; j < 4; ++j) { const float p = __expf(s[i][j] - mn); ps += p; Ps[(ty * 4 + i) * 65 + tx * 4 + j] = p; }
#pragma unroll
            for (int x = 1; x < 16; x <<= 1) ps += __shfl_xor(ps, x);
            l[i] = l[i] * alpha + ps;
#pragma unroll
            for (int j = 0; j < 8; ++j) o[i][j] *= alpha;
        }
        __syncthreads();
        for (int c = 0; c < 64; ++c) { const f32x4 v0 = *(const f32x4*)&Vs[c * 132 + tx * 8], v1 = *(const f32x4*)&Vs[c * 132 + tx * 8 + 4];
            const float vv[8] = {v0.x, v0.y, v0.z, v0.w, v1.x, v1.y, v1.z, v1.w};
#pragma unroll
            for (int i = 0; i < 4; ++i) { const float p = Ps[(ty * 4 + i) * 65 + c];
#pragma unroll
                for (int j = 0; j < 8; ++j) o[i][j] += p * vv[j]; } }
    }
#pragma unroll
    for (int i = 0; i < 4; ++i) { const float il = 1.0f / l[i]; u32x4 w; w.x = pk2(o[i][0] * il, o[i][1] * il); w.y = pk2(o[i][2] * il, o[i][3] * il); w.z = pk2(o[i][4] * il, o[i][5] * il); w.w = pk2(o[i][6] * il, o[i][7] * il);
        *(u32x4*)(a.O + (qrow0 + ty * 4 + i) * a.ldo + h * a.ohs + tx * 8) = w; }
}

__global__ __launch_bounds__(256) void k_router(const float* H, const float* RWT, const float* rg_b, const float* re_b, float* RS2, int* cnt, int* list, float* gw) {
    const int t = blockIdx.x * 4 + (threadIdx.x >> 6), lane = threadIdx.x & 63;
    const f32x4* x = (const f32x4*)(H + (size_t)t * D) + lane; f32x4 v[8]; float ss = 0.f;
#pragma unroll
    for (int j = 0; j < 8; ++j) { v[j] = x[64 * j]; ss += (v[j].x * v[j].x + v[j].y * v[j].y) + (v[j].z * v[j].z + v[j].w * v[j].w); }
    ss = wave_sum(ss); const float rs = rsqrtf(ss * (1.0f / D) + EPS);
    float mine = 0.f;
    for (int n = 0; n < 36; ++n) { const f32x4* w = (const f32x4*)(RWT + (size_t)n * D) + lane; float p = 0.f;
#pragma unroll
        for (int j = 0; j < 8; ++j) { const f32x4 ww = w[64 * j]; p += (v[j].x * ww.x + v[j].y * ww.y) + (v[j].z * ww.z + v[j].w * ww.w); }
        p = wave_sum(p); const float bias = n < 4 ? rg_b[n] : re_b[n - 4]; if (lane == n) mine = p * rs + bias; }
    const float g0 = __shfl(mine, 0), g1 = __shfl(mine, 1), g2 = __shfl(mine, 2), g3 = __shfl(mine, 3);
    int gs = 0; float gm = g0; if (g1 > gm) { gm = g1; gs = 1; } if (g2 > gm) { gm = g2; gs = 2; } if (g3 > gm) { gm = g3; gs = 3; }
    const float gp = 1.0f / (__expf(g0 - gm) + __expf(g1 - gm) + __expf(g2 - gm) + __expf(g3 - gm));
    float ev[8];
#pragma unroll
    for (int i = 0; i < 8; ++i) ev[i] = __shfl(mine, 4 + gs * 8 + i);
    int i0 = 0; float m0 = ev[0];
#pragma unroll
    for (int i = 1; i < 8; ++i) if (ev[i] > m0) { m0 = ev[i]; i0 = i; }
    int i1 = -1; float m1 = -3.0e38f;
#pragma unroll
    for (int i = 0; i < 8; ++i) if (i != i0 && ev[i] > m1) { m1 = ev[i]; i1 = i; }
    const float e1 = __expf(m1 - m0), w0 = gp / (1.0f + e1), w1 = gp * e1 / (1.0f + e1);
    if (lane == 0) { RS2[t] = rs;
        const int ea = gs * 8 + i0, eb = gs * 8 + i1;
        const int pa = atomicAdd(&cnt[ea], 1); list[(size_t)ea * CAP + pa] = 2 * t; gw[2 * t] = w0;
        const int pb = atomicAdd(&cnt[eb], 1); list[(size_t)eb * CAP + pb] = 2 * t + 1; gw[2 * t + 1] = w1; }
}


#define LAS __attribute__((address_space(3)))
typedef short bf16x8 __attribute__((ext_vector_type(8)));
namespace fg {
constexpr int BM = 256, BK = 64, HALF = 128, HTB = HALF * BK * 2, STAGE_BYTES = 8 * HTB, NXCD = 8, WGM = 8;
DI int lds_byte(int r, int c) { const int st = (r >> 4) * 2 + (c >> 5), rr = r & 15, cc = c & 31, ob = rr * 64 + cc * 2; return st * 1024 + (ob ^ (((ob >> 9) & 1) << 5)); }
DI void stage_rc(int b, int& R, int& C) { const int st = b / 1024, sb = b % 1024, swz = sb ^ (((sb >> 9) & 1) << 5); R = (st >> 1) * 16 + swz / 64; C = (st & 1) * 32 + (swz % 64) / 2; }
DI int perm32(int rho) { const int n = rho >> 4, i = rho & 15; return 8 * (i >> 2) + 4 * n + (i & 3); }
DI unsigned cvt_pk_bf16(float lo, float hi) { unsigned r; asm volatile("v_cvt_pk_bf16_f32 %0, %1, %2" : "=v"(r) : "v"(lo), "v"(hi)); return r; }
struct Unit { int pm, pn, e, r0, cnt; };

struct ProbDense {
    const char* A0; const char* B0; const char* A1; const char* B1; int nM, nN, nN0, K, lda, pool, G, c;
    static constexpr bool GATHER = false;
    DI bool next(int i, Unit& u) const {
        const long L = (long)i * G + c; const int nwg = nM * nN; if (L >= nwg) return false;
        int wgid = (int)L; { const int q = nwg / NXCD, r = nwg % NXCD, xcd = wgid % NXCD, off = wgid / NXCD; wgid = (xcd < r ? xcd * (q + 1) : r * (q + 1) + (xcd - r) * q) + off; }
        const int nig = WGM * nN, gid = wgid / nig, fm = gid * WGM, gsz = (nM - fm) < WGM ? (nM - fm) : WGM;
        u.pm = fm + ((wgid % nig) % gsz); u.pn = (wgid % nig) / gsz; u.e = 0; u.r0 = 0; u.cnt = 256; return true; }
    DI const char* aptr(const Unit& u) const { return (u.pn < nN0 ? A0 : A1) + (size_t)u.pm * 256 * lda * 2 + (pool ? (size_t)(u.pn >> 1) * 1024 : 0); }
    DI const char* bptr(const Unit& u) const { return u.pn < nN0 ? B0 + (size_t)u.pn * 256 * K * 2 : B1 + (size_t)(u.pn - nN0) * 256 * K * 2; }
    DI void avoff(const Unit&, const int (&R)[2], const int (&C)[2], unsigned (&vo)[2][2]) const {
#pragma unroll
        for (int h = 0; h < 2; ++h)
#pragma unroll
            for (int i = 0; i < 2; ++i) vo[h][i] = (unsigned)((h * 128 + R[i]) * lda + C[i]) * 2u; }
};
struct ProbMoe {
    const char* A; const char* Bt; const int* list; const LAS int* pref; int npn, K, lda, gather, G, c; long estride;
    static constexpr bool GATHER = true;
    DI bool next(int i, Unit& u) const {
        const int L = i * G + c, tile = L / npn; if (tile >= pref[32]) return false;
        int e = 0; while (pref[e + 1] <= tile) ++e;
        u.pm = tile; u.pn = L % npn; u.e = e; u.r0 = (tile - pref[e]) * 256; u.cnt = pref[64 + e]; return true; }
    DI const char* aptr(const Unit& u) const { return gather ? A : A + (size_t)u.pm * 256 * lda * 2; }
    DI const char* bptr(const Unit& u) const { return Bt + (size_t)u.e * estride + (size_t)u.pn * 256 * K * 2; }
    DI void avoff(const Unit& u, const int (&R)[2], const int (&C)[2], unsigned (&vo)[2][2]) const {
#pragma unroll
        for (int h = 0; h < 2; ++h)
#pragma unroll
            for (int i = 0; i < 2; ++i) { const int row = h * 128 + R[i];
                if (gather) { const int ri = u.r0 + row; const int tok = ri < u.cnt ? (list[(size_t)u.e * CAP + ri] >> 1) : 0; vo[h][i] = (unsigned)(tok * lda + C[i]) * 2u; }
                else vo[h][i] = (unsigned)(row * lda + C[i]) * 2u; } }
};

typedef f32x4 Acc[2][2][4][2];
DI float quad_sum(float s) { s += __shfl_xor(s, 16); s += __shfl_xor(s, 32); return s; }
DI float sq8(const f32x4& a, const f32x4& b) { return ((a.x * a.x + a.y * a.y) + (a.z * a.z + a.w * a.w)) + ((b.x * b.x + b.y * b.y) + (b.z * b.z + b.w * b.w)); }
DI u32x4 pack8(const f32x4& a, const f32x4& b) { u32x4 w; w.x = cvt_pk_bf16(a.x, a.y); w.y = cvt_pk_bf16(a.z, a.w); w.z = cvt_pk_bf16(b.x, b.y); w.w = cvt_pk_bf16(b.z, b.w); return w; }
template <int NP> DI float rs_from_parts(const float* part, int r, int fq, float inv_n) {
    float s;
    if (NP == 32) { const f32x4 a = *(const f32x4*)(part + (size_t)r * 32 + fq * 8), b = *(const f32x4*)(part + (size_t)r * 32 + fq * 8 + 4); s = ((a.x + a.y) + (a.z + a.w)) + ((b.x + b.y) + (b.z + b.w)); }
    else { const float* p = part + (size_t)r * 8 + fq * 2; s = p[0] + p[1]; }
    s = quad_sum(s); return rsqrtf(s * inv_n + EPS);
}
DI void rope8(f32x4& a, f32x4& b, const float* COS, const float* SIN, int r, int i0) {
    const f32x4 c = *(const f32x4*)(COS + (size_t)r * 32 + i0), s = *(const f32x4*)(SIN + (size_t)r * 32 + i0);
    const f32x4 a2 = {a.x * c.x - a.y * s.x, a.y * c.x + a.x * s.x, a.z * c.y - a.w * s.y, a.w * c.y + a.z * s.y};
    const f32x4 b2 = {b.x * c.z - b.y * s.z, b.y * c.z + b.x * s.z, b.z * c.w - b.w * s.w, b.w * c.w + b.z * s.w};
    a = a2; b = b2;
}
template <bool STATS> struct EpiRes {
    float* H; bf16_t* HB; float* SSP;
    DI void operator()(const Acc& acc, const Unit& u, int wr, int wc, int fr, int fq) const {
#pragma unroll
        for (int ai = 0; ai < 2; ++ai)
#pragma unroll
            for (int m = 0; m < 4; ++m) { const int r = u.pm * BM + ai * HALF + wr * 64 + m * 16 + fr; float ss = 0.f;
#pragma unroll
                for (int bj = 0; bj < 2; ++bj) { const int c0 = u.pn * BM + bj * HALF + wc * 32 + 8 * fq; float* hp = H + (size_t)r * D + c0;
                    const f32x4 h0 = *(const f32x4*)hp + acc[ai][bj][m][0], h1 = *(const f32x4*)(hp + 4) + acc[ai][bj][m][1];
                    *(f32x4*)hp = h0; *(f32x4*)(hp + 4) = h1; *(u32x4*)(HB + (size_t)r * D + c0) = pack8(h0, h1); if (STATS) ss += sq8(h0, h1); }
                if (STATS) { ss = quad_sum(ss); if (fq == 0) SSP[(size_t)r * 32 + u.pn * 4 + wc] = ss; }
                asm volatile("" ::: "memory"); }
    }
};
template <int MODE  > struct EpiBf16RS {
    bf16_t* O; int ldo; const float* rs;
    DI void operator()(const Acc& acc, const Unit& u, int wr, int wc, int fr, int fq) const {
#pragma unroll
        for (int ai = 0; ai < 2; ++ai)
#pragma unroll
            for (int m = 0; m < 4; ++m) { const int r = u.pm * BM + ai * HALF + wr * 64 + m * 16 + fr;
                const float sc = MODE == 1 ? rs[r] : rs_from_parts<32>(rs, r, fq, 1.0f / D);
#pragma unroll
                for (int bj = 0; bj < 2; ++bj) { const int c0 = u.pn * BM + bj * HALF + wc * 32 + 8 * fq;
                    *(u32x4*)(O + (size_t)r * ldo + c0) = pack8(acc[ai][bj][m][0] * sc, acc[ai][bj][m][1] * sc); } }
    }
};
struct EpiDQ {
    bf16_t* CQ; bf16_t* CKV; bf16_t* KR; const float* RS0; float* LSQ; float* LSKV; const float* COS; const float* SIN;
    DI void operator()(const Acc& acc, const Unit& u, int wr, int wc, int fr, int fq) const {
#pragma unroll
        for (int ai = 0; ai < 2; ++ai)
#pragma unroll
            for (int m = 0; m < 4; ++m) { const int r = u.pm * BM + ai * HALF + wr * 64 + m * 16 + fr; const float sc = RS0[r]; float ss = 0.f;
#pragma unroll
                for (int bj = 0; bj < 2; ++bj) { const int cl = bj * HALF + wc * 32 + 8 * fq; f32x4 v0 = acc[ai][bj][m][0] * sc, v1 = acc[ai][bj][m][1] * sc;
                    if (u.pn < 4) { ss += sq8(v0, v1); bf16_t* o = (u.pn < 2 ? CQ : CKV) + (size_t)r * 512 + (u.pn & 1) * 256 + cl; *(u32x4*)o = pack8(v0, v1); }
                    else if (cl < 64) { rope8(v0, v1, COS, SIN, r, cl >> 1); *(u32x4*)(KR + (size_t)r * 64 + cl) = pack8(v0, v1); } }
                if (u.pn < 4) { ss = quad_sum(ss); if (fq == 0) (u.pn < 2 ? LSQ : LSKV)[(size_t)r * 8 + (u.pn & 1) * 4 + wc] = ss; } }
    }
};
struct EpiUQ {
    bf16_t* Q; bf16_t* KN; bf16_t* V; const float* LSQ; const float* LSKV; const float* COS; const float* SIN;
    DI void operator()(const Acc& acc, const Unit& u, int wr, int wc, int fr, int fq) const {
        const bool isq = u.pn < 12;
#pragma unroll
        for (int ai = 0; ai < 2; ++ai)
#pragma unroll
            for (int m = 0; m < 4; ++m) { const int r = u.pm * BM + ai * HALF + wr * 64 + m * 16 + fr;
                const float sc = rs_from_parts<8>(isq ? LSQ : LSKV, r, fq, 1.0f / 512.0f);
#pragma unroll
                for (int bj = 0; bj < 2; ++bj) { f32x4 v0 = acc[ai][bj][m][0] * sc, v1 = acc[ai][bj][m][1] * sc;
                    if (isq) { const int c0 = u.pn * BM + bj * HALF + wc * 32 + 8 * fq, hc = c0 % QKD;
                        if (hc >= NOPE) rope8(v0, v1, COS, SIN, r, (hc - NOPE) >> 1);
                        *(u32x4*)(Q + (size_t)r * NQ + c0) = pack8(v0, v1); }
                    else { const int c0 = (u.pn - 12) * BM + bj * HALF + wc * 32 + 8 * fq;
                        *(u32x4*)((c0 < 2048 ? KN + c0 : V + (c0 - 2048)) + (size_t)r * D) = pack8(v0, v1); } } }
    }
};
struct EpiMoe1 {
    bf16_t* HH; const float* RS2; const int* list;
    DI void operator()(const Acc& acc, const Unit& u, int wr, int wc, int fr, int fq) const {
#pragma unroll
        for (int ai = 0; ai < 2; ++ai)
#pragma unroll
            for (int m = 0; m < 4; ++m) { const int lr = ai * HALF + wr * 64 + m * 16 + fr, ri = u.r0 + lr;
                if (ri < u.cnt) { const float sc = RS2[list[(size_t)u.e * CAP + ri] >> 1];
                    const f32x4 g0 = acc[ai][0][m][0] * sc, g1 = acc[ai][0][m][1] * sc, u0 = acc[ai][1][m][0] * sc, u1 = acc[ai][1][m][1] * sc;
                    const f32x4 h0 = {silu(g0.x) * u0.x, silu(g0.y) * u0.y, silu(g0.z) * u0.z, silu(g0.w) * u0.w}, h1 = {silu(g1.x) * u1.x, silu(g1.y) * u1.y, silu(g1.z) * u1.z, silu(g1.w) * u1.w};
                    *(u32x4*)(HH + (size_t)(u.pm * BM + lr) * EFF + u.pn * 128 + wc * 32 + 8 * fq) = pack8(h0, h1); } }
    }
};
struct EpiMoe2 {
    bf16_t* Y; const float* GW; const int* list;
    DI void operator()(const Acc& acc, const Unit& u, int wr, int wc, int fr, int fq) const {
#pragma unroll
        for (int ai = 0; ai < 2; ++ai)
#pragma unroll
            for (int m = 0; m < 4; ++m) { const int lr = ai * HALF + wr * 64 + m * 16 + fr, ri = u.r0 + lr;
                if (ri < u.cnt) { const int a = list[(size_t)u.e * CAP + ri]; const float sc = GW[a];
#pragma unroll
                    for (int bj = 0; bj < 2; ++bj) { const int c0 = u.pn * BM + bj * HALF + wc * 32 + 8 * fq;
                        *(u32x4*)(Y + (size_t)a * D + c0) = pack8(acc[ai][bj][m][0] * sc, acc[ai][bj][m][1] * sc); } } }
    }
};

template <class Epi, class Prob>
DI void gemm_phase(LAS unsigned char* lds, const Prob& P, const Epi& E) {
    const int tid = threadIdx.x, wid = __builtin_amdgcn_readfirstlane(tid >> 6), lane = tid & 63, wr = wid >> 2, wc = wid & 3, fr = lane & 15, fq = lane >> 4;
    const int K = P.K, nt = K / BK;
    int sR[2], sC[2]; unsigned voffB[2];
#pragma unroll
    for (int i = 0; i < 2; ++i) { stage_rc(tid * 16 + i * 8192, sR[i], sC[i]); const int Rb = (sR[i] & ~31) + perm32(sR[i] & 31); voffB[i] = (unsigned)(Rb * K + sC[i]) * 2u; }
    const size_t kstep = (size_t)(BK * 2), hstepB = (size_t)HALF * K * 2;
    const unsigned ldsw = (unsigned)wid * 1024u;
    const int aoff = lds_byte(wr * 64 + fr, fq * 8), boff = lds_byte(wc * 32 + fr, fq * 8);
#define PG8_SA(b, h) (((b) * 2 + (h)) * HTB)
#define PG8_SB(b, h) ((4 + (b) * 2 + (h)) * HTB)
#define PG8_STAGE(bufoff, gbase, voff) do { _Pragma("unroll") for (int _i = 0; _i < 2; ++_i) \
        __builtin_amdgcn_global_load_lds((const unsigned*)((const char*)(gbase) + (voff)[_i]), (LAS unsigned*)(lds + (bufoff) + ldsw + _i * 8192), 16, 0, 0); } while (0)
#define PG8_LDA(dst, b, h) do { _Pragma("unroll") for (int m = 0; m < 4; ++m) _Pragma("unroll") for (int k = 0; k < 2; ++k) dst[m][k] = *(const LAS bf16x8*)(lds + PG8_SA(b, h) + aoff + m * 2048 + k * 1024); } while (0)
#define PG8_LDB(dst, b, h) do { _Pragma("unroll") for (int n = 0; n < 2; ++n) _Pragma("unroll") for (int k = 0; k < 2; ++k) dst[n][k] = *(const LAS bf16x8*)(lds + PG8_SB(b, h) + boff + n * 2048 + k * 1024); } while (0)
#define PG8_MMA(ai, bj, At, Bt) do { __builtin_amdgcn_s_setprio(1); _Pragma("unroll") for (int m = 0; m < 4; ++m) _Pragma("unroll") for (int n = 0; n < 2; ++n) _Pragma("unroll") for (int k = 0; k < 2; ++k) \
        acc[ai][bj][m][n] = __builtin_amdgcn_mfma_f32_16x16x32_bf16(Bt[n][k], At[m][k], acc[ai][bj][m][n], 0, 0, 0); __builtin_amdgcn_s_setprio(0); } while (0)
#define PG8_WAIT_V(n) asm volatile("s_waitcnt vmcnt(" #n ")" ::: "memory")
#define PG8_WAIT_L(n) asm volatile("s_waitcnt lgkmcnt(" #n ")" ::: "memory")
#define PG8_BAR __builtin_amdgcn_s_barrier()
#define PG8_SCHED __builtin_amdgcn_sched_barrier(0)
    Unit cur, nxt; int ui = 0;
    if (!P.next(0, cur)) return;
    f32x4 acc[2][2][4][2];
#pragma unroll
    for (int a = 0; a < 2; ++a)
#pragma unroll
        for (int b = 0; b < 2; ++b)
#pragma unroll
            for (int m = 0; m < 4; ++m)
#pragma unroll
                for (int n = 0; n < 2; ++n) acc[a][b][m][n] = (f32x4){0.f, 0.f, 0.f, 0.f};
    bf16x8 At[4][2], B0[2][2], B1[2][2];
    const char* cA = P.aptr(cur); const char* cB = P.bptr(cur);
    unsigned voA[2][2], vnA[2][2];
    P.avoff(cur, sR, sC, voA);
    if constexpr (Prob::GATHER) asm volatile("s_waitcnt vmcnt(0)" ::: "memory");
    PG8_STAGE(PG8_SB(0, 0), cB, voffB); PG8_STAGE(PG8_SB(0, 1), cB + hstepB, voffB); PG8_STAGE(PG8_SA(0, 0), cA, voA[0]); PG8_STAGE(PG8_SA(0, 1), cA, voA[1]);
    if (wr == 1) PG8_BAR;
    PG8_WAIT_V(2); PG8_BAR;
    PG8_STAGE(PG8_SB(1, 0), cB + kstep, voffB); PG8_STAGE(PG8_SA(1, 0), cA + kstep, voA[0]); PG8_STAGE(PG8_SB(1, 1), cB + hstepB + kstep, voffB);
    PG8_WAIT_V(6); PG8_BAR;
    for (;;) {
        const bool has_next = P.next(ui + 1, nxt);
        const char* nA = has_next ? P.aptr(nxt) : cA; const char* nB = has_next ? P.bptr(nxt) : cB;
#pragma unroll
        for (int h = 0; h < 2; ++h)
#pragma unroll
            for (int i = 0; i < 2; ++i) vnA[h][i] = voA[h][i];
        for (int t = 0; t < nt; t += 2) {
            const bool last = (t == nt - 2);
            if constexpr (Prob::GATHER) { if (last && has_next) P.avoff(nxt, sR, sC, vnA); }
            const char* a1 = cA + (size_t)(t + 1) * kstep;
            const char* a2 = last ? nA : cA + (size_t)(t + 2) * kstep; const char* b2 = last ? nB : cB + (size_t)(t + 2) * kstep;
            const char* a3 = a2 + kstep; const char* b3 = b2 + kstep;
            unsigned w0[2], w1[2];
#pragma unroll
            for (int i = 0; i < 2; ++i) { w0[i] = last ? vnA[0][i] : voA[0][i]; w1[i] = last ? vnA[1][i] : voA[1][i]; }
            PG8_LDB(B0, 0, 0); PG8_LDB(B1, 0, 1); PG8_SCHED; PG8_LDA(At, 0, 0); PG8_STAGE(PG8_SA(1, 1), a1, voA[1]);
            PG8_WAIT_V(8); PG8_WAIT_L(0); PG8_BAR; PG8_MMA(0, 0, At, B0); PG8_MMA(0, 1, At, B1); PG8_BAR; PG8_SCHED;
            PG8_LDA(At, 0, 1); PG8_STAGE(PG8_SB(0, 0), b2, voffB); PG8_STAGE(PG8_SB(0, 1), b2 + hstepB, voffB); PG8_STAGE(PG8_SA(0, 0), a2, w0);
            PG8_WAIT_V(8); PG8_WAIT_L(0); PG8_BAR; PG8_MMA(1, 0, At, B0); PG8_MMA(1, 1, At, B1); PG8_BAR; PG8_SCHED;
            PG8_LDB(B0, 1, 0); PG8_LDB(B1, 1, 1); PG8_SCHED; PG8_LDA(At, 1, 0); PG8_STAGE(PG8_SA(0, 1), a2, w1);
            PG8_WAIT_V(8); PG8_WAIT_L(0); PG8_BAR; PG8_MMA(0, 0, At, B0); PG8_MMA(0, 1, At, B1); PG8_BAR; PG8_SCHED;
            PG8_LDA(At, 1, 1); PG8_STAGE(PG8_SB(1, 0), b3, voffB); PG8_STAGE(PG8_SB(1, 1), b3 + hstepB, voffB); PG8_STAGE(PG8_SA(1, 0), a3, w0);
            PG8_WAIT_V(8); PG8_WAIT_L(0); PG8_BAR; PG8_MMA(1, 0, At, B0); PG8_MMA(1, 1, At, B1); PG8_BAR; PG8_SCHED;
        }
        if (wr == 0) PG8_BAR;
        E(acc, cur, wr, wc, fr, fq);
        if (!has_next) break;
#pragma unroll
        for (int a = 0; a < 2; ++a)
#pragma unroll
            for (int b = 0; b < 2; ++b)
#pragma unroll
                for (int m = 0; m < 4; ++m)
#pragma unroll
                    for (int n = 0; n < 2; ++n) acc[a][b][m][n] = (f32x4){0.f, 0.f, 0.f, 0.f};
        cur = nxt; cA = nA; cB = nB; ++ui;
#pragma unroll
        for (int h = 0; h < 2; ++h)
#pragma unroll
            for (int i = 0; i < 2; ++i) voA[h][i] = vnA[h][i];
        if (wr == 1) PG8_BAR;
    }
    PG8_WAIT_V(0);
    PG8_BAR;
#undef PG8_SA
#undef PG8_SB
#undef PG8_STAGE
#undef PG8_LDA
#undef PG8_LDB
#undef PG8_MMA
#undef PG8_WAIT_V
#undef PG8_WAIT_L
#undef PG8_BAR
#undef PG8_SCHED
}
}

constexpr int LDS_BYTES = 147456, LDS_MISC = 131072;
struct FArgs { const void* p[16]; int i[8]; };
template <int KIND> __global__ __launch_bounds__(512, 2) void k_fgemm(FArgs a) {
    extern __shared__ __attribute__((aligned(16))) unsigned char lds_raw[];
    LAS unsigned char* lds = (LAS unsigned char*)lds_raw;
    const int G = gridDim.x, c = blockIdx.x;
    if constexpr (KIND == K_MOE1 || KIND == K_MOE2) {
        LAS int* pref = (LAS int*)(lds + LDS_MISC + 1024);
        const int* cnt = (const int*)a.p[3];
        if (threadIdx.x < 32) pref[64 + threadIdx.x] = cnt[threadIdx.x];
        __syncthreads();
        if (threadIdx.x == 0) { int s = 0; for (int e = 0; e < NE; ++e) { pref[e] = s; s += (pref[64 + e] + 255) >> 8; } pref[32] = s; }
        __syncthreads();
        fg::ProbMoe P{(const char*)a.p[0], (const char*)a.p[1], (const int*)a.p[2], pref, a.i[0], a.i[1], a.i[2], KIND == K_MOE1 ? 1 : 0, G, c, (long)a.i[3] * 2};
        if constexpr (KIND == K_MOE1) { fg::EpiMoe1 E{(bf16_t*)a.p[4], (const float*)a.p[5], (const int*)a.p[2]}; fg::gemm_phase(lds, P, E); }
        else { fg::EpiMoe2 E{(bf16_t*)a.p[4], (const float*)a.p[5], (const int*)a.p[2]}; fg::gemm_phase(lds, P, E); }
    } else {
        fg::ProbDense P{(const char*)a.p[0], (const char*)a.p[1], (const char*)a.p[2], (const char*)a.p[3], a.i[0], a.i[1], a.i[2], a.i[3], a.i[4], a.i[5], G, c};
        if constexpr (KIND == K_RES) { if (a.i[6]) { fg::EpiRes<true> E{(float*)a.p[4], (bf16_t*)a.p[5], (float*)a.p[6]}; fg::gemm_phase(lds, P, E); } else { fg::EpiRes<false> E{(float*)a.p[4], (bf16_t*)a.p[5], nullptr}; fg::gemm_phase(lds, P, E); } }
        if constexpr (KIND == K_BF16RS) { if (a.i[6] == 1) { fg::EpiBf16RS<1> E{(bf16_t*)a.p[4], a.i[7], (const float*)a.p[5]}; fg::gemm_phase(lds, P, E); } else { fg::EpiBf16RS<2> E{(bf16_t*)a.p[4], a.i[7], (const float*)a.p[5]}; fg::gemm_phase(lds, P, E); } }
        if constexpr (KIND == K_DQ) { fg::EpiDQ E{(bf16_t*)a.p[4], (bf16_t*)a.p[5], (bf16_t*)a.p[6], (const float*)a.p[7], (float*)a.p[8], (float*)a.p[9], (const float*)a.p[10], (const float*)a.p[11]}; fg::gemm_phase(lds, P, E); }
        if constexpr (KIND == K_UQ) { fg::EpiUQ E{(bf16_t*)a.p[4], (bf16_t*)a.p[5], (bf16_t*)a.p[6], (const float*)a.p[7], (const float*)a.p[8], (const float*)a.p[9], (const float*)a.p[10]}; fg::gemm_phase(lds, P, E); }
    }
}


#ifndef FASTMASK
#define FASTMASK 0x7f
#endif
constexpr unsigned FAST = FASTMASK;
static int g_grid = 256;
template <int KIND> static void fl(hipStream_t st, const FArgs& a) { hipLaunchKernelGGL(k_fgemm<KIND>, dim3(g_grid), dim3(512), LDS_BYTES, st, a); }
static FArgs fdense(const void* A0, const void* B0, const void* A1, const void* B1, int M, int N, int N0, int K, int lda, int pool) {
    FArgs a; memset(&a, 0, sizeof(a)); a.p[0] = A0; a.p[1] = B0; a.p[2] = A1 ? A1 : A0; a.p[3] = B1 ? B1 : B0; a.i[0] = M / 256; a.i[1] = N / 256; a.i[2] = N0 / 256; a.i[3] = K; a.i[4] = lda; a.i[5] = pool; return a; }
static void wt(hipStream_t st, const float* W, bf16_t* WT, const float* kg, const float* ng, int K, int N, int perm, int row_off, float scale, int nb = 1, long ws = 0, long ts = 0) {
    WtJob j; memset(&j, 0, sizeof(j)); j.W = W; j.WT = WT; j.kgain = kg; j.ngain = ng; j.wstride = ws; j.tstride = ts; j.K = K; j.N = N; j.perm = perm; j.row_off = row_off; j.scale = scale;
    const int items = (N / 32) * (K / 64);
    hipLaunchKernelGGL(k_wt, dim3((items + 3) / 4, nb), dim3(256), 0, st, j);
}
extern "C" void kernel_launch(void* const* d_in, const int* in_sizes, int n_in, void* d_out, int out_size, void* d_ws, size_t ws_size, hipStream_t stream) {
    static int ok = 0;
    constexpr int SM_MLA = (64 * 193 * 2 + 64 * 132 + 64 * 65) * 4, SM_MEM = (64 * 129 * 2 + 64 * 132 + 64 * 65) * 4;
    if (ok == 0) {
        if (n_in != 32 || in_sizes[0] != T * D || out_size != T * D || ws_size < WS_END) { fprintf(stderr, "kernel_launch: shape/ws mismatch (ws %zu need %zu)\n", ws_size, (size_t)WS_END); ok = -1; return; }
        if (hipFuncSetAttribute((const void*)k_attn<192, true>, hipFuncAttributeMaxDynamicSharedMemorySize, SM_MLA) != hipSuccess ||
            hipFuncSetAttribute((const void*)k_attn<128, false>, hipFuncAttributeMaxDynamicSharedMemorySize, SM_MEM) != hipSuccess) { fprintf(stderr, "kernel_launch: hipFuncSetAttribute failed\n"); ok = -1; return; }
        int dev = 0, cus = 0; hipGetDevice(&dev); hipDeviceGetAttribute(&cus, hipDeviceAttributeMultiprocessorCount, dev); if (cus > 0) g_grid = cus;
        bool e = false;
        e |= hipFuncSetAttribute((const void*)k_fgemm<K_BF16RS>, hipFuncAttributeMaxDynamicSharedMemorySize, LDS_BYTES) != hipSuccess;
        e |= hipFuncSetAttribute((const void*)k_fgemm<K_RES>, hipFuncAttributeMaxDynamicSharedMemorySize, LDS_BYTES) != hipSuccess;
        e |= hipFuncSetAttribute((const void*)k_fgemm<K_DQ>, hipFuncAttributeMaxDynamicSharedMemorySize, LDS_BYTES) != hipSuccess;
        e |= hipFuncSetAttribute((const void*)k_fgemm<K_UQ>, hipFuncAttributeMaxDynamicSharedMemorySize, LDS_BYTES) != hipSuccess;
        e |= hipFuncSetAttribute((const void*)k_fgemm<K_MOE1>, hipFuncAttributeMaxDynamicSharedMemorySize, LDS_BYTES) != hipSuccess;
        e |= hipFuncSetAttribute((const void*)k_fgemm<K_MOE2>, hipFuncAttributeMaxDynamicSharedMemorySize, LDS_BYTES) != hipSuccess;
        if (e) { fprintf(stderr, "kernel_launch: hipFuncSetAttribute (fgemm) failed\n"); ok = -1; return; }
        ok = 1;
    }
    if (ok < 0) return;
    hipStream_t st = stream;
    char* ws = (char*)d_ws;
#define IN(i) ((const float*)d_in[i])
    const float *x = IN(0), *mem = IN(1); const int* pos = (const int*)d_in[2];
    const float *norm_mix = IN(3), *norm_mem = IN(4), *norm_memtok = IN(5), *norm_ffn = IN(6), *pool_w = IN(7), *pool_scale = IN(8), *kv_in_norm = IN(9), *w_dkv = IN(10), *kv_latent_norm = IN(11),
                *w_kr = IN(12), *w_uk = IN(13), *w_uv = IN(14), *w_dq = IN(15), *q_latent_norm = IN(16), *w_uq = IN(17), *w_qr = IN(18), *w_o = IN(19), *mem_wq = IN(20), *mem_wk = IN(21), *mem_wv = IN(22),
                *mem_wo = IN(23), *rg_w = IN(24), *rg_b = IN(25), *re_w = IN(26), *re_b = IN(27), *w_gate = IN(28), *w_up = IN(29), *w_down = IN(30), *final_norm = IN(31);
    bf16_t *WPOOL = (bf16_t*)(ws + WS_WPOOL), *WMQ = (bf16_t*)(ws + WS_WMQ), *WMK = (bf16_t*)(ws + WS_WMK), *WMV = (bf16_t*)(ws + WS_WMV), *WMO = (bf16_t*)(ws + WS_WMO), *WDQ0 = (bf16_t*)(ws + WS_WDQ0),
           *WDQ1 = (bf16_t*)(ws + WS_WDQ1), *WUQ = (bf16_t*)(ws + WS_WUQ), *WUKV = (bf16_t*)(ws + WS_WUKV), *WO = (bf16_t*)(ws + WS_WO), *WGU = (bf16_t*)(ws + WS_WGU), *WD = (bf16_t*)(ws + WS_WD);
    float* RWT = (float*)(ws + WS_RWT);
    float *H = (float*)(ws + WS_H), *SSP = (float*)(ws + WS_SSP), *LSQ = (float*)(ws + WS_LSQ), *LSKV = (float*)(ws + WS_LSKV), *RS0 = (float*)(ws + WS_RS0), *RS2 = (float*)(ws + WS_RS2), *MEMRS = (float*)(ws + WS_MEMRS),
          *COS = (float*)(ws + WS_COS), *SIN = (float*)(ws + WS_SIN), *GW = (float*)(ws + WS_GW);
    bf16_t *HB = (bf16_t*)(ws + WS_HB), *Y = (bf16_t*)(ws + WS_Y), *HH = (bf16_t*)(ws + WS_HH), *KN = (bf16_t*)(ws + WS_KN), *V = (bf16_t*)(ws + WS_V), *Q = (bf16_t*)(ws + WS_Q), *HN = (bf16_t*)(ws + WS_HN), *U = (bf16_t*)(ws + WS_U),
           *AO = (bf16_t*)(ws + WS_AO), *MQ = (bf16_t*)(ws + WS_MQ), *MO = (bf16_t*)(ws + WS_MO), *CQ = (bf16_t*)(ws + WS_CQ), *CKV = (bf16_t*)(ws + WS_CKV), *KR = (bf16_t*)(ws + WS_KR), *MEMB = (bf16_t*)(ws + WS_MEMB),
           *MK = (bf16_t*)(ws + WS_MK), *MV = (bf16_t*)(ws + WS_MV);
    int* CNT = (int*)(ws + WS_CTL + OFF_CNT); int* LIST = (int*)(ws + WS_LIST);
    hipMemsetAsync(ws + WS_CTL, 0, CTL_BYTES, st);

    const float SC_MEM = 0.08838834764831845f  , SC_MLA = 0.07216878364870323f  ;
    for (int l = 0; l < NA; ++l) for (int g = 0; g < 4; ++g)
        wt(st, pool_w + ((size_t)l * 4 + g) * PG * PG, WPOOL + (size_t)l * D * PG, nullptr, pool_scale + l * D + g * PG, PG, PG, 0, g * PG, 1.f);
    for (int l = 0; l < DEPTH; ++l) {
        wt(st, mem_wq + (size_t)l * D * MI, WMQ + (size_t)l * MI * D, norm_mem + l * D, nullptr, D, MI, 0, 0, SC_MEM);
        wt(st, mem_wk + (size_t)l * D * MI, WMK + (size_t)l * MI * D, norm_memtok + l * D, nullptr, D, MI, 0, 0, 1.f);
        wt(st, mem_wv + (size_t)l * D * MI, WMV + (size_t)l * MI * D, norm_memtok + l * D, nullptr, D, MI, 0, 0, 1.f);
        wt(st, mem_wo + (size_t)l * MI * D, WMO + (size_t)l * D * MI, nullptr, nullptr, MI, D, 0, 0, 1.f);
        wt(st, w_gate + (size_t)l * NE * D * EFF, WGU + (size_t)l * NE * 1024 * D, norm_ffn + l * D, nullptr, D, EFF, 3, 0, 1.f, NE, (long)D * EFF, (long)1024 * D);
        wt(st, w_up + (size_t)l * NE * D * EFF, WGU + (size_t)l * NE * 1024 * D, norm_ffn + l * D, nullptr, D, EFF, 4, 0, 1.f, NE, (long)D * EFF, (long)1024 * D);
        wt(st, w_down + (size_t)l * NE * EFF * D, WD + (size_t)l * NE * D * EFF, nullptr, nullptr, EFF, D, 0, 0, 1.f, NE, (long)EFF * D, (long)D * EFF);
    }
    hipLaunchKernelGGL(k_zero, dim3(256), dim3(256), 0, st, (unsigned*)(WDQ0 + (size_t)1088 * D), (long)(NDQ0 - 1088) * D / 2);
    wt(st, w_dq, WDQ0, norm_mix + 2 * D, nullptr, D, QR, 0, 0, 1.f);
    wt(st, w_dkv, WDQ0, kv_in_norm, nullptr, D, KVR, 0, 512, 1.f);
    wt(st, w_kr, WDQ0, kv_in_norm, nullptr, D, ROPE, 5, 1024, 1.f);
    wt(st, w_dq + (size_t)D * QR, WDQ1, norm_mix + 3 * D, nullptr, D, QR, 0, 0, 1.f);
    for (int j = 0; j < 2; ++j) {
        wt(st, w_uq + (size_t)j * QR * D, WUQ + (size_t)j * NQ * QR, q_latent_norm + j * QR, nullptr, QR, HEADS * NOPE, 1, 0, SC_MLA);
        wt(st, w_qr + (size_t)j * QR * HEADS * ROPE, WUQ + (size_t)j * NQ * QR, q_latent_norm + j * QR, nullptr, QR, HEADS * ROPE, 2, 0, SC_MLA);
        wt(st, w_o + (size_t)j * D * D, WO + (size_t)j * D * D, nullptr, nullptr, D, D, 0, 0, 1.f);
    }
    wt(st, w_uk, WUKV, kv_latent_norm, nullptr, KVR, D, 0, 0, 1.f);
    wt(st, w_uv, WUKV, kv_latent_norm, nullptr, KVR, D, 0, 2048, 1.f);
    hipLaunchKernelGGL(k_rwt, dim3((DEPTH * 36 * D + 255) / 256), dim3(256), 0, st, rg_w, re_w, norm_ffn, RWT);
    hipLaunchKernelGGL(k_rope, dim3(T * 32 / 256), dim3(256), 0, st, pos, COS, SIN);
    hipLaunchKernelGGL(k_memprep, dim3(NB * MEMT / 4), dim3(256), 0, st, mem, MEMB, MEMRS);
    for (int l = 0; l < DEPTH; ++l) for (int kv = 0; kv < 2; ++kv) {
        if (FAST >> K_BF16RS & 1) { FArgs a = fdense(MEMB, (kv ? WMV : WMK) + (size_t)l * MI * D, nullptr, nullptr, NB * MEMT, MI, MI, D, D, 0); a.p[4] = (kv ? MV : MK) + (size_t)l * NB * MEMT * MI; a.p[5] = MEMRS; a.i[6] = 1; a.i[7] = MI; fl<K_BF16RS>(st, a); continue; }
        GArgs g; memset(&g, 0, sizeof(g)); g.A = MEMB; g.lda = D; g.K = D; g.Bt = (kv ? WMV : WMK) + (size_t)l * MI * D; g.kind = K_BF16RS; g.O1 = (kv ? MV : MK) + (size_t)l * NB * MEMT * MI; g.ldo = MI; g.rs = MEMRS;
        hipLaunchKernelGGL(k_gemm<false>, dim3(MI / 128, NB * MEMT / 128), dim3(256), 0, st, g);
    }
    for (int l = 0; l < DEPTH; ++l) {
        const bool isA = l < NA;
        hipLaunchKernelGGL(k_combine, dim3(T / 4), dim3(256), 0, st, l == 0 ? x : (const float*)H, l == 0 ? (const bf16_t*)nullptr : (const bf16_t*)Y, H, HB, RS0, isA ? norm_mix + l * D : (const float*)nullptr, isA ? HN : (bf16_t*)nullptr, (float*)nullptr);
        if (isA) {
            hipLaunchKernelGGL(k_pool, dim3(T), dim3(256), 0, st, (const bf16_t*)HN, U);
            if (FAST >> K_RES & 1) { FArgs a = fdense(U, WPOOL + (size_t)l * D * PG, nullptr, nullptr, T, D, D, PG, D, 1); a.p[4] = H; a.p[5] = HB; a.p[6] = SSP; a.i[6] = 1; fl<K_RES>(st, a); }
            else { GArgs g; memset(&g, 0, sizeof(g)); g.A = U; g.lda = D; g.K = PG; g.Bt = WPOOL + (size_t)l * D * PG; g.kind = K_RES; g.pool = 1; g.H = H; g.HB = HB;
            hipLaunchKernelGGL(k_gemm<false>, dim3(D / 128, T / 128), dim3(256), 0, st, g); }
        } else {
            const int j = l - NA;
            if (FAST >> K_DQ & 1) { FArgs a = fdense(HB, j == 0 ? WDQ0 : WDQ1, nullptr, nullptr, T, j == 0 ? NDQ0 : QR, j == 0 ? NDQ0 : QR, D, D, 0);
              a.p[4] = CQ; a.p[5] = CKV; a.p[6] = KR; a.p[7] = RS0; a.p[8] = LSQ; a.p[9] = LSKV; a.p[10] = COS; a.p[11] = SIN; fl<K_DQ>(st, a); }
            else { GArgs g; memset(&g, 0, sizeof(g)); g.A = HB; g.lda = D; g.K = D; g.Bt = j == 0 ? WDQ0 : WDQ1; g.kind = K_DQ; g.O1 = CQ; g.O2 = j == 0 ? CKV : nullptr; g.O3 = j == 0 ? KR : nullptr; g.rs = RS0; g.COS = COS; g.SIN = SIN;
              hipLaunchKernelGGL(k_gemm<false>, dim3((j == 0 ? NDQ0 : QR) / 128, T / 128), dim3(256), 0, st, g); }
            if (!(FAST >> K_DQ & 1)) hipLaunchKernelGGL(k_rowstats_bf16, dim3(T / 4), dim3(256), 0, st, (const bf16_t*)CQ, QR, LSQ, 8);
            if (j == 0 && !(FAST >> K_DQ & 1)) hipLaunchKernelGGL(k_rowstats_bf16, dim3(T / 4), dim3(256), 0, st, (const bf16_t*)CKV, KVR, LSKV, 8);
            if (FAST >> K_UQ & 1) { FArgs a = fdense(CQ, WUQ + (size_t)j * NQ * QR, CKV, WUKV, T, j == 0 ? NQ + 4096 : NQ, NQ, QR, QR, 0);
              a.p[4] = Q; a.p[5] = KN; a.p[6] = V; a.p[7] = LSQ; a.p[8] = LSKV; a.p[9] = COS; a.p[10] = SIN; fl<K_UQ>(st, a); }
            else { GArgs g; memset(&g, 0, sizeof(g)); g.A = CQ; g.lda = QR; g.K = QR; g.Bt = WUQ + (size_t)j * NQ * QR; g.kind = K_UQ; g.O1 = Q; g.part = LSQ; g.np = 8; g.pdiv = (float)QR; g.COS = COS; g.SIN = SIN;
              hipLaunchKernelGGL(k_gemm<false>, dim3(NQ / 128, T / 128), dim3(256), 0, st, g); }
            if (j == 0 && !(FAST >> K_UQ & 1)) {
                GArgs g; memset(&g, 0, sizeof(g)); g.A = CKV; g.lda = KVR; g.K = KVR; g.Bt = WUKV; g.kind = K_UKV; g.O1 = KN; g.O2 = V; g.part = LSKV; g.np = 8; g.pdiv = (float)KVR;
                hipLaunchKernelGGL(k_gemm<false>, dim3(4096 / 128, T / 128), dim3(256), 0, st, g);
            }
            { AArgs a; memset(&a, 0, sizeof(a)); a.Q = Q; a.ldq = NQ; a.qhs = QKD; a.K1 = KN; a.ldk1 = D; a.k1hs = NOPE; a.K2 = KR; a.ldk2 = ROPE; a.V = V; a.ldv = D; a.vhs = VD; a.O = AO; a.ldo = D; a.ohs = VD; a.nq = S; a.nk = S;
              hipLaunchKernelGGL((k_attn<192, true>), dim3(S / 64, HEADS, NB), dim3(256), SM_MLA, st, a); }
            if (FAST >> K_RES & 1) { FArgs a = fdense(AO, WO + (size_t)j * D * D, nullptr, nullptr, T, D, D, D, D, 0); a.p[4] = H; a.p[5] = HB; a.p[6] = SSP; a.i[6] = 1; fl<K_RES>(st, a); }
            else { GArgs g; memset(&g, 0, sizeof(g)); g.A = AO; g.lda = D; g.K = D; g.Bt = WO + (size_t)j * D * D; g.kind = K_RES; g.H = H; g.HB = HB;
              hipLaunchKernelGGL(k_gemm<false>, dim3(D / 128, T / 128), dim3(256), 0, st, g); }
        }
        if (!(FAST >> K_RES & 1)) hipLaunchKernelGGL(k_rowstats_f32, dim3(T / 4), dim3(256), 0, st, (const float*)H, D, SSP, 32);
        if (FAST >> K_BF16RS & 1) { FArgs a = fdense(HB, WMQ + (size_t)l * MI * D, nullptr, nullptr, T, MI, MI, D, D, 0); a.p[4] = MQ; a.p[5] = SSP; a.i[6] = 2; a.i[7] = MI; fl<K_BF16RS>(st, a); }
        else { GArgs g; memset(&g, 0, sizeof(g)); g.A = HB; g.lda = D; g.K = D; g.Bt = WMQ + (size_t)l * MI * D; g.kind = K_BF16RS; g.O1 = MQ; g.ldo = MI; g.part = SSP; g.np = 32; g.pdiv = (float)D;
          hipLaunchKernelGGL(k_gemm<false>, dim3(MI / 128, T / 128), dim3(256), 0, st, g); }
        { AArgs a; memset(&a, 0, sizeof(a)); a.Q = MQ; a.ldq = MI; a.qhs = MHD; a.K1 = MK + (size_t)l * NB * MEMT * MI; a.ldk1 = MI; a.k1hs = MHD; a.V = MV + (size_t)l * NB * MEMT * MI; a.ldv = MI; a.vhs = MHD; a.O = MO; a.ldo = MI; a.ohs = MHD; a.nq = S; a.nk = MEMT;
          hipLaunchKernelGGL((k_attn<128, false>), dim3(S / 64, MH, NB), dim3(256), SM_MEM, st, a); }
        if (FAST >> K_RES & 1) { FArgs a = fdense(MO, WMO + (size_t)l * D * MI, nullptr, nullptr, T, D, D, MI, MI, 0); a.p[4] = H; a.p[5] = HB; a.i[6] = 0; fl<K_RES>(st, a); }
        else { GArgs g; memset(&g, 0, sizeof(g)); g.A = MO; g.lda = MI; g.K = MI; g.Bt = WMO + (size_t)l * D * MI; g.kind = K_RES; g.H = H; g.HB = HB;
          hipLaunchKernelGGL(k_gemm<false>, dim3(D / 128, T / 128), dim3(256), 0, st, g); }
        hipLaunchKernelGGL(k_router, dim3(T / 4), dim3(256), 0, st, (const float*)H, (const float*)(RWT + (size_t)l * 36 * D), rg_b + l * NG, re_b + l * NE, RS2, CNT + l * NE, LIST, GW);
        if (FAST >> K_MOE1 & 1) { FArgs a; memset(&a, 0, sizeof(a)); a.p[0] = HB; a.p[1] = WGU + (size_t)l * NE * 1024 * D; a.p[2] = LIST; a.p[3] = CNT + l * NE; a.p[4] = HH; a.p[5] = RS2; a.i[0] = 4; a.i[1] = D; a.i[2] = D; a.i[3] = 1024 * D; fl<K_MOE1>(st, a); }
        else { GArgs g; memset(&g, 0, sizeof(g)); g.A = HB; g.lda = D; g.K = D; g.Bt = WGU + (size_t)l * NE * 1024 * D; g.kind = K_MOE1; g.O1 = HH; g.rs = RS2; g.cnt = CNT + l * NE; g.list = LIST; g.estride = (long)1024 * D;
          hipLaunchKernelGGL(k_gemm<true>, dim3(EFF / 128, MAXROWS / 128), dim3(256), 0, st, g); }
        if (FAST >> K_MOE2 & 1) { FArgs a; memset(&a, 0, sizeof(a)); a.p[0] = HH; a.p[1] = WD + (size_t)l * NE * D * EFF; a.p[2] = LIST; a.p[3] = CNT + l * NE; a.p[4] = Y; a.p[5] = GW; a.i[0] = 8; a.i[1] = EFF; a.i[2] = EFF; a.i[3] = D * EFF; fl<K_MOE2>(st, a); }
        else { GArgs g; memset(&g, 0, sizeof(g)); g.A = HH; g.lda = EFF; g.K = EFF; g.Bt = WD + (size_t)l * NE * D * EFF; g.kind = K_MOE2; g.O1 = Y; g.cnt = CNT + l * NE; g.list = LIST; g.gw = GW; g.estride = (long)D * EFF;
          hipLaunchKernelGGL(k_gemm<false>, dim3(D / 128, MAXROWS / 128), dim3(256), 0, st, g); }
    }
    hipLaunchKernelGGL(k_combine, dim3(T / 4), dim3(256), 0, st, (const float*)H, (const bf16_t*)Y, (float*)nullptr, (bf16_t*)nullptr, (float*)nullptr, final_norm, (bf16_t*)nullptr, (float*)d_out);
    const hipError_t le = hipPeekAtLastError();
    if (le != hipSuccess) fprintf(stderr, "kernel_launch: launch failed: %s\n", hipGetErrorName(le));
#undef IN
}
```

```cpp
#include <hip/hip_runtime.h>
#include <cstdio>
#include <cstdint>
#include <cstring>

typedef unsigned short bf16_t;
typedef float f32x4 __attribute__((ext_vector_type(4)));
typedef unsigned u32x4 __attribute__((ext_vector_type(4)));
typedef unsigned u32x2 __attribute__((ext_vector_type(2)));
#define DI __device__ __forceinline__

constexpr int D = 2048, NB = 4, S = 4096, T = NB * S, DEPTH = 4, NA = 2;
constexpr int CHUNK = 64;
constexpr int PG = 512;
constexpr int HEADS = 16, QR = 512, KVR = 512, NOPE = 128, ROPE = 64, VD = 128, QKD = NOPE + ROPE;
constexpr int MEMT = 256, MH = 4, MHD = 128, MI = 512;
constexpr int NG = 4, EPG = 8, NE = 32, EFF = 512;
constexpr float EPS = 1e-6f;
constexpr int CAP = T;
constexpr int MAXROWS = 2 * T + NE * 256;
constexpr int NQ = HEADS * QKD;
constexpr int NDQ0 = 1280;

constexpr size_t al(size_t x) { return (x + 255) & ~(size_t)255; }
constexpr size_t WS_CTL = 0, CTL_BYTES = 1u << 20;
constexpr size_t OFF_CNT = 65536;
constexpr size_t WS_WPOOL = WS_CTL + CTL_BYTES;
constexpr size_t WS_WMQ = WS_WPOOL + (size_t)NA * D * PG * 2;
constexpr size_t WS_WMK = WS_WMQ + (size_t)DEPTH * MI * D * 2;
constexpr size_t WS_WMV = WS_WMK + (size_t)DEPTH * MI * D * 2;
constexpr size_t WS_WMO = WS_WMV + (size_t)DEPTH * MI * D * 2;
constexpr size_t WS_WDQ0 = WS_WMO + (size_t)DEPTH * D * MI * 2;
constexpr size_t WS_WDQ1 = WS_WDQ0 + (size_t)NDQ0 * D * 2;
constexpr size_t WS_WUQ = WS_WDQ1 + (size_t)QR * D * 2;
constexpr size_t WS_WUKV = WS_WUQ + (size_t)2 * NQ * QR * 2;
constexpr size_t WS_WO = WS_WUKV + (size_t)4096 * KVR * 2;
constexpr size_t WS_RWT = WS_WO + (size_t)2 * D * D * 2;
constexpr size_t WS_WGU = al(WS_RWT + (size_t)DEPTH * 36 * D * 4);
constexpr size_t WS_WD = WS_WGU + (size_t)DEPTH * NE * 1024 * D * 2;
constexpr size_t WS_H = WS_WD + (size_t)DEPTH * NE * D * EFF * 2;
constexpr size_t WS_HB = WS_H + (size_t)T * D * 4;
constexpr size_t WS_Y = WS_HB + (size_t)T * D * 2;
constexpr size_t WS_HH = WS_Y + (size_t)2 * T * D * 2;
constexpr size_t WS_KN = WS_HH + (size_t)MAXROWS * EFF * 2;
constexpr size_t WS_V = WS_KN + (size_t)T * D * 2;
constexpr size_t WS_Q = WS_V + (size_t)T * D * 2;
constexpr size_t WS_HN = WS_Q;
constexpr size_t WS_U = WS_Q + (size_t)T * D * 2;
constexpr size_t WS_AO = WS_Q + (size_t)T * NQ * 2;
constexpr size_t WS_MQ = WS_AO + (size_t)T * D * 2;
constexpr size_t WS_MO = WS_MQ + (size_t)T * MI * 2;
constexpr size_t WS_CQ = WS_MO + (size_t)T * MI * 2;
constexpr size_t WS_CKV = WS_CQ + (size_t)T * QR * 2;
constexpr size_t WS_KR = WS_CKV + (size_t)T * KVR * 2;
constexpr size_t WS_MEMB = WS_KR + (size_t)T * ROPE * 2;
constexpr size_t WS_MK = WS_MEMB + (size_t)NB * MEMT * D * 2;
constexpr size_t WS_MV = WS_MK + (size_t)DEPTH * NB * MEMT * MI * 2;
constexpr size_t WS_SSP = WS_MV + (size_t)DEPTH * NB * MEMT * MI * 2;
constexpr size_t WS_LSQ = WS_SSP + (size_t)T * 32 * 4;
constexpr size_t WS_LSKV = WS_LSQ + (size_t)T * 8 * 4;
constexpr size_t WS_RS0 = WS_LSKV + (size_t)T * 8 * 4;
constexpr size_t WS_RS2 = WS_RS0 + (size_t)T * 4;
constexpr size_t WS_MEMRS = WS_RS2 + (size_t)T * 4;
constexpr size_t WS_COS = WS_MEMRS + 4096;
constexpr size_t WS_SIN = WS_COS + (size_t)T * 32 * 4;
constexpr size_t WS_GW = WS_SIN + (size_t)T * 32 * 4;
constexpr size_t WS_LIST = WS_GW + (size_t)2 * T * 4;
constexpr size_t WS_END = WS_LIST + (size_t)NE * CAP * 4;
static_assert(WS_U + (size_t)T * D * 2 <= WS_MQ, "U overlay inside Q|AO");

DI float bf2f(bf16_t b) { return __uint_as_float(((unsigned)b) << 16); }
DI unsigned f2bf(float f) { unsigned u = __float_as_uint(f); return (u + 0x7fffu + ((u >> 16) & 1u)) >> 16; }
DI unsigned pk2(float lo, float hi) { return f2bf(lo) | (f2bf(hi) << 16); }
DI float wave_sum(float v) {
#pragma unroll
    for (int o = 1; o < 64; o <<= 1) v += __shfl_xor(v, o);
    return v;
}
DI float silu(float x) { return x / (1.0f + __expf(-x)); }

DI int permrow(int perm, int n) {
    switch (perm) {
        case 1: return (n >> 7) * QKD + (n & 127);
        case 2: { const int h = n >> 6, r = n & 63; return h * QKD + NOPE + 2 * (r & 31) + (r >> 5); }
        case 3: return (n >> 7) * 256 + (n & 127);
        case 4: return (n >> 7) * 256 + 128 + (n & 127);
        case 5: return 2 * (n & 31) + (n >> 5);
        default: return n;
    }
}
struct WtJob { const float* W; bf16_t* WT; const float* kgain; const float* ngain; long wstride, tstride; int K, N, perm, row_off; float scale; int pad; };
__global__ __launch_bounds__(256) void k_wt(WtJob j) {
    __shared__ float scr_all[4][64 * 33];
    const int wave = threadIdx.x >> 6, lane = threadIdx.x & 63;
    float* scr = scr_all[wave];
    const int nblk = j.N / 32, kblk = j.K / 64, item = blockIdx.x * 4 + wave;
    if (item >= nblk * kblk) return;
    const float* W = j.W + (long)blockIdx.y * j.wstride; bf16_t* WT = j.WT + (long)blockIdx.y * j.tstride;
    const int kb = item / nblk, nb = item % nblk, k0 = 64 * kb, n0 = 32 * nb;
    const float ng = (j.ngain ? j.ngain[n0 + (lane & 31)] : 1.0f) * j.scale;
#pragma unroll 8
    for (int i = 0; i < 32; ++i) { const int kk = 2 * i + (lane >> 5);
        float v = W[(size_t)(k0 + kk) * j.N + n0 + (lane & 31)] * ng; if (j.kgain) v *= j.kgain[k0 + kk];
        scr[kk * 33 + (lane & 31)] = v; }
    asm volatile("s_waitcnt lgkmcnt(0)" ::: "memory");
    const int c = lane & 7;
#pragma unroll
    for (int q = 0; q < 4; ++q) { const int n = (lane >> 3) + 8 * q; const float* s = scr + (8 * c) * 33 + n;
        u32x4 o; o.x = pk2(s[0 * 33], s[1 * 33]); o.y = pk2(s[2 * 33], s[3 * 33]); o.z = pk2(s[4 * 33], s[5 * 33]); o.w = pk2(s[6 * 33], s[7 * 33]);
        *(u32x4*)(WT + (size_t)(j.row_off + permrow(j.perm, n0 + n)) * j.K + k0 + 8 * c) = o; }
}
__global__ void k_rwt(const float* rg_w, const float* re_w, const float* gain, float* RWT) {
    const int idx = blockIdx.x * 256 + threadIdx.x; if (idx >= DEPTH * 36 * D) return;
    const int l = idx / (36 * D), n = (idx / D) % 36, k = idx % D;
    const float w = n < 4 ? rg_w[((size_t)l * D + k) * 4 + n] : re_w[((size_t)l * D + k) * 32 + (n - 4)];
    RWT[idx] = w * gain[l * D + k];
}
__global__ void k_zero(unsigned* p, long n) { for (long i = blockIdx.x * 256L + threadIdx.x; i < n; i += gridDim.x * 256L) p[i] = 0u; }
__global__ void k_rope(const int* pos, float* COS, float* SIN) {
    const int idx = blockIdx.x * 256 + threadIdx.x; if (idx >= T * 32) return;
    const int t = idx >> 5, i = idx & 31;
    const float inv = (float)(1.0 / pow(10000.0, (double)i / 32.0));
    const float ang = (float)pos[t] * inv;
    const double rev = (double)ang * 0.15915494309189533577; const float fr = (float)(rev - rint(rev));
    COS[idx] = __builtin_amdgcn_cosf(fr); SIN[idx] = __builtin_amdgcn_sinf(fr);
}
__global__ __launch_bounds__(256) void k_memprep(const float* mem, bf16_t* MEMB, float* MEMRS) {
    const int r = blockIdx.x * 4 + (threadIdx.x >> 6), lane = threadIdx.x & 63;
    const f32x4* x = (const f32x4*)(mem + (size_t)r * D) + lane; float ss = 0.f;
#pragma unroll
    for (int j = 0; j < 8; ++j) { const f32x4 v = x[64 * j]; ss += (v.x * v.x + v.y * v.y) + (v.z * v.z + v.w * v.w);
        u32x2 o; o.x = pk2(v.x, v.y); o.y = pk2(v.z, v.w); *((u32x2*)(MEMB + (size_t)r * D) + lane + 64 * j) = o; }
    ss = wave_sum(ss); if (lane == 0) MEMRS[r] = rsqrtf(ss * (1.0f / D) + EPS);
}
__global__ __launch_bounds__(256) void k_combine(const float* src, const bf16_t* Y, float* H, bf16_t* HB, float* RS0, const float* gain, bf16_t* HN, float* out) {
    const int t = blockIdx.x * 4 + (threadIdx.x >> 6), lane = threadIdx.x & 63;
    const f32x4* x = (const f32x4*)(src + (size_t)t * D) + lane; f32x4 v[8]; float ss = 0.f;
#pragma unroll
    for (int j = 0; j < 8; ++j) { v[j] = x[64 * j];
        if (Y) { const u32x2 a = *((const u32x2*)(Y + (size_t)(2 * t) * D) + lane + 64 * j), b = *((const u32x2*)(Y + (size_t)(2 * t + 1) * D) + lane + 64 * j);
            v[j].x = (v[j].x + __uint_as_float(a.x << 16)) + __uint_as_float(b.x << 16); v[j].y = (v[j].y + __uint_as_float(a.x & 0xffff0000u)) + __uint_as_float(b.x & 0xffff0000u);
            v[j].z = (v[j].z + __uint_as_float(a.y << 16)) + __uint_as_float(b.y << 16); v[j].w = (v[j].w + __uint_as_float(a.y & 0xffff0000u)) + __uint_as_float(b.y & 0xffff0000u); }
        ss += (v[j].x * v[j].x + v[j].y * v[j].y) + (v[j].z * v[j].z + v[j].w * v[j].w); }
    ss = wave_sum(ss); const float rs = rsqrtf(ss * (1.0f / D) + EPS);
    if (lane == 0 && RS0) RS0[t] = rs;
#pragma unroll
    for (int j = 0; j < 8; ++j) {
        if (H) *((f32x4*)(H + (size_t)t * D) + lane + 64 * j) = v[j];
        if (HB) { u32x2 o; o.x = pk2(v[j].x, v[j].y); o.y = pk2(v[j].z, v[j].w); *((u32x2*)(HB + (size_t)t * D) + lane + 64 * j) = o; }
        if (gain) { const f32x4 g = *((const f32x4*)gain + lane + 64 * j); const f32x4 n = v[j] * g * rs;
            if (HN) { u32x2 o; o.x = pk2(n.x, n.y); o.y = pk2(n.z, n.w); *((u32x2*)(HN + (size_t)t * D) + lane + 64 * j) = o; }
            if (out) *((f32x4*)(out + (size_t)t * D) + lane + 64 * j) = n; }
    }
}
__global__ __launch_bounds__(256) void k_pool(const bf16_t* HN, bf16_t* U) {
    const int t = blockIdx.x, c = threadIdx.x * 8, s = t & (S - 1), w = 2 << (c >> 9);
    const int n = (s + 1 < w) ? s + 1 : w;
    float acc[8] = {0.f, 0.f, 0.f, 0.f, 0.f, 0.f, 0.f, 0.f}, self[8];
    for (int i = 0; i < n; ++i) { const u32x4 v = *(const u32x4*)(HN + (size_t)(t - i) * D + c);
        const float f[8] = {__uint_as_float(v.x << 16), __uint_as_float(v.x & 0xffff0000u), __uint_as_float(v.y << 16), __uint_as_float(v.y & 0xffff0000u),
                            __uint_as_float(v.z << 16), __uint_as_float(v.z & 0xffff0000u), __uint_as_float(v.w << 16), __uint_as_float(v.w & 0xffff0000u)};
#pragma unroll
        for (int q = 0; q < 8; ++q) { acc[q] += f[q]; if (i == 0) self[q] = f[q]; } }
    const float inv = 1.0f / (float)n; u32x4 o;
    o.x = pk2(acc[0] * inv - self[0], acc[1] * inv - self[1]); o.y = pk2(acc[2] * inv - self[2], acc[3] * inv - self[3]);
    o.z = pk2(acc[4] * inv - self[4], acc[5] * inv - self[5]); o.w = pk2(acc[6] * inv - self[6], acc[7] * inv - self[7]);
    *(u32x4*)(U + (size_t)t * D + c) = o;
}
__global__ __launch_bounds__(256) void k_rowstats_f32(const float* X, int ncol, float* P, int np) {
    const int t = blockIdx.x * 4 + (threadIdx.x >> 6), lane = threadIdx.x & 63; float ss = 0.f;
    for (int c = lane * 4; c < ncol; c += 256) { const f32x4 v = *(const f32x4*)(X + (size_t)t * ncol + c); ss += (v.x * v.x + v.y * v.y) + (v.z * v.z + v.w * v.w); }
    ss = wave_sum(ss); if (lane < np) P[(size_t)t * np + lane] = lane == 0 ? ss : 0.f;
}
__global__ __launch_bounds__(256) void k_rowstats_bf16(const bf16_t* X, int ncol, float* P, int np) {
    const int t = blockIdx.x * 4 + (threadIdx.x >> 6), lane = threadIdx.x & 63; float ss = 0.f;
    for (int c = lane * 4; c < ncol; c += 256) { const u32x2 v = *(const u32x2*)(X + (size_t)t * ncol + c);
        const float a = __uint_as_float(v.x << 16), b = __uint_as_float(v.x & 0xffff0000u), cc = __uint_as_float(v.y << 16), d = __uint_as_float(v.y & 0xffff0000u); ss += (a * a + b * b) + (cc * cc + d * d); }
    ss = wave_sum(ss); if (lane < np) P[(size_t)t * np + lane] = lane == 0 ? ss : 0.f;
}

enum { K_BF16RS = 0, K_RES = 1, K_DQ = 2, K_UQ = 3, K_UKV = 4, K_MOE1 = 5, K_MOE2 = 6 };
struct GArgs {
    const bf16_t* A; const bf16_t* Bt; float* H; bf16_t* HB; bf16_t* O1; bf16_t* O2; bf16_t* O3;
    const float* rs; const float* part;
    const float* COS; const float* SIN;
    const int* cnt; const int* list; const float* gw; long estride;
    int lda, K, kind, pool, ldo, np; float pdiv; int pad;
};
DI float rowscale(const GArgs& g, int r) {
    if (g.rs) return g.rs[r];
    if (g.part) { float s = 0.f; for (int p = 0; p < g.np; ++p) s += g.part[(size_t)r * g.np + p]; return rsqrtf(s / g.pdiv + EPS); }
    return 1.0f;
}
template <bool DUAL>
__global__ __launch_bounds__(256) void k_gemm(GArgs g) {
    __shared__ __attribute__((aligned(16))) float As[16][132];
    __shared__ __attribute__((aligned(16))) float Bs[DUAL ? 2 : 1][16][132];
    const int tid = threadIdx.x, tx = tid & 15, ty = tid >> 4, lr = tid >> 1, lk = (tid & 1) * 8;
    const int n0 = blockIdx.x * 128, m0 = blockIdx.y * 128;
    int e = 0, rie0 = 0, ecnt = 0;
    if (g.cnt) { const int tile256 = blockIdx.y >> 1; int acc = 0; bool found = false;
        for (int i = 0; i < NE; ++i) { const int c = g.cnt[i], nt = (c + 255) >> 8; if (!found && tile256 < acc + nt) { found = true; e = i; ecnt = c; rie0 = (tile256 - acc) * 256 + (blockIdx.y & 1) * 128; } acc += nt; }
        if (!found) return; }
    const bf16_t* ap; const bf16_t* bp; const bf16_t* bp2 = nullptr;
    if (g.kind == K_MOE1) { const int ri = rie0 + lr; ap = ri < ecnt ? g.A + (size_t)(g.list[(size_t)e * CAP + ri] >> 1) * g.lda : nullptr;
        bp = g.Bt + (size_t)e * g.estride + (size_t)(blockIdx.x * 256 + lr) * g.K; bp2 = bp + (size_t)128 * g.K; }
    else if (g.kind == K_MOE2) { ap = g.A + (size_t)(m0 + lr) * g.lda; bp = g.Bt + (size_t)e * g.estride + (size_t)(n0 + lr) * g.K; }
    else { ap = g.A + (size_t)(m0 + lr) * g.lda + (g.pool ? (n0 / 512) * 512 : 0); bp = g.Bt + (size_t)(n0 + lr) * g.K; }
    float acc[8][8], acc2[DUAL ? 8 : 1][8];
#pragma unroll
    for (int i = 0; i < 8; ++i)
#pragma unroll
        for (int j = 0; j < 8; ++j) { acc[i][j] = 0.f; if (DUAL) acc2[i][j] = 0.f; }
    for (int k0 = 0; k0 < g.K; k0 += 16) {
        u32x4 av = {0u, 0u, 0u, 0u}, bv, bv2 = {0u, 0u, 0u, 0u};
        if (ap) av = *(const u32x4*)(ap + k0 + lk);
        bv = *(const u32x4*)(bp + k0 + lk);
        if (DUAL) bv2 = *(const u32x4*)(bp2 + k0 + lk);
        __syncthreads();
        const unsigned aw[4] = {av.x, av.y, av.z, av.w}, bw[4] = {bv.x, bv.y, bv.z, bv.w}, bw2[4] = {bv2.x, bv2.y, bv2.z, bv2.w};
#pragma unroll
        for (int q = 0; q < 4; ++q) {
            As[lk + 2 * q][lr] = __uint_as_float(aw[q] << 16); As[lk + 2 * q + 1][lr] = __uint_as_float(aw[q] & 0xffff0000u);
            Bs[0][lk + 2 * q][lr] = __uint_as_float(bw[q] << 16); Bs[0][lk + 2 * q + 1][lr] = __uint_as_float(bw[q] & 0xffff0000u);
            if (DUAL) { Bs[DUAL ? 1 : 0][lk + 2 * q][lr] = __uint_as_float(bw2[q] << 16); Bs[DUAL ? 1 : 0][lk + 2 * q + 1][lr] = __uint_as_float(bw2[q] & 0xffff0000u); }
        }
        __syncthreads();
#pragma unroll
        for (int kk = 0; kk < 16; ++kk) {
            const f32x4 a0 = *(const f32x4*)&As[kk][ty * 8], a1 = *(const f32x4*)&As[kk][ty * 8 + 4];
            const f32x4 b0 = *(const f32x4*)&Bs[0][kk][tx * 8], b1 = *(const f32x4*)&Bs[0][kk][tx * 8 + 4];
            const float a[8] = {a0.x, a0.y, a0.z, a0.w, a1.x, a1.y, a1.z, a1.w}, b[8] = {b0.x, b0.y, b0.z, b0.w, b1.x, b1.y, b1.z, b1.w};
#pragma unroll
            for (int i = 0; i < 8; ++i)
#pragma unroll
                for (int j = 0; j < 8; ++j) acc[i][j] += a[i] * b[j];
            if (DUAL) { const f32x4 c0 = *(const f32x4*)&Bs[DUAL ? 1 : 0][kk][tx * 8], c1 = *(const f32x4*)&Bs[DUAL ? 1 : 0][kk][tx * 8 + 4];
                const float c[8] = {c0.x, c0.y, c0.z, c0.w, c1.x, c1.y, c1.z, c1.w};
#pragma unroll
                for (int i = 0; i < 8; ++i)
#pragma unroll
                    for (int j = 0; j < 8; ++j) acc2[i][j] += a[i] * c[j]; }
        }
    }
#pragma unroll
    for (int i = 0; i < 8; ++i) {
        const int r = m0 + ty * 8 + i, n = n0 + tx * 8;
        float v[8];
#pragma unroll
        for (int j = 0; j < 8; ++j) v[j] = acc[i][j];
        if (g.kind == K_BF16RS) { const float sc = rowscale(g, r); u32x4 o; o.x = pk2(v[0] * sc, v[1] * sc); o.y = pk2(v[2] * sc, v[3] * sc); o.z = pk2(v[4] * sc, v[5] * sc); o.w = pk2(v[6] * sc, v[7] * sc);
            *(u32x4*)(g.O1 + (size_t)r * g.ldo + n) = o; }
        else if (g.kind == K_RES) { float* hp = g.H + (size_t)r * D + n; f32x4 h0 = *(f32x4*)hp, h1 = *(f32x4*)(hp + 4);
            h0.x += v[0]; h0.y += v[1]; h0.z += v[2]; h0.w += v[3]; h1.x += v[4]; h1.y += v[5]; h1.z += v[6]; h1.w += v[7];
            *(f32x4*)hp = h0; *(f32x4*)(hp + 4) = h1;
            u32x4 o; o.x = pk2(h0.x, h0.y); o.y = pk2(h0.z, h0.w); o.z = pk2(h1.x, h1.y); o.w = pk2(h1.z, h1.w); *(u32x4*)(g.HB + (size_t)r * D + n) = o; }
        else if (g.kind == K_DQ) { const float sc = rowscale(g, r);
#pragma unroll
            for (int j = 0; j < 8; ++j) v[j] *= sc;
            if (n >= 1024 && n < 1088) { const int i0 = (n - 1024) >> 1;
#pragma unroll
                for (int p = 0; p < 4; ++p) { const float c = g.COS[(size_t)r * 32 + i0 + p], s = g.SIN[(size_t)r * 32 + i0 + p], x1 = v[2 * p], x2 = v[2 * p + 1]; v[2 * p] = x1 * c - x2 * s; v[2 * p + 1] = x2 * c + x1 * s; } }
            u32x4 o; o.x = pk2(v[0], v[1]); o.y = pk2(v[2], v[3]); o.z = pk2(v[4], v[5]); o.w = pk2(v[6], v[7]);
            if (n < 512) *(u32x4*)(g.O1 + (size_t)r * 512 + n) = o;
            else if (n < 1024) { if (g.O2) *(u32x4*)(g.O2 + (size_t)r * 512 + (n - 512)) = o; }
            else if (n < 1088) { if (g.O3) *(u32x4*)(g.O3 + (size_t)r * 64 + (n - 1024)) = o; } }
        else if (g.kind == K_UQ) { const float sc = rowscale(g, r); const int hc = n % QKD;
#pragma unroll
            for (int j = 0; j < 8; ++j) v[j] *= sc;
            if (hc >= NOPE) { const int i0 = (hc - NOPE) >> 1;
#pragma unroll
                for (int p = 0; p < 4; ++p) { const float c = g.COS[(size_t)r * 32 + i0 + p], s = g.SIN[(size_t)r * 32 + i0 + p], x1 = v[2 * p], x2 = v[2 * p + 1]; v[2 * p] = x1 * c - x2 * s; v[2 * p + 1] = x2 * c + x1 * s; } }
            u32x4 o; o.x = pk2(v[0], v[1]); o.y = pk2(v[2], v[3]); o.z = pk2(v[4], v[5]); o.w = pk2(v[6], v[7]); *(u32x4*)(g.O1 + (size_t)r * NQ + n) = o; }
        else if (g.kind == K_UKV) { const float sc = rowscale(g, r); u32x4 o; o.x = pk2(v[0] * sc, v[1] * sc); o.y = pk2(v[2] * sc, v[3] * sc); o.z = pk2(v[4] * sc, v[5] * sc); o.w = pk2(v[6] * sc, v[7] * sc);
            if (n < 2048) *(u32x4*)(g.O1 + (size_t)r * D + n) = o; else *(u32x4*)(g.O2 + (size_t)r * D + (n - 2048)) = o; }
        else if (g.kind == K_MOE1) { const int ri = rie0 + ty * 8 + i;
            if (ri < ecnt) { const float sc = g.rs[g.list[(size_t)e * CAP + ri] >> 1]; float hv[8];
#pragma unroll
                for (int j = 0; j < 8; ++j) hv[j] = silu(v[j] * sc) * (acc2[DUAL ? i : 0][j] * sc);
                u32x4 o; o.x = pk2(hv[0], hv[1]); o.y = pk2(hv[2], hv[3]); o.z = pk2(hv[4], hv[5]); o.w = pk2(hv[6], hv[7]);
                *(u32x4*)(g.O1 + (size_t)r * EFF + blockIdx.x * 128 + tx * 8) = o; } }
        else if (g.kind == K_MOE2) { const int ri = rie0 + ty * 8 + i;
            if (ri < ecnt) { const int a = g.list[(size_t)e * CAP + ri]; const float sc = g.gw[a];
                u32x4 o; o.x = pk2(v[0] * sc, v[1] * sc); o.y = pk2(v[2] * sc, v[3] * sc); o.z = pk2(v[4] * sc, v[5] * sc); o.w = pk2(v[6] * sc, v[7] * sc);
                *(u32x4*)(g.O1 + (size_t)a * D + n) = o; } }
    }
}

struct AArgs { const bf16_t* Q; const bf16_t* K1; const bf16_t* K2; const bf16_t* V; bf16_t* O; int ldq, qhs, ldk1, k1hs, ldk2, ldv, vhs, ldo, ohs, nq, nk, pad; };
template <int DQK, bool CAUSAL>
__global__ __launch_bounds__(256) void k_attn(AArgs a) {
    extern __shared__ __attribute__((aligned(16))) float sm[];
    constexpr int LQ = DQK + 1;
    float* Qs = sm; float* Ks = Qs + 64 * LQ; float* Vs = Ks + 64 * LQ; float* Ps = Vs + 64 * 132;
    const int tid = threadIdx.x, tx = tid & 15, ty = tid >> 4, qc = blockIdx.x, h = blockIdx.y, b = blockIdx.z;
    const size_t qrow0 = (size_t)b * a.nq + (size_t)qc * 64, krow0 = (size_t)b * a.nk;
    for (int i = tid; i < 64 * DQK / 8; i += 256) { const int r = i / (DQK / 8), c = (i % (DQK / 8)) * 8;
        const u32x4 v = *(const u32x4*)(a.Q + (qrow0 + r) * a.ldq + h * a.qhs + c); const unsigned w[4] = {v.x, v.y, v.z, v.w};
#pragma unroll
        for (int q = 0; q < 4; ++q) { Qs[r * LQ + c + 2 * q] = __uint_as_float(w[q] << 16); Qs[r * LQ + c + 2 * q + 1] = __uint_as_float(w[q] & 0xffff0000u); } }
    float m[4], l[4], o[4][8];
#pragma unroll
    for (int i = 0; i < 4; ++i) { m[i] = -1e30f; l[i] = 0.f;
#pragma unroll
        for (int j = 0; j < 8; ++j) o[i][j] = 0.f; }
    const int ntile = CAUSAL ? qc + 1 : a.nk / 64;
    for (int kt = 0; kt < ntile; ++kt) {
        __syncthreads();
        for (int i = tid; i < 64 * DQK / 8; i += 256) { const int r = i / (DQK / 8), c = (i % (DQK / 8)) * 8; const size_t kr = krow0 + kt * 64 + r;
            const u32x4 v = (c < 128) ? *(const u32x4*)(a.K1 + kr * a.ldk1 + h * a.k1hs + c) : *(const u32x4*)(a.K2 + kr * a.ldk2 + (c - 128));
            const unsigned w[4] = {v.x, v.y, v.z, v.w};
#pragma unroll
            for (int q = 0; q < 4; ++q) { Ks[r * LQ + c + 2 * q] = __uint_as_float(w[q] << 16); Ks[r * LQ + c + 2 * q + 1] = __uint_as_float(w[q] & 0xffff0000u); } }
        for (int i = tid; i < 64 * 16; i += 256) { const int r = i >> 4, c = (i & 15) * 8; const size_t kr = krow0 + kt * 64 + r;
            const u32x4 v = *(const u32x4*)(a.V + kr * a.ldv + h * a.vhs + c); const unsigned w[4] = {v.x, v.y, v.z, v.w};
#pragma unroll
            for (int q = 0; q < 4; ++q) { Vs[r * 132 + c + 2 * q] = __uint_as_float(w[q] << 16); Vs[r * 132 + c + 2 * q + 1] = __uint_as_float(w[q] & 0xffff0000u); } }
        __syncthreads();
        float s[4][4];
#pragma unroll
        for (int i = 0; i < 4; ++i)
#pragma unroll
            for (int j = 0; j < 4; ++j) s[i][j] = 0.f;
        for (int d = 0; d < DQK; ++d) { float qv[4], kv[4];
#pragma unroll
            for (int i = 0; i < 4; ++i) { qv[i] = Qs[(ty * 4 + i) * LQ + d]; kv[i] = Ks[(tx * 4 + i) * LQ + d]; }
#pragma unroll
            for (int i = 0; i < 4; ++i)
#pragma unroll
                for (int j = 0; j < 4; ++j) s[i][j] += qv[i] * kv[j]; }
#pragma unroll
        for (int i = 0; i < 4; ++i) {
            float mx = fmaxf(fmaxf(s[i][0], s[i][1]), fmaxf(s[i][2], s[i][3]));
#pragma unroll
            for (int x = 1; x < 16; x <<= 1) mx = fmaxf(mx, __shfl_xor(mx, x));
            const float mn = fmaxf(m[i], mx), alpha = __expf(m[i] - mn); m[i] = mn; float ps = 0.f;
#pragma unroll
            for (int j = 0; j < 4; ++j) { const float p = __expf(s[i][j] - mn); ps += p; Ps[(ty * 4 + i) * 65 + tx * 4 + j] = p; }
#pragma unroll
            for (int x = 1; x < 16; x <<= 1) ps += __shfl_xor(ps, x);
            l[i] = l[i] * alpha + ps;
#pragma unroll
            for (int j = 0; j < 8; ++j) o[i][j] *= alpha;
        }
        __syncthreads();
        for (int c = 0; c < 64; ++c) { const f32x4 v0 = *(const f32x4*)&Vs[c * 132 + tx * 8], v1 = *(const f32x4*)&Vs[c * 132 + tx * 8 + 4];
            const float vv[8] = {v0.x, v0.y, v0.z, v0.w, v1.x, v1.y, v1.z, v1.w};
#pragma unroll
            for (int i = 0; i < 4; ++i) { const float p = Ps[(ty * 4 + i) * 65 + c];
#pragma unroll
                for (int j = 0; j < 8; ++j) o[i][j] += p * vv[j]; } }
    }
#pragma unroll
    for (int i = 0; i < 4; ++i) { const float il = 1.0f / l[i]; u32x4 w; w.x = pk2(o[i][0] * il, o[i][1] * il); w.y = pk2(o[i][2] * il, o[i][3] * il); w.z = pk2(o[i][4] * il, o[i][5] * il); w.w = pk2(o[i][6] * il, o[i][7] * il);
        *(u32x4*)(a.O + (qrow0 + ty * 4 + i) * a.ldo + h * a.ohs + tx * 8) = w; }
}

__global__ __launch_bounds__(256) void k_router(const float* H, const float* RWT, const float* rg_b, const float* re_b, float* RS2, int* cnt, int* list, float* gw) {
    const int t = blockIdx.x * 4 + (threadIdx.x >> 6), lane = threadIdx.x & 63;
    const f32x4* x = (const f32x4*)(H + (size_t)t * D) + lane; f32x4 v[8]; float ss = 0.f;
#pragma unroll
    for (int j = 0; j < 8; ++j) { v[j] = x[64 * j]; ss += (v[j].x * v[j].x + v[j].y * v[j].y) + (v[j].z * v[j].z + v[j].w * v[j].w); }
    ss = wave_sum(ss); const float rs = rsqrtf(ss * (1.0f / D) + EPS);
    float mine = 0.f;
    for (int n = 0; n < 36; ++n) { const f32x4* w = (const f32x4*)(RWT + (size_t)n * D) + lane; float p = 0.f;
#pragma unroll
        for (int j = 0; j < 8; ++j) { const f32x4 ww = w[64 * j]; p += (v[j].x * ww.x + v[j].y * ww.y) + (v[j].z * ww.z + v[j].w * ww.w); }
        p = wave_sum(p); const float bias = n < 4 ? rg_b[n] : re_b[n - 4]; if (lane == n) mine = p * rs + bias; }
    const float g0 = __shfl(mine, 0), g1 = __shfl(mine, 1), g2 = __shfl(mine, 2), g3 = __shfl(mine, 3);
    int gs = 0; float gm = g0; if (g1 > gm) { gm = g1; gs = 1; } if (g2 > gm) { gm = g2; gs = 2; } if (g3 > gm) { gm = g3; gs = 3; }
    const float gp = 1.0f / (__expf(g0 - gm) + __expf(g1 - gm) + __expf(g2 - gm) + __expf(g3 - gm));
    float ev[8];
#pragma unroll
    for (int i = 0; i < 8; ++i) ev[i] = __shfl(mine, 4 + gs * 8 + i);
    int i0 = 0; float m0 = ev[0];
#pragma unroll
    for (int i = 1; i < 8; ++i) if (ev[i] > m0) { m0 = ev[i]; i0 = i; }
    int i1 = -1; float m1 = -3.0e38f;
#pragma unroll
    for (int i = 0; i < 8; ++i) if (i != i0 && ev[i] > m1) { m1 = ev[i]; i1 = i; }
    const float e1 = __expf(m1 - m0), w0 = gp / (1.0f + e1), w1 = gp * e1 / (1.0f + e1);
    if (lane == 0) { RS2[t] = rs;
        const int ea = gs * 8 + i0, eb = gs * 8 + i1;
        const int pa = atomicAdd(&cnt[ea], 1); list[(size_t)ea * CAP + pa] = 2 * t; gw[2 * t] = w0;
        const int pb = atomicAdd(&cnt[eb], 1); list[(size_t)eb * CAP + pb] = 2 * t + 1; gw[2 * t + 1] = w1; }
}


#define LAS __attribute__((address_space(3)))
typedef short bf16x8 __attribute__((ext_vector_type(8)));
namespace fg {
constexpr int BM = 256, BK = 64, HALF = 128, HTB = HALF * BK * 2, STAGE_BYTES = 8 * HTB, NXCD = 8, WGM = 8;
DI int lds_byte(int r, int c) { const int st = (r >> 4) * 2 + (c >> 5), rr = r & 15, cc = c & 31, ob = rr * 64 + cc * 2; return st * 1024 + (ob ^ (((ob >> 9) & 1) << 5)); }
DI void stage_rc(int b, int& R, int& C) { const int st = b / 1024, sb = b % 1024, swz = sb ^ (((sb >> 9) & 1) << 5); R = (st >> 1) * 16 + swz / 64; C = (st & 1) * 32 + (swz % 64) / 2; }
DI int perm32(int rho) { const int n = rho >> 4, i = rho & 15; return 8 * (i >> 2) + 4 * n + (i & 3); }
DI unsigned cvt_pk_bf16(float lo, float hi) { unsigned r; asm volatile("v_cvt_pk_bf16_f32 %0, %1, %2" : "=v"(r) : "v"(lo), "v"(hi)); return r; }
struct Unit { int pm, pn, e, r0, cnt; };

struct ProbDense {
    const char* A0; const char* B0; const char* A1; const char* B1; int nM, nN, nN0, K, lda, pool, G, c;
    static constexpr bool GATHER = false;
    DI bool next(int i, Unit& u) const {
        const long L = (long)i * G + c; const int nwg = nM * nN; if (L >= nwg) return false;
        int wgid = (int)L; { const int q = nwg / NXCD, r = nwg % NXCD, xcd = wgid % NXCD, off = wgid / NXCD; wgid = (xcd < r ? xcd * (q + 1) : r * (q + 1) + (xcd - r) * q) + off; }
        const int nig = WGM * nN, gid = wgid / nig, fm = gid * WGM, gsz = (nM - fm) < WGM ? (nM - fm) : WGM;
        u.pm = fm + ((wgid % nig) % gsz); u.pn = (wgid % nig) / gsz; u.e = 0; u.r0 = 0; u.cnt = 256; return true; }
    DI const char* aptr(const Unit& u) const { return (u.pn < nN0 ? A0 : A1) + (size_t)u.pm * 256 * lda * 2 + (pool ? (size_t)(u.pn >> 1) * 1024 : 0); }
    DI const char* bptr(const Unit& u) const { return u.pn < nN0 ? B0 + (size_t)u.pn * 256 * K * 2 : B1 + (size_t)(u.pn - nN0) * 256 * K * 2; }
    DI void avoff(const Unit&, const int (&R)[2], const int (&C)[2], unsigned (&vo)[2][2]) const {
#pragma unroll
        for (int h = 0; h < 2; ++h)
#pragma unroll
            for (int i = 0; i < 2; ++i) vo[h][i] = (unsigned)((h * 128 + R[i]) * lda + C[i]) * 2u; }
};
struct ProbMoe {
    const char* A; const char* Bt; const int* list; const LAS int* pref; int npn, K, lda, gather, G, c; long estride;
    static constexpr bool GATHER = true;
    DI bool next(int i, Unit& u) const {
        const int L = i * G + c, tile = L / npn; if (tile >= pref[32]) return false;
        int e = 0; while (pref[e + 1] <= tile) ++e;
        u.pm = tile; u.pn = L % npn; u.e = e; u.r0 = (tile - pref[e]) * 256; u.cnt = pref[64 + e]; return true; }
    DI const char* aptr(const Unit& u) const { return gather ? A : A + (size_t)u.pm * 256 * lda * 2; }
    DI const char* bptr(const Unit& u) const { return Bt + (size_t)u.e * estride + (size_t)u.pn * 256 * K * 2; }
    DI void avoff(const Unit& u, const int (&R)[2], const int (&C)[2], unsigned (&vo)[2][2]) const {
#pragma unroll
        for (int h = 0; h < 2; ++h)
#pragma unroll
            for (int i = 0; i < 2; ++i) { const int row = h * 128 + R[i];
                if (gather) { const int ri = u.r0 + row; const int tok = ri < u.cnt ? (list[(size_t)u.e * CAP + ri] >> 1) : 0; vo[h][i] = (unsigned)(tok * lda + C[i]) * 2u; }
                else vo[h][i] = (unsigned)(row * lda + C[i]) * 2u; } }
};

typedef f32x4 Acc[2][2][4][2];
DI float quad_sum(float s) { s += __shfl_xor(s, 16); s += __shfl_xor(s, 32); return s; }
DI float sq8(const f32x4& a, const f32x4& b) { return ((a.x * a.x + a.y * a.y) + (a.z * a.z + a.w * a.w)) + ((b.x * b.x + b.y * b.y) + (b.z * b.z + b.w * b.w)); }
DI u32x4 pack8(const f32x4& a, const f32x4& b) { u32x4 w; w.x = cvt_pk_bf16(a.x, a.y); w.y = cvt_pk_bf16(a.z, a.w); w.z = cvt_pk_bf16(b.x, b.y); w.w = cvt_pk_bf16(b.z, b.w); return w; }
template <int NP> DI float rs_from_parts(const float* part, int r, int fq, float inv_n) {
    float s;
    if (NP == 32) { const f32x4 a = *(const f32x4*)(part + (size_t)r * 32 + fq * 8), b = *(const f32x4*)(part + (size_t)r * 32 + fq * 8 + 4); s = ((a.x + a.y) + (a.z + a.w)) + ((b.x + b.y) + (b.z + b.w)); }
    else { const float* p = part + (size_t)r * 8 + fq * 2; s = p[0] + p[1]; }
    s = quad_sum(s); return rsqrtf(s * inv_n + EPS);
}
DI void rope8(f32x4& a, f32x4& b, const float* COS, const float* SIN, int r, int i0) {
    const f32x4 c = *(const f32x4*)(COS + (size_t)r * 32 + i0), s = *(const f32x4*)(SIN + (size_t)r * 32 + i0);
    const f32x4 a2 = {a.x * c.x - a.y * s.x, a.y * c.x + a.x * s.x, a.z * c.y - a.w * s.y, a.w * c.y + a.z * s.y};
    const f32x4 b2 = {b.x * c.z - b.y * s.z, b.y * c.z + b.x * s.z, b.z * c.w - b.w * s.w, b.w * c.w + b.z * s.w};
    a = a2; b = b2;
}
template <bool STATS> struct EpiRes {
    float* H; bf16_t* HB; float* SSP;
    DI void operator()(const Acc& acc, const Unit& u, int wr, int wc, int fr, int fq) const {
#pragma unroll
        for (int ai = 0; ai < 2; ++ai)
#pragma unroll
            for (int m = 0; m < 4; ++m) { const int r = u.pm * BM + ai * HALF + wr * 64 + m * 16 + fr; float ss = 0.f;
#pragma unroll
                for (int bj = 0; bj < 2; ++bj) { const int c0 = u.pn * BM + bj * HALF + wc * 32 + 8 * fq; float* hp = H + (size_t)r * D + c0;
                    const f32x4 h0 = *(const f32x4*)hp + acc[ai][bj][m][0], h1 = *(const f32x4*)(hp + 4) + acc[ai][bj][m][1];
                    *(f32x4*)hp = h0; *(f32x4*)(hp + 4) = h1; *(u32x4*)(HB + (size_t)r * D + c0) = pack8(h0, h1); if (STATS) ss += sq8(h0, h1); }
                if (STATS) { ss = quad_sum(ss); if (fq == 0) SSP[(size_t)r * 32 + u.pn * 4 + wc] = ss; }
                asm volatile("" ::: "memory"); }
    }
};
template <int MODE  > struct EpiBf16RS {
    bf16_t* O; int ldo; const float* rs;
    DI void operator()(const Acc& acc, const Unit& u, int wr, int wc, int fr, int fq) const {
#pragma unroll
        for (int ai = 0; ai < 2; ++ai)
#pragma unroll
            for (int m = 0; m < 4; ++m) { const int r = u.pm * BM + ai * HALF + wr * 64 + m * 16 + fr;
                const float sc = MODE == 1 ? rs[r] : rs_from_parts<32>(rs, r, fq, 1.0f / D);
#pragma unroll
                for (int bj = 0; bj < 2; ++bj) { const int c0 = u.pn * BM + bj * HALF + wc * 32 + 8 * fq;
                    *(u32x4*)(O + (size_t)r * ldo + c0) = pack8(acc[ai][bj][m][0] * sc, acc[ai][bj][m][1] * sc); } }
    }
};
struct EpiDQ {
    bf16_t* CQ; bf16_t* CKV; bf16_t* KR; const float* RS0; float* LSQ; float* LSKV; const float* COS; const float* SIN;
    DI void operator()(const Acc& acc, const Unit& u, int wr, int wc, int fr, int fq) const {
#pragma unroll
        for (int ai = 0; ai < 2; ++ai)
#pragma unroll
            for (int m = 0; m < 4; ++m) { const int r = u.pm * BM + ai * HALF + wr * 64 + m * 16 + fr; const float sc = RS0[r]; float ss = 0.f;
#pragma unroll
                for (int bj = 0; bj < 2; ++bj) { const int cl = bj * HALF + wc * 32 + 8 * fq; f32x4 v0 = acc[ai][bj][m][0] * sc, v1 = acc[ai][bj][m][1] * sc;
                    if (u.pn < 4) { ss += sq8(v0, v1); bf16_t* o = (u.pn < 2 ? CQ : CKV) + (size_t)r * 512 + (u.pn & 1) * 256 + cl; *(u32x4*)o = pack8(v0, v1); }
                    else if (cl < 64) { rope8(v0, v1, COS, SIN, r, cl >> 1); *(u32x4*)(KR + (size_t)r * 64 + cl) = pack8(v0, v1); } }
                if (u.pn < 4) { ss = quad_sum(ss); if (fq == 0) (u.pn < 2 ? LSQ : LSKV)[(size_t)r * 8 + (u.pn & 1) * 4 + wc] = ss; } }
    }
};
struct EpiUQ {
    bf16_t* Q; bf16_t* KN; bf16_t* V; const float* LSQ; const float* LSKV; const float* COS; const float* SIN;
    DI void operator()(const Acc& acc, const Unit& u, int wr, int wc, int fr, int fq) const {
        const bool isq = u.pn < 12;
#pragma unroll
        for (int ai = 0; ai < 2; ++ai)
#pragma unroll
            for (int m = 0; m < 4; ++m) { const int r = u.pm * BM + ai * HALF + wr * 64 + m * 16 + fr;
                const float sc = rs_from_parts<8>(isq ? LSQ : LSKV, r, fq, 1.0f / 512.0f);
#pragma unroll
                for (int bj = 0; bj < 2; ++bj) { f32x4 v0 = acc[ai][bj][m][0] * sc, v1 = acc[ai][bj][m][1] * sc;
                    if (isq) { const int c0 = u.pn * BM + bj * HALF + wc * 32 + 8 * fq, hc = c0 % QKD;
                        if (hc >= NOPE) rope8(v0, v1, COS, SIN, r, (hc - NOPE) >> 1);
                        *(u32x4*)(Q + (size_t)r * NQ + c0) = pack8(v0, v1); }
                    else { const int c0 = (u.pn - 12) * BM + bj * HALF + wc * 32 + 8 * fq;
                        *(u32x4*)((c0 < 2048 ? KN + c0 : V + (c0 - 2048)) + (size_t)r * D) = pack8(v0, v1); } } }
    }
};
struct EpiMoe1 {
    bf16_t* HH; const float* RS2; const int* list;
    DI void operator()(const Acc& acc, const Unit& u, int wr, int wc, int fr, int fq) const {
#pragma unroll
        for (int ai = 0; ai < 2; ++ai)
#pragma unroll
            for (int m = 0; m < 4; ++m) { const int lr = ai * HALF + wr * 64 + m * 16 + fr, ri = u.r0 + lr;
                if (ri < u.cnt) { const float sc = RS2[list[(size_t)u.e * CAP + ri] >> 1];
                    const f32x4 g0 = acc[ai][0][m][0] * sc, g1 = acc[ai][0][m][1] * sc, u0 = acc[ai][1][m][0] * sc, u1 = acc[ai][1][m][1] * sc;
                    const f32x4 h0 = {silu(g0.x) * u0.x, silu(g0.y) * u0.y, silu(g0.z) * u0.z, silu(g0.w) * u0.w}, h1 = {silu(g1.x) * u1.x, silu(g1.y) * u1.y, silu(g1.z) * u1.z, silu(g1.w) * u1.w};
                    *(u32x4*)(HH + (size_t)(u.pm * BM + lr) * EFF + u.pn * 128 + wc * 32 + 8 * fq) = pack8(h0, h1); } }
    }
};
struct EpiMoe2 {
    bf16_t* Y; const float* GW; const int* list;
    DI void operator()(const Acc& acc, const Unit& u, int wr, int wc, int fr, int fq) const {
#pragma unroll
        for (int ai = 0; ai < 2; ++ai)
#pragma unroll
            for (int m = 0; m < 4; ++m) { const int lr = ai * HALF + wr * 64 + m * 16 + fr, ri = u.r0 + lr;
                if (ri < u.cnt) { const int a = list[(size_t)u.e * CAP + ri]; const float sc = GW[a];
#pragma unroll
                    for (int bj = 0; bj < 2; ++bj) { const int c0 = u.pn * BM + bj * HALF + wc * 32 + 8 * fq;
                        *(u32x4*)(Y + (size_t)a * D + c0) = pack8(acc[ai][bj][m][0] * sc, acc[ai][bj][m][1] * sc); } } }
    }
};

template <class Epi, class Prob>
DI void gemm_phase(LAS unsigned char* lds, const Prob& P, const Epi& E) {
    const int tid = threadIdx.x, wid = __builtin_amdgcn_readfirstlane(tid >> 6), lane = tid & 63, wr = wid >> 2, wc = wid & 3, fr = lane & 15, fq = lane >> 4;
    const int K = P.K, nt = K / BK;
    int sR[2], sC[2]; unsigned voffB[2];
#pragma unroll
    for (int i = 0; i < 2; ++i) { stage_rc(tid * 16 + i * 8192, sR[i], sC[i]); const int Rb = (sR[i] & ~31) + perm32(sR[i] & 31); voffB[i] = (unsigned)(Rb * K + sC[i]) * 2u; }
    const size_t kstep = (size_t)(BK * 2), hstepB = (size_t)HALF * K * 2;
    const unsigned ldsw = (unsigned)wid * 1024u;
    const int aoff = lds_byte(wr * 64 + fr, fq * 8), boff = lds_byte(wc * 32 + fr, fq * 8);
#define PG8_SA(b, h) (((b) * 2 + (h)) * HTB)
#define PG8_SB(b, h) ((4 + (b) * 2 + (h)) * HTB)
#define PG8_STAGE(bufoff, gbase, voff) do { _Pragma("unroll") for (int _i = 0; _i < 2; ++_i) \
        __builtin_amdgcn_global_load_lds((const unsigned*)((const char*)(gbase) + (voff)[_i]), (LAS unsigned*)(lds + (bufoff) + ldsw + _i * 8192), 16, 0, 0); } while (0)
#define PG8_LDA(dst, b, h) do { _Pragma("unroll") for (int m = 0; m < 4; ++m) _Pragma("unroll") for (int k = 0; k < 2; ++k) dst[m][k] = *(const LAS bf16x8*)(lds + PG8_SA(b, h) + aoff + m * 2048 + k * 1024); } while (0)
#define PG8_LDB(dst, b, h) do { _Pragma("unroll") for (int n = 0; n < 2; ++n) _Pragma("unroll") for (int k = 0; k < 2; ++k) dst[n][k] = *(const LAS bf16x8*)(lds + PG8_SB(b, h) + boff + n * 2048 + k * 1024); } while (0)
#define PG8_MMA(ai, bj, At, Bt) do { __builtin_amdgcn_s_setprio(1); _Pragma("unroll") for (int m = 0; m < 4; ++m) _Pragma("unroll") for (int n = 0; n < 2; ++n) _Pragma("unroll") for (int k = 0; k < 2; ++k) \
        acc[ai][bj][m][n] = __builtin_amdgcn_mfma_f32_16x16x32_bf16(Bt[n][k], At[m][k], acc[ai][bj][m][n], 0, 0, 0); __builtin_amdgcn_s_setprio(0); } while (0)
#define PG8_WAIT_V(n) asm volatile("s_waitcnt vmcnt(" #n ")" ::: "memory")
#define PG8_WAIT_L(n) asm volatile("s_waitcnt lgkmcnt(" #n ")" ::: "memory")
#define PG8_BAR __builtin_amdgcn_s_barrier()
#define PG8_SCHED __builtin_amdgcn_sched_barrier(0)
    Unit cur, nxt; int ui = 0;
    if (!P.next(0, cur)) return;
    f32x4 acc[2][2][4][2];
#pragma unroll
    for (int a = 0; a < 2; ++a)
#pragma unroll
        for (int b = 0; b < 2; ++b)
#pragma unroll
            for (int m = 0; m < 4; ++m)
#pragma unroll
                for (int n = 0; n < 2; ++n) acc[a][b][m][n] = (f32x4){0.f, 0.f, 0.f, 0.f};
    bf16x8 At[4][2], B0[2][2], B1[2][2];
    const char* cA = P.aptr(cur); const char* cB = P.bptr(cur);
    unsigned voA[2][2], vnA[2][2];
    P.avoff(cur, sR, sC, voA);
    if constexpr (Prob::GATHER) asm volatile("s_waitcnt vmcnt(0)" ::: "memory");
    PG8_STAGE(PG8_SB(0, 0), cB, voffB); PG8_STAGE(PG8_SB(0, 1), cB + hstepB, voffB); PG8_STAGE(PG8_SA(0, 0), cA, voA[0]); PG8_STAGE(PG8_SA(0, 1), cA, voA[1]);
    if (wr == 1) PG8_BAR;
    PG8_WAIT_V(2); PG8_BAR;
    PG8_STAGE(PG8_SB(1, 0), cB + kstep, voffB); PG8_STAGE(PG8_SA(1, 0), cA + kstep, voA[0]); PG8_STAGE(PG8_SB(1, 1), cB + hstepB + kstep, voffB);
    PG8_WAIT_V(6); PG8_BAR;
    for (;;) {
        const bool has_next = P.next(ui + 1, nxt);
        const char* nA = has_next ? P.aptr(nxt) : cA; const char* nB = has_next ? P.bptr(nxt) : cB;
#pragma unroll
        for (int h = 0; h < 2; ++h)
#pragma unroll
            for (int i = 0; i < 2; ++i) vnA[h][i] = voA[h][i];
        for (int t = 0; t < nt; t += 2) {
            const bool last = (t == nt - 2);
            if constexpr (Prob::GATHER) { if (last && has_next) P.avoff(nxt, sR, sC, vnA); }
            const char* a1 = cA + (size_t)(t + 1) * kstep;
            const char* a2 = last ? nA : cA + (size_t)(t + 2) * kstep; const char* b2 = last ? nB : cB + (size_t)(t + 2) * kstep;
            const char* a3 = a2 + kstep; const char* b3 = b2 + kstep;
            unsigned w0[2], w1[2];
#pragma unroll
            for (int i = 0; i < 2; ++i) { w0[i] = last ? vnA[0][i] : voA[0][i]; w1[i] = last ? vnA[1][i] : voA[1][i]; }
            PG8_LDB(B0, 0, 0); PG8_LDB(B1, 0, 1); PG8_SCHED; PG8_LDA(At, 0, 0); PG8_STAGE(PG8_SA(1, 1), a1, voA[1]);
            PG8_WAIT_V(8); PG8_WAIT_L(0); PG8_BAR; PG8_MMA(0, 0, At, B0); PG8_MMA(0, 1, At, B1); PG8_BAR; PG8_SCHED;
            PG8_LDA(At, 0, 1); PG8_STAGE(PG8_SB(0, 0), b2, voffB); PG8_STAGE(PG8_SB(0, 1), b2 + hstepB, voffB); PG8_STAGE(PG8_SA(0, 0), a2, w0);
            PG8_WAIT_V(8); PG8_WAIT_L(0); PG8_BAR; PG8_MMA(1, 0, At, B0); PG8_MMA(1, 1, At, B1); PG8_BAR; PG8_SCHED;
            PG8_LDB(B0, 1, 0); PG8_LDB(B1, 1, 1); PG8_SCHED; PG8_LDA(At, 1, 0); PG8_STAGE(PG8_SA(0, 1), a2, w1);
            PG8_WAIT_V(8); PG8_WAIT_L(0); PG8_BAR; PG8_MMA(0, 0, At, B0); PG8_MMA(0, 1, At, B1); PG8_BAR; PG8_SCHED;
            PG8_LDA(At, 1, 1); PG8_STAGE(PG8_SB(1, 0), b3, voffB); PG8_STAGE(PG8_SB(1, 1), b3 + hstepB, voffB); PG8_STAGE(PG8_SA(1, 0), a3, w0);
            PG8_WAIT_V(8); PG8_WAIT_L(0); PG8_BAR; PG8_MMA(1, 0, At, B0); PG8_MMA(1, 1, At, B1); PG8_BAR; PG8_SCHED;
        }
        if (wr == 0) PG8_BAR;
        E(acc, cur, wr, wc, fr, fq);
        if (!has_next) break;
#pragma unroll
        for (int a = 0; a < 2; ++a)
#pragma unroll
            for (int b = 0; b < 2; ++b)
#pragma unroll
                for (int m = 0; m < 4; ++m)
#pragma unroll
                    for (int n = 0; n < 2; ++n) acc[a][b][m][n] = (f32x4){0.f, 0.f, 0.f, 0.f};
        cur = nxt; cA = nA; cB = nB; ++ui;
#pragma unroll
        for (int h = 0; h < 2; ++h)
#pragma unroll
            for (int i = 0; i < 2; ++i) voA[h][i] = vnA[h][i];
        if (wr == 1) PG8_BAR;
    }
    PG8_WAIT_V(0);
    PG8_BAR;
#undef PG8_SA
#undef PG8_SB
#undef PG8_STAGE
#undef PG8_LDA
#undef PG8_LDB
#undef PG8_MMA
#undef PG8_WAIT_V
#undef PG8_WAIT_L
#undef PG8_BAR
#undef PG8_SCHED
}
}


namespace fa {
typedef float f32x16 __attribute__((ext_vector_type(16)));
typedef short s16x4 __attribute__((ext_vector_type(4)));
#define SBAR() __builtin_amdgcn_sched_barrier(0)
constexpr float THR = 8.f, LOG2E = 1.4426950408889634f;
DI int crow(int r, int hi) { return (r & 3) + 8 * (r >> 2) + 4 * hi; }
DI unsigned cvtpk(float lo, float hi) { unsigned r; asm volatile("v_cvt_pk_bf16_f32 %0, %1, %2" : "=v"(r) : "v"(lo), "v"(hi)); return r; }
DI void partialSM(f32x16& p0, f32x16& p1, float& m_reg, float& mn, float& alpha) {
    float pmax = p0[0];
#pragma unroll
    for (int r = 1; r < 16; ++r) pmax = fmaxf(pmax, p0[r]);
#pragma unroll
    for (int r = 0; r < 16; ++r) pmax = fmaxf(pmax, p1[r]);
    { auto rr = __builtin_amdgcn_permlane32_swap(__float_as_uint(pmax), __float_as_uint(pmax), false, false); pmax = fmaxf(__uint_as_float(rr[0]), __uint_as_float(rr[1])); }
    if (__builtin_expect(__all(pmax - m_reg <= THR), 1)) { mn = m_reg; alpha = 1.f; }
    else { mn = fmaxf(m_reg, pmax); alpha = __builtin_amdgcn_exp2f((m_reg - mn) * LOG2E); m_reg = mn; }
    const float mnC = -mn * LOG2E;
#pragma unroll
    for (int r = 0; r < 16; ++r) p0[r] = fmaf(p0[r], LOG2E, mnC);
#pragma unroll
    for (int r = 0; r < 16; ++r) p1[r] = fmaf(p1[r], LOG2E, mnC);
#pragma unroll
    for (int r = 0; r < 16; ++r) p0[r] = __builtin_amdgcn_exp2f(p0[r]);
}
DI void finishSM(f32x16& p0, f32x16& p1, float alpha, float& l_reg, bf16x8& pa0, bf16x8& pa1, bf16x8& pa2, bf16x8& pa3) {
#pragma unroll
    for (int r = 0; r < 16; ++r) p1[r] = __builtin_amdgcn_exp2f(p1[r]);
    float ps = 0;
#pragma unroll
    for (int r = 0; r < 16; ++r) ps += p0[r];
#pragma unroll
    for (int r = 0; r < 16; ++r) ps += p1[r];
    { auto rr = __builtin_amdgcn_permlane32_swap(__float_as_uint(ps), __float_as_uint(ps), false, false); ps = __uint_as_float(rr[0]) + __uint_as_float(rr[1]); }
    l_reg = l_reg * alpha + ps;
#define PK4(P, BASE, OUT) do { unsigned a0 = cvtpk(P[BASE + 0], P[BASE + 1]), a1 = cvtpk(P[BASE + 2], P[BASE + 3]);   \
    unsigned b0 = cvtpk(P[BASE + 4], P[BASE + 5]), b1 = cvtpk(P[BASE + 6], P[BASE + 7]);                              \
    auto r0 = __builtin_amdgcn_permlane32_swap(a0, b0, false, false); auto r1 = __builtin_amdgcn_permlane32_swap(a1, b1, false, false); \
    u32x4 w = {r0[0], r1[0], r0[1], r1[1]}; OUT = *reinterpret_cast<bf16x8*>(&w); } while (0)
    PK4(p0, 0, pa0); PK4(p0, 8, pa1); PK4(p1, 0, pa2); PK4(p1, 8, pa3);
#undef PK4
}
template <int DQK> DI void qkt(f32x16& p0, f32x16& p1, LAS const char* Ks, const int (&kb)[4], const bf16x8* qr) {
    constexpr int KROW = DQK * 2;
#pragma unroll
    for (int r = 0; r < 16; ++r) { p0[r] = 0.f; p1[r] = 0.f; }
#pragma unroll
    for (int d0 = 0; d0 < DQK / 16; ++d0) {
        const bf16x8 b0 = *(LAS const bf16x8*)(Ks + kb[d0 & 3] + (d0 >> 2) * 128);
        const bf16x8 b1 = *(LAS const bf16x8*)(Ks + kb[d0 & 3] + (d0 >> 2) * 128 + 32 * KROW);
        p0 = __builtin_amdgcn_mfma_f32_32x32x16_bf16(b0, qr[d0], p0, 0, 0, 0);
        p1 = __builtin_amdgcn_mfma_f32_32x32x16_bf16(b1, qr[d0], p1, 0, 0, 0); }
}
DI int v_rd_base(int lane) { return ((lane & 3) << 3) | (((lane >> 2) & 3) << 6) | (((lane >> 4) & 1) << 5) | (((lane >> 5) & 1) << 8); }
constexpr int v_rd_off(int d0, int ks, int half) { return d0 * 512 + ks * 4096 + half * 2048; }
template <int OFF> DI s16x4 tr_read(int vb) { s16x4 r; asm volatile("ds_read_b64_tr_b16 %0, %1 offset:%2" : "=&v"(r) : "v"(vb), "i"(OFF) : "memory"); return r; }
template <int D0> DI void pv_one(f32x16& od, int vb, bf16x8 pa0, bf16x8 pa1, bf16x8 pa2, bf16x8 pa3) {
    const s16x4 l0 = tr_read<v_rd_off(D0, 0, 0)>(vb), h0 = tr_read<v_rd_off(D0, 0, 1)>(vb), l1 = tr_read<v_rd_off(D0, 1, 0)>(vb), h1 = tr_read<v_rd_off(D0, 1, 1)>(vb);
    const s16x4 l2 = tr_read<v_rd_off(D0, 2, 0)>(vb), h2 = tr_read<v_rd_off(D0, 2, 1)>(vb), l3 = tr_read<v_rd_off(D0, 3, 0)>(vb), h3 = tr_read<v_rd_off(D0, 3, 1)>(vb);
    asm volatile("s_waitcnt lgkmcnt(0)" ::: "memory"); SBAR();
#define PK(L, H) (bf16x8){L[0], L[1], L[2], L[3], H[0], H[1], H[2], H[3]}
    od = __builtin_amdgcn_mfma_f32_32x32x16_bf16(pa0, PK(l0, h0), od, 0, 0, 0);
    od = __builtin_amdgcn_mfma_f32_32x32x16_bf16(pa1, PK(l1, h1), od, 0, 0, 0);
    od = __builtin_amdgcn_mfma_f32_32x32x16_bf16(pa2, PK(l2, h2), od, 0, 0, 0);
    od = __builtin_amdgcn_mfma_f32_32x32x16_bf16(pa3, PK(l3, h3), od, 0, 0, 0);
#undef PK
}
DI void pv_d0(f32x16* o, int vb, bf16x8 pa0, bf16x8 pa1, bf16x8 pa2, bf16x8 pa3) {
    pv_one<0>(o[0], vb, pa0, pa1, pa2, pa3); pv_one<1>(o[1], vb, pa0, pa1, pa2, pa3); pv_one<2>(o[2], vb, pa0, pa1, pa2, pa3); pv_one<3>(o[3], vb, pa0, pa1, pa2, pa3);
}
template <int DQK, bool CAUSAL>
DI void attn_unit(LAS char* lds, const bf16_t* Qb, int ldq, const bf16_t* K1, int ldk1, const bf16_t* K2, int ldk2, const bf16_t* Vb, int ldv, bf16_t* Ob, int ldo, int NT, int qtile0) {
    constexpr int KROW = DQK * 2, KT = 64 * KROW, BUF = KT + 16384, NKP = DQK / 64, ND0 = DQK / 16;
    const int tid = threadIdx.x, wid = __builtin_amdgcn_readfirstlane(tid >> 6), lane = tid & 63, r32 = lane & 31, hi = lane >> 5;
    LAS float* wsf = (LAS float*)(lds + 3 * BUF) + wid * 64; LAS float* li_l = wsf; LAS float* al_l = wsf + 32;
    const char* kp[NKP]; int kst[NKP]; const char* vp[2];
#pragma unroll
    for (int i = 0; i < NKP; ++i) { const int p = (wid * NKP + i) * 1024 + lane * 16, row = p / KROW, cbs = p % KROW, cb = cbs ^ ((row & 7) << 4);
        if (DQK == 128 || cb < 256) { kp[i] = (const char*)K1 + (size_t)row * ldk1 * 2 + cb; kst[i] = 64 * ldk1 * 2; }
        else { kp[i] = (const char*)K2 + (size_t)row * ldk2 * 2 + (cb - 256); kst[i] = 64 * ldk2 * 2; } }
#pragma unroll
    for (int i = 0; i < 2; ++i) { const int p = (wid * 2 + i) * 1024 + lane * 16, sub = p >> 9, q = (p & 511) >> 1, kk = (sub >> 2) * 8 + (q >> 5), k = (kk & ~0xC) | ((kk & 4) << 1) | ((kk & 8) >> 1), c = (sub & 3) * 32 + (q & 31);
        vp[i] = (const char*)Vb + ((size_t)k * ldv + c) * 2; }
    const int vstep = 64 * ldv * 2;
#define FA_DMA(bo) do { _Pragma("unroll") for (int _i = 0; _i < NKP; ++_i) { __builtin_amdgcn_global_load_lds((const unsigned*)kp[_i], (LAS unsigned*)(lds + (bo) + (wid * NKP + _i) * 1024), 16, 0, 0); kp[_i] += kst[_i]; } \
        _Pragma("unroll") for (int _i = 0; _i < 2; ++_i) { __builtin_amdgcn_global_load_lds((const unsigned*)vp[_i], (LAS unsigned*)(lds + (bo) + KT + (wid * 2 + _i) * 1024), 16, 0, 0); vp[_i] += vstep; } } while (0)
#define FA_SYNC() do { asm volatile("s_waitcnt vmcnt(0)" ::: "memory"); __builtin_amdgcn_s_barrier(); asm volatile("" ::: "memory"); } while (0)
    int bm1 = 0, bc = BUF, bp1 = 2 * BUF;
    FA_DMA(bm1); FA_DMA(bc);
    bf16x8 qr[ND0];
    { const bf16_t* Qw = Qb + (size_t)(wid * 32 + r32) * ldq + hi * 8;
#pragma unroll
      for (int d0 = 0; d0 < ND0; ++d0) qr[d0] = *(const bf16x8*)(Qw + d0 * 16); }
    int kb[4];
#pragma unroll
    for (int q = 0; q < 4; ++q) kb[q] = r32 * KROW + ((q * 32 + hi * 16) ^ ((r32 & 7) << 4));
    const int vb0 = (int)(uintptr_t)lds + KT + v_rd_base(lane);
    const int lim = CAUSAL ? qtile0 + (wid >> 1) : 0x7fffffff;
    float m_reg = -1e30f, l_reg = 0; f32x16 o[4];
#pragma unroll
    for (int d = 0; d < 4; ++d)
#pragma unroll
        for (int r = 0; r < 16; ++r) o[d][r] = 0.f;
    f32x16 pA0, pA1, pB0, pB1; float mnA, mnB, alA, alB; bf16x8 pa0, pa1, pa2, pa3;
#define FA_MASK(P0, P1, j) do { if (CAUSAL && (j) > lim) { _Pragma("unroll") for (int _r = 0; _r < 16; ++_r) { P0[_r] = -1e30f; P1[_r] = -1e30f; } } } while (0)
#define FA_RESC(a) do { if (__any((a) < 1.f)) { if (hi == 0) al_l[r32] = (a); asm volatile("s_waitcnt lgkmcnt(0)" ::: "memory"); \
        _Pragma("unroll") for (int _d = 0; _d < 4; ++_d) _Pragma("unroll") for (int _r = 0; _r < 16; ++_r) o[_d][_r] *= al_l[crow(_r, hi)]; } } while (0)
#define FA_ROT() do { const int _t = bm1; bm1 = bc; bc = bp1; bp1 = _t; } while (0)
    FA_SYNC();
    FA_DMA(bp1);
    qkt<DQK>(pA0, pA1, lds + bm1, kb, qr); partialSM(pA0, pA1, m_reg, mnA, alA);
    for (int j = 1; j + 1 < NT; j += 2) {
        SBAR(); qkt<DQK>(pB0, pB1, lds + bc, kb, qr);
        finishSM(pA0, pA1, alA, l_reg, pa0, pa1, pa2, pa3); SBAR();
        pv_d0(o, vb0 + bm1, pa0, pa1, pa2, pa3); FA_MASK(pB0, pB1, j); partialSM(pB0, pB1, m_reg, mnB, alB);
        FA_SYNC(); if (j + 2 < NT) FA_DMA(bm1);
        FA_RESC(alB); FA_ROT();
        SBAR(); qkt<DQK>(pA0, pA1, lds + bc, kb, qr);
        finishSM(pB0, pB1, alB, l_reg, pa0, pa1, pa2, pa3); SBAR();
        pv_d0(o, vb0 + bm1, pa0, pa1, pa2, pa3); FA_MASK(pA0, pA1, j + 1); partialSM(pA0, pA1, m_reg, mnA, alA);
        FA_SYNC(); if (j + 3 < NT) FA_DMA(bm1);
        FA_RESC(alA); FA_ROT();
    }
    SBAR(); qkt<DQK>(pB0, pB1, lds + bc, kb, qr);
    finishSM(pA0, pA1, alA, l_reg, pa0, pa1, pa2, pa3); SBAR();
    pv_d0(o, vb0 + bm1, pa0, pa1, pa2, pa3); FA_MASK(pB0, pB1, NT - 1); partialSM(pB0, pB1, m_reg, mnB, alB);
    FA_RESC(alB);
    finishSM(pB0, pB1, alB, l_reg, pa0, pa1, pa2, pa3); SBAR();
    pv_d0(o, vb0 + bc, pa0, pa1, pa2, pa3);
    if (hi == 0) li_l[r32] = l_reg; asm volatile("s_waitcnt lgkmcnt(0)" ::: "memory");
    float rli[16];
#pragma unroll
    for (int r = 0; r < 16; ++r) rli[r] = __builtin_amdgcn_rcpf(li_l[crow(r, hi)]);
    FA_SYNC();
    LAS char* Ot = lds + wid * 8704;
#pragma unroll
    for (int r = 0; r < 16; ++r)
#pragma unroll
        for (int d0 = 0; d0 < 4; ++d0) *(LAS bf16_t*)(Ot + crow(r, hi) * 272 + (d0 * 32 + r32) * 2) = (bf16_t)f2bf(o[d0][r] * rli[r]);
    asm volatile("s_waitcnt lgkmcnt(0)" ::: "memory");
#pragma unroll
    for (int i = 0; i < 8; ++i) { const int idx = i * 64 + lane, row = idx >> 4, c16 = idx & 15;
        const u32x4 v = *(LAS const u32x4*)(Ot + row * 272 + c16 * 16); *(u32x4*)(Ob + (size_t)(wid * 32 + row) * ldo + c16 * 8) = v; }
    asm volatile("s_waitcnt lgkmcnt(0)" ::: "memory"); __builtin_amdgcn_s_barrier(); asm volatile("" ::: "memory");
#undef FA_DMA
#undef FA_SYNC
#undef FA_MASK
#undef FA_RESC
#undef FA_ROT
}
DI int vcu_of(int bx, int G) { return (G % 8 == 0) ? (bx % 8) * (G / 8) + bx / 8 : bx; }
DI void mla_phase(LAS char* lds, const bf16_t* Q, const bf16_t* KN, const bf16_t* KR, const bf16_t* V, bf16_t* AO, int G, int bx) {
    const int v = vcu_of(bx, G);
    for (int p = v; p < NB * HEADS * 8; p += G) { const int bh = p >> 3, i = p & 7, b = bh / HEADS, h = bh % HEADS;
#pragma unroll 1
        for (int s = 0; s < 2; ++s) { const int qb = s ? 15 - i : i; const size_t row0 = (size_t)b * S + qb * 256, key0 = (size_t)b * S;
            attn_unit<192, true>(lds, Q + row0 * NQ + h * QKD, NQ, KN + key0 * D + h * NOPE, D, KR + key0 * ROPE, ROPE, V + key0 * D + h * VD, D, AO + row0 * D + h * VD, D, 4 * qb + 4, 4 * qb); } }
}
DI void memattn_phase(LAS char* lds, const bf16_t* MQ, const bf16_t* MK, const bf16_t* MV, bf16_t* MO, int G, int bx) {
    for (int u = bx; u < NB * MH * (S / 256); u += G) { const int qb = u % (S / 256), h = (u / (S / 256)) % MH, b = u / (S / 256 * MH); const size_t row0 = (size_t)b * S + qb * 256, key0 = (size_t)b * MEMT;
        attn_unit<128, false>(lds, MQ + row0 * MI + h * MHD, MI, MK + key0 * MI + h * MHD, MI, nullptr, 0, MV + key0 * MI + h * MHD, MI, MO + row0 * MI + h * MHD, MI, MEMT / 64, 0); }
}
}
struct FAArgs { const bf16_t* q; const bf16_t* k1; const bf16_t* k2; const bf16_t* v; bf16_t* o; };
template <int WHICH> __global__ __launch_bounds__(512, 2) void k_fattn(FAArgs a) {
    extern __shared__ __attribute__((aligned(16))) unsigned char lds_raw[];
    LAS char* lds = (LAS char*)lds_raw;
    if (WHICH == 0) fa::mla_phase(lds, a.q, a.k1, a.k2, a.v, a.o, gridDim.x, blockIdx.x);
    else fa::memattn_phase(lds, a.q, a.k1, a.v, a.o, gridDim.x, blockIdx.x);
}

constexpr int LDS_BYTES = 147456, LDS_MISC = 131072;
struct FArgs { const void* p[16]; int i[8]; };
template <int KIND> __global__ __launch_bounds__(512, 2) void k_fgemm(FArgs a) {
    extern __shared__ __attribute__((aligned(16))) unsigned char lds_raw[];
    LAS unsigned char* lds = (LAS unsigned char*)lds_raw;
    const int G = gridDim.x, c = blockIdx.x;
    if constexpr (KIND == K_MOE1 || KIND == K_MOE2) {
        LAS int* pref = (LAS int*)(lds + LDS_MISC + 1024);
        const int* cnt = (const int*)a.p[3];
        if (threadIdx.x < 32) pref[64 + threadIdx.x] = cnt[threadIdx.x];
        __syncthreads();
        if (threadIdx.x == 0) { int s = 0; for (int e = 0; e < NE; ++e) { pref[e] = s; s += (pref[64 + e] + 255) >> 8; } pref[32] = s; }
        __syncthreads();
        fg::ProbMoe P{(const char*)a.p[0], (const char*)a.p[1], (const int*)a.p[2], pref, a.i[0], a.i[1], a.i[2], KIND == K_MOE1 ? 1 : 0, G, c, (long)a.i[3] * 2};
        if constexpr (KIND == K_MOE1) { fg::EpiMoe1 E{(bf16_t*)a.p[4], (const float*)a.p[5], (const int*)a.p[2]}; fg::gemm_phase(lds, P, E); }
        else { fg::EpiMoe2 E{(bf16_t*)a.p[4], (const float*)a.p[5], (const int*)a.p[2]}; fg::gemm_phase(lds, P, E); }
    } else {
        fg::ProbDense P{(const char*)a.p[0], (const char*)a.p[1], (const char*)a.p[2], (const char*)a.p[3], a.i[0], a.i[1], a.i[2], a.i[3], a.i[4], a.i[5], G, c};
        if constexpr (KIND == K_RES) { if (a.i[6]) { fg::EpiRes<true> E{(float*)a.p[4], (bf16_t*)a.p[5], (float*)a.p[6]}; fg::gemm_phase(lds, P, E); } else { fg::EpiRes<false> E{(float*)a.p[4], (bf16_t*)a.p[5], nullptr}; fg::gemm_phase(lds, P, E); } }
        if constexpr (KIND == K_BF16RS) { if (a.i[6] == 1) { fg::EpiBf16RS<1> E{(bf16_t*)a.p[4], a.i[7], (const float*)a.p[5]}; fg::gemm_phase(lds, P, E); } else { fg::EpiBf16RS<2> E{(bf16_t*)a.p[4], a.i[7], (const float*)a.p[5]}; fg::gemm_phase(lds, P, E); } }
        if constexpr (KIND == K_DQ) { fg::EpiDQ E{(bf16_t*)a.p[4], (bf16_t*)a.p[5], (bf16_t*)a.p[6], (const float*)a.p[7], (float*)a.p[8], (float*)a.p[9], (const float*)a.p[10], (const float*)a.p[11]}; fg::gemm_phase(lds, P, E); }
        if constexpr (KIND == K_UQ) { fg::EpiUQ E{(bf16_t*)a.p[4], (bf16_t*)a.p[5], (bf16_t*)a.p[6], (const float*)a.p[7], (const float*)a.p[8], (const float*)a.p[9], (const float*)a.p[10]}; fg::gemm_phase(lds, P, E); }
    }
}


#ifndef FASTMASK
#define FASTMASK 0x1ff
#endif
constexpr unsigned FAST = FASTMASK;
static int g_grid = 256;
template <int KIND> static void fl(hipStream_t st, const FArgs& a) { hipLaunchKernelGGL(k_fgemm<KIND>, dim3(g_grid), dim3(512), LDS_BYTES, st, a); }
static FArgs fdense(const void* A0, const void* B0, const void* A1, const void* B1, int M, int N, int N0, int K, int lda, int pool) {
    FArgs a; memset(&a, 0, sizeof(a)); a.p[0] = A0; a.p[1] = B0; a.p[2] = A1 ? A1 : A0; a.p[3] = B1 ? B1 : B0; a.i[0] = M / 256; a.i[1] = N / 256; a.i[2] = N0 / 256; a.i[3] = K; a.i[4] = lda; a.i[5] = pool; return a; }
static void wt(hipStream_t st, const float* W, bf16_t* WT, const float* kg, const float* ng, int K, int N, int perm, int row_off, float scale, int nb = 1, long ws = 0, long ts = 0) {
    WtJob j; memset(&j, 0, sizeof(j)); j.W = W; j.WT = WT; j.kgain = kg; j.ngain = ng; j.wstride = ws; j.tstride = ts; j.K = K; j.N = N; j.perm = perm; j.row_off = row_off; j.scale = scale;
    const int items = (N / 32) * (K / 64);
    hipLaunchKernelGGL(k_wt, dim3((items + 3) / 4, nb), dim3(256), 0, st, j);
}
extern "C" void kernel_launch(void* const* d_in, const int* in_sizes, int n_in, void* d_out, int out_size, void* d_ws, size_t ws_size, hipStream_t stream) {
    static int ok = 0;
    constexpr int SM_MLA = (64 * 193 * 2 + 64 * 132 + 64 * 65) * 4, SM_MEM = (64 * 129 * 2 + 64 * 132 + 64 * 65) * 4;
    if (ok == 0) {
        if (n_in != 32 || in_sizes[0] != T * D || out_size != T * D || ws_size < WS_END) { fprintf(stderr, "kernel_launch: shape/ws mismatch (ws %zu need %zu)\n", ws_size, (size_t)WS_END); ok = -1; return; }
        if (hipFuncSetAttribute((const void*)k_attn<192, true>, hipFuncAttributeMaxDynamicSharedMemorySize, SM_MLA) != hipSuccess ||
            hipFuncSetAttribute((const void*)k_attn<128, false>, hipFuncAttributeMaxDynamicSharedMemorySize, SM_MEM) != hipSuccess) { fprintf(stderr, "kernel_launch: hipFuncSetAttribute failed\n"); ok = -1; return; }
        int dev = 0, cus = 0; hipGetDevice(&dev); hipDeviceGetAttribute(&cus, hipDeviceAttributeMultiprocessorCount, dev); if (cus > 0) g_grid = cus;
        bool e = false;
        e |= hipFuncSetAttribute((const void*)k_fgemm<K_BF16RS>, hipFuncAttributeMaxDynamicSharedMemorySize, LDS_BYTES) != hipSuccess;
        e |= hipFuncSetAttribute((const void*)k_fgemm<K_RES>, hipFuncAttributeMaxDynamicSharedMemorySize, LDS_BYTES) != hipSuccess;
        e |= hipFuncSetAttribute((const void*)k_fgemm<K_DQ>, hipFuncAttributeMaxDynamicSharedMemorySize, LDS_BYTES) != hipSuccess;
        e |= hipFuncSetAttribute((const void*)k_fgemm<K_UQ>, hipFuncAttributeMaxDynamicSharedMemorySize, LDS_BYTES) != hipSuccess;
        e |= hipFuncSetAttribute((const void*)k_fgemm<K_MOE1>, hipFuncAttributeMaxDynamicSharedMemorySize, LDS_BYTES) != hipSuccess;
        e |= hipFuncSetAttribute((const void*)k_fgemm<K_MOE2>, hipFuncAttributeMaxDynamicSharedMemorySize, LDS_BYTES) != hipSuccess;
        e |= hipFuncSetAttribute((const void*)k_fattn<0>, hipFuncAttributeMaxDynamicSharedMemorySize, LDS_BYTES) != hipSuccess;
        e |= hipFuncSetAttribute((const void*)k_fattn<1>, hipFuncAttributeMaxDynamicSharedMemorySize, LDS_BYTES) != hipSuccess;
        if (e) { fprintf(stderr, "kernel_launch: hipFuncSetAttribute (fgemm) failed\n"); ok = -1; return; }
        ok = 1;
    }
    if (ok < 0) return;
    hipStream_t st = stream;
    char* ws = (char*)d_ws;
#define IN(i) ((const float*)d_in[i])
    const float *x = IN(0), *mem = IN(1); const int* pos = (const int*)d_in[2];
    const float *norm_mix = IN(3), *norm_mem = IN(4), *norm_memtok = IN(5), *norm_ffn = IN(6), *pool_w = IN(7), *pool_scale = IN(8), *kv_in_norm = IN(9), *w_dkv = IN(10), *kv_latent_norm = IN(11),
                *w_kr = IN(12), *w_uk = IN(13), *w_uv = IN(14), *w_dq = IN(15), *q_latent_norm = IN(16), *w_uq = IN(17), *w_qr = IN(18), *w_o = IN(19), *mem_wq = IN(20), *mem_wk = IN(21), *mem_wv = IN(22),
                *mem_wo = IN(23), *rg_w = IN(24), *rg_b = IN(25), *re_w = IN(26), *re_b = IN(27), *w_gate = IN(28), *w_up = IN(29), *w_down = IN(30), *final_norm = IN(31);
    bf16_t *WPOOL = (bf16_t*)(ws + WS_WPOOL), *WMQ = (bf16_t*)(ws + WS_WMQ), *WMK = (bf16_t*)(ws + WS_WMK), *WMV = (bf16_t*)(ws + WS_WMV), *WMO = (bf16_t*)(ws + WS_WMO), *WDQ0 = (bf16_t*)(ws + WS_WDQ0),
           *WDQ1 = (bf16_t*)(ws + WS_WDQ1), *WUQ = (bf16_t*)(ws + WS_WUQ), *WUKV = (bf16_t*)(ws + WS_WUKV), *WO = (bf16_t*)(ws + WS_WO), *WGU = (bf16_t*)(ws + WS_WGU), *WD = (bf16_t*)(ws + WS_WD);
    float* RWT = (float*)(ws + WS_RWT);
    float *H = (float*)(ws + WS_H), *SSP = (float*)(ws + WS_SSP), *LSQ = (float*)(ws + WS_LSQ), *LSKV = (float*)(ws + WS_LSKV), *RS0 = (float*)(ws + WS_RS0), *RS2 = (float*)(ws + WS_RS2), *MEMRS = (float*)(ws + WS_MEMRS),
          *COS = (float*)(ws + WS_COS), *SIN = (float*)(ws + WS_SIN), *GW = (float*)(ws + WS_GW);
    bf16_t *HB = (bf16_t*)(ws + WS_HB), *Y = (bf16_t*)(ws + WS_Y), *HH = (bf16_t*)(ws + WS_HH), *KN = (bf16_t*)(ws + WS_KN), *V = (bf16_t*)(ws + WS_V), *Q = (bf16_t*)(ws + WS_Q), *HN = (bf16_t*)(ws + WS_HN), *U = (bf16_t*)(ws + WS_U),
           *AO = (bf16_t*)(ws + WS_AO), *MQ = (bf16_t*)(ws + WS_MQ), *MO = (bf16_t*)(ws + WS_MO), *CQ = (bf16_t*)(ws + WS_CQ), *CKV = (bf16_t*)(ws + WS_CKV), *KR = (bf16_t*)(ws + WS_KR), *MEMB = (bf16_t*)(ws + WS_MEMB),
           *MK = (bf16_t*)(ws + WS_MK), *MV = (bf16_t*)(ws + WS_MV);
    int* CNT = (int*)(ws + WS_CTL + OFF_CNT); int* LIST = (int*)(ws + WS_LIST);
    hipMemsetAsync(ws + WS_CTL, 0, CTL_BYTES, st);

    const float SC_MEM = 0.08838834764831845f  , SC_MLA = 0.07216878364870323f  ;
    for (int l = 0; l < NA; ++l) for (int g = 0; g < 4; ++g)
        wt(st, pool_w + ((size_t)l * 4 + g) * PG * PG, WPOOL + (size_t)l * D * PG, nullptr, pool_scale + l * D + g * PG, PG, PG, 0, g * PG, 1.f);
    for (int l = 0; l < DEPTH; ++l) {
        wt(st, mem_wq + (size_t)l * D * MI, WMQ + (size_t)l * MI * D, norm_mem + l * D, nullptr, D, MI, 0, 0, SC_MEM);
        wt(st, mem_wk + (size_t)l * D * MI, WMK + (size_t)l * MI * D, norm_memtok + l * D, nullptr, D, MI, 0, 0, 1.f);
        wt(st, mem_wv + (size_t)l * D * MI, WMV + (size_t)l * MI * D, norm_memtok + l * D, nullptr, D, MI, 0, 0, 1.f);
        wt(st, mem_wo + (size_t)l * MI * D, WMO + (size_t)l * D * MI, nullptr, nullptr, MI, D, 0, 0, 1.f);
        wt(st, w_gate + (size_t)l * NE * D * EFF, WGU + (size_t)l * NE * 1024 * D, norm_ffn + l * D, nullptr, D, EFF, 3, 0, 1.f, NE, (long)D * EFF, (long)1024 * D);
        wt(st, w_up + (size_t)l * NE * D * EFF, WGU + (size_t)l * NE * 1024 * D, norm_ffn + l * D, nullptr, D, EFF, 4, 0, 1.f, NE, (long)D * EFF, (long)1024 * D);
        wt(st, w_down + (size_t)l * NE * EFF * D, WD + (size_t)l * NE * D * EFF, nullptr, nullptr, EFF, D, 0, 0, 1.f, NE, (long)EFF * D, (long)D * EFF);
    }
    hipLaunchKernelGGL(k_zero, dim3(256), dim3(256), 0, st, (unsigned*)(WDQ0 + (size_t)1088 * D), (long)(NDQ0 - 1088) * D / 2);
    wt(st, w_dq, WDQ0, norm_mix + 2 * D, nullptr, D, QR, 0, 0, 1.f);
    wt(st, w_dkv, WDQ0, kv_in_norm, nullptr, D, KVR, 0, 512, 1.f);
    wt(st, w_kr, WDQ0, kv_in_norm, nullptr, D, ROPE, 5, 1024, 1.f);
    wt(st, w_dq + (size_t)D * QR, WDQ1, norm_mix + 3 * D, nullptr, D, QR, 0, 0, 1.f);
    for (int j = 0; j < 2; ++j) {
        wt(st, w_uq + (size_t)j * QR * D, WUQ + (size_t)j * NQ * QR, q_latent_norm + j * QR, nullptr, QR, HEADS * NOPE, 1, 0, SC_MLA);
        wt(st, w_qr + (size_t)j * QR * HEADS * ROPE, WUQ + (size_t)j * NQ * QR, q_latent_norm + j * QR, nullptr, QR, HEADS * ROPE, 2, 0, SC_MLA);
        wt(st, w_o + (size_t)j * D * D, WO + (size_t)j * D * D, nullptr, nullptr, D, D, 0, 0, 1.f);
    }
    wt(st, w_uk, WUKV, kv_latent_norm, nullptr, KVR, D, 0, 0, 1.f);
    wt(st, w_uv, WUKV, kv_latent_norm, nullptr, KVR, D, 0, 2048, 1.f);
    hipLaunchKernelGGL(k_rwt, dim3((DEPTH * 36 * D + 255) / 256), dim3(256), 0, st, rg_w, re_w, norm_ffn, RWT);
    hipLaunchKernelGGL(k_rope, dim3(T * 32 / 256), dim3(256), 0, st, pos, COS, SIN);
    hipLaunchKernelGGL(k_memprep, dim3(NB * MEMT / 4), dim3(256), 0, st, mem, MEMB, MEMRS);
    for (int l = 0; l < DEPTH; ++l) for (int kv = 0; kv < 2; ++kv) {
        if (FAST >> K_BF16RS & 1) { FArgs a = fdense(MEMB, (kv ? WMV : WMK) + (size_t)l * MI * D, nullptr, nullptr, NB * MEMT, MI, MI, D, D, 0); a.p[4] = (kv ? MV : MK) + (size_t)l * NB * MEMT * MI; a.p[5] = MEMRS; a.i[6] = 1; a.i[7] = MI; fl<K_BF16RS>(st, a); continue; }
        GArgs g; memset(&g, 0, sizeof(g)); g.A = MEMB; g.lda = D; g.K = D; g.Bt = (kv ? WMV : WMK) + (size_t)l * MI * D; g.kind = K_BF16RS; g.O1 = (kv ? MV : MK) + (size_t)l * NB * MEMT * MI; g.ldo = MI; g.rs = MEMRS;
        hipLaunchKernelGGL(k_gemm<false>, dim3(MI / 128, NB * MEMT / 128), dim3(256), 0, st, g);
    }
    for (int l = 0; l < DEPTH; ++l) {
        const bool isA = l < NA;
        hipLaunchKernelGGL(k_combine, dim3(T / 4), dim3(256), 0, st, l == 0 ? x : (const float*)H, l == 0 ? (const bf16_t*)nullptr : (const bf16_t*)Y, H, HB, RS0, isA ? norm_mix + l * D : (const float*)nullptr, isA ? HN : (bf16_t*)nullptr, (float*)nullptr);
        if (isA) {
            hipLaunchKernelGGL(k_pool, dim3(T), dim3(256), 0, st, (const bf16_t*)HN, U);
            if (FAST >> K_RES & 1) { FArgs a = fdense(U, WPOOL + (size_t)l * D * PG, nullptr, nullptr, T, D, D, PG, D, 1); a.p[4] = H; a.p[5] = HB; a.p[6] = SSP; a.i[6] = 1; fl<K_RES>(st, a); }
            else { GArgs g; memset(&g, 0, sizeof(g)); g.A = U; g.lda = D; g.K = PG; g.Bt = WPOOL + (size_t)l * D * PG; g.kind = K_RES; g.pool = 1; g.H = H; g.HB = HB;
            hipLaunchKernelGGL(k_gemm<false>, dim3(D / 128, T / 128), dim3(256), 0, st, g); }
        } else {
            const int j = l - NA;
            if (FAST >> K_DQ & 1) { FArgs a = fdense(HB, j == 0 ? WDQ0 : WDQ1, nullptr, nullptr, T, j == 0 ? NDQ0 : QR, j == 0 ? NDQ0 : QR, D, D, 0);
              a.p[4] = CQ; a.p[5] = CKV; a.p[6] = KR; a.p[7] = RS0; a.p[8] = LSQ; a.p[9] = LSKV; a.p[10] = COS; a.p[11] = SIN; fl<K_DQ>(st, a); }
            else { GArgs g; memset(&g, 0, sizeof(g)); g.A = HB; g.lda = D; g.K = D; g.Bt = j == 0 ? WDQ0 : WDQ1; g.kind = K_DQ; g.O1 = CQ; g.O2 = j == 0 ? CKV : nullptr; g.O3 = j == 0 ? KR : nullptr; g.rs = RS0; g.COS = COS; g.SIN = SIN;
              hipLaunchKernelGGL(k_gemm<false>, dim3((j == 0 ? NDQ0 : QR) / 128, T / 128), dim3(256), 0, st, g); }
            if (!(FAST >> K_DQ & 1)) hipLaunchKernelGGL(k_rowstats_bf16, dim3(T / 4), dim3(256), 0, st, (const bf16_t*)CQ, QR, LSQ, 8);
            if (j == 0 && !(FAST >> K_DQ & 1)) hipLaunchKernelGGL(k_rowstats_bf16, dim3(T / 4), dim3(256), 0, st, (const bf16_t*)CKV, KVR, LSKV, 8);
            if (FAST >> K_UQ & 1) { FArgs a = fdense(CQ, WUQ + (size_t)j * NQ * QR, CKV, WUKV, T, j == 0 ? NQ + 4096 : NQ, NQ, QR, QR, 0);
              a.p[4] = Q; a.p[5] = KN; a.p[6] = V; a.p[7] = LSQ; a.p[8] = LSKV; a.p[9] = COS; a.p[10] = SIN; fl<K_UQ>(st, a); }
            else { GArgs g; memset(&g, 0, sizeof(g)); g.A = CQ; g.lda = QR; g.K = QR; g.Bt = WUQ + (size_t)j * NQ * QR; g.kind = K_UQ; g.O1 = Q; g.part = LSQ; g.np = 8; g.pdiv = (float)QR; g.COS = COS; g.SIN = SIN;
              hipLaunchKernelGGL(k_gemm<false>, dim3(NQ / 128, T / 128), dim3(256), 0, st, g); }
            if (j == 0 && !(FAST >> K_UQ & 1)) {
                GArgs g; memset(&g, 0, sizeof(g)); g.A = CKV; g.lda = KVR; g.K = KVR; g.Bt = WUKV; g.kind = K_UKV; g.O1 = KN; g.O2 = V; g.part = LSKV; g.np = 8; g.pdiv = (float)KVR;
                hipLaunchKernelGGL(k_gemm<false>, dim3(4096 / 128, T / 128), dim3(256), 0, st, g);
            }
            if (FAST >> 7 & 1) { FAArgs a; memset(&a, 0, sizeof(a)); a.q = Q; a.k1 = KN; a.k2 = KR; a.v = V; a.o = AO; hipLaunchKernelGGL(k_fattn<0>, dim3(g_grid), dim3(512), LDS_BYTES, st, a); }
            else { AArgs a; memset(&a, 0, sizeof(a)); a.Q = Q; a.ldq = NQ; a.qhs = QKD; a.K1 = KN; a.ldk1 = D; a.k1hs = NOPE; a.K2 = KR; a.ldk2 = ROPE; a.V = V; a.ldv = D; a.vhs = VD; a.O = AO; a.ldo = D; a.ohs = VD; a.nq = S; a.nk = S;
              hipLaunchKernelGGL((k_attn<192, true>), dim3(S / 64, HEADS, NB), dim3(256), SM_MLA, st, a); }
            if (FAST >> K_RES & 1) { FArgs a = fdense(AO, WO + (size_t)j * D * D, nullptr, nullptr, T, D, D, D, D, 0); a.p[4] = H; a.p[5] = HB; a.p[6] = SSP; a.i[6] = 1; fl<K_RES>(st, a); }
            else { GArgs g; memset(&g, 0, sizeof(g)); g.A = AO; g.lda = D; g.K = D; g.Bt = WO + (size_t)j * D * D; g.kind = K_RES; g.H = H; g.HB = HB;
              hipLaunchKernelGGL(k_gemm<false>, dim3(D / 128, T / 128), dim3(256), 0, st, g); }
        }
        if (!(FAST >> K_RES & 1)) hipLaunchKernelGGL(k_rowstats_f32, dim3(T / 4), dim3(256), 0, st, (const float*)H, D, SSP, 32);
        if (FAST >> K_BF16RS & 1) { FArgs a = fdense(HB, WMQ + (size_t)l * MI * D, nullptr, nullptr, T, MI, MI, D, D, 0); a.p[4] = MQ; a.p[5] = SSP; a.i[6] = 2; a.i[7] = MI; fl<K_BF16RS>(st, a); }
        else { GArgs g; memset(&g, 0, sizeof(g)); g.A = HB; g.lda = D; g.K = D; g.Bt = WMQ + (size_t)l * MI * D; g.kind = K_BF16RS; g.O1 = MQ; g.ldo = MI; g.part = SSP; g.np = 32; g.pdiv = (float)D;
          hipLaunchKernelGGL(k_gemm<false>, dim3(MI / 128, T / 128), dim3(256), 0, st, g); }
        if (FAST >> 8 & 1) { FAArgs a; memset(&a, 0, sizeof(a)); a.q = MQ; a.k1 = MK + (size_t)l * NB * MEMT * MI; a.v = MV + (size_t)l * NB * MEMT * MI; a.o = MO; hipLaunchKernelGGL(k_fattn<1>, dim3(g_grid), dim3(512), LDS_BYTES, st, a); }
        else { AArgs a; memset(&a, 0, sizeof(a)); a.Q = MQ; a.ldq = MI; a.qhs = MHD; a.K1 = MK + (size_t)l * NB * MEMT * MI; a.ldk1 = MI; a.k1hs = MHD; a.V = MV + (size_t)l * NB * MEMT * MI; a.ldv = MI; a.vhs = MHD; a.O = MO; a.ldo = MI; a.ohs = MHD; a.nq = S; a.nk = MEMT;
          hipLaunchKernelGGL((k_attn<128, false>), dim3(S / 64, MH, NB), dim3(256), SM_MEM, st, a); }
        if (FAST >> K_RES & 1) { FArgs a = fdense(MO, WMO + (size_t)l * D * MI, nullptr, nullptr, T, D, D, MI, MI, 0); a.p[4] = H; a.p[5] = HB; a.i[6] = 0; fl<K_RES>(st, a); }
        else { GArgs g; memset(&g, 0, sizeof(g)); g.A = MO; g.lda = MI; g.K = MI; g.Bt = WMO + (size_t)l * D * MI; g.kind = K_RES; g.H = H; g.HB = HB;
          hipLaunchKernelGGL(k_gemm<false>, dim3(D / 128, T / 128), dim3(256), 0, st, g); }
        hipLaunchKernelGGL(k_router, dim3(T / 4), dim3(256), 0, st, (const float*)H, (const float*)(RWT + (size_t)l * 36 * D), rg_b + l * NG, re_b + l * NE, RS2, CNT + l * NE, LIST, GW);
        if (FAST >> K_MOE1 & 1) { FArgs a; memset(&a, 0, sizeof(a)); a.p[0] = HB; a.p[1] = WGU + (size_t)l * NE * 1024 * D; a.p[2] = LIST; a.p[3] = CNT + l * NE; a.p[4] = HH; a.p[5] = RS2; a.i[0] = 4; a.i[1] = D; a.i[2] = D; a.i[3] = 1024 * D; fl<K_MOE1>(st, a); }
        else { GArgs g; memset(&g, 0, sizeof(g)); g.A = HB; g.lda = D; g.K = D; g.Bt = WGU + (size_t)l * NE * 1024 * D; g.kind = K_MOE1; g.O1 = HH; g.rs = RS2; g.cnt = CNT + l * NE; g.list = LIST; g.estride = (long)1024 * D;
          hipLaunchKernelGGL(k_gemm<true>, dim3(EFF / 128, MAXROWS / 128), dim3(256), 0, st, g); }
        if (FAST >> K_MOE2 & 1) { FArgs a; memset(&a, 0, sizeof(a)); a.p[0] = HH; a.p[1] = WD + (size_t)l * NE * D * EFF; a.p[2] = LIST; a.p[3] = CNT + l * NE; a.p[4] = Y; a.p[5] = GW; a.i[0] = 8; a.i[1] = EFF; a.i[2] = EFF; a.i[3] = D * EFF; fl<K_MOE2>(st, a); }
        else { GArgs g; memset(&g, 0, sizeof(g)); g.A = HH; g.lda = EFF; g.K = EFF; g.Bt = WD + (size_t)l * NE * D * EFF; g.kind = K_MOE2; g.O1 = Y; g.cnt = CNT + l * NE; g.list = LIST; g.gw = GW; g.estride = (long)D * EFF;
          hipLaunchKernelGGL(k_gemm<false>, dim3(D / 128, MAXROWS / 128), dim3(256), 0, st, g); }
    }
    hipLaunchKernelGGL(k_combine, dim3(T / 4), dim3(256), 0, st, (const float*)H, (const bf16_t*)Y, (float*)nullptr, (bf16_t*)nullptr, (float*)nullptr, final_norm, (bf16_t*)nullptr, (float*)d_out);
    const hipError_t le = hipPeekAtLastError();
    if (le != hipSuccess) fprintf(stderr, "kernel_launch: launch failed: %s\n", hipGetErrorName(le));
#undef IN
}
```

```cpp
#include <hip/hip_runtime.h>
#include <cstdio>
#include <cstdint>
#include <cstring>

typedef unsigned short bf16_t;
typedef float f32x4 __attribute__((ext_vector_type(4)));
typedef unsigned u32x4 __attribute__((ext_vector_type(4)));
typedef unsigned u32x2 __attribute__((ext_vector_type(2)));
#define DI __device__ __forceinline__

constexpr int D = 2048, NB = 4, S = 4096, T = NB * S, DEPTH = 4, NA = 2;
constexpr int CHUNK = 64;
constexpr int PG = 512;
constexpr int HEADS = 16, QR = 512, KVR = 512, NOPE = 128, ROPE = 64, VD = 128, QKD = NOPE + ROPE;
constexpr int MEMT = 256, MH = 4, MHD = 128, MI = 512;
constexpr int NG = 4, EPG = 8, NE = 32, EFF = 512;
constexpr float EPS = 1e-6f;
constexpr int CAP = T;
constexpr int MAXROWS = 2 * T + NE * 256;
constexpr int NQ = HEADS * QKD;
constexpr int NDQ0 = 1280;

constexpr size_t al(size_t x) { return (x + 255) & ~(size_t)255; }
constexpr size_t WS_CTL = 0, CTL_BYTES = 1u << 20;
constexpr size_t OFF_CNT = 65536;
constexpr size_t WS_WPOOL = WS_CTL + CTL_BYTES;
constexpr size_t WS_WMQ = WS_WPOOL + (size_t)NA * D * PG * 2;
constexpr size_t WS_WMK = WS_WMQ + (size_t)DEPTH * MI * D * 2;
constexpr size_t WS_WMV = WS_WMK + (size_t)DEPTH * MI * D * 2;
constexpr size_t WS_WMO = WS_WMV + (size_t)DEPTH * MI * D * 2;
constexpr size_t WS_WDQ0 = WS_WMO + (size_t)DEPTH * D * MI * 2;
constexpr size_t WS_WDQ1 = WS_WDQ0 + (size_t)NDQ0 * D * 2;
constexpr size_t WS_WUQ = WS_WDQ1 + (size_t)QR * D * 2;
constexpr size_t WS_WUKV = WS_WUQ + (size_t)2 * NQ * QR * 2;
constexpr size_t WS_WO = WS_WUKV + (size_t)4096 * KVR * 2;
constexpr size_t WS_RWT = WS_WO + (size_t)2 * D * D * 2;
constexpr size_t WS_WGU = al(WS_RWT + (size_t)DEPTH * 36 * D * 4);
constexpr size_t WS_WD = WS_WGU + (size_t)DEPTH * NE * 1024 * D * 2;
constexpr size_t WS_H = WS_WD + (size_t)DEPTH * NE * D * EFF * 2;
constexpr size_t WS_HB = WS_H + (size_t)T * D * 4;
constexpr size_t WS_Y = WS_HB + (size_t)T * D * 2;
constexpr size_t WS_HH = WS_Y + (size_t)2 * T * D * 2;
constexpr size_t WS_KN = WS_HH + (size_t)MAXROWS * EFF * 2;
constexpr size_t WS_V = WS_KN + (size_t)T * D * 2;
constexpr size_t WS_Q = WS_V + (size_t)T * D * 2;
constexpr size_t WS_HN = WS_Q;
constexpr size_t WS_U = WS_Q + (size_t)T * D * 2;
constexpr size_t WS_AO = WS_Q + (size_t)T * NQ * 2;
constexpr size_t WS_MQ = WS_AO + (size_t)T * D * 2;
constexpr size_t WS_MO = WS_MQ + (size_t)T * MI * 2;
constexpr size_t WS_CQ = WS_MO + (size_t)T * MI * 2;
constexpr size_t WS_CKV = WS_CQ + (size_t)T * QR * 2;
constexpr size_t WS_KR = WS_CKV + (size_t)T * KVR * 2;
constexpr size_t WS_MEMB = WS_KR + (size_t)T * ROPE * 2;
constexpr size_t WS_MK = WS_MEMB + (size_t)NB * MEMT * D * 2;
constexpr size_t WS_MV = WS_MK + (size_t)DEPTH * NB * MEMT * MI * 2;
constexpr size_t WS_SSP = WS_MV + (size_t)DEPTH * NB * MEMT * MI * 2;
constexpr size_t WS_LSQ = WS_SSP + (size_t)T * 32 * 4;
constexpr size_t WS_LSKV = WS_LSQ + (size_t)T * 8 * 4;
constexpr size_t WS_RS0 = WS_LSKV + (size_t)T * 8 * 4;
constexpr size_t WS_RS2 = WS_RS0 + (size_t)T * 4;
constexpr size_t WS_MEMRS = WS_RS2 + (size_t)T * 4;
constexpr size_t WS_COS = WS_MEMRS + 4096;
constexpr size_t WS_SIN = WS_COS + (size_t)T * 32 * 4;
constexpr size_t WS_GW = WS_SIN + (size_t)T * 32 * 4;
constexpr size_t WS_LIST = WS_GW + (size_t)2 * T * 4;
constexpr size_t WS_END = WS_LIST + (size_t)NE * CAP * 4;
static_assert(WS_U + (size_t)T * D * 2 <= WS_MQ, "U overlay inside Q|AO");

DI float bf2f(bf16_t b) { return __uint_as_float(((unsigned)b) << 16); }
DI unsigned f2bf(float f) { unsigned u = __float_as_uint(f); return (u + 0x7fffu + ((u >> 16) & 1u)) >> 16; }
DI unsigned pk2(float lo, float hi) { return f2bf(lo) | (f2bf(hi) << 16); }
DI float wave_sum(float v) {
#pragma unroll
    for (int o = 1; o < 64; o <<= 1) v += __shfl_xor(v, o);
    return v;
}
DI int opaque_tid() { int t = threadIdx.x; asm volatile("" : "+v"(t)); return t; }
DI float silu(float x) { return x / (1.0f + __expf(-x)); }

DI int permrow(int perm, int n) {
    switch (perm) {
        case 1: return (n >> 7) * QKD + (n & 127);
        case 2: { const int h = n >> 6, r = n & 63; return h * QKD + NOPE + 2 * (r & 31) + (r >> 5); }
        case 3: return (n >> 7) * 256 + (n & 127);
        case 4: return (n >> 7) * 256 + 128 + (n & 127);
        case 5: return 2 * (n & 31) + (n >> 5);
        default: return n;
    }
}
#define LAS __attribute__((address_space(3)))
typedef short bf16x8 __attribute__((ext_vector_type(8)));
namespace fg {
constexpr int BM = 256, BK = 64, HALF = 128, HTB = HALF * BK * 2, STAGE_BYTES = 8 * HTB, NXCD = 8, WGM = 8;
DI int lds_byte(int r, int c) { const int st = (r >> 4) * 2 + (c >> 5), rr = r & 15, cc = c & 31, ob = rr * 64 + cc * 2; return st * 1024 + (ob ^ (((ob >> 9) & 1) << 5)); }
DI void stage_rc(int b, int& R, int& C) { const int st = b / 1024, sb = b % 1024, swz = sb ^ (((sb >> 9) & 1) << 5); R = (st >> 1) * 16 + swz / 64; C = (st & 1) * 32 + (swz % 64) / 2; }
DI int perm32(int rho) { const int n = rho >> 4, i = rho & 15; return 8 * (i >> 2) + 4 * n + (i & 3); }
DI unsigned cvt_pk_bf16(float lo, float hi) { unsigned r; asm volatile("v_cvt_pk_bf16_f32 %0, %1, %2" : "=v"(r) : "v"(lo), "v"(hi)); return r; }
struct Unit { int pm, pn, e, r0, cnt; };

struct ProbDense {
    const char* A0; const char* B0; const char* A1; const char* B1; int nM, nN, nN0, K, lda, pool, G, c;
    static constexpr bool GATHER = false;
    DI bool next(int i, Unit& u) const {
        const long L = (long)i * G + c; const int nwg = nM * nN; if (L >= nwg) return false;
        int wgid = (int)L; { const int q = nwg / NXCD, r = nwg % NXCD, xcd = wgid % NXCD, off = wgid / NXCD; wgid = (xcd < r ? xcd * (q + 1) : r * (q + 1) + (xcd - r) * q) + off; }
        const int nig = WGM * nN, gid = wgid / nig, fm = gid * WGM, gsz = (nM - fm) < WGM ? (nM - fm) : WGM;
        u.pm = fm + ((wgid % nig) % gsz); u.pn = (wgid % nig) / gsz; u.e = 0; u.r0 = 0; u.cnt = 256; return true; }
    DI const char* aptr(const Unit& u) const { return (u.pn < nN0 ? A0 : A1) + (size_t)u.pm * 256 * lda * 2 + (pool ? (size_t)(u.pn >> 1) * 1024 : 0); }
    DI const char* bptr(const Unit& u) const { return u.pn < nN0 ? B0 + (size_t)u.pn * 256 * K * 2 : B1 + (size_t)(u.pn - nN0) * 256 * K * 2; }
    DI void avoff(const Unit&, const int (&R)[2], const int (&C)[2], unsigned (&vo)[2][2]) const {
#pragma unroll
        for (int h = 0; h < 2; ++h)
#pragma unroll
            for (int i = 0; i < 2; ++i) vo[h][i] = (unsigned)((h * 128 + R[i]) * lda + C[i]) * 2u; }
};
struct ProbMoe {
    const char* A; const char* Bt; const int* list; const LAS int* pref; int npn, K, lda, gather, G, c; long estride;
    static constexpr bool GATHER = true;
    DI bool next(int i, Unit& u) const {
        const int L = i * G + c, tile = L / npn; if (tile >= pref[32]) return false;
        int e = 0; while (pref[e + 1] <= tile) ++e;
        u.pm = tile; u.pn = L % npn; u.e = e; u.r0 = (tile - pref[e]) * 256; u.cnt = pref[64 + e]; return true; }
    DI const char* aptr(const Unit& u) const { return gather ? A : A + (size_t)u.pm * 256 * lda * 2; }
    DI const char* bptr(const Unit& u) const { return Bt + (size_t)u.e * estride + (size_t)u.pn * 256 * K * 2; }
    DI void avoff(const Unit& u, const int (&R)[2], const int (&C)[2], unsigned (&vo)[2][2]) const {
#pragma unroll
        for (int h = 0; h < 2; ++h)
#pragma unroll
            for (int i = 0; i < 2; ++i) { const int row = h * 128 + R[i];
                if (gather) { const int ri = u.r0 + row; const int tok = ri < u.cnt ? (list[(size_t)u.e * CAP + ri] >> 1) : 0; vo[h][i] = (unsigned)(tok * lda + C[i]) * 2u; }
                else vo[h][i] = (unsigned)(row * lda + C[i]) * 2u; } }
};

typedef f32x4 Acc[2][2][4][2];
DI float quad_sum(float s) { s += __shfl_xor(s, 16); s += __shfl_xor(s, 32); return s; }
DI float sq8(const f32x4& a, const f32x4& b) { return ((a.x * a.x + a.y * a.y) + (a.z * a.z + a.w * a.w)) + ((b.x * b.x + b.y * b.y) + (b.z * b.z + b.w * b.w)); }
DI u32x4 pack8(const f32x4& a, const f32x4& b) { u32x4 w; w.x = cvt_pk_bf16(a.x, a.y); w.y = cvt_pk_bf16(a.z, a.w); w.z = cvt_pk_bf16(b.x, b.y); w.w = cvt_pk_bf16(b.z, b.w); return w; }
template <int NP> DI float rs_from_parts(const float* part, int r, int fq, float inv_n) {
    float s;
    if (NP == 32) { const f32x4 a = *(const f32x4*)(part + (size_t)r * 32 + fq * 8), b = *(const f32x4*)(part + (size_t)r * 32 + fq * 8 + 4); s = ((a.x + a.y) + (a.z + a.w)) + ((b.x + b.y) + (b.z + b.w)); }
    else { const float* p = part + (size_t)r * 8 + fq * 2; s = p[0] + p[1]; }
    s = quad_sum(s); return rsqrtf(s * inv_n + EPS);
}
DI void rope8(f32x4& a, f32x4& b, const float* COS, const float* SIN, int r, int i0) {
    const f32x4 c = *(const f32x4*)(COS + (size_t)r * 32 + i0), s = *(const f32x4*)(SIN + (size_t)r * 32 + i0);
    const f32x4 a2 = {a.x * c.x - a.y * s.x, a.y * c.x + a.x * s.x, a.z * c.y - a.w * s.y, a.w * c.y + a.z * s.y};
    const f32x4 b2 = {b.x * c.z - b.y * s.z, b.y * c.z + b.x * s.z, b.z * c.w - b.w * s.w, b.w * c.w + b.z * s.w};
    a = a2; b = b2;
}
template <bool STATS> struct EpiRes {
    float* H; bf16_t* HB; float* SSP;
    DI void operator()(const Acc& acc, const Unit& u, int wr, int wc, int fr, int fq) const {
#pragma unroll
        for (int ai = 0; ai < 2; ++ai)
#pragma unroll
            for (int m = 0; m < 4; ++m) { const int r = u.pm * BM + ai * HALF + wr * 64 + m * 16 + fr; float ss = 0.f;
#pragma unroll
                for (int bj = 0; bj < 2; ++bj) { const int c0 = u.pn * BM + bj * HALF + wc * 32 + 8 * fq; float* hp = H + (size_t)r * D + c0;
                    const f32x4 h0 = *(const f32x4*)hp + acc[ai][bj][m][0], h1 = *(const f32x4*)(hp + 4) + acc[ai][bj][m][1];
                    *(f32x4*)hp = h0; *(f32x4*)(hp + 4) = h1; *(u32x4*)(HB + (size_t)r * D + c0) = pack8(h0, h1); if (STATS) ss += sq8(h0, h1); }
                if (STATS) { ss = quad_sum(ss); if (fq == 0) SSP[(size_t)r * 32 + u.pn * 4 + wc] = ss; }
                asm volatile("" ::: "memory"); }
    }
};
template <int MODE  > struct EpiBf16RS {
    bf16_t* O; int ldo; const float* rs;
    DI void operator()(const Acc& acc, const Unit& u, int wr, int wc, int fr, int fq) const {
#pragma unroll
        for (int ai = 0; ai < 2; ++ai)
#pragma unroll
            for (int m = 0; m < 4; ++m) { const int r = u.pm * BM + ai * HALF + wr * 64 + m * 16 + fr;
                const float sc = MODE == 1 ? rs[r] : rs_from_parts<32>(rs, r, fq, 1.0f / D);
#pragma unroll
                for (int bj = 0; bj < 2; ++bj) { const int c0 = u.pn * BM + bj * HALF + wc * 32 + 8 * fq;
                    *(u32x4*)(O + (size_t)r * ldo + c0) = pack8(acc[ai][bj][m][0] * sc, acc[ai][bj][m][1] * sc); } }
    }
};
struct EpiDQ {
    bf16_t* CQ; bf16_t* CKV; bf16_t* KR; const float* RS0; float* LSQ; float* LSKV; const float* COS; const float* SIN;
    DI void operator()(const Acc& acc, const Unit& u, int wr, int wc, int fr, int fq) const {
#pragma unroll
        for (int ai = 0; ai < 2; ++ai)
#pragma unroll
            for (int m = 0; m < 4; ++m) { const int r = u.pm * BM + ai * HALF + wr * 64 + m * 16 + fr; const float sc = RS0[r]; float ss = 0.f;
#pragma unroll
                for (int bj = 0; bj < 2; ++bj) { const int cl = bj * HALF + wc * 32 + 8 * fq; f32x4 v0 = acc[ai][bj][m][0] * sc, v1 = acc[ai][bj][m][1] * sc;
                    if (u.pn < 4) { ss += sq8(v0, v1); bf16_t* o = (u.pn < 2 ? CQ : CKV) + (size_t)r * 512 + (u.pn & 1) * 256 + cl; *(u32x4*)o = pack8(v0, v1); }
                    else if (cl < 64) { rope8(v0, v1, COS, SIN, r, cl >> 1); *(u32x4*)(KR + (size_t)r * 64 + cl) = pack8(v0, v1); } }
                if (u.pn < 4) { ss = quad_sum(ss); if (fq == 0) (u.pn < 2 ? LSQ : LSKV)[(size_t)r * 8 + (u.pn & 1) * 4 + wc] = ss; } }
    }
};
struct EpiUQ {
    bf16_t* Q; bf16_t* KN; bf16_t* V; const float* LSQ; const float* LSKV; const float* COS; const float* SIN;
    DI void operator()(const Acc& acc, const Unit& u, int wr, int wc, int fr, int fq) const {
        const bool isq = u.pn < 12;
#pragma unroll
        for (int ai = 0; ai < 2; ++ai)
#pragma unroll
            for (int m = 0; m < 4; ++m) { const int r = u.pm * BM + ai * HALF + wr * 64 + m * 16 + fr;
                const float sc = rs_from_parts<8>(isq ? LSQ : LSKV, r, fq, 1.0f / 512.0f);
#pragma unroll
                for (int bj = 0; bj < 2; ++bj) { f32x4 v0 = acc[ai][bj][m][0] * sc, v1 = acc[ai][bj][m][1] * sc;
                    if (isq) { const int c0 = u.pn * BM + bj * HALF + wc * 32 + 8 * fq, hc = c0 % QKD;
                        if (hc >= NOPE) rope8(v0, v1, COS, SIN, r, (hc - NOPE) >> 1);
                        *(u32x4*)(Q + (size_t)r * NQ + c0) = pack8(v0, v1); }
                    else { const int c0 = (u.pn - 12) * BM + bj * HALF + wc * 32 + 8 * fq;
                        *(u32x4*)((c0 < 2048 ? KN + c0 : V + (c0 - 2048)) + (size_t)r * D) = pack8(v0, v1); } } }
    }
};
struct EpiMoe1 {
    bf16_t* HH; const float* RS2; const int* list;
    DI void operator()(const Acc& acc, const Unit& u, int wr, int wc, int fr, int fq) const {
#pragma unroll
        for (int ai = 0; ai < 2; ++ai)
#pragma unroll
            for (int m = 0; m < 4; ++m) { const int lr = ai * HALF + wr * 64 + m * 16 + fr, ri = u.r0 + lr;
                if (ri < u.cnt) { const float sc = RS2[list[(size_t)u.e * CAP + ri] >> 1];
                    const f32x4 g0 = acc[ai][0][m][0] * sc, g1 = acc[ai][0][m][1] * sc, u0 = acc[ai][1][m][0] * sc, u1 = acc[ai][1][m][1] * sc;
                    const f32x4 h0 = {silu(g0.x) * u0.x, silu(g0.y) * u0.y, silu(g0.z) * u0.z, silu(g0.w) * u0.w}, h1 = {silu(g1.x) * u1.x, silu(g1.y) * u1.y, silu(g1.z) * u1.z, silu(g1.w) * u1.w};
                    *(u32x4*)(HH + (size_t)(u.pm * BM + lr) * EFF + u.pn * 128 + wc * 32 + 8 * fq) = pack8(h0, h1); } }
    }
};
struct EpiMoe2 {
    bf16_t* Y; const float* GW; const int* list;
    DI void operator()(const Acc& acc, const Unit& u, int wr, int wc, int fr, int fq) const {
#pragma unroll
        for (int ai = 0; ai < 2; ++ai)
#pragma unroll
            for (int m = 0; m < 4; ++m) { const int lr = ai * HALF + wr * 64 + m * 16 + fr, ri = u.r0 + lr;
                if (ri < u.cnt) { const int a = list[(size_t)u.e * CAP + ri]; const float sc = GW[a];
#pragma unroll
                    for (int bj = 0; bj < 2; ++bj) { const int c0 = u.pn * BM + bj * HALF + wc * 32 + 8 * fq;
                        *(u32x4*)(Y + (size_t)a * D + c0) = pack8(acc[ai][bj][m][0] * sc, acc[ai][bj][m][1] * sc); } } }
    }
};

template <class Epi, class Prob>
DI void gemm_phase(LAS unsigned char* lds, const Prob& P, const Epi& E) {
    const int tid = opaque_tid(), wid = __builtin_amdgcn_readfirstlane(tid >> 6), lane = tid & 63, wr = wid >> 2, wc = wid & 3, fr = lane & 15, fq = lane >> 4;
    const int K = P.K, nt = K / BK;
    int sR[2], sC[2]; unsigned voffB[2];
#pragma unroll
    for (int i = 0; i < 2; ++i) { stage_rc(tid * 16 + i * 8192, sR[i], sC[i]); const int Rb = (sR[i] & ~31) + perm32(sR[i] & 31); voffB[i] = (unsigned)(Rb * K + sC[i]) * 2u; }
    const size_t kstep = (size_t)(BK * 2), hstepB = (size_t)HALF * K * 2;
    const unsigned ldsw = (unsigned)wid * 1024u;
    const int aoff = lds_byte(wr * 64 + fr, fq * 8), boff = lds_byte(wc * 32 + fr, fq * 8);
#define PG8_SA(b, h) (((b) * 2 + (h)) * HTB)
#define PG8_SB(b, h) ((4 + (b) * 2 + (h)) * HTB)
#define PG8_STAGE(bufoff, gbase, voff) do { _Pragma("unroll") for (int _i = 0; _i < 2; ++_i) \
        __builtin_amdgcn_global_load_lds((const unsigned*)((const char*)(gbase) + (voff)[_i]), (LAS unsigned*)(lds + (bufoff) + ldsw + _i * 8192), 16, 0, 0); } while (0)
#define PG8_LDA(dst, b, h) do { _Pragma("unroll") for (int m = 0; m < 4; ++m) _Pragma("unroll") for (int k = 0; k < 2; ++k) dst[m][k] = *(const LAS bf16x8*)(lds + PG8_SA(b, h) + aoff + m * 2048 + k * 1024); } while (0)
#define PG8_LDB(dst, b, h) do { _Pragma("unroll") for (int n = 0; n < 2; ++n) _Pragma("unroll") for (int k = 0; k < 2; ++k) dst[n][k] = *(const LAS bf16x8*)(lds + PG8_SB(b, h) + boff + n * 2048 + k * 1024); } while (0)
#define PG8_MMA(ai, bj, At, Bt) do { __builtin_amdgcn_s_setprio(1); _Pragma("unroll") for (int m = 0; m < 4; ++m) _Pragma("unroll") for (int n = 0; n < 2; ++n) _Pragma("unroll") for (int k = 0; k < 2; ++k) \
        acc[ai][bj][m][n] = __builtin_amdgcn_mfma_f32_16x16x32_bf16(Bt[n][k], At[m][k], acc[ai][bj][m][n], 0, 0, 0); __builtin_amdgcn_s_setprio(0); } while (0)
#define PG8_WAIT_V(n) asm volatile("s_waitcnt vmcnt(" #n ")" ::: "memory")
#define PG8_WAIT_L(n) asm volatile("s_waitcnt lgkmcnt(" #n ")" ::: "memory")
#define PG8_BAR __builtin_amdgcn_s_barrier()
#define PG8_SCHED __builtin_amdgcn_sched_barrier(0)
    Unit cur, nxt; int ui = 0;
    if (!P.next(0, cur)) return;
    f32x4 acc[2][2][4][2];
#pragma unroll
    for (int a = 0; a < 2; ++a)
#pragma unroll
        for (int b = 0; b < 2; ++b)
#pragma unroll
            for (int m = 0; m < 4; ++m)
#pragma unroll
                for (int n = 0; n < 2; ++n) acc[a][b][m][n] = (f32x4){0.f, 0.f, 0.f, 0.f};
    bf16x8 At[4][2], B0[2][2], B1[2][2];
    const char* cA = P.aptr(cur); const char* cB = P.bptr(cur);
    unsigned voA[2][2], vnA[2][2];
    P.avoff(cur, sR, sC, voA);
    if constexpr (Prob::GATHER) asm volatile("s_waitcnt vmcnt(0)" ::: "memory");
    PG8_STAGE(PG8_SB(0, 0), cB, voffB); PG8_STAGE(PG8_SB(0, 1), cB + hstepB, voffB); PG8_STAGE(PG8_SA(0, 0), cA, voA[0]); PG8_STAGE(PG8_SA(0, 1), cA, voA[1]);
    if (wr == 1) PG8_BAR;
    PG8_WAIT_V(2); PG8_BAR;
    PG8_STAGE(PG8_SB(1, 0), cB + kstep, voffB); PG8_STAGE(PG8_SA(1, 0), cA + kstep, voA[0]); PG8_STAGE(PG8_SB(1, 1), cB + hstepB + kstep, voffB);
    PG8_WAIT_V(6); PG8_BAR;
    for (;;) {
        const bool has_next = P.next(ui + 1, nxt);
        const char* nA = has_next ? P.aptr(nxt) : cA; const char* nB = has_next ? P.bptr(nxt) : cB;
#pragma unroll
        for (int h = 0; h < 2; ++h)
#pragma unroll
            for (int i = 0; i < 2; ++i) vnA[h][i] = voA[h][i];
        for (int t = 0; t < nt; t += 2) {
            const bool last = (t == nt - 2);
            if constexpr (Prob::GATHER) { if (last && has_next) P.avoff(nxt, sR, sC, vnA); }
            const char* a1 = cA + (size_t)(t + 1) * kstep;
            const char* a2 = last ? nA : cA + (size_t)(t + 2) * kstep; const char* b2 = last ? nB : cB + (size_t)(t + 2) * kstep;
            const char* a3 = a2 + kstep; const char* b3 = b2 + kstep;
            unsigned w0[2], w1[2];
#pragma unroll
            for (int i = 0; i < 2; ++i) { w0[i] = last ? vnA[0][i] : voA[0][i]; w1[i] = last ? vnA[1][i] : voA[1][i]; }
            PG8_LDB(B0, 0, 0); PG8_LDB(B1, 0, 1); PG8_SCHED; PG8_LDA(At, 0, 0); PG8_STAGE(PG8_SA(1, 1), a1, voA[1]);
            PG8_WAIT_V(8); PG8_WAIT_L(0); PG8_BAR; PG8_MMA(0, 0, At, B0); PG8_MMA(0, 1, At, B1); PG8_BAR; PG8_SCHED;
            PG8_LDA(At, 0, 1); PG8_STAGE(PG8_SB(0, 0), b2, voffB); PG8_STAGE(PG8_SB(0, 1), b2 + hstepB, voffB); PG8_STAGE(PG8_SA(0, 0), a2, w0);
            PG8_WAIT_V(8); PG8_WAIT_L(0); PG8_BAR; PG8_MMA(1, 0, At, B0); PG8_MMA(1, 1, At, B1); PG8_BAR; PG8_SCHED;
            PG8_LDB(B0, 1, 0); PG8_LDB(B1, 1, 1); PG8_SCHED; PG8_LDA(At, 1, 0); PG8_STAGE(PG8_SA(0, 1), a2, w1);
            PG8_WAIT_V(8); PG8_WAIT_L(0); PG8_BAR; PG8_MMA(0, 0, At, B0); PG8_MMA(0, 1, At, B1); PG8_BAR; PG8_SCHED;
            PG8_LDA(At, 1, 1); PG8_STAGE(PG8_SB(1, 0), b3, voffB); PG8_STAGE(PG8_SB(1, 1), b3 + hstepB, voffB); PG8_STAGE(PG8_SA(1, 0), a3, w0);
            PG8_WAIT_V(8); PG8_WAIT_L(0); PG8_BAR; PG8_MMA(1, 0, At, B0); PG8_MMA(1, 1, At, B1); PG8_BAR; PG8_SCHED;
        }
        if (wr == 0) PG8_BAR;
        E(acc, cur, wr, wc, fr, fq);
        if (!has_next) break;
#pragma unroll
        for (int a = 0; a < 2; ++a)
#pragma unroll
            for (int b = 0; b < 2; ++b)
#pragma unroll
                for (int m = 0; m < 4; ++m)
#pragma unroll
                    for (int n = 0; n < 2; ++n) acc[a][b][m][n] = (f32x4){0.f, 0.f, 0.f, 0.f};
        cur = nxt; cA = nA; cB = nB; ++ui;
#pragma unroll
        for (int h = 0; h < 2; ++h)
#pragma unroll
            for (int i = 0; i < 2; ++i) voA[h][i] = vnA[h][i];
        if (wr == 1) PG8_BAR;
    }
    PG8_WAIT_V(0);
    PG8_BAR;
#undef PG8_SA
#undef PG8_SB
#undef PG8_STAGE
#undef PG8_LDA
#undef PG8_LDB
#undef PG8_MMA
#undef PG8_WAIT_V
#undef PG8_WAIT_L
#undef PG8_BAR
#undef PG8_SCHED
}
}


namespace fa {
typedef float f32x16 __attribute__((ext_vector_type(16)));
typedef short s16x4 __attribute__((ext_vector_type(4)));
#define SBAR() __builtin_amdgcn_sched_barrier(0)
constexpr float THR = 8.f, LOG2E = 1.4426950408889634f;
DI int crow(int r, int hi) { return (r & 3) + 8 * (r >> 2) + 4 * hi; }
DI unsigned cvtpk(float lo, float hi) { unsigned r; asm volatile("v_cvt_pk_bf16_f32 %0, %1, %2" : "=v"(r) : "v"(lo), "v"(hi)); return r; }
DI void partialSM(f32x16& p0, f32x16& p1, float& m_reg, float& mn, float& alpha) {
    float pmax = p0[0];
#pragma unroll
    for (int r = 1; r < 16; ++r) pmax = fmaxf(pmax, p0[r]);
#pragma unroll
    for (int r = 0; r < 16; ++r) pmax = fmaxf(pmax, p1[r]);
    { auto rr = __builtin_amdgcn_permlane32_swap(__float_as_uint(pmax), __float_as_uint(pmax), false, false); pmax = fmaxf(__uint_as_float(rr[0]), __uint_as_float(rr[1])); }
    if (__builtin_expect(__all(pmax - m_reg <= THR), 1)) { mn = m_reg; alpha = 1.f; }
    else { mn = fmaxf(m_reg, pmax); alpha = __builtin_amdgcn_exp2f((m_reg - mn) * LOG2E); m_reg = mn; }
    const float mnC = -mn * LOG2E;
#pragma unroll
    for (int r = 0; r < 16; ++r) p0[r] = fmaf(p0[r], LOG2E, mnC);
#pragma unroll
    for (int r = 0; r < 16; ++r) p1[r] = fmaf(p1[r], LOG2E, mnC);
#pragma unroll
    for (int r = 0; r < 16; ++r) p0[r] = __builtin_amdgcn_exp2f(p0[r]);
}
DI void finishSM(f32x16& p0, f32x16& p1, float alpha, float& l_reg, bf16x8& pa0, bf16x8& pa1, bf16x8& pa2, bf16x8& pa3) {
#pragma unroll
    for (int r = 0; r < 16; ++r) p1[r] = __builtin_amdgcn_exp2f(p1[r]);
    float ps = 0;
#pragma unroll
    for (int r = 0; r < 16; ++r) ps += p0[r];
#pragma unroll
    for (int r = 0; r < 16; ++r) ps += p1[r];
    { auto rr = __builtin_amdgcn_permlane32_swap(__float_as_uint(ps), __float_as_uint(ps), false, false); ps = __uint_as_float(rr[0]) + __uint_as_float(rr[1]); }
    l_reg = l_reg * alpha + ps;
#define PK4(P, BASE, OUT) do { unsigned a0 = cvtpk(P[BASE + 0], P[BASE + 1]), a1 = cvtpk(P[BASE + 2], P[BASE + 3]);   \
    unsigned b0 = cvtpk(P[BASE + 4], P[BASE + 5]), b1 = cvtpk(P[BASE + 6], P[BASE + 7]);                              \
    auto r0 = __builtin_amdgcn_permlane32_swap(a0, b0, false, false); auto r1 = __builtin_amdgcn_permlane32_swap(a1, b1, false, false); \
    u32x4 w = {r0[0], r1[0], r0[1], r1[1]}; OUT = *reinterpret_cast<bf16x8*>(&w); } while (0)
    PK4(p0, 0, pa0); PK4(p0, 8, pa1); PK4(p1, 0, pa2); PK4(p1, 8, pa3);
#undef PK4
}
template <int DQK> DI void qkt(f32x16& p0, f32x16& p1, LAS const char* Ks, const int (&kb)[4], const bf16x8* qr) {
    constexpr int KROW = DQK * 2;
#pragma unroll
    for (int r = 0; r < 16; ++r) { p0[r] = 0.f; p1[r] = 0.f; }
#pragma unroll
    for (int d0 = 0; d0 < DQK / 16; ++d0) {
        const bf16x8 b0 = *(LAS const bf16x8*)(Ks + kb[d0 & 3] + (d0 >> 2) * 128);
        const bf16x8 b1 = *(LAS const bf16x8*)(Ks + kb[d0 & 3] + (d0 >> 2) * 128 + 32 * KROW);
        p0 = __builtin_amdgcn_mfma_f32_32x32x16_bf16(b0, qr[d0], p0, 0, 0, 0);
        p1 = __builtin_amdgcn_mfma_f32_32x32x16_bf16(b1, qr[d0], p1, 0, 0, 0); }
}
DI int v_rd_base(int lane) { return ((lane & 3) << 3) | (((lane >> 2) & 3) << 6) | (((lane >> 4) & 1) << 5) | (((lane >> 5) & 1) << 8); }
constexpr int v_rd_off(int d0, int ks, int half) { return d0 * 512 + ks * 4096 + half * 2048; }
template <int OFF> DI s16x4 tr_read(int vb) { s16x4 r; asm volatile("ds_read_b64_tr_b16 %0, %1 offset:%2" : "=&v"(r) : "v"(vb), "i"(OFF) : "memory"); return r; }
template <int D0> DI void pv_one(f32x16& od, int vb, bf16x8 pa0, bf16x8 pa1, bf16x8 pa2, bf16x8 pa3) {
    const s16x4 l0 = tr_read<v_rd_off(D0, 0, 0)>(vb), h0 = tr_read<v_rd_off(D0, 0, 1)>(vb), l1 = tr_read<v_rd_off(D0, 1, 0)>(vb), h1 = tr_read<v_rd_off(D0, 1, 1)>(vb);
    const s16x4 l2 = tr_read<v_rd_off(D0, 2, 0)>(vb), h2 = tr_read<v_rd_off(D0, 2, 1)>(vb), l3 = tr_read<v_rd_off(D0, 3, 0)>(vb), h3 = tr_read<v_rd_off(D0, 3, 1)>(vb);
    asm volatile("s_waitcnt lgkmcnt(0)" ::: "memory"); SBAR();
#define PK(L, H) (bf16x8){L[0], L[1], L[2], L[3], H[0], H[1], H[2], H[3]}
    od = __builtin_amdgcn_mfma_f32_32x32x16_bf16(pa0, PK(l0, h0), od, 0, 0, 0);
    od = __builtin_amdgcn_mfma_f32_32x32x16_bf16(pa1, PK(l1, h1), od, 0, 0, 0);
    od = __builtin_amdgcn_mfma_f32_32x32x16_bf16(pa2, PK(l2, h2), od, 0, 0, 0);
    od = __builtin_amdgcn_mfma_f32_32x32x16_bf16(pa3, PK(l3, h3), od, 0, 0, 0);
#undef PK
}
DI void pv_d0(f32x16* o, int vb, bf16x8 pa0, bf16x8 pa1, bf16x8 pa2, bf16x8 pa3) {
    pv_one<0>(o[0], vb, pa0, pa1, pa2, pa3); pv_one<1>(o[1], vb, pa0, pa1, pa2, pa3); pv_one<2>(o[2], vb, pa0, pa1, pa2, pa3); pv_one<3>(o[3], vb, pa0, pa1, pa2, pa3);
}
template <int DQK, bool CAUSAL>
DI void attn_unit(LAS char* lds, const bf16_t* Qb, int ldq, const bf16_t* K1, int ldk1, const bf16_t* K2, int ldk2, const bf16_t* Vb, int ldv, bf16_t* Ob, int ldo, int NT, int qtile0) {
    constexpr int KROW = DQK * 2, KT = 64 * KROW, BUF = KT + 16384, NKP = DQK / 64, ND0 = DQK / 16;
    const int tid = opaque_tid(), wid = __builtin_amdgcn_readfirstlane(tid >> 6), lane = tid & 63, r32 = lane & 31, hi = lane >> 5;
    LAS float* wsf = (LAS float*)(lds + 3 * BUF) + wid * 64; LAS float* li_l = wsf; LAS float* al_l = wsf + 32;
    const char* kp[NKP]; int kst[NKP]; const char* vp[2];
#pragma unroll
    for (int i = 0; i < NKP; ++i) { const int p = (wid * NKP + i) * 1024 + lane * 16, row = p / KROW, cbs = p % KROW, cb = cbs ^ ((row & 7) << 4);
        if (DQK == 128 || cb < 256) { kp[i] = (const char*)K1 + (size_t)row * ldk1 * 2 + cb; kst[i] = 64 * ldk1 * 2; }
        else { kp[i] = (const char*)K2 + (size_t)row * ldk2 * 2 + (cb - 256); kst[i] = 64 * ldk2 * 2; } }
#pragma unroll
    for (int i = 0; i < 2; ++i) { const int p = (wid * 2 + i) * 1024 + lane * 16, sub = p >> 9, q = (p & 511) >> 1, kk = (sub >> 2) * 8 + (q >> 5), k = (kk & ~0xC) | ((kk & 4) << 1) | ((kk & 8) >> 1), c = (sub & 3) * 32 + (q & 31);
        vp[i] = (const char*)Vb + ((size_t)k * ldv + c) * 2; }
    const int vstep = 64 * ldv * 2;
#define FA_DMA(bo) do { _Pragma("unroll") for (int _i = 0; _i < NKP; ++_i) { __builtin_amdgcn_global_load_lds((const unsigned*)kp[_i], (LAS unsigned*)(lds + (bo) + (wid * NKP + _i) * 1024), 16, 0, 0); kp[_i] += kst[_i]; } \
        _Pragma("unroll") for (int _i = 0; _i < 2; ++_i) { __builtin_amdgcn_global_load_lds((const unsigned*)vp[_i], (LAS unsigned*)(lds + (bo) + KT + (wid * 2 + _i) * 1024), 16, 0, 0); vp[_i] += vstep; } } while (0)
#define FA_SYNC() do { asm volatile("s_waitcnt vmcnt(0)" ::: "memory"); __builtin_amdgcn_s_barrier(); asm volatile("" ::: "memory"); } while (0)
    int bm1 = 0, bc = BUF, bp1 = 2 * BUF;
    FA_DMA(bm1); FA_DMA(bc);
    bf16x8 qr[ND0];
    { const bf16_t* Qw = Qb + (size_t)(wid * 32 + r32) * ldq + hi * 8;
#pragma unroll
      for (int d0 = 0; d0 < ND0; ++d0) qr[d0] = *(const bf16x8*)(Qw + d0 * 16); }
    int kb[4];
#pragma unroll
    for (int q = 0; q < 4; ++q) kb[q] = r32 * KROW + ((q * 32 + hi * 16) ^ ((r32 & 7) << 4));
    const int vb0 = (int)(uintptr_t)lds + KT + v_rd_base(lane);
    const int lim = CAUSAL ? qtile0 + (wid >> 1) : 0x7fffffff;
    float m_reg = -1e30f, l_reg = 0; f32x16 o[4];
#pragma unroll
    for (int d = 0; d < 4; ++d)
#pragma unroll
        for (int r = 0; r < 16; ++r) o[d][r] = 0.f;
    f32x16 pA0, pA1, pB0, pB1; float mnA, mnB, alA, alB; bf16x8 pa0, pa1, pa2, pa3;
#define FA_MASK(P0, P1, j) do { if (CAUSAL && (j) > lim) { _Pragma("unroll") for (int _r = 0; _r < 16; ++_r) { P0[_r] = -1e30f; P1[_r] = -1e30f; } } } while (0)
#define FA_RESC(a) do { if (__any((a) < 1.f)) { if (hi == 0) al_l[r32] = (a); asm volatile("s_waitcnt lgkmcnt(0)" ::: "memory"); \
        _Pragma("unroll") for (int _d = 0; _d < 4; ++_d) _Pragma("unroll") for (int _r = 0; _r < 16; ++_r) o[_d][_r] *= al_l[crow(_r, hi)]; } } while (0)
#define FA_ROT() do { const int _t = bm1; bm1 = bc; bc = bp1; bp1 = _t; } while (0)
    FA_SYNC();
    FA_DMA(bp1);
    qkt<DQK>(pA0, pA1, lds + bm1, kb, qr); partialSM(pA0, pA1, m_reg, mnA, alA);
    for (int j = 1; j + 1 < NT; j += 2) {
        SBAR(); qkt<DQK>(pB0, pB1, lds + bc, kb, qr);
        finishSM(pA0, pA1, alA, l_reg, pa0, pa1, pa2, pa3); SBAR();
        pv_d0(o, vb0 + bm1, pa0, pa1, pa2, pa3); FA_MASK(pB0, pB1, j); partialSM(pB0, pB1, m_reg, mnB, alB);
        FA_SYNC(); if (j + 2 < NT) FA_DMA(bm1);
        FA_RESC(alB); FA_ROT();
        SBAR(); qkt<DQK>(pA0, pA1, lds + bc, kb, qr);
        finishSM(pB0, pB1, alB, l_reg, pa0, pa1, pa2, pa3); SBAR();
        pv_d0(o, vb0 + bm1, pa0, pa1, pa2, pa3); FA_MASK(pA0, pA1, j + 1); partialSM(pA0, pA1, m_reg, mnA, alA);
        FA_SYNC(); if (j + 3 < NT) FA_DMA(bm1);
        FA_RESC(alA); FA_ROT();
    }
    SBAR(); qkt<DQK>(pB0, pB1, lds + bc, kb, qr);
    finishSM(pA0, pA1, alA, l_reg, pa0, pa1, pa2, pa3); SBAR();
    pv_d0(o, vb0 + bm1, pa0, pa1, pa2, pa3); FA_MASK(pB0, pB1, NT - 1); partialSM(pB0, pB1, m_reg, mnB, alB);
    FA_RESC(alB);
    finishSM(pB0, pB1, alB, l_reg, pa0, pa1, pa2, pa3); SBAR();
    pv_d0(o, vb0 + bc, pa0, pa1, pa2, pa3);
    if (hi == 0) li_l[r32] = l_reg; asm volatile("s_waitcnt lgkmcnt(0)" ::: "memory");
    float rli[16];
#pragma unroll
    for (int r = 0; r < 16; ++r) rli[r] = __builtin_amdgcn_rcpf(li_l[crow(r, hi)]);
    FA_SYNC();
    LAS char* Ot = lds + wid * 8704;
#pragma unroll
    for (int r = 0; r < 16; ++r)
#pragma unroll
        for (int d0 = 0; d0 < 4; ++d0) *(LAS bf16_t*)(Ot + crow(r, hi) * 272 + (d0 * 32 + r32) * 2) = (bf16_t)f2bf(o[d0][r] * rli[r]);
    asm volatile("s_waitcnt lgkmcnt(0)" ::: "memory");
#pragma unroll
    for (int i = 0; i < 8; ++i) { const int idx = i * 64 + lane, row = idx >> 4, c16 = idx & 15;
        const u32x4 v = *(LAS const u32x4*)(Ot + row * 272 + c16 * 16); *(u32x4*)(Ob + (size_t)(wid * 32 + row) * ldo + c16 * 8) = v; }
    asm volatile("s_waitcnt lgkmcnt(0)" ::: "memory"); __builtin_amdgcn_s_barrier(); asm volatile("" ::: "memory");
#undef FA_DMA
#undef FA_SYNC
#undef FA_MASK
#undef FA_RESC
#undef FA_ROT
}
DI int vcu_of(int bx, int G) { return (G % 8 == 0) ? (bx % 8) * (G / 8) + bx / 8 : bx; }
DI void mla_phase(LAS char* lds, const bf16_t* Q, const bf16_t* KN, const bf16_t* KR, const bf16_t* V, bf16_t* AO, int G, int bx) {
    const int v = vcu_of(bx, G);
    for (int p = v; p < NB * HEADS * 8; p += G) { const int bh = p >> 3, i = p & 7, b = bh / HEADS, h = bh % HEADS;
#pragma unroll 1
        for (int s = 0; s < 2; ++s) { const int qb = s ? 15 - i : i; const size_t row0 = (size_t)b * S + qb * 256, key0 = (size_t)b * S;
            attn_unit<192, true>(lds, Q + row0 * NQ + h * QKD, NQ, KN + key0 * D + h * NOPE, D, KR + key0 * ROPE, ROPE, V + key0 * D + h * VD, D, AO + row0 * D + h * VD, D, 4 * qb + 4, 4 * qb); } }
}
DI void memattn_phase(LAS char* lds, const bf16_t* MQ, const bf16_t* MK, const bf16_t* MV, bf16_t* MO, int G, int bx) {
    for (int u = bx; u < NB * MH * (S / 256); u += G) { const int qb = u % (S / 256), h = (u / (S / 256)) % MH, b = u / (S / 256 * MH); const size_t row0 = (size_t)b * S + qb * 256, key0 = (size_t)b * MEMT;
        attn_unit<128, false>(lds, MQ + row0 * MI + h * MHD, MI, MK + key0 * MI + h * MHD, MI, nullptr, 0, MV + key0 * MI + h * MHD, MI, MO + row0 * MI + h * MHD, MI, MEMT / 64, 0); }
}
}

constexpr int LDS_BYTES = 147456, LDS_MISC = 131072;
#define XB_TMO      128
#define XB_XCNT(j)  (256  + 64 * (j))
#define XB_XSUB(j)  (1280 + 64 * (j))
#define XB_XGEN(j)  (2304 + 64 * (j))
#define XB_TOP      3328
#define XB_TOPGEN   3392
#define XCD_BAR_WORDS 3456
#define XB_SPIN_CAP (1u << 18)
constexpr int CW_BAR = 4096;
DI unsigned xb_ld(unsigned* p)              { return __hip_atomic_load(p, __ATOMIC_RELAXED, __HIP_MEMORY_SCOPE_AGENT); }
DI unsigned xb_add(unsigned* p, unsigned v) { return __hip_atomic_fetch_add(p, v, __ATOMIC_RELAXED, __HIP_MEMORY_SCOPE_AGENT); }
DI unsigned xb_xcc_id() { return (unsigned)__builtin_amdgcn_s_getreg((3 << 11) | 20) & 0xFu; }
#define XB_SPIN(cond, bar) do { unsigned _sp = 0; while (cond) { __builtin_amdgcn_s_sleep(1); \
    if ((++_sp & 255u) == 0u) { if (xb_ld(&(bar)[XB_TMO])) break; if (_sp > XB_SPIN_CAP) { atomicAdd(&(bar)[XB_TMO], 1u); break; } } } } while (0)
struct XcdBarrier { unsigned* bar; unsigned x; volatile LAS unsigned* st; };
DI XcdBarrier xcd_barrier_post(unsigned* bar, volatile LAS unsigned* st) {
    XcdBarrier b; b.bar = bar; b.x = xb_xcc_id(); b.st = st;
    if (threadIdx.x == 0) (void)xb_add(&bar[XB_XCNT(b.x)], 1u);
    return b;
}
DI void xcd_barrier_complete(unsigned* bar, unsigned x, unsigned& nloc, unsigned& nx) {
    const unsigned G = gridDim.x * gridDim.y * gridDim.z;
    unsigned sum, cnt, mine, sp = 0u;
    for (;;) {
        sum = 0u; cnt = 0u; mine = 0u;
#pragma unroll
        for (unsigned j = 0; j < 16; ++j) { const unsigned c = xb_ld(&bar[XB_XCNT(j)]); sum += c; cnt += (c > 0u) ? 1u : 0u; mine = (j == x) ? c : mine; }
        if (sum == G) break;
        __builtin_amdgcn_s_sleep(1);
        if ((++sp & 255u) == 0u) { if (xb_ld(&bar[XB_TMO])) break; if (sp > XB_SPIN_CAP) { atomicAdd(&bar[XB_TMO], 1u); break; } }
    }
    nloc = mine > 0u ? mine : 1u; nx = cnt > 0u ? cnt : 1u;
}
DI void xcd_barrier(const XcdBarrier& b) {
    asm volatile("s_waitcnt vmcnt(0)" ::: "memory");
    __syncthreads();
    if (threadIdx.x == 0) {
        unsigned* bar = b.bar;
        __builtin_amdgcn_s_waitcnt(0);
        unsigned nloc = b.st[0], nx = b.st[1];
        if (nloc == 0u) { xcd_barrier_complete(bar, b.x, nloc, nx); b.st[0] = nloc; b.st[1] = nx; }
        const unsigned old = xb_add(&bar[XB_XSUB(b.x)], 1u);
        const unsigned gen = old / nloc;
        if (old + 1u == (gen + 1u) * nloc) {
            __builtin_amdgcn_fence(__ATOMIC_RELEASE, "agent");
            asm volatile("s_waitcnt vmcnt(0)" ::: "memory");
            const unsigned og = xb_add(&bar[XB_TOP], 1u);
            const unsigned tg = og / nx;
            if (og + 1u == (tg + 1u) * nx) xb_add(&bar[XB_TOPGEN], 1u);
            else XB_SPIN(xb_ld(&bar[XB_TOPGEN]) == tg, bar);
            __builtin_amdgcn_fence(__ATOMIC_ACQUIRE, "agent");
            xb_add(&bar[XB_XGEN(b.x)], 1u);
            asm volatile("s_waitcnt vmcnt(0)" ::: "memory");
        } else {
            XB_SPIN(xb_ld(&bar[XB_XGEN(b.x)]) == gen, bar);
            __builtin_amdgcn_fence(__ATOMIC_ACQUIRE, "agent");
            asm volatile("s_waitcnt vmcnt(0)" ::: "memory");
        }
    }
    __syncthreads();
}

#define LDS_WAIT() asm volatile("s_waitcnt lgkmcnt(0)" ::: "memory")
DI void wt_item(const float* W, int K, int N, bf16_t* WT, const float* kgain, const float* ngain, float scale, int perm, int row_off, LAS float* scr, int item, int lane) {
    const int nblk = N >> 5, kb = item / nblk, nb = item - kb * nblk, k0 = kb * 64, n0 = nb * 32, kr = lane >> 3, n4 = (lane & 7) * 4;
    f32x4 ng = {scale, scale, scale, scale}; if (ngain) ng = *(const f32x4*)(ngain + n0 + n4) * scale;
    f32x4 v[8];
#pragma unroll
    for (int i = 0; i < 8; ++i) v[i] = *(const f32x4*)(W + (size_t)(k0 + 8 * i + kr) * N + n0 + n4);
#pragma unroll
    for (int i = 0; i < 8; ++i) { const int k = 8 * i + kr; f32x4 x = v[i] * ng; if (kgain) x = x * kgain[k0 + k];
        scr[(n4 + 0) * 65 + k] = x.x; scr[(n4 + 1) * 65 + k] = x.y; scr[(n4 + 2) * 65 + k] = x.z; scr[(n4 + 3) * 65 + k] = x.w; }
    LDS_WAIT();
    const int kc = lane & 7;
#pragma unroll
    for (int q = 0; q < 4; ++q) { const int n = (lane >> 3) + 8 * q; const LAS float* sp = scr + n * 65 + 8 * kc;
        u32x4 o; o.x = pk2(sp[0], sp[1]); o.y = pk2(sp[2], sp[3]); o.z = pk2(sp[4], sp[5]); o.w = pk2(sp[6], sp[7]);
        *(u32x4*)(WT + (size_t)(row_off + permrow(perm, n0 + n)) * K + k0 + 8 * kc) = o; }
    LDS_WAIT();
}
struct MArgs { const void* in[32]; float* out; unsigned char* ws; int ph_lo, ph_hi, bar_region, pad; };
#define INF(i) ((const float*)P.in[i])
#define WSB(off) ((bf16_t*)(P.ws + (off)))
#define WSF(off) ((float*)(P.ws + (off)))
constexpr float SC_MEM = 0.08838834764831845f  , SC_MLA = 0.07216878364870323f  ;
DI void conv_phase(const MArgs& P, LAS unsigned char* lds, int gw, int NGW, int wave, int lane) {
    LAS float* scr = (LAS float*)(lds + wave * 16384);
    constexpr int I_POOL = 8 * 128, I_MQ = 4 * 512, I_MO = 4 * 512, I_E = 128 * 512, I_DQ = 512, I_KR = 64, I_UQ = 2 * 512, I_QR = 2 * 256, I_O = 2 * 2048, I_UK = 512;
    constexpr int NITEMS = I_POOL + 3 * I_MQ + I_MO + 3 * I_E + 3 * I_DQ + I_KR + I_UQ + I_QR + I_O + 2 * I_UK;
    for (int it = gw; it < NITEMS; it += NGW) {
        int r = it;
        if (r < I_E) { const int m = r >> 9; wt_item(INF(28) + (size_t)m * D * EFF, D, EFF, WSB(WS_WGU) + (size_t)m * 1024 * D, INF(6) + (m >> 5) * D, nullptr, 1.f, 3, 0, scr, r & 511, lane); continue; } r -= I_E;
        if (r < I_E) { const int m = r >> 9; wt_item(INF(29) + (size_t)m * D * EFF, D, EFF, WSB(WS_WGU) + (size_t)m * 1024 * D, INF(6) + (m >> 5) * D, nullptr, 1.f, 4, 0, scr, r & 511, lane); continue; } r -= I_E;
        if (r < I_E) { const int m = r >> 9; wt_item(INF(30) + (size_t)m * EFF * D, EFF, D, WSB(WS_WD) + (size_t)m * D * EFF, nullptr, nullptr, 1.f, 0, 0, scr, r & 511, lane); continue; } r -= I_E;
        if (r < I_POOL) { const int m = r >> 7; wt_item(INF(7) + (size_t)m * PG * PG, PG, PG, WSB(WS_WPOOL) + (size_t)(m >> 2) * D * PG, nullptr, INF(8) + (m >> 2) * D + (m & 3) * PG, 1.f, 0, (m & 3) * PG, scr, r & 127, lane); continue; } r -= I_POOL;
        if (r < I_MQ) { const int m = r >> 9; wt_item(INF(20) + (size_t)m * D * MI, D, MI, WSB(WS_WMQ) + (size_t)m * MI * D, INF(4) + m * D, nullptr, SC_MEM, 0, 0, scr, r & 511, lane); continue; } r -= I_MQ;
        if (r < I_MQ) { const int m = r >> 9; wt_item(INF(21) + (size_t)m * D * MI, D, MI, WSB(WS_WMK) + (size_t)m * MI * D, INF(5) + m * D, nullptr, 1.f, 0, 0, scr, r & 511, lane); continue; } r -= I_MQ;
        if (r < I_MQ) { const int m = r >> 9; wt_item(INF(22) + (size_t)m * D * MI, D, MI, WSB(WS_WMV) + (size_t)m * MI * D, INF(5) + m * D, nullptr, 1.f, 0, 0, scr, r & 511, lane); continue; } r -= I_MQ;
        if (r < I_MO) { const int m = r >> 9; wt_item(INF(23) + (size_t)m * MI * D, MI, D, WSB(WS_WMO) + (size_t)m * D * MI, nullptr, nullptr, 1.f, 0, 0, scr, r & 511, lane); continue; } r -= I_MO;
        if (r < I_DQ) { wt_item(INF(15), D, QR, WSB(WS_WDQ0), INF(3) + 2 * D, nullptr, 1.f, 0, 0, scr, r, lane); continue; } r -= I_DQ;
        if (r < I_DQ) { wt_item(INF(10), D, KVR, WSB(WS_WDQ0), INF(9), nullptr, 1.f, 0, 512, scr, r, lane); continue; } r -= I_DQ;
        if (r < I_KR) { wt_item(INF(12), D, ROPE, WSB(WS_WDQ0), INF(9), nullptr, 1.f, 5, 1024, scr, r, lane); continue; } r -= I_KR;
        if (r < I_DQ) { wt_item(INF(15) + (size_t)D * QR, D, QR, WSB(WS_WDQ1), INF(3) + 3 * D, nullptr, 1.f, 0, 0, scr, r, lane); continue; } r -= I_DQ;
        if (r < I_UQ) { const int m = r >> 9; wt_item(INF(17) + (size_t)m * QR * D, QR, HEADS * NOPE, WSB(WS_WUQ) + (size_t)m * NQ * QR, INF(16) + m * QR, nullptr, SC_MLA, 1, 0, scr, r & 511, lane); continue; } r -= I_UQ;
        if (r < I_QR) { const int m = r >> 8; wt_item(INF(18) + (size_t)m * QR * HEADS * ROPE, QR, HEADS * ROPE, WSB(WS_WUQ) + (size_t)m * NQ * QR, INF(16) + m * QR, nullptr, SC_MLA, 2, 0, scr, r & 255, lane); continue; } r -= I_QR;
        if (r < I_O) { const int m = r >> 11; wt_item(INF(19) + (size_t)m * D * D, D, D, WSB(WS_WO) + (size_t)m * D * D, nullptr, nullptr, 1.f, 0, 0, scr, r & 2047, lane); continue; } r -= I_O;
        if (r < I_UK) { wt_item(INF(13), KVR, D, WSB(WS_WUKV), INF(11), nullptr, 1.f, 0, 0, scr, r, lane); continue; } r -= I_UK;
        wt_item(INF(14), KVR, D, WSB(WS_WUKV), INF(11), nullptr, 1.f, 0, 2048, scr, r, lane);
    }
}
DI void tables_phase(const MArgs& P, int gtid, int NT_) {
    for (int idx = gtid; idx < T * 32; idx += NT_) { const int t = idx >> 5, i = idx & 31;
        const float inv = (float)(1.0 / pow(10000.0, (double)i / 32.0)); const float ang = (float)((const int*)P.in[2])[t] * inv;
        const double rev = (double)ang * 0.15915494309189533577; const float fr = (float)(rev - rint(rev));
        WSF(WS_COS)[idx] = __builtin_amdgcn_cosf(fr); WSF(WS_SIN)[idx] = __builtin_amdgcn_sinf(fr); }
    for (int idx = gtid; idx < DEPTH * 36 * D; idx += NT_) { const int l = idx / (36 * D), n = (idx / D) % 36, k = idx % D;
        const float w = n < 4 ? INF(24)[((size_t)l * D + k) * 4 + n] : INF(26)[((size_t)l * D + k) * 32 + (n - 4)]; WSF(WS_RWT)[idx] = w * INF(6)[l * D + k]; }
    unsigned* z = (unsigned*)(WSB(WS_WDQ0) + (size_t)1088 * D);
    for (int idx = gtid; idx < (NDQ0 - 1088) * D / 2; idx += NT_) z[idx] = 0u;
}
DI void memprep_phase(const MArgs& P, int gw, int NGW, int lane) {
    for (int r = gw; r < NB * MEMT; r += NGW) { const f32x4* x = (const f32x4*)(INF(1) + (size_t)r * D) + lane; float ss = 0.f;
#pragma unroll
        for (int j = 0; j < 8; ++j) { const f32x4 v = x[64 * j]; ss += (v.x * v.x + v.y * v.y) + (v.z * v.z + v.w * v.w);
            u32x2 o; o.x = pk2(v.x, v.y); o.y = pk2(v.z, v.w); *((u32x2*)(WSB(WS_MEMB) + (size_t)r * D) + lane + 64 * j) = o; }
        ss = wave_sum(ss); if (lane == 0) WSF(WS_MEMRS)[r] = rsqrtf(ss * (1.0f / D) + EPS); }
}
DI void combine_phase(const float* src, const bf16_t* Y, float* H, bf16_t* HB, float* RS0, const float* gain, bf16_t* HN, float* out, int gw, int NGW, int lane) {
    for (int t = gw; t < T; t += NGW) {
        const f32x4* x = (const f32x4*)(src + (size_t)t * D) + lane; f32x4 v[8]; float ss = 0.f;
#pragma unroll
        for (int j = 0; j < 8; ++j) { v[j] = x[64 * j];
            if (Y) { const u32x2 a = *((const u32x2*)(Y + (size_t)(2 * t) * D) + lane + 64 * j), b = *((const u32x2*)(Y + (size_t)(2 * t + 1) * D) + lane + 64 * j);
                v[j].x = (v[j].x + __uint_as_float(a.x << 16)) + __uint_as_float(b.x << 16); v[j].y = (v[j].y + __uint_as_float(a.x & 0xffff0000u)) + __uint_as_float(b.x & 0xffff0000u);
                v[j].z = (v[j].z + __uint_as_float(a.y << 16)) + __uint_as_float(b.y << 16); v[j].w = (v[j].w + __uint_as_float(a.y & 0xffff0000u)) + __uint_as_float(b.y & 0xffff0000u); }
            ss += (v[j].x * v[j].x + v[j].y * v[j].y) + (v[j].z * v[j].z + v[j].w * v[j].w); }
        ss = wave_sum(ss); const float rs = rsqrtf(ss * (1.0f / D) + EPS);
        if (lane == 0 && RS0) RS0[t] = rs;
#pragma unroll
        for (int j = 0; j < 8; ++j) {
            if (H) *((f32x4*)(H + (size_t)t * D) + lane + 64 * j) = v[j];
            if (HB) { u32x2 o; o.x = pk2(v[j].x, v[j].y); o.y = pk2(v[j].z, v[j].w); *((u32x2*)(HB + (size_t)t * D) + lane + 64 * j) = o; }
            if (gain) { const f32x4 g = *((const f32x4*)gain + lane + 64 * j); const f32x4 n = v[j] * g * rs;
                if (HN) { u32x2 o; o.x = pk2(n.x, n.y); o.y = pk2(n.z, n.w); *((u32x2*)(HN + (size_t)t * D) + lane + 64 * j) = o; }
                if (out) *((f32x4*)(out + (size_t)t * D) + lane + 64 * j) = n; } }
    }
}
DI void pool_phase(const bf16_t* HN, bf16_t* U, int vcu, int G, int tid) {
    for (int t = vcu * 2 + (tid >> 8); t < T; t += 2 * G) { const int c = (tid & 255) * 8, s = t & (S - 1), w = 2 << (c >> 9), n = (s + 1 < w) ? s + 1 : w;
        float acc[8] = {0.f, 0.f, 0.f, 0.f, 0.f, 0.f, 0.f, 0.f}, self[8] = {0.f, 0.f, 0.f, 0.f, 0.f, 0.f, 0.f, 0.f};
        for (int i = 0; i < n; ++i) { const u32x4 v = *(const u32x4*)(HN + (size_t)(t - i) * D + c);
            const float f[8] = {__uint_as_float(v.x << 16), __uint_as_float(v.x & 0xffff0000u), __uint_as_float(v.y << 16), __uint_as_float(v.y & 0xffff0000u),
                                __uint_as_float(v.z << 16), __uint_as_float(v.z & 0xffff0000u), __uint_as_float(v.w << 16), __uint_as_float(v.w & 0xffff0000u)};
#pragma unroll
            for (int q = 0; q < 8; ++q) { acc[q] += f[q]; if (i == 0) self[q] = f[q]; } }
        const float inv = 1.0f / (float)n; u32x4 o;
        o.x = pk2(acc[0] * inv - self[0], acc[1] * inv - self[1]); o.y = pk2(acc[2] * inv - self[2], acc[3] * inv - self[3]);
        o.z = pk2(acc[4] * inv - self[4], acc[5] * inv - self[5]); o.w = pk2(acc[6] * inv - self[6], acc[7] * inv - self[7]);
        *(u32x4*)(U + (size_t)t * D + c) = o; }
}
DI void router_phase(const float* H, const float* RWT, const float* rg_b, const float* re_b, float* RS2, int* cnt, int* list, float* gwt, int gw, int NGW, int lane) {
    for (int t = gw; t < T; t += NGW) {
        const f32x4* x = (const f32x4*)(H + (size_t)t * D) + lane; f32x4 v[8]; float ss = 0.f;
#pragma unroll
        for (int j = 0; j < 8; ++j) { v[j] = x[64 * j]; ss += (v[j].x * v[j].x + v[j].y * v[j].y) + (v[j].z * v[j].z + v[j].w * v[j].w); }
        ss = wave_sum(ss); const float rs = rsqrtf(ss * (1.0f / D) + EPS);
        float mine = 0.f;
        for (int n = 0; n < 36; ++n) { const f32x4* w = (const f32x4*)(RWT + (size_t)n * D) + lane; float p = 0.f;
#pragma unroll
            for (int j = 0; j < 8; ++j) { const f32x4 ww = w[64 * j]; p += (v[j].x * ww.x + v[j].y * ww.y) + (v[j].z * ww.z + v[j].w * ww.w); }
            p = wave_sum(p); const float bias = n < 4 ? rg_b[n] : re_b[n - 4]; if (lane == n) mine = p * rs + bias; }
        const float g0 = __shfl(mine, 0), g1 = __shfl(mine, 1), g2 = __shfl(mine, 2), g3 = __shfl(mine, 3);
        int gs = 0; float gm = g0; if (g1 > gm) { gm = g1; gs = 1; } if (g2 > gm) { gm = g2; gs = 2; } if (g3 > gm) { gm = g3; gs = 3; }
        const float gp = 1.0f / (__expf(g0 - gm) + __expf(g1 - gm) + __expf(g2 - gm) + __expf(g3 - gm));
        float ev[8];
#pragma unroll
        for (int i = 0; i < 8; ++i) ev[i] = __shfl(mine, 4 + gs * 8 + i);
        int i0 = 0; float m0 = ev[0];
#pragma unroll
        for (int i = 1; i < 8; ++i) if (ev[i] > m0) { m0 = ev[i]; i0 = i; }
        int i1 = -1; float m1 = -3.0e38f;
#pragma unroll
        for (int i = 0; i < 8; ++i) if (i != i0 && ev[i] > m1) { m1 = ev[i]; i1 = i; }
        const float e1 = __expf(m1 - m0), w0 = gp / (1.0f + e1), w1 = gp * e1 / (1.0f + e1);
        if (lane == 0) { RS2[t] = rs; const int ea = gs * 8 + i0, eb = gs * 8 + i1;
            const int pa = atomicAdd(&cnt[ea], 1); list[(size_t)ea * CAP + pa] = 2 * t; gwt[2 * t] = w0;
            const int pb = atomicAdd(&cnt[eb], 1); list[(size_t)eb * CAP + pb] = 2 * t + 1; gwt[2 * t + 1] = w1; }
    }
}
namespace fg {
struct EpiMemKV {
    bf16_t* O; const float* rs;
    DI void operator()(const Acc& acc, const Unit& u, int wr, int wc, int fr, int fq) const {
#pragma unroll
        for (int ai = 0; ai < 2; ++ai)
#pragma unroll
            for (int m = 0; m < 4; ++m) { const int r = u.pm * BM + ai * HALF + wr * 64 + m * 16 + fr; const float sc = rs[r];
#pragma unroll
                for (int bj = 0; bj < 2; ++bj) { const int c0 = (u.pn & 1) * BM + bj * HALF + wc * 32 + 8 * fq;
                    *(u32x4*)(O + (size_t)(u.pn >> 1) * (NB * MEMT * MI) + (size_t)r * MI + c0) = pack8(acc[ai][bj][m][0] * sc, acc[ai][bj][m][1] * sc); } }
    }
};
}
DI void moe_prefix(LAS unsigned char* lds, const int* cnt) {
    LAS int* pref = (LAS int*)(lds + LDS_MISC + 1024); const int tid = opaque_tid();
    if (tid < 32) pref[64 + tid] = cnt[tid];
    __syncthreads();
    if (tid == 0) { int s = 0; for (int e = 0; e < NE; ++e) { pref[e] = s; s += (pref[64 + e] + 255) >> 8; } pref[32] = s; }
    __syncthreads();
}

__global__ void __launch_bounds__(512, 2) mk_fwd(MArgs a) {
    extern __shared__ __attribute__((aligned(16))) unsigned char lds_raw[];
    LAS unsigned char* lds = (LAS unsigned char*)lds_raw;
    const int G = gridDim.x, bx = blockIdx.x, vcu = fa::vcu_of(bx, G), NGW = G * 8;
    volatile LAS unsigned* MISC = (volatile LAS unsigned*)(lds + LDS_MISC);
    if (threadIdx.x < 64) MISC[threadIdx.x] = 0u;
    __syncthreads();
    unsigned char* ws = a.ws;
    XcdBarrier bar = xcd_barrier_post((unsigned*)(ws + WS_CTL) + CW_BAR + a.bar_region * XCD_BAR_WORDS, MISC + 8);
    const MArgs& P = a;
    int pid = 0; const int lo = a.ph_lo, hi = a.ph_hi;
#define PH_IF if (pid >= lo && pid < hi)
#define TL const int tid = opaque_tid(), lane = tid & 63, wave = __builtin_amdgcn_readfirstlane(tid >> 6), gw = vcu * 8 + wave; (void)lane; (void)gw
#define PH_END do { if (pid >= lo && pid + 1 < hi) xcd_barrier(bar); ++pid; } while (0)
    PH_IF { TL; conv_phase(P, lds, gw, NGW, wave, lane); tables_phase(P, vcu * 512 + tid, G * 512); memprep_phase(P, gw, NGW, lane);
            combine_phase(INF(0), nullptr, WSF(WS_H), WSB(WS_HB), WSF(WS_RS0), INF(3), WSB(WS_HN), nullptr, gw, NGW, lane); }
    PH_END;
    for (int l = 0; l < DEPTH; ++l) {
        const bool isA = l < NA; const int j = l - NA;
        if (l > 0) { PH_IF { TL; combine_phase(WSF(WS_H), WSB(WS_Y), WSF(WS_H), WSB(WS_HB), WSF(WS_RS0), isA ? INF(3) + l * D : nullptr, isA ? WSB(WS_HN) : nullptr, nullptr, gw, NGW, lane); } PH_END; }
        if (isA) {
            PH_IF { if (l == 0) { fg::ProbDense pr{(const char*)WSB(WS_MEMB), (const char*)WSB(WS_WMK), (const char*)WSB(WS_MEMB), (const char*)WSB(WS_WMK), NB * MEMT / 256, 16, 16, D, D, 0, G, bx}; fg::EpiMemKV E{WSB(WS_MK), WSF(WS_MEMRS)}; fg::gemm_phase(lds, pr, E); }
                    { TL; pool_phase(WSB(WS_HN), WSB(WS_U), vcu, G, tid); } }
            PH_END;
        } else {
            PH_IF { const int n = j == 0 ? NDQ0 : QR; const char* B = (const char*)(j == 0 ? WSB(WS_WDQ0) : WSB(WS_WDQ1));
                    fg::ProbDense pr{(const char*)WSB(WS_HB), B, (const char*)WSB(WS_HB), B, T / 256, n / 256, n / 256, D, D, 0, G, bx};
                    fg::EpiDQ E{WSB(WS_CQ), WSB(WS_CKV), WSB(WS_KR), WSF(WS_RS0), WSF(WS_LSQ), WSF(WS_LSKV), WSF(WS_COS), WSF(WS_SIN)}; fg::gemm_phase(lds, pr, E); }
            PH_END;
            PH_IF { fg::ProbDense pr{(const char*)WSB(WS_CQ), (const char*)(WSB(WS_WUQ) + (size_t)j * NQ * QR), (const char*)WSB(WS_CKV), (const char*)WSB(WS_WUKV), T / 256, (j == 0 ? NQ + 4096 : NQ) / 256, NQ / 256, QR, QR, 0, G, bx};
                    fg::EpiUQ E{WSB(WS_Q), WSB(WS_KN), WSB(WS_V), WSF(WS_LSQ), WSF(WS_LSKV), WSF(WS_COS), WSF(WS_SIN)}; fg::gemm_phase(lds, pr, E); }
            PH_END;
            PH_IF { fa::mla_phase((LAS char*)lds, WSB(WS_Q), WSB(WS_KN), WSB(WS_KR), WSB(WS_V), WSB(WS_AO), G, bx); }
            PH_END;
        }
        PH_IF { const char* A = (const char*)(isA ? WSB(WS_U) : WSB(WS_AO)); const char* B = (const char*)(isA ? WSB(WS_WPOOL) + (size_t)l * D * PG : WSB(WS_WO) + (size_t)j * D * D);
                fg::ProbDense pr{A, B, A, B, T / 256, D / 256, D / 256, isA ? PG : D, D, isA ? 1 : 0, G, bx}; fg::EpiRes<true> E{WSF(WS_H), WSB(WS_HB), WSF(WS_SSP)}; fg::gemm_phase(lds, pr, E); }
        PH_END;
        PH_IF { const char* B = (const char*)(WSB(WS_WMQ) + (size_t)l * MI * D); fg::ProbDense pr{(const char*)WSB(WS_HB), B, (const char*)WSB(WS_HB), B, T / 256, MI / 256, MI / 256, D, D, 0, G, bx};
                fg::EpiBf16RS<2> E{WSB(WS_MQ), MI, WSF(WS_SSP)}; fg::gemm_phase(lds, pr, E); }
        PH_END;
        PH_IF { fa::memattn_phase((LAS char*)lds, WSB(WS_MQ), WSB(WS_MK) + (size_t)l * NB * MEMT * MI, WSB(WS_MV) + (size_t)l * NB * MEMT * MI, WSB(WS_MO), G, bx); }
        PH_END;
        PH_IF { const char* B = (const char*)(WSB(WS_WMO) + (size_t)l * D * MI); fg::ProbDense pr{(const char*)WSB(WS_MO), B, (const char*)WSB(WS_MO), B, T / 256, D / 256, D / 256, MI, MI, 0, G, bx};
                fg::EpiRes<false> E{WSF(WS_H), WSB(WS_HB), nullptr}; fg::gemm_phase(lds, pr, E); }
        PH_END;
        PH_IF { TL; router_phase(WSF(WS_H), WSF(WS_RWT) + (size_t)l * 36 * D, INF(25) + l * NG, INF(27) + l * NE, WSF(WS_RS2), ((int*)(P.ws + WS_CTL + OFF_CNT)) + l * NE, ((int*)(P.ws + WS_LIST)), WSF(WS_GW), gw, NGW, lane); }
        PH_END;
        PH_IF { moe_prefix(lds, ((int*)(P.ws + WS_CTL + OFF_CNT)) + l * NE);
                fg::ProbMoe pr{(const char*)WSB(WS_HB), (const char*)(WSB(WS_WGU) + (size_t)l * NE * 1024 * D), ((int*)(P.ws + WS_LIST)), (const LAS int*)(lds + LDS_MISC + 1024), 4, D, D, 1, G, bx, (long)1024 * D * 2};
                fg::EpiMoe1 E{WSB(WS_HH), WSF(WS_RS2), ((int*)(P.ws + WS_LIST))}; fg::gemm_phase(lds, pr, E); }
        PH_END;
        PH_IF { moe_prefix(lds, ((int*)(P.ws + WS_CTL + OFF_CNT)) + l * NE);
                fg::ProbMoe pr{(const char*)WSB(WS_HH), (const char*)(WSB(WS_WD) + (size_t)l * NE * D * EFF), ((int*)(P.ws + WS_LIST)), (const LAS int*)(lds + LDS_MISC + 1024), 8, EFF, EFF, 0, G, bx, (long)D * EFF * 2};
                fg::EpiMoe2 E{WSB(WS_Y), WSF(WS_GW), ((int*)(P.ws + WS_LIST))}; fg::gemm_phase(lds, pr, E); }
        PH_END;
    }
    PH_IF { TL; combine_phase(WSF(WS_H), WSB(WS_Y), nullptr, nullptr, nullptr, INF(31), nullptr, P.out, gw, NGW, lane); }
#undef PH_IF
#undef PH_END
}
constexpr int NPHASES = 1 + 8 + 9 + 11 + 11 + 1;

#ifndef MK_SPLIT
#define MK_SPLIT 0
#endif
extern "C" void kernel_launch(void* const* d_in, const int* in_sizes, int n_in, void* d_out, int out_size, void* d_ws, size_t ws_size, hipStream_t stream) {
    static int grid = 0;
    if (grid == 0) {
        if (n_in != 32 || in_sizes[0] != T * D || out_size != T * D || ws_size < WS_END) { fprintf(stderr, "kernel_launch: shape/ws mismatch (ws %zu need %zu)\n", ws_size, (size_t)WS_END); grid = -1; return; }
        int dev = 0, cus = 0;
        if (hipGetDevice(&dev) != hipSuccess || hipDeviceGetAttribute(&cus, hipDeviceAttributeMultiprocessorCount, dev) != hipSuccess || cus <= 0) { fprintf(stderr, "kernel_launch: device query failed\n"); grid = -1; return; }
        if (hipFuncSetAttribute((const void*)mk_fwd, hipFuncAttributeMaxDynamicSharedMemorySize, LDS_BYTES) != hipSuccess) { fprintf(stderr, "kernel_launch: hipFuncSetAttribute failed\n"); grid = -1; return; }
        int per_cu = 0;
        if (hipOccupancyMaxActiveBlocksPerMultiprocessor(&per_cu, (const void*)mk_fwd, 512, LDS_BYTES) != hipSuccess || per_cu < 1) fprintf(stderr, "kernel_launch: occupancy query says %d\n", per_cu);
        (void)hipGetLastError();
        grid = cus;
    }
    if (grid < 0) return;
    if (hipMemsetAsync((char*)d_ws + WS_CTL, 0, CTL_BYTES, stream) != hipSuccess) { fprintf(stderr, "kernel_launch: memset failed\n"); return; }
    MArgs a; memset(&a, 0, sizeof(a));
    for (int i = 0; i < 32; ++i) a.in[i] = d_in[i];
    a.out = (float*)d_out; a.ws = (unsigned char*)d_ws;
#if MK_SPLIT
    for (int p = 0; p < NPHASES; ++p) { a.ph_lo = p; a.ph_hi = p + 1; a.bar_region = 0; hipLaunchKernelGGL(mk_fwd, dim3(grid), dim3(512), LDS_BYTES, stream, a); }
#else
    a.ph_lo = 0; a.ph_hi = NPHASES; a.bar_region = 0; hipLaunchKernelGGL(mk_fwd, dim3(grid), dim3(512), LDS_BYTES, stream, a);
#endif
    const hipError_t le = hipPeekAtLastError();
    if (le != hipSuccess) fprintf(stderr, "kernel_launch: launch failed: %s\n", hipGetErrorName(le));
}
```

```cpp
#include <hip/hip_runtime.h>
#include <cstdio>
#include <cstdint>
#include <cstring>

typedef unsigned short bf16_t;
typedef float f32x4 __attribute__((ext_vector_type(4)));
typedef unsigned u32x4 __attribute__((ext_vector_type(4)));
typedef unsigned u32x2 __attribute__((ext_vector_type(2)));
#define DI __device__ __forceinline__

constexpr int D = 2048, NB = 4, S = 4096, T = NB * S, DEPTH = 4, NA = 2;
constexpr int CHUNK = 64;
constexpr int PG = 512;
constexpr int HEADS = 16, QR = 512, KVR = 512, NOPE = 128, ROPE = 64, VD = 128, QKD = NOPE + ROPE;
constexpr int MEMT = 256, MH = 4, MHD = 128, MI = 512;
constexpr int NG = 4, EPG = 8, NE = 32, EFF = 512;
constexpr float EPS = 1e-6f;
constexpr int CAP = T;
constexpr int MAXROWS = 2 * T + NE * 256;
constexpr int NQ = HEADS * QKD;
constexpr int NDQ0 = 1280;

constexpr size_t al(size_t x) { return (x + 255) & ~(size_t)255; }
constexpr size_t WS_CTL = 0, CTL_BYTES = 1u << 20;
constexpr size_t OFF_CNT = 65536;
constexpr size_t WS_WPOOL = WS_CTL + CTL_BYTES;
constexpr size_t WS_WMQ = WS_WPOOL + (size_t)NA * D * PG * 2;
constexpr size_t WS_WMK = WS_WMQ + (size_t)DEPTH * MI * D * 2;
constexpr size_t WS_WMV = WS_WMK + (size_t)DEPTH * MI * D * 2;
constexpr size_t WS_WMO = WS_WMV + (size_t)DEPTH * MI * D * 2;
constexpr size_t WS_WDQ0 = WS_WMO + (size_t)DEPTH * D * MI * 2;
constexpr size_t WS_WDQ1 = WS_WDQ0 + (size_t)NDQ0 * D * 2;
constexpr size_t WS_WUQ = WS_WDQ1 + (size_t)QR * D * 2;
constexpr size_t WS_WUKV = WS_WUQ + (size_t)2 * NQ * QR * 2;
constexpr size_t WS_WO = WS_WUKV + (size_t)4096 * KVR * 2;
constexpr size_t WS_RWT = WS_WO + (size_t)2 * D * D * 2;
constexpr size_t WS_WGU = al(WS_RWT + (size_t)DEPTH * 36 * D * 4);
constexpr size_t WS_WD = WS_WGU + (size_t)DEPTH * NE * 1024 * D * 2;
constexpr size_t WS_H = WS_WD + (size_t)DEPTH * NE * D * EFF * 2;
constexpr size_t WS_HB = WS_H + (size_t)T * D * 4;
constexpr size_t WS_Y = WS_HB + (size_t)T * D * 2;
constexpr size_t WS_HH = WS_Y + (size_t)2 * T * D * 2;
constexpr size_t WS_KN = WS_HH + (size_t)MAXROWS * EFF * 2;
constexpr size_t WS_V = WS_KN + (size_t)T * D * 2;
constexpr size_t WS_Q = WS_V + (size_t)T * D * 2;
constexpr size_t WS_HN = WS_Q;
constexpr size_t WS_U = WS_Q + (size_t)T * D * 2;
constexpr size_t WS_AO = WS_Q + (size_t)T * NQ * 2;
constexpr size_t WS_MQ = WS_AO + (size_t)T * D * 2;
constexpr size_t WS_MO = WS_MQ + (size_t)T * MI * 2;
constexpr size_t WS_CQ = WS_MO + (size_t)T * MI * 2;
constexpr size_t WS_CKV = WS_CQ + (size_t)T * QR * 2;
constexpr size_t WS_KR = WS_CKV + (size_t)T * KVR * 2;
constexpr size_t WS_MEMB = WS_KR + (size_t)T * ROPE * 2;
constexpr size_t WS_MK = WS_MEMB + (size_t)NB * MEMT * D * 2;
constexpr size_t WS_MV = WS_MK + (size_t)DEPTH * NB * MEMT * MI * 2;
constexpr size_t WS_SSP = WS_MV + (size_t)DEPTH * NB * MEMT * MI * 2;
constexpr size_t WS_LSQ = WS_SSP + (size_t)T * 32 * 4;
constexpr size_t WS_LSKV = WS_LSQ + (size_t)T * 8 * 4;
constexpr size_t WS_RS0 = WS_LSKV + (size_t)T * 8 * 4;
constexpr size_t WS_RS2 = WS_RS0 + (size_t)T * 4;
constexpr size_t WS_MEMRS = WS_RS2 + (size_t)T * 4;
constexpr size_t WS_COS = WS_MEMRS + 4096;
constexpr size_t WS_SIN = WS_COS + (size_t)T * 32 * 4;
constexpr size_t WS_GW = WS_SIN + (size_t)T * 32 * 4;
constexpr size_t WS_LIST = WS_GW + (size_t)2 * T * 4;
constexpr size_t WS_RWH = WS_LIST + (size_t)NE * CAP * 4;
constexpr size_t WS_END = WS_RWH + (size_t)DEPTH * 2 * 48 * D * 2;
static_assert(WS_U + (size_t)T * D * 2 <= WS_MQ, "U overlay inside Q|AO");

DI float bf2f(bf16_t b) { return __uint_as_float(((unsigned)b) << 16); }
DI unsigned f2bf(float f) { unsigned u = __float_as_uint(f); return (u + 0x7fffu + ((u >> 16) & 1u)) >> 16; }
DI unsigned pk2(float lo, float hi) { return f2bf(lo) | (f2bf(hi) << 16); }
DI float wave_sum(float v) {
#pragma unroll
    for (int o = 1; o < 64; o <<= 1) v += __shfl_xor(v, o);
    return v;
}
DI int opaque_tid() { int t = threadIdx.x; asm volatile("" : "+v"(t)); return t; }
DI float silu(float x) { return x / (1.0f + __expf(-x)); }

DI int permrow(int perm, int n) {
    switch (perm) {
        case 1: return (n >> 7) * QKD + (n & 127);
        case 2: { const int h = n >> 6, r = n & 63; return h * QKD + NOPE + 2 * (r & 31) + (r >> 5); }
        case 3: return (n >> 7) * 256 + (n & 127);
        case 4: return (n >> 7) * 256 + 128 + (n & 127);
        case 5: return 2 * (n & 31) + (n >> 5);
        default: return n;
    }
}
#define LAS __attribute__((address_space(3)))
typedef short bf16x8 __attribute__((ext_vector_type(8)));
namespace fg {
constexpr int BM = 256, BK = 64, HALF = 128, HTB = HALF * BK * 2, STAGE_BYTES = 8 * HTB, NXCD = 8, WGM = 8;
DI int lds_byte(int r, int c) { const int st = (r >> 4) * 2 + (c >> 5), rr = r & 15, cc = c & 31, ob = rr * 64 + cc * 2; return st * 1024 + (ob ^ (((ob >> 9) & 1) << 5)); }
DI void stage_rc(int b, int& R, int& C) { const int st = b / 1024, sb = b % 1024, swz = sb ^ (((sb >> 9) & 1) << 5); R = (st >> 1) * 16 + swz / 64; C = (st & 1) * 32 + (swz % 64) / 2; }
DI int perm32(int rho) { const int n = rho >> 4, i = rho & 15; return 8 * (i >> 2) + 4 * n + (i & 3); }
DI unsigned cvt_pk_bf16(float lo, float hi) { unsigned r; asm volatile("v_cvt_pk_bf16_f32 %0, %1, %2" : "=v"(r) : "v"(lo), "v"(hi)); return r; }
struct Unit { int pm, pn, e, r0, cnt; };

struct ProbDense {
    const char* A0; const char* B0; const char* A1; const char* B1; int nM, nN, nN0, K, lda, pool, G, c;
    static constexpr bool GATHER = false;
    DI bool next(int i, Unit& u) const {
        const long L = (long)i * G + c; const int nwg = nM * nN; if (L >= nwg) return false;
        int wgid = (int)L; { const int q = nwg / NXCD, r = nwg % NXCD, xcd = wgid % NXCD, off = wgid / NXCD; wgid = (xcd < r ? xcd * (q + 1) : r * (q + 1) + (xcd - r) * q) + off; }
        const int nig = WGM * nN, gid = wgid / nig, fm = gid * WGM, gsz = (nM - fm) < WGM ? (nM - fm) : WGM;
        u.pm = fm + ((wgid % nig) % gsz); u.pn = (wgid % nig) / gsz; u.e = 0; u.r0 = 0; u.cnt = 256; return true; }
    DI const char* aptr(const Unit& u) const { return (u.pn < nN0 ? A0 : A1) + (size_t)u.pm * 256 * lda * 2 + (pool ? (size_t)(u.pn >> 1) * 1024 : 0); }
    DI const char* bptr(const Unit& u) const { return u.pn < nN0 ? B0 + (size_t)u.pn * 256 * K * 2 : B1 + (size_t)(u.pn - nN0) * 256 * K * 2; }
    DI void avoff(const Unit&, const int (&R)[2], const int (&C)[2], unsigned (&vo)[2][2]) const {
#pragma unroll
        for (int h = 0; h < 2; ++h)
#pragma unroll
            for (int i = 0; i < 2; ++i) vo[h][i] = (unsigned)((h * 128 + R[i]) * lda + C[i]) * 2u; }
};
struct ProbMoe {
    const char* A; const char* Bt; const int* list; const LAS int* pref; int npn, K, lda, gather, G, c; long estride;
    static constexpr bool GATHER = true;
    DI bool next(int i, Unit& u) const {
        const int L = i * G + c, tile = L / npn; if (tile >= pref[32]) return false;
        int e = 0; while (pref[e + 1] <= tile) ++e;
        u.pm = tile; u.pn = L % npn; u.e = e; u.r0 = (tile - pref[e]) * 256; u.cnt = pref[64 + e]; return true; }
    DI const char* aptr(const Unit& u) const { return gather ? A : A + (size_t)u.pm * 256 * lda * 2; }
    DI const char* bptr(const Unit& u) const { return Bt + (size_t)u.e * estride + (size_t)u.pn * 256 * K * 2; }
    DI void avoff(const Unit& u, const int (&R)[2], const int (&C)[2], unsigned (&vo)[2][2]) const {
#pragma unroll
        for (int h = 0; h < 2; ++h)
#pragma unroll
            for (int i = 0; i < 2; ++i) { const int row = h * 128 + R[i];
                if (gather) { const int ri = u.r0 + row; const int tok = ri < u.cnt ? (list[(size_t)u.e * CAP + ri] >> 1) : 0; vo[h][i] = (unsigned)(tok * lda + C[i]) * 2u; }
                else vo[h][i] = (unsigned)(row * lda + C[i]) * 2u; } }
};

typedef f32x4 Acc[2][2][4][2];
DI float quad_sum(float s) { s += __shfl_xor(s, 16); s += __shfl_xor(s, 32); return s; }
DI float sq8(const f32x4& a, const f32x4& b) { return ((a.x * a.x + a.y * a.y) + (a.z * a.z + a.w * a.w)) + ((b.x * b.x + b.y * b.y) + (b.z * b.z + b.w * b.w)); }
DI u32x4 pack8(const f32x4& a, const f32x4& b) { u32x4 w; w.x = cvt_pk_bf16(a.x, a.y); w.y = cvt_pk_bf16(a.z, a.w); w.z = cvt_pk_bf16(b.x, b.y); w.w = cvt_pk_bf16(b.z, b.w); return w; }
template <int NP> DI float rs_from_parts(const float* part, int r, int fq, float inv_n) {
    float s;
    if (NP == 32) { const f32x4 a = *(const f32x4*)(part + (size_t)r * 32 + fq * 8), b = *(const f32x4*)(part + (size_t)r * 32 + fq * 8 + 4); s = ((a.x + a.y) + (a.z + a.w)) + ((b.x + b.y) + (b.z + b.w)); }
    else { const float* p = part + (size_t)r * 8 + fq * 2; s = p[0] + p[1]; }
    s = quad_sum(s); return rsqrtf(s * inv_n + EPS);
}
DI void rope8(f32x4& a, f32x4& b, const float* COS, const float* SIN, int r, int i0) {
    const f32x4 c = *(const f32x4*)(COS + (size_t)r * 32 + i0), s = *(const f32x4*)(SIN + (size_t)r * 32 + i0);
    const f32x4 a2 = {a.x * c.x - a.y * s.x, a.y * c.x + a.x * s.x, a.z * c.y - a.w * s.y, a.w * c.y + a.z * s.y};
    const f32x4 b2 = {b.x * c.z - b.y * s.z, b.y * c.z + b.x * s.z, b.z * c.w - b.w * s.w, b.w * c.w + b.z * s.w};
    a = a2; b = b2;
}
template <bool STATS> struct EpiRes {
    float* H; bf16_t* HB; float* SSP;
    DI void operator()(const Acc& acc, const Unit& u, int wr, int wc, int fr, int fq) const {
#pragma unroll
        for (int ai = 0; ai < 2; ++ai)
#pragma unroll
            for (int m = 0; m < 4; ++m) { const int r = u.pm * BM + ai * HALF + wr * 64 + m * 16 + fr; float ss = 0.f;
#pragma unroll
                for (int bj = 0; bj < 2; ++bj) { const int c0 = u.pn * BM + bj * HALF + wc * 32 + 8 * fq; float* hp = H + (size_t)r * D + c0;
                    const f32x4 h0 = *(const f32x4*)hp + acc[ai][bj][m][0], h1 = *(const f32x4*)(hp + 4) + acc[ai][bj][m][1];
                    *(f32x4*)hp = h0; *(f32x4*)(hp + 4) = h1; *(u32x4*)(HB + (size_t)r * D + c0) = pack8(h0, h1); if (STATS) ss += sq8(h0, h1); }
                if (STATS) { ss = quad_sum(ss); if (fq == 0) SSP[(size_t)r * 32 + u.pn * 4 + wc] = ss; }
                asm volatile("" ::: "memory"); }
    }
};
template <int MODE  > struct EpiBf16RS {
    bf16_t* O; int ldo; const float* rs;
    DI void operator()(const Acc& acc, const Unit& u, int wr, int wc, int fr, int fq) const {
#pragma unroll
        for (int ai = 0; ai < 2; ++ai)
#pragma unroll
            for (int m = 0; m < 4; ++m) { const int r = u.pm * BM + ai * HALF + wr * 64 + m * 16 + fr;
                const float sc = MODE == 1 ? rs[r] : rs_from_parts<32>(rs, r, fq, 1.0f / D);
#pragma unroll
                for (int bj = 0; bj < 2; ++bj) { const int c0 = u.pn * BM + bj * HALF + wc * 32 + 8 * fq;
                    *(u32x4*)(O + (size_t)r * ldo + c0) = pack8(acc[ai][bj][m][0] * sc, acc[ai][bj][m][1] * sc); } }
    }
};
struct EpiDQ {
    bf16_t* CQ; bf16_t* CKV; bf16_t* KR; const float* RS0; float* LSQ; float* LSKV; const float* COS; const float* SIN;
    DI void operator()(const Acc& acc, const Unit& u, int wr, int wc, int fr, int fq) const {
#pragma unroll
        for (int ai = 0; ai < 2; ++ai)
#pragma unroll
            for (int m = 0; m < 4; ++m) { const int r = u.pm * BM + ai * HALF + wr * 64 + m * 16 + fr; const float sc = RS0[r]; float ss = 0.f;
#pragma unroll
                for (int bj = 0; bj < 2; ++bj) { const int cl = bj * HALF + wc * 32 + 8 * fq; f32x4 v0 = acc[ai][bj][m][0] * sc, v1 = acc[ai][bj][m][1] * sc;
                    if (u.pn < 4) { ss += sq8(v0, v1); bf16_t* o = (u.pn < 2 ? CQ : CKV) + (size_t)r * 512 + (u.pn & 1) * 256 + cl; *(u32x4*)o = pack8(v0, v1); }
                    else if (cl < 64) { rope8(v0, v1, COS, SIN, r, cl >> 1); *(u32x4*)(KR + (size_t)r * 64 + cl) = pack8(v0, v1); } }
                if (u.pn < 4) { ss = quad_sum(ss); if (fq == 0) (u.pn < 2 ? LSQ : LSKV)[(size_t)r * 8 + (u.pn & 1) * 4 + wc] = ss; } }
    }
};
struct EpiUQ {
    bf16_t* Q; bf16_t* KN; bf16_t* V; const float* LSQ; const float* LSKV; const float* COS; const float* SIN;
    DI void operator()(const Acc& acc, const Unit& u, int wr, int wc, int fr, int fq) const {
        const bool isq = u.pn < 12;
#pragma unroll
        for (int ai = 0; ai < 2; ++ai)
#pragma unroll
            for (int m = 0; m < 4; ++m) { const int r = u.pm * BM + ai * HALF + wr * 64 + m * 16 + fr;
                const float sc = rs_from_parts<8>(isq ? LSQ : LSKV, r, fq, 1.0f / 512.0f);
#pragma unroll
                for (int bj = 0; bj < 2; ++bj) { f32x4 v0 = acc[ai][bj][m][0] * sc, v1 = acc[ai][bj][m][1] * sc;
                    if (isq) { const int c0 = u.pn * BM + bj * HALF + wc * 32 + 8 * fq, hc = c0 % QKD;
                        if (hc >= NOPE) rope8(v0, v1, COS, SIN, r, (hc - NOPE) >> 1);
                        *(u32x4*)(Q + (size_t)r * NQ + c0) = pack8(v0, v1); }
                    else { const int c0 = (u.pn - 12) * BM + bj * HALF + wc * 32 + 8 * fq;
                        *(u32x4*)((c0 < 2048 ? KN + c0 : V + (c0 - 2048)) + (size_t)r * D) = pack8(v0, v1); } } }
    }
};
struct EpiMoe1 {
    bf16_t* HH; const float* RS2; const int* list;
    DI void operator()(const Acc& acc, const Unit& u, int wr, int wc, int fr, int fq) const {
#pragma unroll
        for (int ai = 0; ai < 2; ++ai)
#pragma unroll
            for (int m = 0; m < 4; ++m) { const int lr = ai * HALF + wr * 64 + m * 16 + fr, ri = u.r0 + lr;
                if (ri < u.cnt) { const float sc = RS2[list[(size_t)u.e * CAP + ri] >> 1];
                    const f32x4 g0 = acc[ai][0][m][0] * sc, g1 = acc[ai][0][m][1] * sc, u0 = acc[ai][1][m][0] * sc, u1 = acc[ai][1][m][1] * sc;
                    const f32x4 h0 = {silu(g0.x) * u0.x, silu(g0.y) * u0.y, silu(g0.z) * u0.z, silu(g0.w) * u0.w}, h1 = {silu(g1.x) * u1.x, silu(g1.y) * u1.y, silu(g1.z) * u1.z, silu(g1.w) * u1.w};
                    *(u32x4*)(HH + (size_t)(u.pm * BM + lr) * EFF + u.pn * 128 + wc * 32 + 8 * fq) = pack8(h0, h1); } }
    }
};
struct EpiMoe2 {
    bf16_t* Y; const float* GW; const int* list;
    DI void operator()(const Acc& acc, const Unit& u, int wr, int wc, int fr, int fq) const {
#pragma unroll
        for (int ai = 0; ai < 2; ++ai)
#pragma unroll
            for (int m = 0; m < 4; ++m) { const int lr = ai * HALF + wr * 64 + m * 16 + fr, ri = u.r0 + lr;
                if (ri < u.cnt) { const int a = list[(size_t)u.e * CAP + ri]; const float sc = GW[a];
#pragma unroll
                    for (int bj = 0; bj < 2; ++bj) { const int c0 = u.pn * BM + bj * HALF + wc * 32 + 8 * fq;
                        *(u32x4*)(Y + (size_t)a * D + c0) = pack8(acc[ai][bj][m][0] * sc, acc[ai][bj][m][1] * sc); } } }
    }
};

template <class Epi, class Prob>
DI void gemm_phase(LAS unsigned char* lds, const Prob& P, const Epi& E) {
    const int tid = opaque_tid(), wid = __builtin_amdgcn_readfirstlane(tid >> 6), lane = tid & 63, wr = wid >> 2, wc = wid & 3, fr = lane & 15, fq = lane >> 4;
    const int K = P.K, nt = K / BK;
    int sR[2], sC[2]; unsigned voffB[2];
#pragma unroll
    for (int i = 0; i < 2; ++i) { stage_rc(tid * 16 + i * 8192, sR[i], sC[i]); const int Rb = (sR[i] & ~31) + perm32(sR[i] & 31); voffB[i] = (unsigned)(Rb * K + sC[i]) * 2u; }
    const size_t kstep = (size_t)(BK * 2), hstepB = (size_t)HALF * K * 2;
    const unsigned ldsw = (unsigned)wid * 1024u;
    const int aoff = lds_byte(wr * 64 + fr, fq * 8), boff = lds_byte(wc * 32 + fr, fq * 8);
#define PG8_SA(b, h) (((b) * 2 + (h)) * HTB)
#define PG8_SB(b, h) ((4 + (b) * 2 + (h)) * HTB)
#define PG8_STAGE(bufoff, gbase, voff) do { _Pragma("unroll") for (int _i = 0; _i < 2; ++_i) \
        __builtin_amdgcn_global_load_lds((const unsigned*)((const char*)(gbase) + (voff)[_i]), (LAS unsigned*)(lds + (bufoff) + ldsw + _i * 8192), 16, 0, 0); } while (0)
#define PG8_LDA(dst, b, h) do { _Pragma("unroll") for (int m = 0; m < 4; ++m) _Pragma("unroll") for (int k = 0; k < 2; ++k) dst[m][k] = *(const LAS bf16x8*)(lds + PG8_SA(b, h) + aoff + m * 2048 + k * 1024); } while (0)
#define PG8_LDB(dst, b, h) do { _Pragma("unroll") for (int n = 0; n < 2; ++n) _Pragma("unroll") for (int k = 0; k < 2; ++k) dst[n][k] = *(const LAS bf16x8*)(lds + PG8_SB(b, h) + boff + n * 2048 + k * 1024); } while (0)
#define PG8_MMA(ai, bj, At, Bt) do { __builtin_amdgcn_s_setprio(1); _Pragma("unroll") for (int m = 0; m < 4; ++m) _Pragma("unroll") for (int n = 0; n < 2; ++n) _Pragma("unroll") for (int k = 0; k < 2; ++k) \
        acc[ai][bj][m][n] = __builtin_amdgcn_mfma_f32_16x16x32_bf16(Bt[n][k], At[m][k], acc[ai][bj][m][n], 0, 0, 0); __builtin_amdgcn_s_setprio(0); } while (0)
#define PG8_WAIT_V(n) asm volatile("s_waitcnt vmcnt(" #n ")" ::: "memory")
#define PG8_WAIT_L(n) asm volatile("s_waitcnt lgkmcnt(" #n ")" ::: "memory")
#define PG8_BAR __builtin_amdgcn_s_barrier()
#define PG8_SCHED __builtin_amdgcn_sched_barrier(0)
    Unit cur, nxt; int ui = 0;
    if (!P.next(0, cur)) return;
    f32x4 acc[2][2][4][2];
#pragma unroll
    for (int a = 0; a < 2; ++a)
#pragma unroll
        for (int b = 0; b < 2; ++b)
#pragma unroll
            for (int m = 0; m < 4; ++m)
#pragma unroll
                for (int n = 0; n < 2; ++n) acc[a][b][m][n] = (f32x4){0.f, 0.f, 0.f, 0.f};
    bf16x8 At[4][2], B0[2][2], B1[2][2];
    const char* cA = P.aptr(cur); const char* cB = P.bptr(cur);
    unsigned voA[2][2], vnA[2][2];
    P.avoff(cur, sR, sC, voA);
    if constexpr (Prob::GATHER) asm volatile("s_waitcnt vmcnt(0)" ::: "memory");
    PG8_STAGE(PG8_SB(0, 0), cB, voffB); PG8_STAGE(PG8_SB(0, 1), cB + hstepB, voffB); PG8_STAGE(PG8_SA(0, 0), cA, voA[0]); PG8_STAGE(PG8_SA(0, 1), cA, voA[1]);
    if (wr == 1) PG8_BAR;
    PG8_WAIT_V(2); PG8_BAR;
    PG8_STAGE(PG8_SB(1, 0), cB + kstep, voffB); PG8_STAGE(PG8_SA(1, 0), cA + kstep, voA[0]); PG8_STAGE(PG8_SB(1, 1), cB + hstepB + kstep, voffB);
    PG8_WAIT_V(6); PG8_BAR;
    for (;;) {
        const bool has_next = P.next(ui + 1, nxt);
        const char* nA = has_next ? P.aptr(nxt) : cA; const char* nB = has_next ? P.bptr(nxt) : cB;
#pragma unroll
        for (int h = 0; h < 2; ++h)
#pragma unroll
            for (int i = 0; i < 2; ++i) vnA[h][i] = voA[h][i];
        for (int t = 0; t < nt; t += 2) {
            const bool last = (t == nt - 2);
            if constexpr (Prob::GATHER) { if (last && has_next) P.avoff(nxt, sR, sC, vnA); }
            const char* a1 = cA + (size_t)(t + 1) * kstep;
            const char* a2 = last ? nA : cA + (size_t)(t + 2) * kstep; const char* b2 = last ? nB : cB + (size_t)(t + 2) * kstep;
            const char* a3 = a2 + kstep; const char* b3 = b2 + kstep;
            unsigned w0[2], w1[2];
#pragma unroll
            for (int i = 0; i < 2; ++i) { w0[i] = last ? vnA[0][i] : voA[0][i]; w1[i] = last ? vnA[1][i] : voA[1][i]; }
            PG8_LDB(B0, 0, 0); PG8_LDB(B1, 0, 1); PG8_SCHED; PG8_LDA(At, 0, 0); PG8_STAGE(PG8_SA(1, 1), a1, voA[1]);
            PG8_WAIT_V(8); PG8_WAIT_L(0); PG8_BAR; PG8_MMA(0, 0, At, B0); PG8_MMA(0, 1, At, B1); PG8_BAR; PG8_SCHED;
            PG8_LDA(At, 0, 1); PG8_STAGE(PG8_SB(0, 0), b2, voffB); PG8_STAGE(PG8_SB(0, 1), b2 + hstepB, voffB); PG8_STAGE(PG8_SA(0, 0), a2, w0);
            PG8_WAIT_V(8); PG8_WAIT_L(0); PG8_BAR; PG8_MMA(1, 0, At, B0); PG8_MMA(1, 1, At, B1); PG8_BAR; PG8_SCHED;
            PG8_LDB(B0, 1, 0); PG8_LDB(B1, 1, 1); PG8_SCHED; PG8_LDA(At, 1, 0); PG8_STAGE(PG8_SA(0, 1), a2, w1);
            PG8_WAIT_V(8); PG8_WAIT_L(0); PG8_BAR; PG8_MMA(0, 0, At, B0); PG8_MMA(0, 1, At, B1); PG8_BAR; PG8_SCHED;
            PG8_LDA(At, 1, 1); PG8_STAGE(PG8_SB(1, 0), b3, voffB); PG8_STAGE(PG8_SB(1, 1), b3 + hstepB, voffB); PG8_STAGE(PG8_SA(1, 0), a3, w0);
            PG8_WAIT_V(8); PG8_WAIT_L(0); PG8_BAR; PG8_MMA(1, 0, At, B0); PG8_MMA(1, 1, At, B1); PG8_BAR; PG8_SCHED;
        }
        if (wr == 0) PG8_BAR;
        E(acc, cur, wr, wc, fr, fq);
        if (!has_next) break;
#pragma unroll
        for (int a = 0; a < 2; ++a)
#pragma unroll
            for (int b = 0; b < 2; ++b)
#pragma unroll
                for (int m = 0; m < 4; ++m)
#pragma unroll
                    for (int n = 0; n < 2; ++n) acc[a][b][m][n] = (f32x4){0.f, 0.f, 0.f, 0.f};
        cur = nxt; cA = nA; cB = nB; ++ui;
#pragma unroll
        for (int h = 0; h < 2; ++h)
#pragma unroll
            for (int i = 0; i < 2; ++i) voA[h][i] = vnA[h][i];
        if (wr == 1) PG8_BAR;
    }
    PG8_WAIT_V(0);
    PG8_BAR;
#undef PG8_SA
#undef PG8_SB
#undef PG8_STAGE
#undef PG8_LDA
#undef PG8_LDB
#undef PG8_MMA
#undef PG8_WAIT_V
#undef PG8_WAIT_L
#undef PG8_BAR
#undef PG8_SCHED
}
}


namespace fa {
typedef float f32x16 __attribute__((ext_vector_type(16)));
typedef short s16x4 __attribute__((ext_vector_type(4)));
#define SBAR() __builtin_amdgcn_sched_barrier(0)
constexpr float THR = 8.f, LOG2E = 1.4426950408889634f;
DI int crow(int r, int hi) { return (r & 3) + 8 * (r >> 2) + 4 * hi; }
DI unsigned cvtpk(float lo, float hi) { unsigned r; asm volatile("v_cvt_pk_bf16_f32 %0, %1, %2" : "=v"(r) : "v"(lo), "v"(hi)); return r; }
DI void partialSM(f32x16& p0, f32x16& p1, float& m_reg, float& mn, float& alpha) {
    float pmax = p0[0];
#pragma unroll
    for (int r = 1; r < 16; ++r) pmax = fmaxf(pmax, p0[r]);
#pragma unroll
    for (int r = 0; r < 16; ++r) pmax = fmaxf(pmax, p1[r]);
    { auto rr = __builtin_amdgcn_permlane32_swap(__float_as_uint(pmax), __float_as_uint(pmax), false, false); pmax = fmaxf(__uint_as_float(rr[0]), __uint_as_float(rr[1])); }
    if (__builtin_expect(__all(pmax - m_reg <= THR), 1)) { mn = m_reg; alpha = 1.f; }
    else { mn = fmaxf(m_reg, pmax); alpha = __builtin_amdgcn_exp2f((m_reg - mn) * LOG2E); m_reg = mn; }
    const float mnC = -mn * LOG2E;
#pragma unroll
    for (int r = 0; r < 16; ++r) p0[r] = fmaf(p0[r], LOG2E, mnC);
#pragma unroll
    for (int r = 0; r < 16; ++r) p1[r] = fmaf(p1[r], LOG2E, mnC);
#pragma unroll
    for (int r = 0; r < 16; ++r) p0[r] = __builtin_amdgcn_exp2f(p0[r]);
}
DI void finishSM(f32x16& p0, f32x16& p1, float alpha, float& l_reg, bf16x8& pa0, bf16x8& pa1, bf16x8& pa2, bf16x8& pa3) {
#pragma unroll
    for (int r = 0; r < 16; ++r) p1[r] = __builtin_amdgcn_exp2f(p1[r]);
    float ps = 0;
#pragma unroll
    for (int r = 0; r < 16; ++r) ps += p0[r];
#pragma unroll
    for (int r = 0; r < 16; ++r) ps += p1[r];
    { auto rr = __builtin_amdgcn_permlane32_swap(__float_as_uint(ps), __float_as_uint(ps), false, false); ps = __uint_as_float(rr[0]) + __uint_as_float(rr[1]); }
    l_reg = l_reg * alpha + ps;
#define PK4(P, BASE, OUT) do { unsigned a0 = cvtpk(P[BASE + 0], P[BASE + 1]), a1 = cvtpk(P[BASE + 2], P[BASE + 3]);   \
    unsigned b0 = cvtpk(P[BASE + 4], P[BASE + 5]), b1 = cvtpk(P[BASE + 6], P[BASE + 7]);                              \
    auto r0 = __builtin_amdgcn_permlane32_swap(a0, b0, false, false); auto r1 = __builtin_amdgcn_permlane32_swap(a1, b1, false, false); \
    u32x4 w = {r0[0], r1[0], r0[1], r1[1]}; OUT = *reinterpret_cast<bf16x8*>(&w); } while (0)
    PK4(p0, 0, pa0); PK4(p0, 8, pa1); PK4(p1, 0, pa2); PK4(p1, 8, pa3);
#undef PK4
}
template <int DQK> DI void qkt(f32x16& p0, f32x16& p1, LAS const char* Ks, const int (&kb)[4], const bf16x8* qr) {
    constexpr int KROW = DQK * 2;
#pragma unroll
    for (int r = 0; r < 16; ++r) { p0[r] = 0.f; p1[r] = 0.f; }
#pragma unroll
    for (int d0 = 0; d0 < DQK / 16; ++d0) {
        const bf16x8 b0 = *(LAS const bf16x8*)(Ks + kb[d0 & 3] + (d0 >> 2) * 128);
        const bf16x8 b1 = *(LAS const bf16x8*)(Ks + kb[d0 & 3] + (d0 >> 2) * 128 + 32 * KROW);
        p0 = __builtin_amdgcn_mfma_f32_32x32x16_bf16(b0, qr[d0], p0, 0, 0, 0);
        p1 = __builtin_amdgcn_mfma_f32_32x32x16_bf16(b1, qr[d0], p1, 0, 0, 0); }
}
DI int v_rd_base(int lane) { return ((lane & 3) << 3) | (((lane >> 2) & 3) << 6) | (((lane >> 4) & 1) << 5) | (((lane >> 5) & 1) << 8); }
constexpr int v_rd_off(int d0, int ks, int half) { return d0 * 512 + ks * 4096 + half * 2048; }
template <int OFF> DI s16x4 tr_read(int vb) { s16x4 r; asm volatile("ds_read_b64_tr_b16 %0, %1 offset:%2" : "=&v"(r) : "v"(vb), "i"(OFF) : "memory"); return r; }
template <int D0> DI void pv_one(f32x16& od, int vb, bf16x8 pa0, bf16x8 pa1, bf16x8 pa2, bf16x8 pa3) {
    const s16x4 l0 = tr_read<v_rd_off(D0, 0, 0)>(vb), h0 = tr_read<v_rd_off(D0, 0, 1)>(vb), l1 = tr_read<v_rd_off(D0, 1, 0)>(vb), h1 = tr_read<v_rd_off(D0, 1, 1)>(vb);
    const s16x4 l2 = tr_read<v_rd_off(D0, 2, 0)>(vb), h2 = tr_read<v_rd_off(D0, 2, 1)>(vb), l3 = tr_read<v_rd_off(D0, 3, 0)>(vb), h3 = tr_read<v_rd_off(D0, 3, 1)>(vb);
    asm volatile("s_waitcnt lgkmcnt(0)" ::: "memory"); SBAR();
#define PK(L, H) (bf16x8){L[0], L[1], L[2], L[3], H[0], H[1], H[2], H[3]}
    od = __builtin_amdgcn_mfma_f32_32x32x16_bf16(pa0, PK(l0, h0), od, 0, 0, 0);
    od = __builtin_amdgcn_mfma_f32_32x32x16_bf16(pa1, PK(l1, h1), od, 0, 0, 0);
    od = __builtin_amdgcn_mfma_f32_32x32x16_bf16(pa2, PK(l2, h2), od, 0, 0, 0);
    od = __builtin_amdgcn_mfma_f32_32x32x16_bf16(pa3, PK(l3, h3), od, 0, 0, 0);
#undef PK
}
DI void pv_d0(f32x16* o, int vb, bf16x8 pa0, bf16x8 pa1, bf16x8 pa2, bf16x8 pa3) {
    pv_one<0>(o[0], vb, pa0, pa1, pa2, pa3); pv_one<1>(o[1], vb, pa0, pa1, pa2, pa3); pv_one<2>(o[2], vb, pa0, pa1, pa2, pa3); pv_one<3>(o[3], vb, pa0, pa1, pa2, pa3);
}
template <int DQK, bool CAUSAL>
DI void attn_unit(LAS char* lds, const bf16_t* Qb, int ldq, const bf16_t* K1, int ldk1, const bf16_t* K2, int ldk2, const bf16_t* Vb, int ldv, bf16_t* Ob, int ldo, int NT, int qtile0) {
    constexpr int KROW = DQK * 2, KT = 64 * KROW, BUF = KT + 16384, NKP = DQK / 64, ND0 = DQK / 16;
    const int tid = opaque_tid(), wid = __builtin_amdgcn_readfirstlane(tid >> 6), lane = tid & 63, r32 = lane & 31, hi = lane >> 5;
    LAS float* wsf = (LAS float*)(lds + 3 * BUF) + wid * 64; LAS float* li_l = wsf; LAS float* al_l = wsf + 32;
    const char* kp[NKP]; int kst[NKP]; const char* vp[2];
#pragma unroll
    for (int i = 0; i < NKP; ++i) { const int p = (wid * NKP + i) * 1024 + lane * 16, row = p / KROW, cbs = p % KROW, cb = cbs ^ ((row & 7) << 4);
        if (DQK == 128 || cb < 256) { kp[i] = (const char*)K1 + (size_t)row * ldk1 * 2 + cb; kst[i] = 64 * ldk1 * 2; }
        else { kp[i] = (const char*)K2 + (size_t)row * ldk2 * 2 + (cb - 256); kst[i] = 64 * ldk2 * 2; } }
#pragma unroll
    for (int i = 0; i < 2; ++i) { const int p = (wid * 2 + i) * 1024 + lane * 16, sub = p >> 9, q = (p & 511) >> 1, kk = (sub >> 2) * 8 + (q >> 5), k = (kk & ~0xC) | ((kk & 4) << 1) | ((kk & 8) >> 1), c = (sub & 3) * 32 + (q & 31);
        vp[i] = (const char*)Vb + ((size_t)k * ldv + c) * 2; }
    const int vstep = 64 * ldv * 2;
#define FA_DMA(bo) do { _Pragma("unroll") for (int _i = 0; _i < NKP; ++_i) { __builtin_amdgcn_global_load_lds((const unsigned*)kp[_i], (LAS unsigned*)(lds + (bo) + (wid * NKP + _i) * 1024), 16, 0, 0); kp[_i] += kst[_i]; } \
        _Pragma("unroll") for (int _i = 0; _i < 2; ++_i) { __builtin_amdgcn_global_load_lds((const unsigned*)vp[_i], (LAS unsigned*)(lds + (bo) + KT + (wid * 2 + _i) * 1024), 16, 0, 0); vp[_i] += vstep; } } while (0)
#define FA_SYNC() do { asm volatile("s_waitcnt vmcnt(0)" ::: "memory"); __builtin_amdgcn_s_barrier(); asm volatile("" ::: "memory"); } while (0)
    int bm1 = 0, bc = BUF, bp1 = 2 * BUF;
    FA_DMA(bm1); FA_DMA(bc);
    bf16x8 qr[ND0];
    { const bf16_t* Qw = Qb + (size_t)(wid * 32 + r32) * ldq + hi * 8;
#pragma unroll
      for (int d0 = 0; d0 < ND0; ++d0) qr[d0] = *(const bf16x8*)(Qw + d0 * 16); }
    int kb[4];
#pragma unroll
    for (int q = 0; q < 4; ++q) kb[q] = r32 * KROW + ((q * 32 + hi * 16) ^ ((r32 & 7) << 4));
    const int vb0 = (int)(uintptr_t)lds + KT + v_rd_base(lane);
    const int lim = CAUSAL ? qtile0 + (wid >> 1) : 0x7fffffff;
    float m_reg = -1e30f, l_reg = 0; f32x16 o[4];
#pragma unroll
    for (int d = 0; d < 4; ++d)
#pragma unroll
        for (int r = 0; r < 16; ++r) o[d][r] = 0.f;
    f32x16 pA0, pA1, pB0, pB1; float mnA, mnB, alA, alB; bf16x8 pa0, pa1, pa2, pa3;
#define FA_MASK(P0, P1, j) do { if (CAUSAL && (j) > lim) { _Pragma("unroll") for (int _r = 0; _r < 16; ++_r) { P0[_r] = -1e30f; P1[_r] = -1e30f; } } } while (0)
#define FA_RESC(a) do { if (__any((a) < 1.f)) { if (hi == 0) al_l[r32] = (a); asm volatile("s_waitcnt lgkmcnt(0)" ::: "memory"); \
        _Pragma("unroll") for (int _d = 0; _d < 4; ++_d) _Pragma("unroll") for (int _r = 0; _r < 16; ++_r) o[_d][_r] *= al_l[crow(_r, hi)]; } } while (0)
#define FA_ROT() do { const int _t = bm1; bm1 = bc; bc = bp1; bp1 = _t; } while (0)
    FA_SYNC();
    FA_DMA(bp1);
    qkt<DQK>(pA0, pA1, lds + bm1, kb, qr); partialSM(pA0, pA1, m_reg, mnA, alA);
    for (int j = 1; j + 1 < NT; j += 2) {
        SBAR(); qkt<DQK>(pB0, pB1, lds + bc, kb, qr);
        finishSM(pA0, pA1, alA, l_reg, pa0, pa1, pa2, pa3); SBAR();
        pv_d0(o, vb0 + bm1, pa0, pa1, pa2, pa3); FA_MASK(pB0, pB1, j); partialSM(pB0, pB1, m_reg, mnB, alB);
        FA_SYNC(); if (j + 2 < NT) FA_DMA(bm1);
        FA_RESC(alB); FA_ROT();
        SBAR(); qkt<DQK>(pA0, pA1, lds + bc, kb, qr);
        finishSM(pB0, pB1, alB, l_reg, pa0, pa1, pa2, pa3); SBAR();
        pv_d0(o, vb0 + bm1, pa0, pa1, pa2, pa3); FA_MASK(pA0, pA1, j + 1); partialSM(pA0, pA1, m_reg, mnA, alA);
        FA_SYNC(); if (j + 3 < NT) FA_DMA(bm1);
        FA_RESC(alA); FA_ROT();
    }
    SBAR(); qkt<DQK>(pB0, pB1, lds + bc, kb, qr);
    finishSM(pA0, pA1, alA, l_reg, pa0, pa1, pa2, pa3); SBAR();
    pv_d0(o, vb0 + bm1, pa0, pa1, pa2, pa3); FA_MASK(pB0, pB1, NT - 1); partialSM(pB0, pB1, m_reg, mnB, alB);
    FA_RESC(alB);
    finishSM(pB0, pB1, alB, l_reg, pa0, pa1, pa2, pa3); SBAR();
    pv_d0(o, vb0 + bc, pa0, pa1, pa2, pa3);
    if (hi == 0) li_l[r32] = l_reg; asm volatile("s_waitcnt lgkmcnt(0)" ::: "memory");
    float rli[16];
#pragma unroll
    for (int r = 0; r < 16; ++r) rli[r] = __builtin_amdgcn_rcpf(li_l[crow(r, hi)]);
    FA_SYNC();
    LAS char* Ot = lds + wid * 8704;
#pragma unroll
    for (int r = 0; r < 16; ++r)
#pragma unroll
        for (int d0 = 0; d0 < 4; ++d0) *(LAS bf16_t*)(Ot + crow(r, hi) * 272 + (d0 * 32 + r32) * 2) = (bf16_t)f2bf(o[d0][r] * rli[r]);
    asm volatile("s_waitcnt lgkmcnt(0)" ::: "memory");
#pragma unroll
    for (int i = 0; i < 8; ++i) { const int idx = i * 64 + lane, row = idx >> 4, c16 = idx & 15;
        const u32x4 v = *(LAS const u32x4*)(Ot + row * 272 + c16 * 16); *(u32x4*)(Ob + (size_t)(wid * 32 + row) * ldo + c16 * 8) = v; }
    asm volatile("s_waitcnt lgkmcnt(0)" ::: "memory"); __builtin_amdgcn_s_barrier(); asm volatile("" ::: "memory");
#undef FA_DMA
#undef FA_SYNC
#undef FA_MASK
#undef FA_RESC
#undef FA_ROT
}
DI int vcu_of(int bx, int G) { return (G % 8 == 0) ? (bx % 8) * (G / 8) + bx / 8 : bx; }
DI void mla_phase(LAS char* lds, const bf16_t* Q, const bf16_t* KN, const bf16_t* KR, const bf16_t* V, bf16_t* AO, int G, int bx) {
    const int v = vcu_of(bx, G);
    for (int p = v; p < NB * HEADS * 8; p += G) { const int bh = p >> 3, i = p & 7, b = bh / HEADS, h = bh % HEADS;
#pragma unroll 1
        for (int s = 0; s < 2; ++s) { const int qb = s ? 15 - i : i; const size_t row0 = (size_t)b * S + qb * 256, key0 = (size_t)b * S;
            attn_unit<192, true>(lds, Q + row0 * NQ + h * QKD, NQ, KN + key0 * D + h * NOPE, D, KR + key0 * ROPE, ROPE, V + key0 * D + h * VD, D, AO + row0 * D + h * VD, D, 4 * qb + 4, 4 * qb); } }
}
DI void memattn_phase(LAS char* lds, const bf16_t* MQ, const bf16_t* MK, const bf16_t* MV, bf16_t* MO, int G, int bx) {
    for (int u = bx; u < NB * MH * (S / 256); u += G) { const int qb = u % (S / 256), h = (u / (S / 256)) % MH, b = u / (S / 256 * MH); const size_t row0 = (size_t)b * S + qb * 256, key0 = (size_t)b * MEMT;
        attn_unit<128, false>(lds, MQ + row0 * MI + h * MHD, MI, MK + key0 * MI + h * MHD, MI, nullptr, 0, MV + key0 * MI + h * MHD, MI, MO + row0 * MI + h * MHD, MI, MEMT / 64, 0); }
}
}

#ifndef XCONV
#define XCONV 0
#endif
#ifndef XMLA
#define XMLA 0
#endif
#ifndef XMOE
#define XMOE 0
#endif
#ifndef XROUTER
#define XROUTER 0
#endif
#ifndef XDENSE
#define XDENSE 0
#endif
#ifndef XMEMATT
#define XMEMATT 0
#endif
#ifndef XCOMB
#define XCOMB 0
#endif
#ifndef XPOOL
#define XPOOL 0
#endif
constexpr int LDS_BYTES = 147456, LDS_MISC = 131072;
#define XB_TMO      128
#define XB_XCNT(j)  (256  + 64 * (j))
#define XB_XSUB(j)  (1280 + 64 * (j))
#define XB_XGEN(j)  (2304 + 64 * (j))
#define XB_TOP      3328
#define XB_TOPGEN   3392
#define XCD_BAR_WORDS 3456
#define XB_SPIN_CAP (1u << 18)
constexpr int CW_BAR = 4096;
DI unsigned xb_ld(unsigned* p)              { return __hip_atomic_load(p, __ATOMIC_RELAXED, __HIP_MEMORY_SCOPE_AGENT); }
DI unsigned xb_add(unsigned* p, unsigned v) { return __hip_atomic_fetch_add(p, v, __ATOMIC_RELAXED, __HIP_MEMORY_SCOPE_AGENT); }
DI unsigned xb_xcc_id() { return (unsigned)__builtin_amdgcn_s_getreg((3 << 11) | 20) & 0xFu; }
#define XB_SPIN(cond, bar) do { unsigned _sp = 0; while (cond) { __builtin_amdgcn_s_sleep(1); \
    if ((++_sp & 255u) == 0u) { if (xb_ld(&(bar)[XB_TMO])) break; if (_sp > XB_SPIN_CAP) { atomicAdd(&(bar)[XB_TMO], 1u); break; } } } } while (0)
struct XcdBarrier { unsigned* bar; unsigned x; volatile LAS unsigned* st; };
DI XcdBarrier xcd_barrier_post(unsigned* bar, volatile LAS unsigned* st) {
    XcdBarrier b; b.bar = bar; b.x = xb_xcc_id(); b.st = st;
    if (threadIdx.x == 0) (void)xb_add(&bar[XB_XCNT(b.x)], 1u);
    return b;
}
DI void xcd_barrier_complete(unsigned* bar, unsigned x, unsigned& nloc, unsigned& nx) {
    const unsigned G = gridDim.x * gridDim.y * gridDim.z;
    unsigned sum, cnt, mine, sp = 0u;
    for (;;) {
        sum = 0u; cnt = 0u; mine = 0u;
#pragma unroll
        for (unsigned j = 0; j < 16; ++j) { const unsigned c = xb_ld(&bar[XB_XCNT(j)]); sum += c; cnt += (c > 0u) ? 1u : 0u; mine = (j == x) ? c : mine; }
        if (sum == G) break;
        __builtin_amdgcn_s_sleep(1);
        if ((++sp & 255u) == 0u) { if (xb_ld(&bar[XB_TMO])) break; if (sp > XB_SPIN_CAP) { atomicAdd(&bar[XB_TMO], 1u); break; } }
    }
    nloc = mine > 0u ? mine : 1u; nx = cnt > 0u ? cnt : 1u;
}
DI void xcd_barrier(const XcdBarrier& b) {
    asm volatile("s_waitcnt vmcnt(0)" ::: "memory");
    __syncthreads();
    if (threadIdx.x == 0) {
        unsigned* bar = b.bar;
        __builtin_amdgcn_s_waitcnt(0);
        unsigned nloc = b.st[0], nx = b.st[1];
        if (nloc == 0u) { xcd_barrier_complete(bar, b.x, nloc, nx); b.st[0] = nloc; b.st[1] = nx; }
        const unsigned old = xb_add(&bar[XB_XSUB(b.x)], 1u);
        const unsigned gen = old / nloc;
        if (old + 1u == (gen + 1u) * nloc) {
            __builtin_amdgcn_fence(__ATOMIC_RELEASE, "agent");
            asm volatile("s_waitcnt vmcnt(0)" ::: "memory");
            const unsigned og = xb_add(&bar[XB_TOP], 1u);
            const unsigned tg = og / nx;
            if (og + 1u == (tg + 1u) * nx) xb_add(&bar[XB_TOPGEN], 1u);
            else XB_SPIN(xb_ld(&bar[XB_TOPGEN]) == tg, bar);
            __builtin_amdgcn_fence(__ATOMIC_ACQUIRE, "agent");
            xb_add(&bar[XB_XGEN(b.x)], 1u);
            asm volatile("s_waitcnt vmcnt(0)" ::: "memory");
        } else {
            XB_SPIN(xb_ld(&bar[XB_XGEN(b.x)]) == gen, bar);
            __builtin_amdgcn_fence(__ATOMIC_ACQUIRE, "agent");
            asm volatile("s_waitcnt vmcnt(0)" ::: "memory");
        }
    }
    __syncthreads();
}

#define LDS_WAIT() asm volatile("s_waitcnt lgkmcnt(0)" ::: "memory")
DI void wt_item(const float* W, int K, int N, bf16_t* WT, const float* kgain, const float* ngain, float scale, int perm, int row_off, LAS float* scr, int item, int lane) {
    const int nblk = N >> 5, kb = item / nblk, nb = item - kb * nblk, k0 = kb * 64, n0 = nb * 32, kr = lane >> 3, n4 = (lane & 7) * 4;
    f32x4 ng = {scale, scale, scale, scale}; if (ngain) ng = *(const f32x4*)(ngain + n0 + n4) * scale;
    f32x4 v[8];
#pragma unroll
    for (int i = 0; i < 8; ++i) v[i] = *(const f32x4*)(W + (size_t)(k0 + 8 * i + kr) * N + n0 + n4);
#pragma unroll
    for (int i = 0; i < 8; ++i) { const int k = 8 * i + kr; f32x4 x = v[i] * ng; if (kgain) x = x * kgain[k0 + k];
        scr[(n4 + 0) * 65 + k] = x.x; scr[(n4 + 1) * 65 + k] = x.y; scr[(n4 + 2) * 65 + k] = x.z; scr[(n4 + 3) * 65 + k] = x.w; }
    LDS_WAIT();
    const int kc = lane & 7;
#pragma unroll
    for (int q = 0; q < 4; ++q) { const int n = (lane >> 3) + 8 * q; const LAS float* sp = scr + n * 65 + 8 * kc;
        u32x4 o; o.x = pk2(sp[0], sp[1]); o.y = pk2(sp[2], sp[3]); o.z = pk2(sp[4], sp[5]); o.w = pk2(sp[6], sp[7]);
        *(u32x4*)(WT + (size_t)(row_off + permrow(perm, n0 + n)) * K + k0 + 8 * kc) = o; }
    LDS_WAIT();
}
struct MArgs { const void* in[32]; float* out; unsigned char* ws; int ph_lo, ph_hi, bar_region, pad; };
#define INF(i) ((const float*)P.in[i])
#define WSB(off) ((bf16_t*)(P.ws + (off)))
#define WSF(off) ((float*)(P.ws + (off)))
constexpr float SC_MEM = 0.08838834764831845f  , SC_MLA = 0.07216878364870323f  ;
DI void conv_phase(const MArgs& P, LAS unsigned char* lds, int gw, int NGW, int wave, int lane) {
    LAS float* scr = (LAS float*)(lds + wave * 16384);
    constexpr int I_POOL = 8 * 128, I_MQ = 4 * 512, I_MO = 4 * 512, I_E = 128 * 512, I_DQ = 512, I_KR = 64, I_UQ = 2 * 512, I_QR = 2 * 256, I_O = 2 * 2048, I_UK = 512;
    constexpr int NITEMS = I_POOL + 3 * I_MQ + I_MO + 3 * I_E + 3 * I_DQ + I_KR + I_UQ + I_QR + I_O + 2 * I_UK;
    for (int it = gw; it < NITEMS; it += NGW) {
        int r = it;
        if (r < I_E) { const int m = r >> 9; wt_item(INF(28) + (size_t)m * D * EFF, D, EFF, WSB(WS_WGU) + (size_t)m * 1024 * D, INF(6) + (m >> 5) * D, nullptr, 1.f, 3, 0, scr, r & 511, lane); continue; } r -= I_E;
        if (r < I_E) { const int m = r >> 9; wt_item(INF(29) + (size_t)m * D * EFF, D, EFF, WSB(WS_WGU) + (size_t)m * 1024 * D, INF(6) + (m >> 5) * D, nullptr, 1.f, 4, 0, scr, r & 511, lane); continue; } r -= I_E;
        if (r < I_E) { const int m = r >> 9; wt_item(INF(30) + (size_t)m * EFF * D, EFF, D, WSB(WS_WD) + (size_t)m * D * EFF, nullptr, nullptr, 1.f, 0, 0, scr, r & 511, lane); continue; } r -= I_E;
        if (r < I_POOL) { const int m = r >> 7; wt_item(INF(7) + (size_t)m * PG * PG, PG, PG, WSB(WS_WPOOL) + (size_t)(m >> 2) * D * PG, nullptr, INF(8) + (m >> 2) * D + (m & 3) * PG, 1.f, 0, (m & 3) * PG, scr, r & 127, lane); continue; } r -= I_POOL;
        if (r < I_MQ) { const int m = r >> 9; wt_item(INF(20) + (size_t)m * D * MI, D, MI, WSB(WS_WMQ) + (size_t)m * MI * D, INF(4) + m * D, nullptr, SC_MEM, 0, 0, scr, r & 511, lane); continue; } r -= I_MQ;
        if (r < I_MQ) { const int m = r >> 9; wt_item(INF(21) + (size_t)m * D * MI, D, MI, WSB(WS_WMK) + (size_t)m * MI * D, INF(5) + m * D, nullptr, 1.f, 0, 0, scr, r & 511, lane); continue; } r -= I_MQ;
        if (r < I_MQ) { const int m = r >> 9; wt_item(INF(22) + (size_t)m * D * MI, D, MI, WSB(WS_WMV) + (size_t)m * MI * D, INF(5) + m * D, nullptr, 1.f, 0, 0, scr, r & 511, lane); continue; } r -= I_MQ;
        if (r < I_MO) { const int m = r >> 9; wt_item(INF(23) + (size_t)m * MI * D, MI, D, WSB(WS_WMO) + (size_t)m * D * MI, nullptr, nullptr, 1.f, 0, 0, scr, r & 511, lane); continue; } r -= I_MO;
        if (r < I_DQ) { wt_item(INF(15), D, QR, WSB(WS_WDQ0), INF(3) + 2 * D, nullptr, 1.f, 0, 0, scr, r, lane); continue; } r -= I_DQ;
        if (r < I_DQ) { wt_item(INF(10), D, KVR, WSB(WS_WDQ0), INF(9), nullptr, 1.f, 0, 512, scr, r, lane); continue; } r -= I_DQ;
        if (r < I_KR) { wt_item(INF(12), D, ROPE, WSB(WS_WDQ0), INF(9), nullptr, 1.f, 5, 1024, scr, r, lane); continue; } r -= I_KR;
        if (r < I_DQ) { wt_item(INF(15) + (size_t)D * QR, D, QR, WSB(WS_WDQ1), INF(3) + 3 * D, nullptr, 1.f, 0, 0, scr, r, lane); continue; } r -= I_DQ;
        if (r < I_UQ) { const int m = r >> 9; wt_item(INF(17) + (size_t)m * QR * D, QR, HEADS * NOPE, WSB(WS_WUQ) + (size_t)m * NQ * QR, INF(16) + m * QR, nullptr, SC_MLA, 1, 0, scr, r & 511, lane); continue; } r -= I_UQ;
        if (r < I_QR) { const int m = r >> 8; wt_item(INF(18) + (size_t)m * QR * HEADS * ROPE, QR, HEADS * ROPE, WSB(WS_WUQ) + (size_t)m * NQ * QR, INF(16) + m * QR, nullptr, SC_MLA, 2, 0, scr, r & 255, lane); continue; } r -= I_QR;
        if (r < I_O) { const int m = r >> 11; wt_item(INF(19) + (size_t)m * D * D, D, D, WSB(WS_WO) + (size_t)m * D * D, nullptr, nullptr, 1.f, 0, 0, scr, r & 2047, lane); continue; } r -= I_O;
        if (r < I_UK) { wt_item(INF(13), KVR, D, WSB(WS_WUKV), INF(11), nullptr, 1.f, 0, 0, scr, r, lane); continue; } r -= I_UK;
        wt_item(INF(14), KVR, D, WSB(WS_WUKV), INF(11), nullptr, 1.f, 0, 2048, scr, r, lane);
    }
}
DI void tables_phase(const MArgs& P, int gtid, int NT_) {
    for (int idx = gtid; idx < T * 32; idx += NT_) { const int t = idx >> 5, i = idx & 31;
        const float inv = (float)(1.0 / pow(10000.0, (double)i / 32.0)); const float ang = (float)((const int*)P.in[2])[t] * inv;
        const double rev = (double)ang * 0.15915494309189533577; const float fr = (float)(rev - rint(rev));
        WSF(WS_COS)[idx] = __builtin_amdgcn_cosf(fr); WSF(WS_SIN)[idx] = __builtin_amdgcn_sinf(fr); }
    for (int idx = gtid; idx < DEPTH * 48 * D; idx += NT_) { const int l = idx / (48 * D), n = (idx / D) % 48, k = idx % D;
        float w = 0.f; if (n < 36) w = (n < 4 ? INF(24)[((size_t)l * D + k) * 4 + n] : INF(26)[((size_t)l * D + k) * 32 + (n - 4)]) * INF(6)[l * D + k];
        const unsigned hi = f2bf(w), lo = f2bf(w - __uint_as_float(hi << 16));
        WSB(WS_RWH)[((size_t)(l * 2 + 0) * 48 + n) * D + k] = (bf16_t)hi; WSB(WS_RWH)[((size_t)(l * 2 + 1) * 48 + n) * D + k] = (bf16_t)lo; }
    unsigned* z = (unsigned*)(WSB(WS_WDQ0) + (size_t)1088 * D);
    for (int idx = gtid; idx < (NDQ0 - 1088) * D / 2; idx += NT_) z[idx] = 0u;
}
DI void memprep_phase(const MArgs& P, int gw, int NGW, int lane) {
    for (int r = gw; r < NB * MEMT; r += NGW) { const f32x4* x = (const f32x4*)(INF(1) + (size_t)r * D) + lane; float ss = 0.f;
#pragma unroll
        for (int j = 0; j < 8; ++j) { const f32x4 v = x[64 * j]; ss += (v.x * v.x + v.y * v.y) + (v.z * v.z + v.w * v.w);
            u32x2 o; o.x = pk2(v.x, v.y); o.y = pk2(v.z, v.w); *((u32x2*)(WSB(WS_MEMB) + (size_t)r * D) + lane + 64 * j) = o; }
        ss = wave_sum(ss); if (lane == 0) WSF(WS_MEMRS)[r] = rsqrtf(ss * (1.0f / D) + EPS); }
}
DI void combine_phase(const float* src, const bf16_t* Y, float* H, bf16_t* HB, float* RS0, const float* gain, bf16_t* HN, float* out, int gw, int NGW, int lane) {
    for (int t = gw; t < T; t += NGW) {
        const f32x4* x = (const f32x4*)(src + (size_t)t * D) + lane; f32x4 v[8]; float ss = 0.f;
#pragma unroll
        for (int j = 0; j < 8; ++j) { v[j] = x[64 * j];
            if (Y) { const u32x2 a = *((const u32x2*)(Y + (size_t)(2 * t) * D) + lane + 64 * j), b = *((const u32x2*)(Y + (size_t)(2 * t + 1) * D) + lane + 64 * j);
                v[j].x = (v[j].x + __uint_as_float(a.x << 16)) + __uint_as_float(b.x << 16); v[j].y = (v[j].y + __uint_as_float(a.x & 0xffff0000u)) + __uint_as_float(b.x & 0xffff0000u);
                v[j].z = (v[j].z + __uint_as_float(a.y << 16)) + __uint_as_float(b.y << 16); v[j].w = (v[j].w + __uint_as_float(a.y & 0xffff0000u)) + __uint_as_float(b.y & 0xffff0000u); }
            ss += (v[j].x * v[j].x + v[j].y * v[j].y) + (v[j].z * v[j].z + v[j].w * v[j].w); }
        ss = wave_sum(ss); const float rs = rsqrtf(ss * (1.0f / D) + EPS);
        if (lane == 0 && RS0) RS0[t] = rs;
#pragma unroll
        for (int j = 0; j < 8; ++j) {
            if (H) *((f32x4*)(H + (size_t)t * D) + lane + 64 * j) = v[j];
            if (HB) { u32x2 o; o.x = pk2(v[j].x, v[j].y); o.y = pk2(v[j].z, v[j].w); *((u32x2*)(HB + (size_t)t * D) + lane + 64 * j) = o; }
            if (gain) { const f32x4 g = *((const f32x4*)gain + lane + 64 * j); const f32x4 n = v[j] * g * rs;
                if (HN) { u32x2 o; o.x = pk2(n.x, n.y); o.y = pk2(n.z, n.w); *((u32x2*)(HN + (size_t)t * D) + lane + 64 * j) = o; }
                if (out) *((f32x4*)(out + (size_t)t * D) + lane + 64 * j) = n; } }
    }
}
DI void pool_phase(const bf16_t* HN, bf16_t* U, int vcu, int G, int tid) {
    for (int t = vcu * 2 + (tid >> 8); t < T; t += 2 * G) { const int c = (tid & 255) * 8, s = t & (S - 1), w = 2 << (c >> 9), n = (s + 1 < w) ? s + 1 : w;
        float acc[8] = {0.f, 0.f, 0.f, 0.f, 0.f, 0.f, 0.f, 0.f}, self[8] = {0.f, 0.f, 0.f, 0.f, 0.f, 0.f, 0.f, 0.f};
        for (int i = 0; i < n; ++i) { const u32x4 v = *(const u32x4*)(HN + (size_t)(t - i) * D + c);
            const float f[8] = {__uint_as_float(v.x << 16), __uint_as_float(v.x & 0xffff0000u), __uint_as_float(v.y << 16), __uint_as_float(v.y & 0xffff0000u),
                                __uint_as_float(v.z << 16), __uint_as_float(v.z & 0xffff0000u), __uint_as_float(v.w << 16), __uint_as_float(v.w & 0xffff0000u)};
#pragma unroll
            for (int q = 0; q < 8; ++q) { acc[q] += f[q]; if (i == 0) self[q] = f[q]; } }
        const float inv = 1.0f / (float)n; u32x4 o;
        o.x = pk2(acc[0] * inv - self[0], acc[1] * inv - self[1]); o.y = pk2(acc[2] * inv - self[2], acc[3] * inv - self[3]);
        o.z = pk2(acc[4] * inv - self[4], acc[5] * inv - self[5]); o.w = pk2(acc[6] * inv - self[6], acc[7] * inv - self[7]);
        *(u32x4*)(U + (size_t)t * D + c) = o; }
}
typedef float f32x4r __attribute__((ext_vector_type(4)));
DI void router_phase(const float* H, const bf16_t* RWH, const float* rg_b, const float* re_b, float* RS2, int* cnt, int* list, float* gwt, LAS unsigned char* lds, int vcu, int G, int wave, int lane, bool commit = true) {
    LAS float* tile = (LAS float*)(lds + wave * 4096);
    const bf16_t* RWL = RWH + (size_t)48 * D;
    for (int t16 = wave * G + vcu; t16 < T / 16; t16 += 8 * G) {
        const int r16 = lane & 15, kq = lane >> 4;
        const float* hp = H + (size_t)(t16 * 16 + r16) * D + kq * 8;
        const bf16_t* wh = RWH + (size_t)r16 * D + kq * 8; const bf16_t* wl = RWL + (size_t)r16 * D + kq * 8;
        f32x4 acc[3]; float ss = 0.f;
#pragma unroll
        for (int q = 0; q < 3; ++q) acc[q] = (f32x4){0.f, 0.f, 0.f, 0.f};
        for (int k0 = 0; k0 < D; k0 += 128) {
            f32x4 xa[4], xb[4];
#pragma unroll
            for (int u = 0; u < 4; ++u) { xa[u] = *(const f32x4*)(hp + k0 + u * 32); xb[u] = *(const f32x4*)(hp + k0 + u * 32 + 4); }
#pragma unroll
            for (int u = 0; u < 4; ++u) {
                const f32x4 a = xa[u], b = xb[u];
                ss += ((a.x * a.x + a.y * a.y) + (a.z * a.z + a.w * a.w)) + ((b.x * b.x + b.y * b.y) + (b.z * b.z + b.w * b.w));
                u32x4 h; h.x = fg::cvt_pk_bf16(a.x, a.y); h.y = fg::cvt_pk_bf16(a.z, a.w); h.z = fg::cvt_pk_bf16(b.x, b.y); h.w = fg::cvt_pk_bf16(b.z, b.w);
                u32x4 lo; lo.x = fg::cvt_pk_bf16(a.x - __uint_as_float(h.x << 16), a.y - __uint_as_float(h.x & 0xffff0000u)); lo.y = fg::cvt_pk_bf16(a.z - __uint_as_float(h.y << 16), a.w - __uint_as_float(h.y & 0xffff0000u));
                lo.z = fg::cvt_pk_bf16(b.x - __uint_as_float(h.z << 16), b.y - __uint_as_float(h.z & 0xffff0000u)); lo.w = fg::cvt_pk_bf16(b.z - __uint_as_float(h.w << 16), b.w - __uint_as_float(h.w & 0xffff0000u));
                const bf16x8 ah = *reinterpret_cast<const bf16x8*>(&h), al_ = *reinterpret_cast<const bf16x8*>(&lo);
#pragma unroll
                for (int q = 0; q < 3; ++q) { const bf16x8 bh = *(const bf16x8*)(wh + (size_t)q * 16 * D + k0 + u * 32), bl = *(const bf16x8*)(wl + (size_t)q * 16 * D + k0 + u * 32);
                    acc[q] = __builtin_amdgcn_mfma_f32_16x16x32_bf16(ah, bh, acc[q], 0, 0, 0);
                    acc[q] = __builtin_amdgcn_mfma_f32_16x16x32_bf16(al_, bh, acc[q], 0, 0, 0);
                    acc[q] = __builtin_amdgcn_mfma_f32_16x16x32_bf16(ah, bl, acc[q], 0, 0, 0); }
            }
        }
        ss += __shfl_xor(ss, 16); ss += __shfl_xor(ss, 32);
        const float rs = rsqrtf(ss * (1.0f / D) + EPS);
#pragma unroll
        for (int q = 0; q < 3; ++q)
#pragma unroll
            for (int i = 0; i < 4; ++i) tile[(kq * 4 + i) * 49 + q * 16 + r16] = acc[q][i];
        LDS_WAIT();
        if (lane < 16) {
            const LAS float* tr = tile + lane * 49; const int t = t16 * 16 + lane;
            const float g0 = tr[0] * rs + rg_b[0], g1 = tr[1] * rs + rg_b[1], g2 = tr[2] * rs + rg_b[2], g3 = tr[3] * rs + rg_b[3];
            int gs = 0; float gm = g0; if (g1 > gm) { gm = g1; gs = 1; } if (g2 > gm) { gm = g2; gs = 2; } if (g3 > gm) { gm = g3; gs = 3; }
            const float gp = 1.0f / (__expf(g0 - gm) + __expf(g1 - gm) + __expf(g2 - gm) + __expf(g3 - gm));
            float ev[8];
#pragma unroll
            for (int i = 0; i < 8; ++i) ev[i] = tr[4 + gs * 8 + i] * rs + re_b[gs * 8 + i];
            int i0 = 0; float m0 = ev[0];
#pragma unroll
            for (int i = 1; i < 8; ++i) if (ev[i] > m0) { m0 = ev[i]; i0 = i; }
            int i1 = -1; float m1 = -3.0e38f;
#pragma unroll
            for (int i = 0; i < 8; ++i) if (i != i0 && ev[i] > m1) { m1 = ev[i]; i1 = i; }
            const float e1 = __expf(m1 - m0), w0 = gp / (1.0f + e1), w1 = gp * e1 / (1.0f + e1);
            if (commit || w0 < -1.f) { RS2[t] = rs; const int ea = gs * 8 + i0, eb = gs * 8 + i1;
                const int pa = atomicAdd(&cnt[ea], 1); list[(size_t)ea * CAP + pa] = 2 * t; gwt[2 * t] = w0;
                const int pb = atomicAdd(&cnt[eb], 1); list[(size_t)eb * CAP + pb] = 2 * t + 1; gwt[2 * t + 1] = w1; }
        }
        LDS_WAIT();
    }
}
namespace fg {
struct EpiMemKV {
    bf16_t* O; const float* rs;
    DI void operator()(const Acc& acc, const Unit& u, int wr, int wc, int fr, int fq) const {
#pragma unroll
        for (int ai = 0; ai < 2; ++ai)
#pragma unroll
            for (int m = 0; m < 4; ++m) { const int r = u.pm * BM + ai * HALF + wr * 64 + m * 16 + fr; const float sc = rs[r];
#pragma unroll
                for (int bj = 0; bj < 2; ++bj) { const int c0 = (u.pn & 1) * BM + bj * HALF + wc * 32 + 8 * fq;
                    *(u32x4*)(O + (size_t)(u.pn >> 1) * (NB * MEMT * MI) + (size_t)r * MI + c0) = pack8(acc[ai][bj][m][0] * sc, acc[ai][bj][m][1] * sc); } }
    }
};
}
DI void moe_prefix(LAS unsigned char* lds, const int* cnt) {
    LAS int* pref = (LAS int*)(lds + LDS_MISC + 1024); const int tid = opaque_tid();
    if (tid < 32) pref[64 + tid] = cnt[tid];
    __syncthreads();
    if (tid == 0) { int s = 0; for (int e = 0; e < NE; ++e) { pref[e] = s; s += (pref[64 + e] + 255) >> 8; } pref[32] = s; }
    __syncthreads();
}

__global__ void __launch_bounds__(512, 2) mk_fwd(MArgs a) {
    extern __shared__ __attribute__((aligned(16))) unsigned char lds_raw[];
    LAS unsigned char* lds = (LAS unsigned char*)lds_raw;
    const int G = gridDim.x, bx = blockIdx.x, vcu = fa::vcu_of(bx, G), NGW = G * 8;
    volatile LAS unsigned* MISC = (volatile LAS unsigned*)(lds + LDS_MISC);
    if (threadIdx.x < 64) MISC[threadIdx.x] = 0u;
    __syncthreads();
    unsigned char* ws = a.ws;
    XcdBarrier bar = xcd_barrier_post((unsigned*)(ws + WS_CTL) + CW_BAR + a.bar_region * XCD_BAR_WORDS, MISC + 8);
    const MArgs& P = a;
    int pid = 0; const int lo = a.ph_lo, hi = a.ph_hi;
#define PH_IF if (pid >= lo && pid < hi)
#define TL const int tid = opaque_tid(), lane = tid & 63, wave = __builtin_amdgcn_readfirstlane(tid >> 6), gw = vcu * 8 + wave; (void)lane; (void)gw
#define PH_END do { if (pid >= lo && pid + 1 < hi) xcd_barrier(bar); ++pid; } while (0)
    PH_IF { TL; conv_phase(P, lds, gw, NGW, wave, lane); if (XCONV) conv_phase(P, lds, gw, NGW, wave, lane); tables_phase(P, vcu * 512 + tid, G * 512); memprep_phase(P, gw, NGW, lane);
            combine_phase(INF(0), nullptr, WSF(WS_H), WSB(WS_HB), WSF(WS_RS0), INF(3), WSB(WS_HN), nullptr, gw, NGW, lane); }
    PH_END;
    for (int l = 0; l < DEPTH; ++l) {
        const bool isA = l < NA; const int j = l - NA;
        if (l > 0) { PH_IF { TL; if (XCOMB) combine_phase(WSF(WS_H), WSB(WS_Y), WSF(WS_Q), nullptr, nullptr, nullptr, nullptr, nullptr, gw, NGW, lane);
            combine_phase(WSF(WS_H), WSB(WS_Y), WSF(WS_H), WSB(WS_HB), WSF(WS_RS0), isA ? INF(3) + l * D : nullptr, isA ? WSB(WS_HN) : nullptr, nullptr, gw, NGW, lane); } PH_END; }
        if (isA) {
            PH_IF { if (l == 0) { fg::ProbDense pr{(const char*)WSB(WS_MEMB), (const char*)WSB(WS_WMK), (const char*)WSB(WS_MEMB), (const char*)WSB(WS_WMK), NB * MEMT / 256, 16, 16, D, D, 0, G, bx}; fg::EpiMemKV E{WSB(WS_MK), WSF(WS_MEMRS)}; fg::gemm_phase(lds, pr, E); }
                    { TL; pool_phase(WSB(WS_HN), WSB(WS_U), vcu, G, tid); if (XPOOL) pool_phase(WSB(WS_HN), WSB(WS_U), vcu, G, tid); } }
            PH_END;
        } else {
            PH_IF { const int n = j == 0 ? NDQ0 : QR; const char* B = (const char*)(j == 0 ? WSB(WS_WDQ0) : WSB(WS_WDQ1));
                    fg::ProbDense pr{(const char*)WSB(WS_HB), B, (const char*)WSB(WS_HB), B, T / 256, n / 256, n / 256, D, D, 0, G, bx};
                    fg::EpiDQ E{WSB(WS_CQ), WSB(WS_CKV), WSB(WS_KR), WSF(WS_RS0), WSF(WS_LSQ), WSF(WS_LSKV), WSF(WS_COS), WSF(WS_SIN)}; fg::gemm_phase(lds, pr, E); if (XDENSE) fg::gemm_phase(lds, pr, E); }
            PH_END;
            PH_IF { fg::ProbDense pr{(const char*)WSB(WS_CQ), (const char*)(WSB(WS_WUQ) + (size_t)j * NQ * QR), (const char*)WSB(WS_CKV), (const char*)WSB(WS_WUKV), T / 256, (j == 0 ? NQ + 4096 : NQ) / 256, NQ / 256, QR, QR, 0, G, bx};
                    fg::EpiUQ E{WSB(WS_Q), WSB(WS_KN), WSB(WS_V), WSF(WS_LSQ), WSF(WS_LSKV), WSF(WS_COS), WSF(WS_SIN)}; fg::gemm_phase(lds, pr, E); }
            PH_END;
            PH_IF { fa::mla_phase((LAS char*)lds, WSB(WS_Q), WSB(WS_KN), WSB(WS_KR), WSB(WS_V), WSB(WS_AO), G, bx); if (XMLA) fa::mla_phase((LAS char*)lds, WSB(WS_Q), WSB(WS_KN), WSB(WS_KR), WSB(WS_V), WSB(WS_AO), G, bx); }
            PH_END;
        }
        PH_IF { const char* A = (const char*)(isA ? WSB(WS_U) : WSB(WS_AO)); const char* B = (const char*)(isA ? WSB(WS_WPOOL) + (size_t)l * D * PG : WSB(WS_WO) + (size_t)j * D * D);
                fg::ProbDense pr{A, B, A, B, T / 256, D / 256, D / 256, isA ? PG : D, D, isA ? 1 : 0, G, bx}; fg::EpiRes<true> E{WSF(WS_H), WSB(WS_HB), WSF(WS_SSP)}; fg::gemm_phase(lds, pr, E); }
        PH_END;
        PH_IF { const char* B = (const char*)(WSB(WS_WMQ) + (size_t)l * MI * D); fg::ProbDense pr{(const char*)WSB(WS_HB), B, (const char*)WSB(WS_HB), B, T / 256, MI / 256, MI / 256, D, D, 0, G, bx};
                fg::EpiBf16RS<2> E{WSB(WS_MQ), MI, WSF(WS_SSP)}; fg::gemm_phase(lds, pr, E); if (XDENSE) fg::gemm_phase(lds, pr, E); }
        PH_END;
        PH_IF { fa::memattn_phase((LAS char*)lds, WSB(WS_MQ), WSB(WS_MK) + (size_t)l * NB * MEMT * MI, WSB(WS_MV) + (size_t)l * NB * MEMT * MI, WSB(WS_MO), G, bx); if (XMEMATT) fa::memattn_phase((LAS char*)lds, WSB(WS_MQ), WSB(WS_MK) + (size_t)l * NB * MEMT * MI, WSB(WS_MV) + (size_t)l * NB * MEMT * MI, WSB(WS_MO), G, bx); }
        PH_END;
        PH_IF { const char* B = (const char*)(WSB(WS_WMO) + (size_t)l * D * MI); fg::ProbDense pr{(const char*)WSB(WS_MO), B, (const char*)WSB(WS_MO), B, T / 256, D / 256, D / 256, MI, MI, 0, G, bx};
                fg::EpiRes<false> E{WSF(WS_H), WSB(WS_HB), nullptr}; fg::gemm_phase(lds, pr, E); }
        PH_END;
        PH_IF { TL; if (XROUTER) router_phase(WSF(WS_H), WSB(WS_RWH) + (size_t)l * 2 * 48 * D, INF(25) + l * NG, INF(27) + l * NE, WSF(WS_RS2), ((int*)(P.ws + WS_CTL + OFF_CNT)) + l * NE, ((int*)(P.ws + WS_LIST)), WSF(WS_GW), lds, vcu, G, wave, lane, false);
                router_phase(WSF(WS_H), WSB(WS_RWH) + (size_t)l * 2 * 48 * D, INF(25) + l * NG, INF(27) + l * NE, WSF(WS_RS2), ((int*)(P.ws + WS_CTL + OFF_CNT)) + l * NE, ((int*)(P.ws + WS_LIST)), WSF(WS_GW), lds, vcu, G, wave, lane); }
        PH_END;
        PH_IF { moe_prefix(lds, ((int*)(P.ws + WS_CTL + OFF_CNT)) + l * NE);
                fg::ProbMoe pr{(const char*)WSB(WS_HB), (const char*)(WSB(WS_WGU) + (size_t)l * NE * 1024 * D), ((int*)(P.ws + WS_LIST)), (const LAS int*)(lds + LDS_MISC + 1024), 4, D, D, 1, G, bx, (long)1024 * D * 2};
                fg::EpiMoe1 E{WSB(WS_HH), WSF(WS_RS2), ((int*)(P.ws + WS_LIST))}; fg::gemm_phase(lds, pr, E); if (XMOE) fg::gemm_phase(lds, pr, E); }
        PH_END;
        PH_IF { moe_prefix(lds, ((int*)(P.ws + WS_CTL + OFF_CNT)) + l * NE);
                fg::ProbMoe pr{(const char*)WSB(WS_HH), (const char*)(WSB(WS_WD) + (size_t)l * NE * D * EFF), ((int*)(P.ws + WS_LIST)), (const LAS int*)(lds + LDS_MISC + 1024), 8, EFF, EFF, 0, G, bx, (long)D * EFF * 2};
                fg::EpiMoe2 E{WSB(WS_Y), WSF(WS_GW), ((int*)(P.ws + WS_LIST))}; fg::gemm_phase(lds, pr, E); if (XMOE) fg::gemm_phase(lds, pr, E); }
        PH_END;
    }
    PH_IF { TL; combine_phase(WSF(WS_H), WSB(WS_Y), nullptr, nullptr, nullptr, INF(31), nullptr, P.out, gw, NGW, lane); }
#undef PH_IF
#undef PH_END
}
constexpr int NPHASES = 1 + 8 + 9 + 11 + 11 + 1;

#ifndef MK_SPLIT
#define MK_SPLIT 0
#endif
extern "C" void kernel_launch(void* const* d_in, const int* in_sizes, int n_in, void* d_out, int out_size, void* d_ws, size_t ws_size, hipStream_t stream) {
    static int grid = 0;
    if (grid == 0) {
        if (n_in != 32 || in_sizes[0] != T * D || out_size != T * D || ws_size < WS_END) { fprintf(stderr, "kernel_launch: shape/ws mismatch (ws %zu need %zu)\n", ws_size, (size_t)WS_END); grid = -1; return; }
        int dev = 0, cus = 0;
        if (hipGetDevice(&dev) != hipSuccess || hipDeviceGetAttribute(&cus, hipDeviceAttributeMultiprocessorCount, dev) != hipSuccess || cus <= 0) { fprintf(stderr, "kernel_launch: device query failed\n"); grid = -1; return; }
        if (hipFuncSetAttribute((const void*)mk_fwd, hipFuncAttributeMaxDynamicSharedMemorySize, LDS_BYTES) != hipSuccess) { fprintf(stderr, "kernel_launch: hipFuncSetAttribute failed\n"); grid = -1; return; }
        int per_cu = 0;
        if (hipOccupancyMaxActiveBlocksPerMultiprocessor(&per_cu, (const void*)mk_fwd, 512, LDS_BYTES) != hipSuccess || per_cu < 1) fprintf(stderr, "kernel_launch: occupancy query says %d\n", per_cu);
        (void)hipGetLastError();
        grid = cus;
    }
    if (grid < 0) return;
    if (hipMemsetAsync((char*)d_ws + WS_CTL, 0, CTL_BYTES, stream) != hipSuccess) { fprintf(stderr, "kernel_launch: memset failed\n"); return; }
    MArgs a; memset(&a, 0, sizeof(a));
    for (int i = 0; i < 32; ++i) a.in[i] = d_in[i];
    a.out = (float*)d_out; a.ws = (unsigned char*)d_ws;
#if MK_SPLIT
    for (int p = 0; p < NPHASES; ++p) { a.ph_lo = p; a.ph_hi = p + 1; a.bar_region = 0; hipLaunchKernelGGL(mk_fwd, dim3(grid), dim3(512), LDS_BYTES, stream, a); }
#else
    a.ph_lo = 0; a.ph_hi = NPHASES; a.bar_region = 0; hipLaunchKernelGGL(mk_fwd, dim3(grid), dim3(512), LDS_BYTES, stream, a);
#endif
    const hipError_t le = hipPeekAtLastError();
    if (le != hipSuccess) fprintf(stderr, "kernel_launch: launch failed: %s\n", hipGetErrorName(le));
}
```

```cpp
#include <hip/hip_runtime.h>
#include <cstdio>
#include <cstdint>
#include <cstring>

typedef unsigned short bf16_t;
typedef float f32x4 __attribute__((ext_vector_type(4)));
typedef unsigned u32x4 __attribute__((ext_vector_type(4)));
typedef unsigned u32x2 __attribute__((ext_vector_type(2)));
#define DI __device__ __forceinline__

constexpr int D = 2048, NB = 4, S = 4096, T = NB * S, DEPTH = 4, NA = 2;
constexpr int CHUNK = 64;
constexpr int PG = 512;
constexpr int HEADS = 16, QR = 512, KVR = 512, NOPE = 128, ROPE = 64, VD = 128, QKD = NOPE + ROPE;
constexpr int MEMT = 256, MH = 4, MHD = 128, MI = 512;
constexpr int NG = 4, EPG = 8, NE = 32, EFF = 512;
constexpr float EPS = 1e-6f;
constexpr int CAP = T;
constexpr int MAXROWS = 2 * T + NE * 256;
constexpr int NQ = HEADS * QKD;
constexpr int NDQ0 = 1280;

constexpr size_t al(size_t x) { return (x + 255) & ~(size_t)255; }
constexpr size_t WS_CTL = 0, CTL_BYTES = 1u << 20;
constexpr size_t OFF_CNT = 65536;
constexpr size_t WS_WPOOL = WS_CTL + CTL_BYTES;
constexpr size_t WS_WMQ = WS_WPOOL + (size_t)NA * D * PG * 2;
constexpr size_t WS_WMK = WS_WMQ + (size_t)DEPTH * MI * D * 2;
constexpr size_t WS_WMV = WS_WMK + (size_t)DEPTH * MI * D * 2;
constexpr size_t WS_WMO = WS_WMV + (size_t)DEPTH * MI * D * 2;
constexpr size_t WS_WDQ0 = WS_WMO + (size_t)DEPTH * D * MI * 2;
constexpr size_t WS_WDQ1 = WS_WDQ0 + (size_t)NDQ0 * D * 2;
constexpr size_t WS_WUQ = WS_WDQ1 + (size_t)QR * D * 2;
constexpr size_t WS_WUKV = WS_WUQ + (size_t)2 * NQ * QR * 2;
constexpr size_t WS_WO = WS_WUKV + (size_t)4096 * KVR * 2;
constexpr size_t WS_RWT = WS_WO + (size_t)2 * D * D * 2;
constexpr size_t WS_WGU = al(WS_RWT + (size_t)DEPTH * 36 * D * 4);
constexpr size_t WS_WD = WS_WGU + (size_t)DEPTH * NE * 1024 * D * 2;
constexpr size_t WS_H = WS_WD + (size_t)DEPTH * NE * D * EFF * 2;
constexpr size_t WS_HB = WS_H + (size_t)T * D * 4;
constexpr size_t WS_Y = WS_HB + (size_t)T * D * 2;
constexpr size_t WS_HH = WS_Y + (size_t)2 * T * D * 2;
constexpr size_t WS_KN = WS_HH + (size_t)MAXROWS * EFF * 2;
constexpr size_t WS_V = WS_KN + (size_t)T * D * 2;
constexpr size_t WS_Q = WS_V + (size_t)T * D * 2;
constexpr size_t WS_HN = WS_Q;
constexpr size_t WS_U = WS_Q + (size_t)T * D * 2;
constexpr size_t WS_AO = WS_Q + (size_t)T * NQ * 2;
constexpr size_t WS_MQ = WS_AO + (size_t)T * D * 2;
constexpr size_t WS_MO = WS_MQ + (size_t)T * MI * 2;
constexpr size_t WS_CQ = WS_MO + (size_t)T * MI * 2;
constexpr size_t WS_CKV = WS_CQ + (size_t)T * QR * 2;
constexpr size_t WS_KR = WS_CKV + (size_t)T * KVR * 2;
constexpr size_t WS_MEMB = WS_KR + (size_t)T * ROPE * 2;
constexpr size_t WS_MK = WS_MEMB + (size_t)NB * MEMT * D * 2;
constexpr size_t WS_MV = WS_MK + (size_t)DEPTH * NB * MEMT * MI * 2;
constexpr size_t WS_SSP = WS_MV + (size_t)DEPTH * NB * MEMT * MI * 2;
constexpr size_t WS_LSQ = WS_SSP + (size_t)T * 32 * 4;
constexpr size_t WS_LSKV = WS_LSQ + (size_t)T * 8 * 4;
constexpr size_t WS_RS0 = WS_LSKV + (size_t)T * 8 * 4;
constexpr size_t WS_RS2 = WS_RS0 + (size_t)T * 4;
constexpr size_t WS_MEMRS = WS_RS2 + (size_t)T * 4;
constexpr size_t WS_COS = WS_MEMRS + 4096;
constexpr size_t WS_SIN = WS_COS + (size_t)T * 32 * 4;
constexpr size_t WS_GW = WS_SIN + (size_t)T * 32 * 4;
constexpr size_t WS_LIST = WS_GW + (size_t)2 * T * 4;
constexpr size_t WS_RWH = WS_LIST + (size_t)NE * CAP * 4;
constexpr size_t WS_END = WS_RWH + (size_t)DEPTH * 2 * 48 * D * 2;
static_assert(WS_U + (size_t)T * D * 2 <= WS_MQ, "U overlay inside Q|AO");

DI float bf2f(bf16_t b) { return __uint_as_float(((unsigned)b) << 16); }
DI unsigned f2bf(float f) { unsigned u = __float_as_uint(f); return (u + 0x7fffu + ((u >> 16) & 1u)) >> 16; }
DI unsigned pk2(float lo, float hi) { return f2bf(lo) | (f2bf(hi) << 16); }
DI float wave_sum(float v) {
#pragma unroll
    for (int o = 1; o < 64; o <<= 1) v += __shfl_xor(v, o);
    return v;
}
DI int opaque_tid() { int t = threadIdx.x; asm volatile("" : "+v"(t)); return t; }
DI float silu(float x) { return x / (1.0f + __expf(-x)); }

DI int permrow(int perm, int n) {
    switch (perm) {
        case 1: return (n >> 7) * QKD + (n & 127);
        case 2: { const int h = n >> 6, r = n & 63; return h * QKD + NOPE + 2 * (r & 31) + (r >> 5); }
        case 3: return (n >> 7) * 256 + (n & 127);
        case 4: return (n >> 7) * 256 + 128 + (n & 127);
        case 5: return 2 * (n & 31) + (n >> 5);
        default: return n;
    }
}
#define LAS __attribute__((address_space(3)))
typedef short bf16x8 __attribute__((ext_vector_type(8)));
namespace fg {
constexpr int BM = 256, BK = 64, HALF = 128, HTB = HALF * BK * 2, STAGE_BYTES = 8 * HTB, NXCD = 8, WGM = 8;
DI int lds_byte(int r, int c) { const int st = (r >> 4) * 2 + (c >> 5), rr = r & 15, cc = c & 31, ob = rr * 64 + cc * 2; return st * 1024 + (ob ^ (((ob >> 9) & 1) << 5)); }
DI void stage_rc(int b, int& R, int& C) { const int st = b / 1024, sb = b % 1024, swz = sb ^ (((sb >> 9) & 1) << 5); R = (st >> 1) * 16 + swz / 64; C = (st & 1) * 32 + (swz % 64) / 2; }
DI int perm32(int rho) { const int n = rho >> 4, i = rho & 15; return 8 * (i >> 2) + 4 * n + (i & 3); }
DI unsigned cvt_pk_bf16(float lo, float hi) { unsigned r; asm volatile("v_cvt_pk_bf16_f32 %0, %1, %2" : "=v"(r) : "v"(lo), "v"(hi)); return r; }
struct Unit { int pm, pn, e, r0, cnt; };

struct ProbDense {
    const char* A0; const char* B0; const char* A1; const char* B1; int nM, nN, nN0, K, lda, pool, G, c;
    static constexpr bool GATHER = false;
    DI bool next(int i, Unit& u) const {
        const long L = (long)i * G + c; const int nwg = nM * nN; if (L >= nwg) return false;
        int wgid = (int)L; { const int q = nwg / NXCD, r = nwg % NXCD, xcd = wgid % NXCD, off = wgid / NXCD; wgid = (xcd < r ? xcd * (q + 1) : r * (q + 1) + (xcd - r) * q) + off; }
        const int nig = WGM * nN, gid = wgid / nig, fm = gid * WGM, gsz = (nM - fm) < WGM ? (nM - fm) : WGM;
        u.pm = fm + ((wgid % nig) % gsz); u.pn = (wgid % nig) / gsz; u.e = 0; u.r0 = 0; u.cnt = 256; return true; }
    DI const char* aptr(const Unit& u) const { return (u.pn < nN0 ? A0 : A1) + (size_t)u.pm * 256 * lda * 2 + (pool ? (size_t)(u.pn >> 1) * 1024 : 0); }
    DI const char* bptr(const Unit& u) const { return u.pn < nN0 ? B0 + (size_t)u.pn * 256 * K * 2 : B1 + (size_t)(u.pn - nN0) * 256 * K * 2; }
    DI void avoff(const Unit&, const int (&R)[2], const int (&C)[2], unsigned (&vo)[2][2]) const {
#pragma unroll
        for (int h = 0; h < 2; ++h)
#pragma unroll
            for (int i = 0; i < 2; ++i) vo[h][i] = (unsigned)((h * 128 + R[i]) * lda + C[i]) * 2u; }
};
struct ProbMoe {
    const char* A; const char* Bt; const int* list; const LAS int* pref; int npn, K, lda, gather, G, c; long estride;
    static constexpr bool GATHER = true;
    DI bool next(int i, Unit& u) const {
        const int L = i * G + c, tile = L / npn; if (tile >= pref[32]) return false;
        int e = 0; while (pref[e + 1] <= tile) ++e;
        u.pm = tile; u.pn = L % npn; u.e = e; u.r0 = (tile - pref[e]) * 256; u.cnt = pref[64 + e]; return true; }
    DI const char* aptr(const Unit& u) const { return gather ? A : A + (size_t)u.pm * 256 * lda * 2; }
    DI const char* bptr(const Unit& u) const { return Bt + (size_t)u.e * estride + (size_t)u.pn * 256 * K * 2; }
    DI void avoff(const Unit& u, const int (&R)[2], const int (&C)[2], unsigned (&vo)[2][2]) const {
#pragma unroll
        for (int h = 0; h < 2; ++h)
#pragma unroll
            for (int i = 0; i < 2; ++i) { const int row = h * 128 + R[i];
                if (gather) { const int ri = u.r0 + row; const int tok = ri < u.cnt ? (list[(size_t)u.e * CAP + ri] >> 1) : 0; vo[h][i] = (unsigned)(tok * lda + C[i]) * 2u; }
                else vo[h][i] = (unsigned)(row * lda + C[i]) * 2u; } }
};

typedef f32x4 Acc[2][2][4][2];
DI float quad_sum(float s) { s += __shfl_xor(s, 16); s += __shfl_xor(s, 32); return s; }
DI float sq8(const f32x4& a, const f32x4& b) { return ((a.x * a.x + a.y * a.y) + (a.z * a.z + a.w * a.w)) + ((b.x * b.x + b.y * b.y) + (b.z * b.z + b.w * b.w)); }
DI u32x4 pack8(const f32x4& a, const f32x4& b) { u32x4 w; w.x = cvt_pk_bf16(a.x, a.y); w.y = cvt_pk_bf16(a.z, a.w); w.z = cvt_pk_bf16(b.x, b.y); w.w = cvt_pk_bf16(b.z, b.w); return w; }
template <int NP> DI float rs_from_parts(const float* part, int r, int fq, float inv_n) {
    float s;
    if (NP == 32) { const f32x4 a = *(const f32x4*)(part + (size_t)r * 32 + fq * 8), b = *(const f32x4*)(part + (size_t)r * 32 + fq * 8 + 4); s = ((a.x + a.y) + (a.z + a.w)) + ((b.x + b.y) + (b.z + b.w)); }
    else { const float* p = part + (size_t)r * 8 + fq * 2; s = p[0] + p[1]; }
    s = quad_sum(s); return rsqrtf(s * inv_n + EPS);
}
DI void rope8(f32x4& a, f32x4& b, const float* COS, const float* SIN, int r, int i0) {
    const f32x4 c = *(const f32x4*)(COS + (size_t)r * 32 + i0), s = *(const f32x4*)(SIN + (size_t)r * 32 + i0);
    const f32x4 a2 = {a.x * c.x - a.y * s.x, a.y * c.x + a.x * s.x, a.z * c.y - a.w * s.y, a.w * c.y + a.z * s.y};
    const f32x4 b2 = {b.x * c.z - b.y * s.z, b.y * c.z + b.x * s.z, b.z * c.w - b.w * s.w, b.w * c.w + b.z * s.w};
    a = a2; b = b2;
}
template <bool STATS> struct EpiRes {
    float* H; bf16_t* HB; float* SSP;
    DI void operator()(const Acc& acc, const Unit& u, int wr, int wc, int fr, int fq) const {
#pragma unroll
        for (int ai = 0; ai < 2; ++ai)
#pragma unroll
            for (int m = 0; m < 4; ++m) { const int r = u.pm * BM + ai * HALF + wr * 64 + m * 16 + fr; float ss = 0.f;
#pragma unroll
                for (int bj = 0; bj < 2; ++bj) { const int c0 = u.pn * BM + bj * HALF + wc * 32 + 8 * fq; f32x4 h0, h1;
                    if (H) { float* hp = H + (size_t)r * D + c0; h0 = *(const f32x4*)hp + acc[ai][bj][m][0]; h1 = *(const f32x4*)(hp + 4) + acc[ai][bj][m][1]; *(f32x4*)hp = h0; *(f32x4*)(hp + 4) = h1; }
                    else { const u32x4 w = *(const u32x4*)(HB + (size_t)r * D + c0);
                        h0 = (f32x4){__uint_as_float(w.x << 16), __uint_as_float(w.x & 0xffff0000u), __uint_as_float(w.y << 16), __uint_as_float(w.y & 0xffff0000u)} + acc[ai][bj][m][0];
                        h1 = (f32x4){__uint_as_float(w.z << 16), __uint_as_float(w.z & 0xffff0000u), __uint_as_float(w.w << 16), __uint_as_float(w.w & 0xffff0000u)} + acc[ai][bj][m][1]; }
                    *(u32x4*)(HB + (size_t)r * D + c0) = pack8(h0, h1); if (STATS) ss += sq8(h0, h1); }
                if (STATS) { ss = quad_sum(ss); if (fq == 0) SSP[(size_t)r * 32 + u.pn * 4 + wc] = ss; }
                asm volatile("" ::: "memory"); }
    }
};
template <int MODE  > struct EpiBf16RS {
    bf16_t* O; int ldo; const float* rs;
    DI void operator()(const Acc& acc, const Unit& u, int wr, int wc, int fr, int fq) const {
#pragma unroll
        for (int ai = 0; ai < 2; ++ai)
#pragma unroll
            for (int m = 0; m < 4; ++m) { const int r = u.pm * BM + ai * HALF + wr * 64 + m * 16 + fr;
                const float sc = MODE == 1 ? rs[r] : rs_from_parts<32>(rs, r, fq, 1.0f / D);
#pragma unroll
                for (int bj = 0; bj < 2; ++bj) { const int c0 = u.pn * BM + bj * HALF + wc * 32 + 8 * fq;
                    *(u32x4*)(O + (size_t)r * ldo + c0) = pack8(acc[ai][bj][m][0] * sc, acc[ai][bj][m][1] * sc); } }
    }
};
struct EpiDQ {
    bf16_t* CQ; bf16_t* CKV; bf16_t* KR; const float* RS0; float* LSQ; float* LSKV; const float* COS; const float* SIN;
    DI void operator()(const Acc& acc, const Unit& u, int wr, int wc, int fr, int fq) const {
#pragma unroll
        for (int ai = 0; ai < 2; ++ai)
#pragma unroll
            for (int m = 0; m < 4; ++m) { const int r = u.pm * BM + ai * HALF + wr * 64 + m * 16 + fr; const float sc = RS0[r]; float ss = 0.f;
#pragma unroll
                for (int bj = 0; bj < 2; ++bj) { const int cl = bj * HALF + wc * 32 + 8 * fq; f32x4 v0 = acc[ai][bj][m][0] * sc, v1 = acc[ai][bj][m][1] * sc;
                    if (u.pn < 4) { ss += sq8(v0, v1); bf16_t* o = (u.pn < 2 ? CQ : CKV) + (size_t)r * 512 + (u.pn & 1) * 256 + cl; *(u32x4*)o = pack8(v0, v1); }
                    else if (cl < 64) { rope8(v0, v1, COS, SIN, r, cl >> 1); *(u32x4*)(KR + (size_t)r * 64 + cl) = pack8(v0, v1); } }
                if (u.pn < 4) { ss = quad_sum(ss); if (fq == 0) (u.pn < 2 ? LSQ : LSKV)[(size_t)r * 8 + (u.pn & 1) * 4 + wc] = ss; } }
    }
};
struct EpiUQ {
    bf16_t* Q; bf16_t* KN; bf16_t* V; const float* LSQ; const float* LSKV; const float* COS; const float* SIN;
    DI void operator()(const Acc& acc, const Unit& u, int wr, int wc, int fr, int fq) const {
        const bool isq = u.pn < 12;
#pragma unroll
        for (int ai = 0; ai < 2; ++ai)
#pragma unroll
            for (int m = 0; m < 4; ++m) { const int r = u.pm * BM + ai * HALF + wr * 64 + m * 16 + fr;
                const float sc = rs_from_parts<8>(isq ? LSQ : LSKV, r, fq, 1.0f / 512.0f);
#pragma unroll
                for (int bj = 0; bj < 2; ++bj) { f32x4 v0 = acc[ai][bj][m][0] * sc, v1 = acc[ai][bj][m][1] * sc;
                    if (isq) { const int c0 = u.pn * BM + bj * HALF + wc * 32 + 8 * fq, hc = c0 % QKD;
                        if (hc >= NOPE) rope8(v0, v1, COS, SIN, r, (hc - NOPE) >> 1);
                        *(u32x4*)(Q + (size_t)r * NQ + c0) = pack8(v0, v1); }
                    else { const int c0 = (u.pn - 12) * BM + bj * HALF + wc * 32 + 8 * fq;
                        *(u32x4*)((c0 < 2048 ? KN + c0 : V + (c0 - 2048)) + (size_t)r * D) = pack8(v0, v1); } } }
    }
};
struct EpiMoe1 {
    bf16_t* HH; const float* RS2; const int* list;
    DI void operator()(const Acc& acc, const Unit& u, int wr, int wc, int fr, int fq) const {
#pragma unroll
        for (int ai = 0; ai < 2; ++ai)
#pragma unroll
            for (int m = 0; m < 4; ++m) { const int lr = ai * HALF + wr * 64 + m * 16 + fr, ri = u.r0 + lr;
                if (ri < u.cnt) { const float sc = RS2[list[(size_t)u.e * CAP + ri] >> 1];
                    const f32x4 g0 = acc[ai][0][m][0] * sc, g1 = acc[ai][0][m][1] * sc, u0 = acc[ai][1][m][0] * sc, u1 = acc[ai][1][m][1] * sc;
                    const f32x4 h0 = {silu(g0.x) * u0.x, silu(g0.y) * u0.y, silu(g0.z) * u0.z, silu(g0.w) * u0.w}, h1 = {silu(g1.x) * u1.x, silu(g1.y) * u1.y, silu(g1.z) * u1.z, silu(g1.w) * u1.w};
                    *(u32x4*)(HH + (size_t)(u.pm * BM + lr) * EFF + u.pn * 128 + wc * 32 + 8 * fq) = pack8(h0, h1); } }
    }
};
struct EpiMoe2 {
    bf16_t* Y; const float* GW; const int* list;
    DI void operator()(const Acc& acc, const Unit& u, int wr, int wc, int fr, int fq) const {
#pragma unroll
        for (int ai = 0; ai < 2; ++ai)
#pragma unroll
            for (int m = 0; m < 4; ++m) { const int lr = ai * HALF + wr * 64 + m * 16 + fr, ri = u.r0 + lr;
                if (ri < u.cnt) { const int a = list[(size_t)u.e * CAP + ri]; const float sc = GW[a];
#pragma unroll
                    for (int bj = 0; bj < 2; ++bj) { const int c0 = u.pn * BM + bj * HALF + wc * 32 + 8 * fq;
                        *(u32x4*)(Y + (size_t)a * D + c0) = pack8(acc[ai][bj][m][0] * sc, acc[ai][bj][m][1] * sc); } } }
    }
};

template <class Epi, class Prob>
DI void gemm_phase(LAS unsigned char* lds, const Prob& P, const Epi& E) {
    const int tid = opaque_tid(), wid = __builtin_amdgcn_readfirstlane(tid >> 6), lane = tid & 63, wr = wid >> 2, wc = wid & 3, fr = lane & 15, fq = lane >> 4;
    const int K = P.K, nt = K / BK;
    int sR[2], sC[2]; unsigned voffB[2];
#pragma unroll
    for (int i = 0; i < 2; ++i) { stage_rc(tid * 16 + i * 8192, sR[i], sC[i]); const int Rb = (sR[i] & ~31) + perm32(sR[i] & 31); voffB[i] = (unsigned)(Rb * K + sC[i]) * 2u; }
    const size_t kstep = (size_t)(BK * 2), hstepB = (size_t)HALF * K * 2;
    const unsigned ldsw = (unsigned)wid * 1024u;
    const int aoff = lds_byte(wr * 64 + fr, fq * 8), boff = lds_byte(wc * 32 + fr, fq * 8);
#define PG8_SA(b, h) (((b) * 2 + (h)) * HTB)
#define PG8_SB(b, h) ((4 + (b) * 2 + (h)) * HTB)
#define PG8_STAGE(bufoff, gbase, voff) do { _Pragma("unroll") for (int _i = 0; _i < 2; ++_i) \
        __builtin_amdgcn_global_load_lds((const unsigned*)((const char*)(gbase) + (voff)[_i]), (LAS unsigned*)(lds + (bufoff) + ldsw + _i * 8192), 16, 0, 0); } while (0)
#define PG8_LDA(dst, b, h) do { _Pragma("unroll") for (int m = 0; m < 4; ++m) _Pragma("unroll") for (int k = 0; k < 2; ++k) dst[m][k] = *(const LAS bf16x8*)(lds + PG8_SA(b, h) + aoff + m * 2048 + k * 1024); } while (0)
#define PG8_LDB(dst, b, h) do { _Pragma("unroll") for (int n = 0; n < 2; ++n) _Pragma("unroll") for (int k = 0; k < 2; ++k) dst[n][k] = *(const LAS bf16x8*)(lds + PG8_SB(b, h) + boff + n * 2048 + k * 1024); } while (0)
#define PG8_MMA(ai, bj, At, Bt) do { __builtin_amdgcn_s_setprio(1); _Pragma("unroll") for (int m = 0; m < 4; ++m) _Pragma("unroll") for (int n = 0; n < 2; ++n) _Pragma("unroll") for (int k = 0; k < 2; ++k) \
        acc[ai][bj][m][n] = __builtin_amdgcn_mfma_f32_16x16x32_bf16(Bt[n][k], At[m][k], acc[ai][bj][m][n], 0, 0, 0); __builtin_amdgcn_s_setprio(0); } while (0)
#define PG8_WAIT_V(n) asm volatile("s_waitcnt vmcnt(" #n ")" ::: "memory")
#define PG8_WAIT_L(n) asm volatile("s_waitcnt lgkmcnt(" #n ")" ::: "memory")
#define PG8_BAR __builtin_amdgcn_s_barrier()
#define PG8_SCHED __builtin_amdgcn_sched_barrier(0)
    Unit cur, nxt; int ui = 0;
    if (!P.next(0, cur)) return;
    f32x4 acc[2][2][4][2];
#pragma unroll
    for (int a = 0; a < 2; ++a)
#pragma unroll
        for (int b = 0; b < 2; ++b)
#pragma unroll
            for (int m = 0; m < 4; ++m)
#pragma unroll
                for (int n = 0; n < 2; ++n) acc[a][b][m][n] = (f32x4){0.f, 0.f, 0.f, 0.f};
    bf16x8 At[4][2], B0[2][2], B1[2][2];
    const char* cA = P.aptr(cur); const char* cB = P.bptr(cur);
    unsigned voA[2][2], vnA[2][2];
    P.avoff(cur, sR, sC, voA);
    if constexpr (Prob::GATHER) asm volatile("s_waitcnt vmcnt(0)" ::: "memory");
    PG8_STAGE(PG8_SB(0, 0), cB, voffB); PG8_STAGE(PG8_SB(0, 1), cB + hstepB, voffB); PG8_STAGE(PG8_SA(0, 0), cA, voA[0]); PG8_STAGE(PG8_SA(0, 1), cA, voA[1]);
    if (wr == 1) PG8_BAR;
    PG8_WAIT_V(2); PG8_BAR;
    PG8_STAGE(PG8_SB(1, 0), cB + kstep, voffB); PG8_STAGE(PG8_SA(1, 0), cA + kstep, voA[0]); PG8_STAGE(PG8_SB(1, 1), cB + hstepB + kstep, voffB);
    PG8_WAIT_V(6); PG8_BAR;
    for (;;) {
        const bool has_next = P.next(ui + 1, nxt);
        const char* nA = has_next ? P.aptr(nxt) : cA; const char* nB = has_next ? P.bptr(nxt) : cB;
#pragma unroll
        for (int h = 0; h < 2; ++h)
#pragma unroll
            for (int i = 0; i < 2; ++i) vnA[h][i] = voA[h][i];
        for (int t = 0; t < nt; t += 2) {
            const bool last = (t == nt - 2);
            if constexpr (Prob::GATHER) { if (last && has_next) P.avoff(nxt, sR, sC, vnA); }
            const char* a1 = cA + (size_t)(t + 1) * kstep;
            const char* a2 = last ? nA : cA + (size_t)(t + 2) * kstep; const char* b2 = last ? nB : cB + (size_t)(t + 2) * kstep;
            const char* a3 = a2 + kstep; const char* b3 = b2 + kstep;
            unsigned w0[2], w1[2];
#pragma unroll
            for (int i = 0; i < 2; ++i) { w0[i] = last ? vnA[0][i] : voA[0][i]; w1[i] = last ? vnA[1][i] : voA[1][i]; }
            PG8_LDB(B0, 0, 0); PG8_LDB(B1, 0, 1); PG8_SCHED; PG8_LDA(At, 0, 0); PG8_STAGE(PG8_SA(1, 1), a1, voA[1]);
            PG8_WAIT_V(8); PG8_WAIT_L(0); PG8_BAR; PG8_MMA(0, 0, At, B0); PG8_MMA(0, 1, At, B1); PG8_BAR; PG8_SCHED;
            PG8_LDA(At, 0, 1); PG8_STAGE(PG8_SB(0, 0), b2, voffB); PG8_STAGE(PG8_SB(0, 1), b2 + hstepB, voffB); PG8_STAGE(PG8_SA(0, 0), a2, w0);
            PG8_WAIT_V(8); PG8_WAIT_L(0); PG8_BAR; PG8_MMA(1, 0, At, B0); PG8_MMA(1, 1, At, B1); PG8_BAR; PG8_SCHED;
            PG8_LDB(B0, 1, 0); PG8_LDB(B1, 1, 1); PG8_SCHED; PG8_LDA(At, 1, 0); PG8_STAGE(PG8_SA(0, 1), a2, w1);
            PG8_WAIT_V(8); PG8_WAIT_L(0); PG8_BAR; PG8_MMA(0, 0, At, B0); PG8_MMA(0, 1, At, B1); PG8_BAR; PG8_SCHED;
            PG8_LDA(At, 1, 1); PG8_STAGE(PG8_SB(1, 0), b3, voffB); PG8_STAGE(PG8_SB(1, 1), b3 + hstepB, voffB); PG8_STAGE(PG8_SA(1, 0), a3, w0);
            PG8_WAIT_V(8); PG8_WAIT_L(0); PG8_BAR; PG8_MMA(1, 0, At, B0); PG8_MMA(1, 1, At, B1); PG8_BAR; PG8_SCHED;
        }
        if (wr == 0) PG8_BAR;
        E(acc, cur, wr, wc, fr, fq);
        if (!has_next) break;
#pragma unroll
        for (int a = 0; a < 2; ++a)
#pragma unroll
            for (int b = 0; b < 2; ++b)
#pragma unroll
                for (int m = 0; m < 4; ++m)
#pragma unroll
                    for (int n = 0; n < 2; ++n) acc[a][b][m][n] = (f32x4){0.f, 0.f, 0.f, 0.f};
        cur = nxt; cA = nA; cB = nB; ++ui;
#pragma unroll
        for (int h = 0; h < 2; ++h)
#pragma unroll
            for (int i = 0; i < 2; ++i) voA[h][i] = vnA[h][i];
        if (wr == 1) PG8_BAR;
    }
    PG8_WAIT_V(0);
    PG8_BAR;
#undef PG8_SA
#undef PG8_SB
#undef PG8_STAGE
#undef PG8_LDA
#undef PG8_LDB
#undef PG8_MMA
#undef PG8_WAIT_V
#undef PG8_WAIT_L
#undef PG8_BAR
#undef PG8_SCHED
}
}


namespace fa {
typedef float f32x16 __attribute__((ext_vector_type(16)));
typedef short s16x4 __attribute__((ext_vector_type(4)));
#define SBAR() __builtin_amdgcn_sched_barrier(0)
constexpr float THR = 8.f, LOG2E = 1.4426950408889634f;
DI int crow(int r, int hi) { return (r & 3) + 8 * (r >> 2) + 4 * hi; }
DI unsigned cvtpk(float lo, float hi) { unsigned r; asm volatile("v_cvt_pk_bf16_f32 %0, %1, %2" : "=v"(r) : "v"(lo), "v"(hi)); return r; }
DI void partialSM(f32x16& p0, f32x16& p1, float& m_reg, float& mn, float& alpha) {
    float pmax = p0[0];
#pragma unroll
    for (int r = 1; r < 16; ++r) pmax = fmaxf(pmax, p0[r]);
#pragma unroll
    for (int r = 0; r < 16; ++r) pmax = fmaxf(pmax, p1[r]);
    { auto rr = __builtin_amdgcn_permlane32_swap(__float_as_uint(pmax), __float_as_uint(pmax), false, false); pmax = fmaxf(__uint_as_float(rr[0]), __uint_as_float(rr[1])); }
    if (__builtin_expect(__all(pmax - m_reg <= THR), 1)) { mn = m_reg; alpha = 1.f; }
    else { mn = fmaxf(m_reg, pmax); alpha = __builtin_amdgcn_exp2f((m_reg - mn) * LOG2E); m_reg = mn; }
    const float mnC = -mn * LOG2E;
#pragma unroll
    for (int r = 0; r < 16; ++r) p0[r] = fmaf(p0[r], LOG2E, mnC);
#pragma unroll
    for (int r = 0; r < 16; ++r) p1[r] = fmaf(p1[r], LOG2E, mnC);
#pragma unroll
    for (int r = 0; r < 16; ++r) p0[r] = __builtin_amdgcn_exp2f(p0[r]);
}
DI void finishSM(f32x16& p0, f32x16& p1, float alpha, float& l_reg, bf16x8& pa0, bf16x8& pa1, bf16x8& pa2, bf16x8& pa3) {
#pragma unroll
    for (int r = 0; r < 16; ++r) p1[r] = __builtin_amdgcn_exp2f(p1[r]);
    float ps = 0;
#pragma unroll
    for (int r = 0; r < 16; ++r) ps += p0[r];
#pragma unroll
    for (int r = 0; r < 16; ++r) ps += p1[r];
    { auto rr = __builtin_amdgcn_permlane32_swap(__float_as_uint(ps), __float_as_uint(ps), false, false); ps = __uint_as_float(rr[0]) + __uint_as_float(rr[1]); }
    l_reg = l_reg * alpha + ps;
#define PK4(P, BASE, OUT) do { unsigned a0 = cvtpk(P[BASE + 0], P[BASE + 1]), a1 = cvtpk(P[BASE + 2], P[BASE + 3]);   \
    unsigned b0 = cvtpk(P[BASE + 4], P[BASE + 5]), b1 = cvtpk(P[BASE + 6], P[BASE + 7]);                              \
    auto r0 = __builtin_amdgcn_permlane32_swap(a0, b0, false, false); auto r1 = __builtin_amdgcn_permlane32_swap(a1, b1, false, false); \
    u32x4 w = {r0[0], r1[0], r0[1], r1[1]}; OUT = *reinterpret_cast<bf16x8*>(&w); } while (0)
    PK4(p0, 0, pa0); PK4(p0, 8, pa1); PK4(p1, 0, pa2); PK4(p1, 8, pa3);
#undef PK4
}
template <int DQK> DI void qkt(f32x16& p0, f32x16& p1, LAS const char* Ks, const int (&kb)[4], const bf16x8* qr) {
    constexpr int KROW = DQK * 2;
#pragma unroll
    for (int r = 0; r < 16; ++r) { p0[r] = 0.f; p1[r] = 0.f; }
#pragma unroll
    for (int d0 = 0; d0 < DQK / 16; ++d0) {
        const bf16x8 b0 = *(LAS const bf16x8*)(Ks + kb[d0 & 3] + (d0 >> 2) * 128);
        const bf16x8 b1 = *(LAS const bf16x8*)(Ks + kb[d0 & 3] + (d0 >> 2) * 128 + 32 * KROW);
        p0 = __builtin_amdgcn_mfma_f32_32x32x16_bf16(b0, qr[d0], p0, 0, 0, 0);
        p1 = __builtin_amdgcn_mfma_f32_32x32x16_bf16(b1, qr[d0], p1, 0, 0, 0); }
}
DI int v_rd_base(int lane) { return ((lane & 3) << 3) | (((lane >> 2) & 3) << 6) | (((lane >> 4) & 1) << 5) | (((lane >> 5) & 1) << 8); }
constexpr int v_rd_off(int d0, int ks, int half) { return d0 * 512 + ks * 4096 + half * 2048; }
template <int OFF> DI s16x4 tr_read(int vb) { s16x4 r; asm volatile("ds_read_b64_tr_b16 %0, %1 offset:%2" : "=&v"(r) : "v"(vb), "i"(OFF) : "memory"); return r; }
template <int D0> DI void pv_one(f32x16& od, int vb, bf16x8 pa0, bf16x8 pa1, bf16x8 pa2, bf16x8 pa3) {
    const s16x4 l0 = tr_read<v_rd_off(D0, 0, 0)>(vb), h0 = tr_read<v_rd_off(D0, 0, 1)>(vb), l1 = tr_read<v_rd_off(D0, 1, 0)>(vb), h1 = tr_read<v_rd_off(D0, 1, 1)>(vb);
    const s16x4 l2 = tr_read<v_rd_off(D0, 2, 0)>(vb), h2 = tr_read<v_rd_off(D0, 2, 1)>(vb), l3 = tr_read<v_rd_off(D0, 3, 0)>(vb), h3 = tr_read<v_rd_off(D0, 3, 1)>(vb);
    asm volatile("s_waitcnt lgkmcnt(0)" ::: "memory"); SBAR();
#define PK(L, H) (bf16x8){L[0], L[1], L[2], L[3], H[0], H[1], H[2], H[3]}
    od = __builtin_amdgcn_mfma_f32_32x32x16_bf16(pa0, PK(l0, h0), od, 0, 0, 0);
    od = __builtin_amdgcn_mfma_f32_32x32x16_bf16(pa1, PK(l1, h1), od, 0, 0, 0);
    od = __builtin_amdgcn_mfma_f32_32x32x16_bf16(pa2, PK(l2, h2), od, 0, 0, 0);
    od = __builtin_amdgcn_mfma_f32_32x32x16_bf16(pa3, PK(l3, h3), od, 0, 0, 0);
#undef PK
}
DI void pv_d0(f32x16* o, int vb, bf16x8 pa0, bf16x8 pa1, bf16x8 pa2, bf16x8 pa3) {
    pv_one<0>(o[0], vb, pa0, pa1, pa2, pa3); pv_one<1>(o[1], vb, pa0, pa1, pa2, pa3); pv_one<2>(o[2], vb, pa0, pa1, pa2, pa3); pv_one<3>(o[3], vb, pa0, pa1, pa2, pa3);
}
template <int DQK, bool CAUSAL>
DI void attn_unit(LAS char* lds, const bf16_t* Qb, int ldq, const bf16_t* K1, int ldk1, const bf16_t* K2, int ldk2, const bf16_t* Vb, int ldv, bf16_t* Ob, int ldo, int NT, int qtile0) {
    constexpr int KROW = DQK * 2, KT = 64 * KROW, BUF = KT + 16384, NKP = DQK / 64, ND0 = DQK / 16;
    const int tid = opaque_tid(), wid = __builtin_amdgcn_readfirstlane(tid >> 6), lane = tid & 63, r32 = lane & 31, hi = lane >> 5;
    LAS float* wsf = (LAS float*)(lds + 3 * BUF) + wid * 64; LAS float* li_l = wsf; LAS float* al_l = wsf + 32;
    const char* kp[NKP]; int kst[NKP]; const char* vp[2];
#pragma unroll
    for (int i = 0; i < NKP; ++i) { const int p = (wid * NKP + i) * 1024 + lane * 16, row = p / KROW, cbs = p % KROW, cb = cbs ^ ((row & 7) << 4);
        if (DQK == 128 || cb < 256) { kp[i] = (const char*)K1 + (size_t)row * ldk1 * 2 + cb; kst[i] = 64 * ldk1 * 2; }
        else { kp[i] = (const char*)K2 + (size_t)row * ldk2 * 2 + (cb - 256); kst[i] = 64 * ldk2 * 2; } }
#pragma unroll
    for (int i = 0; i < 2; ++i) { const int p = (wid * 2 + i) * 1024 + lane * 16, sub = p >> 9, q = (p & 511) >> 1, kk = (sub >> 2) * 8 + (q >> 5), k = (kk & ~0xC) | ((kk & 4) << 1) | ((kk & 8) >> 1), c = (sub & 3) * 32 + (q & 31);
        vp[i] = (const char*)Vb + ((size_t)k * ldv + c) * 2; }
    const int vstep = 64 * ldv * 2;
#define FA_DMA(bo) do { _Pragma("unroll") for (int _i = 0; _i < NKP; ++_i) { __builtin_amdgcn_global_load_lds((const unsigned*)kp[_i], (LAS unsigned*)(lds + (bo) + (wid * NKP + _i) * 1024), 16, 0, 0); kp[_i] += kst[_i]; } \
        _Pragma("unroll") for (int _i = 0; _i < 2; ++_i) { __builtin_amdgcn_global_load_lds((const unsigned*)vp[_i], (LAS unsigned*)(lds + (bo) + KT + (wid * 2 + _i) * 1024), 16, 0, 0); vp[_i] += vstep; } } while (0)
#define FA_SYNC() do { asm volatile("s_waitcnt vmcnt(0)" ::: "memory"); __builtin_amdgcn_s_barrier(); asm volatile("" ::: "memory"); } while (0)
    int bm1 = 0, bc = BUF, bp1 = 2 * BUF;
    FA_DMA(bm1); FA_DMA(bc);
    bf16x8 qr[ND0];
    { const bf16_t* Qw = Qb + (size_t)(wid * 32 + r32) * ldq + hi * 8;
#pragma unroll
      for (int d0 = 0; d0 < ND0; ++d0) qr[d0] = *(const bf16x8*)(Qw + d0 * 16); }
    int kb[4];
#pragma unroll
    for (int q = 0; q < 4; ++q) kb[q] = r32 * KROW + ((q * 32 + hi * 16) ^ ((r32 & 7) << 4));
    const int vb0 = (int)(uintptr_t)lds + KT + v_rd_base(lane);
    const int lim = CAUSAL ? qtile0 + (wid >> 1) : 0x7fffffff;
    float m_reg = -1e30f, l_reg = 0; f32x16 o[4];
#pragma unroll
    for (int d = 0; d < 4; ++d)
#pragma unroll
        for (int r = 0; r < 16; ++r) o[d][r] = 0.f;
    f32x16 pA0, pA1, pB0, pB1; float mnA, mnB, alA, alB; bf16x8 pa0, pa1, pa2, pa3;
#define FA_MASK(P0, P1, j) do { if (CAUSAL && (j) > lim) { _Pragma("unroll") for (int _r = 0; _r < 16; ++_r) { P0[_r] = -1e30f; P1[_r] = -1e30f; } } } while (0)
#define FA_RESC(a) do { if (__any((a) < 1.f)) { if (hi == 0) al_l[r32] = (a); asm volatile("s_waitcnt lgkmcnt(0)" ::: "memory"); \
        _Pragma("unroll") for (int _d = 0; _d < 4; ++_d) _Pragma("unroll") for (int _r = 0; _r < 16; ++_r) o[_d][_r] *= al_l[crow(_r, hi)]; } } while (0)
#define FA_ROT() do { const int _t = bm1; bm1 = bc; bc = bp1; bp1 = _t; } while (0)
    FA_SYNC();
    FA_DMA(bp1);
    qkt<DQK>(pA0, pA1, lds + bm1, kb, qr); partialSM(pA0, pA1, m_reg, mnA, alA);
    for (int j = 1; j + 1 < NT; j += 2) {
        SBAR(); qkt<DQK>(pB0, pB1, lds + bc, kb, qr);
        finishSM(pA0, pA1, alA, l_reg, pa0, pa1, pa2, pa3); SBAR();
        pv_d0(o, vb0 + bm1, pa0, pa1, pa2, pa3); FA_MASK(pB0, pB1, j); partialSM(pB0, pB1, m_reg, mnB, alB);
        FA_SYNC(); if (j + 2 < NT) FA_DMA(bm1);
        FA_RESC(alB); FA_ROT();
        SBAR(); qkt<DQK>(pA0, pA1, lds + bc, kb, qr);
        finishSM(pB0, pB1, alB, l_reg, pa0, pa1, pa2, pa3); SBAR();
        pv_d0(o, vb0 + bm1, pa0, pa1, pa2, pa3); FA_MASK(pA0, pA1, j + 1); partialSM(pA0, pA1, m_reg, mnA, alA);
        FA_SYNC(); if (j + 3 < NT) FA_DMA(bm1);
        FA_RESC(alA); FA_ROT();
    }
    SBAR(); qkt<DQK>(pB0, pB1, lds + bc, kb, qr);
    finishSM(pA0, pA1, alA, l_reg, pa0, pa1, pa2, pa3); SBAR();
    pv_d0(o, vb0 + bm1, pa0, pa1, pa2, pa3); FA_MASK(pB0, pB1, NT - 1); partialSM(pB0, pB1, m_reg, mnB, alB);
    FA_RESC(alB);
    finishSM(pB0, pB1, alB, l_reg, pa0, pa1, pa2, pa3); SBAR();
    pv_d0(o, vb0 + bc, pa0, pa1, pa2, pa3);
    if (hi == 0) li_l[r32] = l_reg; asm volatile("s_waitcnt lgkmcnt(0)" ::: "memory");
    float rli[16];
#pragma unroll
    for (int r = 0; r < 16; ++r) rli[r] = __builtin_amdgcn_rcpf(li_l[crow(r, hi)]);
    FA_SYNC();
    LAS char* Ot = lds + wid * 8704;
#pragma unroll
    for (int r = 0; r < 16; ++r)
#pragma unroll
        for (int d0 = 0; d0 < 4; ++d0) *(LAS bf16_t*)(Ot + crow(r, hi) * 272 + (d0 * 32 + r32) * 2) = (bf16_t)f2bf(o[d0][r] * rli[r]);
    asm volatile("s_waitcnt lgkmcnt(0)" ::: "memory");
#pragma unroll
    for (int i = 0; i < 8; ++i) { const int idx = i * 64 + lane, row = idx >> 4, c16 = idx & 15;
        const u32x4 v = *(LAS const u32x4*)(Ot + row * 272 + c16 * 16); *(u32x4*)(Ob + (size_t)(wid * 32 + row) * ldo + c16 * 8) = v; }
    asm volatile("s_waitcnt lgkmcnt(0)" ::: "memory"); __builtin_amdgcn_s_barrier(); asm volatile("" ::: "memory");
#undef FA_DMA
#undef FA_SYNC
#undef FA_MASK
#undef FA_RESC
#undef FA_ROT
}
DI int vcu_of(int bx, int G) { return (G % 8 == 0) ? (bx % 8) * (G / 8) + bx / 8 : bx; }
DI void mla_phase(LAS char* lds, const bf16_t* Q, const bf16_t* KN, const bf16_t* KR, const bf16_t* V, bf16_t* AO, int G, int bx) {
    const int v = vcu_of(bx, G);
    for (int p = v; p < NB * HEADS * 8; p += G) { const int bh = p >> 3, i = p & 7, b = bh / HEADS, h = bh % HEADS;
#pragma unroll 1
        for (int s = 0; s < 2; ++s) { const int qb = s ? 15 - i : i; const size_t row0 = (size_t)b * S + qb * 256, key0 = (size_t)b * S;
            attn_unit<192, true>(lds, Q + row0 * NQ + h * QKD, NQ, KN + key0 * D + h * NOPE, D, KR + key0 * ROPE, ROPE, V + key0 * D + h * VD, D, AO + row0 * D + h * VD, D, 4 * qb + 4, 4 * qb); } }
}
DI void memattn_phase(LAS char* lds, const bf16_t* MQ, const bf16_t* MK, const bf16_t* MV, bf16_t* MO, int G, int bx) {
    for (int u = bx; u < NB * MH * (S / 256); u += G) { const int qb = u % (S / 256), h = (u / (S / 256)) % MH, b = u / (S / 256 * MH); const size_t row0 = (size_t)b * S + qb * 256, key0 = (size_t)b * MEMT;
        attn_unit<128, false>(lds, MQ + row0 * MI + h * MHD, MI, MK + key0 * MI + h * MHD, MI, nullptr, 0, MV + key0 * MI + h * MHD, MI, MO + row0 * MI + h * MHD, MI, MEMT / 64, 0); }
}
}

#ifndef H16
#define H16 1
#endif
#ifndef XCONV
#define XCONV 0
#endif
#ifndef XMLA
#define XMLA 0
#endif
#ifndef XMOE
#define XMOE 0
#endif
#ifndef XROUTER
#define XROUTER 0
#endif
#ifndef XDENSE
#define XDENSE 0
#endif
#ifndef XMEMATT
#define XMEMATT 0
#endif
#ifndef XCOMB
#define XCOMB 0
#endif
#ifndef XPOOL
#define XPOOL 0
#endif
constexpr int LDS_BYTES = 147456, LDS_MISC = 131072;
#define XB_TMO      128
#define XB_XCNT(j)  (256  + 64 * (j))
#define XB_XSUB(j)  (1280 + 64 * (j))
#define XB_XGEN(j)  (2304 + 64 * (j))
#define XB_TOP      3328
#define XB_TOPGEN   3392
#define XCD_BAR_WORDS 3456
#define XB_SPIN_CAP (1u << 18)
constexpr int CW_BAR = 4096;
DI unsigned xb_ld(unsigned* p)              { return __hip_atomic_load(p, __ATOMIC_RELAXED, __HIP_MEMORY_SCOPE_AGENT); }
DI unsigned xb_add(unsigned* p, unsigned v) { return __hip_atomic_fetch_add(p, v, __ATOMIC_RELAXED, __HIP_MEMORY_SCOPE_AGENT); }
DI unsigned xb_xcc_id() { return (unsigned)__builtin_amdgcn_s_getreg((3 << 11) | 20) & 0xFu; }
#define XB_SPIN(cond, bar) do { unsigned _sp = 0; while (cond) { __builtin_amdgcn_s_sleep(1); \
    if ((++_sp & 255u) == 0u) { if (xb_ld(&(bar)[XB_TMO])) break; if (_sp > XB_SPIN_CAP) { atomicAdd(&(bar)[XB_TMO], 1u); break; } } } } while (0)
struct XcdBarrier { unsigned* bar; unsigned x; volatile LAS unsigned* st; };
DI XcdBarrier xcd_barrier_post(unsigned* bar, volatile LAS unsigned* st) {
    XcdBarrier b; b.bar = bar; b.x = xb_xcc_id(); b.st = st;
    if (threadIdx.x == 0) (void)xb_add(&bar[XB_XCNT(b.x)], 1u);
    return b;
}
DI void xcd_barrier_complete(unsigned* bar, unsigned x, unsigned& nloc, unsigned& nx) {
    const unsigned G = gridDim.x * gridDim.y * gridDim.z;
    unsigned sum, cnt, mine, sp = 0u;
    for (;;) {
        sum = 0u; cnt = 0u; mine = 0u;
#pragma unroll
        for (unsigned j = 0; j < 16; ++j) { const unsigned c = xb_ld(&bar[XB_XCNT(j)]); sum += c; cnt += (c > 0u) ? 1u : 0u; mine = (j == x) ? c : mine; }
        if (sum == G) break;
        __builtin_amdgcn_s_sleep(1);
        if ((++sp & 255u) == 0u) { if (xb_ld(&bar[XB_TMO])) break; if (sp > XB_SPIN_CAP) { atomicAdd(&bar[XB_TMO], 1u); break; } }
    }
    nloc = mine > 0u ? mine : 1u; nx = cnt > 0u ? cnt : 1u;
}
DI void xcd_barrier(const XcdBarrier& b) {
    asm volatile("s_waitcnt vmcnt(0)" ::: "memory");
    __syncthreads();
    if (threadIdx.x == 0) {
        unsigned* bar = b.bar;
        __builtin_amdgcn_s_waitcnt(0);
        unsigned nloc = b.st[0], nx = b.st[1];
        if (nloc == 0u) { xcd_barrier_complete(bar, b.x, nloc, nx); b.st[0] = nloc; b.st[1] = nx; }
        const unsigned old = xb_add(&bar[XB_XSUB(b.x)], 1u);
        const unsigned gen = old / nloc;
        if (old + 1u == (gen + 1u) * nloc) {
            __builtin_amdgcn_fence(__ATOMIC_RELEASE, "agent");
            asm volatile("s_waitcnt vmcnt(0)" ::: "memory");
            const unsigned og = xb_add(&bar[XB_TOP], 1u);
            const unsigned tg = og / nx;
            if (og + 1u == (tg + 1u) * nx) xb_add(&bar[XB_TOPGEN], 1u);
            else XB_SPIN(xb_ld(&bar[XB_TOPGEN]) == tg, bar);
            __builtin_amdgcn_fence(__ATOMIC_ACQUIRE, "agent");
            xb_add(&bar[XB_XGEN(b.x)], 1u);
            asm volatile("s_waitcnt vmcnt(0)" ::: "memory");
        } else {
            XB_SPIN(xb_ld(&bar[XB_XGEN(b.x)]) == gen, bar);
            __builtin_amdgcn_fence(__ATOMIC_ACQUIRE, "agent");
            asm volatile("s_waitcnt vmcnt(0)" ::: "memory");
        }
    }
    __syncthreads();
}

#define LDS_WAIT() asm volatile("s_waitcnt lgkmcnt(0)" ::: "memory")
DI void wt_item(const float* W, int K, int N, bf16_t* WT, const float* kgain, const float* ngain, float scale, int perm, int row_off, LAS float* scr, int item, int lane) {
    const int nblk = N >> 5, kb = item / nblk, nb = item - kb * nblk, k0 = kb * 64, n0 = nb * 32, kr = lane >> 3, n4 = (lane & 7) * 4;
    f32x4 ng = {scale, scale, scale, scale}; if (ngain) ng = *(const f32x4*)(ngain + n0 + n4) * scale;
    f32x4 v[8];
#pragma unroll
    for (int i = 0; i < 8; ++i) v[i] = *(const f32x4*)(W + (size_t)(k0 + 8 * i + kr) * N + n0 + n4);
#pragma unroll
    for (int i = 0; i < 8; ++i) { const int k = 8 * i + kr; f32x4 x = v[i] * ng; if (kgain) x = x * kgain[k0 + k];
        scr[(n4 + 0) * 65 + k] = x.x; scr[(n4 + 1) * 65 + k] = x.y; scr[(n4 + 2) * 65 + k] = x.z; scr[(n4 + 3) * 65 + k] = x.w; }
    LDS_WAIT();
    const int kc = lane & 7;
#pragma unroll
    for (int q = 0; q < 4; ++q) { const int n = (lane >> 3) + 8 * q; const LAS float* sp = scr + n * 65 + 8 * kc;
        u32x4 o; o.x = pk2(sp[0], sp[1]); o.y = pk2(sp[2], sp[3]); o.z = pk2(sp[4], sp[5]); o.w = pk2(sp[6], sp[7]);
        *(u32x4*)(WT + (size_t)(row_off + permrow(perm, n0 + n)) * K + k0 + 8 * kc) = o; }
    LDS_WAIT();
}
struct MArgs { const void* in[32]; float* out; unsigned char* ws; int ph_lo, ph_hi, bar_region, pad; };
#define INF(i) ((const float*)P.in[i])
#define WSB(off) ((bf16_t*)(P.ws + (off)))
#define WSF(off) ((float*)(P.ws + (off)))
constexpr float SC_MEM = 0.08838834764831845f  , SC_MLA = 0.07216878364870323f  ;
DI void conv_phase(const MArgs& P, LAS unsigned char* lds, int gw, int NGW, int wave, int lane) {
    LAS float* scr = (LAS float*)(lds + wave * 16384);
    constexpr int I_POOL = 8 * 128, I_MQ = 4 * 512, I_MO = 4 * 512, I_E = 128 * 512, I_DQ = 512, I_KR = 64, I_UQ = 2 * 512, I_QR = 2 * 256, I_O = 2 * 2048, I_UK = 512;
    constexpr int NITEMS = I_POOL + 3 * I_MQ + I_MO + 3 * I_E + 3 * I_DQ + I_KR + I_UQ + I_QR + I_O + 2 * I_UK;
    for (int it = gw; it < NITEMS; it += NGW) {
        int r = it;
        if (r < I_E) { const int m = r >> 9; wt_item(INF(28) + (size_t)m * D * EFF, D, EFF, WSB(WS_WGU) + (size_t)m * 1024 * D, INF(6) + (m >> 5) * D, nullptr, 1.f, 3, 0, scr, r & 511, lane); continue; } r -= I_E;
        if (r < I_E) { const int m = r >> 9; wt_item(INF(29) + (size_t)m * D * EFF, D, EFF, WSB(WS_WGU) + (size_t)m * 1024 * D, INF(6) + (m >> 5) * D, nullptr, 1.f, 4, 0, scr, r & 511, lane); continue; } r -= I_E;
        if (r < I_E) { const int m = r >> 9; wt_item(INF(30) + (size_t)m * EFF * D, EFF, D, WSB(WS_WD) + (size_t)m * D * EFF, nullptr, nullptr, 1.f, 0, 0, scr, r & 511, lane); continue; } r -= I_E;
        if (r < I_POOL) { const int m = r >> 7; wt_item(INF(7) + (size_t)m * PG * PG, PG, PG, WSB(WS_WPOOL) + (size_t)(m >> 2) * D * PG, nullptr, INF(8) + (m >> 2) * D + (m & 3) * PG, 1.f, 0, (m & 3) * PG, scr, r & 127, lane); continue; } r -= I_POOL;
        if (r < I_MQ) { const int m = r >> 9; wt_item(INF(20) + (size_t)m * D * MI, D, MI, WSB(WS_WMQ) + (size_t)m * MI * D, INF(4) + m * D, nullptr, SC_MEM, 0, 0, scr, r & 511, lane); continue; } r -= I_MQ;
        if (r < I_MQ) { const int m = r >> 9; wt_item(INF(21) + (size_t)m * D * MI, D, MI, WSB(WS_WMK) + (size_t)m * MI * D, INF(5) + m * D, nullptr, 1.f, 0, 0, scr, r & 511, lane); continue; } r -= I_MQ;
        if (r < I_MQ) { const int m = r >> 9; wt_item(INF(22) + (size_t)m * D * MI, D, MI, WSB(WS_WMV) + (size_t)m * MI * D, INF(5) + m * D, nullptr, 1.f, 0, 0, scr, r & 511, lane); continue; } r -= I_MQ;
        if (r < I_MO) { const int m = r >> 9; wt_item(INF(23) + (size_t)m * MI * D, MI, D, WSB(WS_WMO) + (size_t)m * D * MI, nullptr, nullptr, 1.f, 0, 0, scr, r & 511, lane); continue; } r -= I_MO;
        if (r < I_DQ) { wt_item(INF(15), D, QR, WSB(WS_WDQ0), INF(3) + 2 * D, nullptr, 1.f, 0, 0, scr, r, lane); continue; } r -= I_DQ;
        if (r < I_DQ) { wt_item(INF(10), D, KVR, WSB(WS_WDQ0), INF(9), nullptr, 1.f, 0, 512, scr, r, lane); continue; } r -= I_DQ;
        if (r < I_KR) { wt_item(INF(12), D, ROPE, WSB(WS_WDQ0), INF(9), nullptr, 1.f, 5, 1024, scr, r, lane); continue; } r -= I_KR;
        if (r < I_DQ) { wt_item(INF(15) + (size_t)D * QR, D, QR, WSB(WS_WDQ1), INF(3) + 3 * D, nullptr, 1.f, 0, 0, scr, r, lane); continue; } r -= I_DQ;
        if (r < I_UQ) { const int m = r >> 9; wt_item(INF(17) + (size_t)m * QR * D, QR, HEADS * NOPE, WSB(WS_WUQ) + (size_t)m * NQ * QR, INF(16) + m * QR, nullptr, SC_MLA, 1, 0, scr, r & 511, lane); continue; } r -= I_UQ;
        if (r < I_QR) { const int m = r >> 8; wt_item(INF(18) + (size_t)m * QR * HEADS * ROPE, QR, HEADS * ROPE, WSB(WS_WUQ) + (size_t)m * NQ * QR, INF(16) + m * QR, nullptr, SC_MLA, 2, 0, scr, r & 255, lane); continue; } r -= I_QR;
        if (r < I_O) { const int m = r >> 11; wt_item(INF(19) + (size_t)m * D * D, D, D, WSB(WS_WO) + (size_t)m * D * D, nullptr, nullptr, 1.f, 0, 0, scr, r & 2047, lane); continue; } r -= I_O;
        if (r < I_UK) { wt_item(INF(13), KVR, D, WSB(WS_WUKV), INF(11), nullptr, 1.f, 0, 0, scr, r, lane); continue; } r -= I_UK;
        wt_item(INF(14), KVR, D, WSB(WS_WUKV), INF(11), nullptr, 1.f, 0, 2048, scr, r, lane);
    }
}
DI void tables_phase(const MArgs& P, int gtid, int NT_) {
    for (int idx = gtid; idx < T * 32; idx += NT_) { const int t = idx >> 5, i = idx & 31;
        const float inv = (float)(1.0 / pow(10000.0, (double)i / 32.0)); const float ang = (float)((const int*)P.in[2])[t] * inv;
        const double rev = (double)ang * 0.15915494309189533577; const float fr = (float)(rev - rint(rev));
        WSF(WS_COS)[idx] = __builtin_amdgcn_cosf(fr); WSF(WS_SIN)[idx] = __builtin_amdgcn_sinf(fr); }
    for (int idx = gtid; idx < DEPTH * 48 * D; idx += NT_) { const int l = idx / (48 * D), n = (idx / D) % 48, k = idx % D;
        float w = 0.f; if (n < 36) w = (n < 4 ? INF(24)[((size_t)l * D + k) * 4 + n] : INF(26)[((size_t)l * D + k) * 32 + (n - 4)]) * INF(6)[l * D + k];
        const unsigned hi = f2bf(w), lo = f2bf(w - __uint_as_float(hi << 16));
        WSB(WS_RWH)[((size_t)(l * 2 + 0) * 48 + n) * D + k] = (bf16_t)hi; WSB(WS_RWH)[((size_t)(l * 2 + 1) * 48 + n) * D + k] = (bf16_t)lo; }
    unsigned* z = (unsigned*)(WSB(WS_WDQ0) + (size_t)1088 * D);
    for (int idx = gtid; idx < (NDQ0 - 1088) * D / 2; idx += NT_) z[idx] = 0u;
}
DI void memprep_phase(const MArgs& P, int gw, int NGW, int lane) {
    for (int r = gw; r < NB * MEMT; r += NGW) { const f32x4* x = (const f32x4*)(INF(1) + (size_t)r * D) + lane; float ss = 0.f;
#pragma unroll
        for (int j = 0; j < 8; ++j) { const f32x4 v = x[64 * j]; ss += (v.x * v.x + v.y * v.y) + (v.z * v.z + v.w * v.w);
            u32x2 o; o.x = pk2(v.x, v.y); o.y = pk2(v.z, v.w); *((u32x2*)(WSB(WS_MEMB) + (size_t)r * D) + lane + 64 * j) = o; }
        ss = wave_sum(ss); if (lane == 0) WSF(WS_MEMRS)[r] = rsqrtf(ss * (1.0f / D) + EPS); }
}
DI void combine_phase(const float* src, const bf16_t* src16, const bf16_t* Y, float* H, bf16_t* HB, float* RS0, const float* gain, bf16_t* HN, float* out, int gw, int NGW, int lane) {
    for (int t = gw; t < T; t += NGW) {
        const f32x4* x = (const f32x4*)(src + (size_t)t * D) + lane; f32x4 v[8]; float ss = 0.f;
#pragma unroll
        for (int j = 0; j < 8; ++j) {
            if (src16) { const u32x2 h = *((const u32x2*)(src16 + (size_t)t * D) + lane + 64 * j); v[j] = (f32x4){__uint_as_float(h.x << 16), __uint_as_float(h.x & 0xffff0000u), __uint_as_float(h.y << 16), __uint_as_float(h.y & 0xffff0000u)}; }
            else v[j] = x[64 * j];
            if (Y) { const u32x2 a = *((const u32x2*)(Y + (size_t)(2 * t) * D) + lane + 64 * j), b = *((const u32x2*)(Y + (size_t)(2 * t + 1) * D) + lane + 64 * j);
                v[j].x = (v[j].x + __uint_as_float(a.x << 16)) + __uint_as_float(b.x << 16); v[j].y = (v[j].y + __uint_as_float(a.x & 0xffff0000u)) + __uint_as_float(b.x & 0xffff0000u);
                v[j].z = (v[j].z + __uint_as_float(a.y << 16)) + __uint_as_float(b.y << 16); v[j].w = (v[j].w + __uint_as_float(a.y & 0xffff0000u)) + __uint_as_float(b.y & 0xffff0000u); }
            ss += (v[j].x * v[j].x + v[j].y * v[j].y) + (v[j].z * v[j].z + v[j].w * v[j].w); }
        ss = wave_sum(ss); const float rs = rsqrtf(ss * (1.0f / D) + EPS);
        if (lane == 0 && RS0) RS0[t] = rs;
#pragma unroll
        for (int j = 0; j < 8; ++j) {
            if (H) *((f32x4*)(H + (size_t)t * D) + lane + 64 * j) = v[j];
            if (HB) { u32x2 o; o.x = pk2(v[j].x, v[j].y); o.y = pk2(v[j].z, v[j].w); *((u32x2*)(HB + (size_t)t * D) + lane + 64 * j) = o; }
            if (gain) { const f32x4 g = *((const f32x4*)gain + lane + 64 * j); const f32x4 n = v[j] * g * rs;
                if (HN) { u32x2 o; o.x = pk2(n.x, n.y); o.y = pk2(n.z, n.w); *((u32x2*)(HN + (size_t)t * D) + lane + 64 * j) = o; }
                if (out) *((f32x4*)(out + (size_t)t * D) + lane + 64 * j) = n; } }
    }
}
DI void pool_phase(const bf16_t* HN, bf16_t* U, int vcu, int G, int tid) {
    for (int t = vcu * 2 + (tid >> 8); t < T; t += 2 * G) { const int c = (tid & 255) * 8, s = t & (S - 1), w = 2 << (c >> 9), n = (s + 1 < w) ? s + 1 : w;
        float acc[8] = {0.f, 0.f, 0.f, 0.f, 0.f, 0.f, 0.f, 0.f}, self[8] = {0.f, 0.f, 0.f, 0.f, 0.f, 0.f, 0.f, 0.f};
        for (int i = 0; i < n; ++i) { const u32x4 v = *(const u32x4*)(HN + (size_t)(t - i) * D + c);
            const float f[8] = {__uint_as_float(v.x << 16), __uint_as_float(v.x & 0xffff0000u), __uint_as_float(v.y << 16), __uint_as_float(v.y & 0xffff0000u),
                                __uint_as_float(v.z << 16), __uint_as_float(v.z & 0xffff0000u), __uint_as_float(v.w << 16), __uint_as_float(v.w & 0xffff0000u)};
#pragma unroll
            for (int q = 0; q < 8; ++q) { acc[q] += f[q]; if (i == 0) self[q] = f[q]; } }
        const float inv = 1.0f / (float)n; u32x4 o;
        o.x = pk2(acc[0] * inv - self[0], acc[1] * inv - self[1]); o.y = pk2(acc[2] * inv - self[2], acc[3] * inv - self[3]);
        o.z = pk2(acc[4] * inv - self[4], acc[5] * inv - self[5]); o.w = pk2(acc[6] * inv - self[6], acc[7] * inv - self[7]);
        *(u32x4*)(U + (size_t)t * D + c) = o; }
}
typedef float f32x4r __attribute__((ext_vector_type(4)));
DI void router_phase(const float* H, const bf16_t* HBs, const bf16_t* RWH, const float* rg_b, const float* re_b, float* RS2, int* cnt, int* list, float* gwt, LAS unsigned char* lds, int vcu, int G, int wave, int lane, bool commit = true) {
    LAS float* tile = (LAS float*)(lds + wave * 4096);
    const bf16_t* RWL = RWH + (size_t)48 * D;
    for (int t16 = wave * G + vcu; t16 < T / 16; t16 += 8 * G) {
        const int r16 = lane & 15, kq = lane >> 4;
        const float* hp = H + (size_t)(t16 * 16 + r16) * D + kq * 8; const bf16_t* hb = HBs + (size_t)(t16 * 16 + r16) * D + kq * 8;
        const bf16_t* wh = RWH + (size_t)r16 * D + kq * 8; const bf16_t* wl = RWL + (size_t)r16 * D + kq * 8;
        f32x4 acc[3]; float ss = 0.f;
#pragma unroll
        for (int q = 0; q < 3; ++q) acc[q] = (f32x4){0.f, 0.f, 0.f, 0.f};
        for (int k0 = 0; k0 < D; k0 += 128) {
            f32x4 xa[4], xb[4];
#pragma unroll
            for (int u = 0; u < 4; ++u) {
                if (H16) { const u32x4 w = *(const u32x4*)(hb + k0 + u * 32);
                    xa[u] = (f32x4){__uint_as_float(w.x << 16), __uint_as_float(w.x & 0xffff0000u), __uint_as_float(w.y << 16), __uint_as_float(w.y & 0xffff0000u)};
                    xb[u] = (f32x4){__uint_as_float(w.z << 16), __uint_as_float(w.z & 0xffff0000u), __uint_as_float(w.w << 16), __uint_as_float(w.w & 0xffff0000u)}; }
                else { xa[u] = *(const f32x4*)(hp + k0 + u * 32); xb[u] = *(const f32x4*)(hp + k0 + u * 32 + 4); } }
#pragma unroll
            for (int u = 0; u < 4; ++u) {
                const f32x4 a = xa[u], b = xb[u];
                ss += ((a.x * a.x + a.y * a.y) + (a.z * a.z + a.w * a.w)) + ((b.x * b.x + b.y * b.y) + (b.z * b.z + b.w * b.w));
                u32x4 h; h.x = fg::cvt_pk_bf16(a.x, a.y); h.y = fg::cvt_pk_bf16(a.z, a.w); h.z = fg::cvt_pk_bf16(b.x, b.y); h.w = fg::cvt_pk_bf16(b.z, b.w);
                u32x4 lo; lo.x = fg::cvt_pk_bf16(a.x - __uint_as_float(h.x << 16), a.y - __uint_as_float(h.x & 0xffff0000u)); lo.y = fg::cvt_pk_bf16(a.z - __uint_as_float(h.y << 16), a.w - __uint_as_float(h.y & 0xffff0000u));
                lo.z = fg::cvt_pk_bf16(b.x - __uint_as_float(h.z << 16), b.y - __uint_as_float(h.z & 0xffff0000u)); lo.w = fg::cvt_pk_bf16(b.z - __uint_as_float(h.w << 16), b.w - __uint_as_float(h.w & 0xffff0000u));
                const bf16x8 ah = *reinterpret_cast<const bf16x8*>(&h), al_ = *reinterpret_cast<const bf16x8*>(&lo);
#pragma unroll
                for (int q = 0; q < 3; ++q) { const bf16x8 bh = *(const bf16x8*)(wh + (size_t)q * 16 * D + k0 + u * 32), bl = *(const bf16x8*)(wl + (size_t)q * 16 * D + k0 + u * 32);
                    acc[q] = __builtin_amdgcn_mfma_f32_16x16x32_bf16(ah, bh, acc[q], 0, 0, 0);
                    if (!H16) acc[q] = __builtin_amdgcn_mfma_f32_16x16x32_bf16(al_, bh, acc[q], 0, 0, 0);
                    acc[q] = __builtin_amdgcn_mfma_f32_16x16x32_bf16(ah, bl, acc[q], 0, 0, 0); }
            }
        }
        ss += __shfl_xor(ss, 16); ss += __shfl_xor(ss, 32);
        const float rs = rsqrtf(ss * (1.0f / D) + EPS);
#pragma unroll
        for (int q = 0; q < 3; ++q)
#pragma unroll
            for (int i = 0; i < 4; ++i) tile[(kq * 4 + i) * 49 + q * 16 + r16] = acc[q][i];
        LDS_WAIT();
        if (lane < 16) {
            const LAS float* tr = tile + lane * 49; const int t = t16 * 16 + lane;
            const float g0 = tr[0] * rs + rg_b[0], g1 = tr[1] * rs + rg_b[1], g2 = tr[2] * rs + rg_b[2], g3 = tr[3] * rs + rg_b[3];
            int gs = 0; float gm = g0; if (g1 > gm) { gm = g1; gs = 1; } if (g2 > gm) { gm = g2; gs = 2; } if (g3 > gm) { gm = g3; gs = 3; }
            const float gp = 1.0f / (__expf(g0 - gm) + __expf(g1 - gm) + __expf(g2 - gm) + __expf(g3 - gm));
            float ev[8];
#pragma unroll
            for (int i = 0; i < 8; ++i) ev[i] = tr[4 + gs * 8 + i] * rs + re_b[gs * 8 + i];
            int i0 = 0; float m0 = ev[0];
#pragma unroll
            for (int i = 1; i < 8; ++i) if (ev[i] > m0) { m0 = ev[i]; i0 = i; }
            int i1 = -1; float m1 = -3.0e38f;
#pragma unroll
            for (int i = 0; i < 8; ++i) if (i != i0 && ev[i] > m1) { m1 = ev[i]; i1 = i; }
            const float e1 = __expf(m1 - m0), w0 = gp / (1.0f + e1), w1 = gp * e1 / (1.0f + e1);
            if (commit || w0 < -1.f) { RS2[t] = rs; const int ea = gs * 8 + i0, eb = gs * 8 + i1;
                const int pa = atomicAdd(&cnt[ea], 1); list[(size_t)ea * CAP + pa] = 2 * t; gwt[2 * t] = w0;
                const int pb = atomicAdd(&cnt[eb], 1); list[(size_t)eb * CAP + pb] = 2 * t + 1; gwt[2 * t + 1] = w1; }
        }
        LDS_WAIT();
    }
}
namespace fg {
struct EpiMemKV {
    bf16_t* O; const float* rs;
    DI void operator()(const Acc& acc, const Unit& u, int wr, int wc, int fr, int fq) const {
#pragma unroll
        for (int ai = 0; ai < 2; ++ai)
#pragma unroll
            for (int m = 0; m < 4; ++m) { const int r = u.pm * BM + ai * HALF + wr * 64 + m * 16 + fr; const float sc = rs[r];
#pragma unroll
                for (int bj = 0; bj < 2; ++bj) { const int c0 = (u.pn & 1) * BM + bj * HALF + wc * 32 + 8 * fq;
                    *(u32x4*)(O + (size_t)(u.pn >> 1) * (NB * MEMT * MI) + (size_t)r * MI + c0) = pack8(acc[ai][bj][m][0] * sc, acc[ai][bj][m][1] * sc); } }
    }
};
}
DI void moe_prefix(LAS unsigned char* lds, const int* cnt) {
    LAS int* pref = (LAS int*)(lds + LDS_MISC + 1024); const int tid = opaque_tid();
    if (tid < 32) pref[64 + tid] = cnt[tid];
    __syncthreads();
    if (tid == 0) { int s = 0; for (int e = 0; e < NE; ++e) { pref[e] = s; s += (pref[64 + e] + 255) >> 8; } pref[32] = s; }
    __syncthreads();
}

__global__ void __launch_bounds__(512, 2) mk_fwd(MArgs a) {
    extern __shared__ __attribute__((aligned(16))) unsigned char lds_raw[];
    LAS unsigned char* lds = (LAS unsigned char*)lds_raw;
    const int G = gridDim.x, bx = blockIdx.x, vcu = fa::vcu_of(bx, G), NGW = G * 8;
    volatile LAS unsigned* MISC = (volatile LAS unsigned*)(lds + LDS_MISC);
    if (threadIdx.x < 64) MISC[threadIdx.x] = 0u;
    __syncthreads();
    unsigned char* ws = a.ws;
    XcdBarrier bar = xcd_barrier_post((unsigned*)(ws + WS_CTL) + CW_BAR + a.bar_region * XCD_BAR_WORDS, MISC + 8);
    const MArgs& P = a;
    int pid = 0; const int lo = a.ph_lo, hi = a.ph_hi;
#define PH_IF if (pid >= lo && pid < hi)
#define TL const int tid = opaque_tid(), lane = tid & 63, wave = __builtin_amdgcn_readfirstlane(tid >> 6), gw = vcu * 8 + wave; (void)lane; (void)gw
#define PH_END do { if (pid >= lo && pid + 1 < hi) xcd_barrier(bar); ++pid; } while (0)
    PH_IF { TL; conv_phase(P, lds, gw, NGW, wave, lane); if (XCONV) conv_phase(P, lds, gw, NGW, wave, lane); tables_phase(P, vcu * 512 + tid, G * 512); memprep_phase(P, gw, NGW, lane);
            combine_phase(INF(0), nullptr, nullptr, H16 ? nullptr : WSF(WS_H), WSB(WS_HB), WSF(WS_RS0), INF(3), WSB(WS_HN), nullptr, gw, NGW, lane); }
    PH_END;
    for (int l = 0; l < DEPTH; ++l) {
        const bool isA = l < NA; const int j = l - NA;
        if (l > 0) { PH_IF { TL; if (XCOMB) combine_phase(WSF(WS_H), H16 ? WSB(WS_HB) : nullptr, WSB(WS_Y), WSF(WS_Q), nullptr, nullptr, nullptr, nullptr, nullptr, gw, NGW, lane);
            combine_phase(WSF(WS_H), H16 ? WSB(WS_HB) : nullptr, WSB(WS_Y), H16 ? nullptr : WSF(WS_H), WSB(WS_HB), WSF(WS_RS0), isA ? INF(3) + l * D : nullptr, isA ? WSB(WS_HN) : nullptr, nullptr, gw, NGW, lane); } PH_END; }
        if (isA) {
            PH_IF { if (l == 0) { fg::ProbDense pr{(const char*)WSB(WS_MEMB), (const char*)WSB(WS_WMK), (const char*)WSB(WS_MEMB), (const char*)WSB(WS_WMK), NB * MEMT / 256, 16, 16, D, D, 0, G, bx}; fg::EpiMemKV E{WSB(WS_MK), WSF(WS_MEMRS)}; fg::gemm_phase(lds, pr, E); }
                    { TL; pool_phase(WSB(WS_HN), WSB(WS_U), vcu, G, tid); if (XPOOL) pool_phase(WSB(WS_HN), WSB(WS_U), vcu, G, tid); } }
            PH_END;
        } else {
            PH_IF { const int n = j == 0 ? NDQ0 : QR; const char* B = (const char*)(j == 0 ? WSB(WS_WDQ0) : WSB(WS_WDQ1));
                    fg::ProbDense pr{(const char*)WSB(WS_HB), B, (const char*)WSB(WS_HB), B, T / 256, n / 256, n / 256, D, D, 0, G, bx};
                    fg::EpiDQ E{WSB(WS_CQ), WSB(WS_CKV), WSB(WS_KR), WSF(WS_RS0), WSF(WS_LSQ), WSF(WS_LSKV), WSF(WS_COS), WSF(WS_SIN)}; fg::gemm_phase(lds, pr, E); if (XDENSE) fg::gemm_phase(lds, pr, E); }
            PH_END;
            PH_IF { fg::ProbDense pr{(const char*)WSB(WS_CQ), (const char*)(WSB(WS_WUQ) + (size_t)j * NQ * QR), (const char*)WSB(WS_CKV), (const char*)WSB(WS_WUKV), T / 256, (j == 0 ? NQ + 4096 : NQ) / 256, NQ / 256, QR, QR, 0, G, bx};
                    fg::EpiUQ E{WSB(WS_Q), WSB(WS_KN), WSB(WS_V), WSF(WS_LSQ), WSF(WS_LSKV), WSF(WS_COS), WSF(WS_SIN)}; fg::gemm_phase(lds, pr, E); }
            PH_END;
            PH_IF { fa::mla_phase((LAS char*)lds, WSB(WS_Q), WSB(WS_KN), WSB(WS_KR), WSB(WS_V), WSB(WS_AO), G, bx); if (XMLA) fa::mla_phase((LAS char*)lds, WSB(WS_Q), WSB(WS_KN), WSB(WS_KR), WSB(WS_V), WSB(WS_AO), G, bx); }
            PH_END;
        }
        PH_IF { const char* A = (const char*)(isA ? WSB(WS_U) : WSB(WS_AO)); const char* B = (const char*)(isA ? WSB(WS_WPOOL) + (size_t)l * D * PG : WSB(WS_WO) + (size_t)j * D * D);
                fg::ProbDense pr{A, B, A, B, T / 256, D / 256, D / 256, isA ? PG : D, D, isA ? 1 : 0, G, bx}; fg::EpiRes<true> E{H16 ? nullptr : WSF(WS_H), WSB(WS_HB), WSF(WS_SSP)}; fg::gemm_phase(lds, pr, E); }
        PH_END;
        PH_IF { const char* B = (const char*)(WSB(WS_WMQ) + (size_t)l * MI * D); fg::ProbDense pr{(const char*)WSB(WS_HB), B, (const char*)WSB(WS_HB), B, T / 256, MI / 256, MI / 256, D, D, 0, G, bx};
                fg::EpiBf16RS<2> E{WSB(WS_MQ), MI, WSF(WS_SSP)}; fg::gemm_phase(lds, pr, E); if (XDENSE) fg::gemm_phase(lds, pr, E); }
        PH_END;
        PH_IF { fa::memattn_phase((LAS char*)lds, WSB(WS_MQ), WSB(WS_MK) + (size_t)l * NB * MEMT * MI, WSB(WS_MV) + (size_t)l * NB * MEMT * MI, WSB(WS_MO), G, bx); if (XMEMATT) fa::memattn_phase((LAS char*)lds, WSB(WS_MQ), WSB(WS_MK) + (size_t)l * NB * MEMT * MI, WSB(WS_MV) + (size_t)l * NB * MEMT * MI, WSB(WS_MO), G, bx); }
        PH_END;
        PH_IF { const char* B = (const char*)(WSB(WS_WMO) + (size_t)l * D * MI); fg::ProbDense pr{(const char*)WSB(WS_MO), B, (const char*)WSB(WS_MO), B, T / 256, D / 256, D / 256, MI, MI, 0, G, bx};
                fg::EpiRes<false> E{H16 ? nullptr : WSF(WS_H), WSB(WS_HB), nullptr}; fg::gemm_phase(lds, pr, E); }
        PH_END;
        PH_IF { TL; if (XROUTER) router_phase(WSF(WS_H), WSB(WS_HB), WSB(WS_RWH) + (size_t)l * 2 * 48 * D, INF(25) + l * NG, INF(27) + l * NE, WSF(WS_RS2), ((int*)(P.ws + WS_CTL + OFF_CNT)) + l * NE, ((int*)(P.ws + WS_LIST)), WSF(WS_GW), lds, vcu, G, wave, lane, false);
                router_phase(WSF(WS_H), WSB(WS_HB), WSB(WS_RWH) + (size_t)l * 2 * 48 * D, INF(25) + l * NG, INF(27) + l * NE, WSF(WS_RS2), ((int*)(P.ws + WS_CTL + OFF_CNT)) + l * NE, ((int*)(P.ws + WS_LIST)), WSF(WS_GW), lds, vcu, G, wave, lane); }
        PH_END;
        PH_IF { moe_prefix(lds, ((int*)(P.ws + WS_CTL + OFF_CNT)) + l * NE);
                fg::ProbMoe pr{(const char*)WSB(WS_HB), (const char*)(WSB(WS_WGU) + (size_t)l * NE * 1024 * D), ((int*)(P.ws + WS_LIST)), (const LAS int*)(lds + LDS_MISC + 1024), 4, D, D, 1, G, bx, (long)1024 * D * 2};
                fg::EpiMoe1 E{WSB(WS_HH), WSF(WS_RS2), ((int*)(P.ws + WS_LIST))}; fg::gemm_phase(lds, pr, E); if (XMOE) fg::gemm_phase(lds, pr, E); }
        PH_END;
        PH_IF { moe_prefix(lds, ((int*)(P.ws + WS_CTL + OFF_CNT)) + l * NE);
                fg::ProbMoe pr{(const char*)WSB(WS_HH), (const char*)(WSB(WS_WD) + (size_t)l * NE * D * EFF), ((int*)(P.ws + WS_LIST)), (const LAS int*)(lds + LDS_MISC + 1024), 8, EFF, EFF, 0, G, bx, (long)D * EFF * 2};
                fg::EpiMoe2 E{WSB(WS_Y), WSF(WS_GW), ((int*)(P.ws + WS_LIST))}; fg::gemm_phase(lds, pr, E); if (XMOE) fg::gemm_phase(lds, pr, E); }
        PH_END;
    }
    PH_IF { TL; combine_phase(WSF(WS_H), H16 ? WSB(WS_HB) : nullptr, WSB(WS_Y), nullptr, nullptr, nullptr, INF(31), nullptr, P.out, gw, NGW, lane); }
#undef PH_IF
#undef PH_END
}
constexpr int NPHASES = 1 + 8 + 9 + 11 + 11 + 1;

#ifndef MK_SPLIT
#define MK_SPLIT 0
#endif
extern "C" void kernel_launch(void* const* d_in, const int* in_sizes, int n_in, void* d_out, int out_size, void* d_ws, size_t ws_size, hipStream_t stream) {
    static int grid = 0;
    if (grid == 0) {
        if (n_in != 32 || in_sizes[0] != T * D || out_size != T * D || ws_size < WS_END) { fprintf(stderr, "kernel_launch: shape/ws mismatch (ws %zu need %zu)\n", ws_size, (size_t)WS_END); grid = -1; return; }
        int dev = 0, cus = 0;
        if (hipGetDevice(&dev) != hipSuccess || hipDeviceGetAttribute(&cus, hipDeviceAttributeMultiprocessorCount, dev) != hipSuccess || cus <= 0) { fprintf(stderr, "kernel_launch: device query failed\n"); grid = -1; return; }
        if (hipFuncSetAttribute((const void*)mk_fwd, hipFuncAttributeMaxDynamicSharedMemorySize, LDS_BYTES) != hipSuccess) { fprintf(stderr, "kernel_launch: hipFuncSetAttribute failed\n"); grid = -1; return; }
        int per_cu = 0;
        if (hipOccupancyMaxActiveBlocksPerMultiprocessor(&per_cu, (const void*)mk_fwd, 512, LDS_BYTES) != hipSuccess || per_cu < 1) fprintf(stderr, "kernel_launch: occupancy query says %d\n", per_cu);
        (void)hipGetLastError();
        grid = cus;
    }
    if (grid < 0) return;
    if (hipMemsetAsync((char*)d_ws + WS_CTL, 0, CTL_BYTES, stream) != hipSuccess) { fprintf(stderr, "kernel_launch: memset failed\n"); return; }
    MArgs a; memset(&a, 0, sizeof(a));
    for (int i = 0; i < 32; ++i) a.in[i] = d_in[i];
    a.out = (float*)d_out; a.ws = (unsigned char*)d_ws;
#if MK_SPLIT
    for (int p = 0; p < NPHASES; ++p) { a.ph_lo = p; a.ph_hi = p + 1; a.bar_region = 0; hipLaunchKernelGGL(mk_fwd, dim3(grid), dim3(512), LDS_BYTES, stream, a); }
#else
    a.ph_lo = 0; a.ph_hi = NPHASES; a.bar_region = 0; hipLaunchKernelGGL(mk_fwd, dim3(grid), dim3(512), LDS_BYTES, stream, a);
#endif
    const hipError_t le = hipPeekAtLastError();
    if (le != hipSuccess) fprintf(stderr, "kernel_launch: launch failed: %s\n", hipGetErrorName(le));
}
```

```cpp
#include <hip/hip_runtime.h>
#include <cstdio>
#include <cstdint>
#include <cstring>

typedef unsigned short bf16_t;
typedef float f32x4 __attribute__((ext_vector_type(4)));
typedef unsigned u32x4 __attribute__((ext_vector_type(4)));
typedef unsigned u32x2 __attribute__((ext_vector_type(2)));
#define DI __device__ __forceinline__

constexpr int D = 2048, NB = 4, S = 4096, T = NB * S, DEPTH = 4, NA = 2;
constexpr int CHUNK = 64;
constexpr int PG = 512;
constexpr int HEADS = 16, QR = 512, KVR = 512, NOPE = 128, ROPE = 64, VD = 128, QKD = NOPE + ROPE;
constexpr int MEMT = 256, MH = 4, MHD = 128, MI = 512;
constexpr int NG = 4, EPG = 8, NE = 32, EFF = 512;
constexpr float EPS = 1e-6f;
constexpr int CAP = T;
constexpr int MAXROWS = 2 * T + NE * 256;
constexpr int NQ = HEADS * QKD;
constexpr int NDQ0 = 1280;

constexpr size_t al(size_t x) { return (x + 255) & ~(size_t)255; }
constexpr size_t WS_CTL = 0, CTL_BYTES = 1u << 20;
constexpr size_t OFF_CNT = 65536;
constexpr size_t WS_WPOOL = WS_CTL + CTL_BYTES;
constexpr size_t WS_WMQ = WS_WPOOL + (size_t)NA * D * PG * 2;
constexpr size_t WS_WMK = WS_WMQ + (size_t)DEPTH * MI * D * 2;
constexpr size_t WS_WMV = WS_WMK + (size_t)DEPTH * MI * D * 2;
constexpr size_t WS_WMO = WS_WMV + (size_t)DEPTH * MI * D * 2;
constexpr size_t WS_WDQ0 = WS_WMO + (size_t)DEPTH * D * MI * 2;
constexpr size_t WS_WDQ1 = WS_WDQ0 + (size_t)NDQ0 * D * 2;
constexpr size_t WS_WUQ = WS_WDQ1 + (size_t)QR * D * 2;
constexpr size_t WS_WUKV = WS_WUQ + (size_t)2 * NQ * QR * 2;
constexpr size_t WS_WO = WS_WUKV + (size_t)4096 * KVR * 2;
constexpr size_t WS_RWT = WS_WO + (size_t)2 * D * D * 2;
constexpr size_t WS_WGU = al(WS_RWT + (size_t)DEPTH * 36 * D * 4);
constexpr size_t WS_WD = WS_WGU + (size_t)DEPTH * NE * 1024 * D * 2;
constexpr size_t WS_H = WS_WD + (size_t)DEPTH * NE * D * EFF * 2;
constexpr size_t WS_HB = WS_H + (size_t)T * D * 4;
constexpr size_t WS_Y = WS_HB + (size_t)T * D * 2;
constexpr size_t WS_HH = WS_Y + (size_t)2 * T * D * 2;
constexpr size_t WS_KN = WS_HH + (size_t)MAXROWS * EFF * 2;
constexpr size_t WS_V = WS_KN + (size_t)T * D * 2;
constexpr size_t WS_Q = WS_V + (size_t)T * D * 2;
constexpr size_t WS_HN = WS_Q;
constexpr size_t WS_U = WS_Q + (size_t)T * D * 2;
constexpr size_t WS_AO = WS_Q + (size_t)T * NQ * 2;
constexpr size_t WS_MQ = WS_AO + (size_t)T * D * 2;
constexpr size_t WS_MO = WS_MQ + (size_t)T * MI * 2;
constexpr size_t WS_CQ = WS_MO + (size_t)T * MI * 2;
constexpr size_t WS_CKV = WS_CQ + (size_t)T * QR * 2;
constexpr size_t WS_KR = WS_CKV + (size_t)T * KVR * 2;
constexpr size_t WS_MEMB = WS_KR + (size_t)T * ROPE * 2;
constexpr size_t WS_MK = WS_MEMB + (size_t)NB * MEMT * D * 2;
constexpr size_t WS_MV = WS_MK + (size_t)DEPTH * NB * MEMT * MI * 2;
constexpr size_t WS_SSP = WS_MV + (size_t)DEPTH * NB * MEMT * MI * 2;
constexpr size_t WS_LSQ = WS_SSP + (size_t)T * 32 * 4;
constexpr size_t WS_LSKV = WS_LSQ + (size_t)T * 8 * 4;
constexpr size_t WS_RS0 = WS_LSKV + (size_t)T * 8 * 4;
constexpr size_t WS_RS2 = WS_RS0 + (size_t)T * 4;
constexpr size_t WS_MEMRS = WS_RS2 + (size_t)T * 4;
constexpr size_t WS_COS = WS_MEMRS + 4096;
constexpr size_t WS_SIN = WS_COS + (size_t)T * 32 * 4;
constexpr size_t WS_GW = WS_SIN + (size_t)T * 32 * 4;
constexpr size_t WS_LIST = WS_GW + (size_t)2 * T * 4;
constexpr size_t WS_RWH = WS_LIST + (size_t)NE * CAP * 4;
constexpr size_t WS_END = WS_RWH + (size_t)DEPTH * 2 * 48 * D * 2;
static_assert(WS_U + (size_t)T * D * 2 <= WS_MQ, "U overlay inside Q|AO");

DI float bf2f(bf16_t b) { return __uint_as_float(((unsigned)b) << 16); }
DI unsigned f2bf(float f) { unsigned u = __float_as_uint(f); return (u + 0x7fffu + ((u >> 16) & 1u)) >> 16; }
DI unsigned pk2(float lo, float hi) { return f2bf(lo) | (f2bf(hi) << 16); }
#define SWZ_XOR(v, m) __int_as_float(__builtin_amdgcn_ds_swizzle(__float_as_int(v), (((m) << 10) | 0x1F)))
DI float half_sum(float s) { auto rr = __builtin_amdgcn_permlane32_swap(__float_as_uint(s), __float_as_uint(s), false, false); return __uint_as_float(rr[0]) + __uint_as_float(rr[1]); }
DI float wave_sum(float v) { v += SWZ_XOR(v, 1); v += SWZ_XOR(v, 2); v += SWZ_XOR(v, 4); v += SWZ_XOR(v, 8); v += SWZ_XOR(v, 16); return half_sum(v); }
DI int opaque_tid() { int t = threadIdx.x; asm volatile("" : "+v"(t)); return t; }
DI float silu(float x) { return x / (1.0f + __expf(-x)); }

DI int permrow(int perm, int n) {
    switch (perm) {
        case 1: return (n >> 7) * QKD + (n & 127);
        case 2: { const int h = n >> 6, r = n & 63; return h * QKD + NOPE + 2 * (r & 31) + (r >> 5); }
        case 3: return (n >> 7) * 256 + (n & 127);
        case 4: return (n >> 7) * 256 + 128 + (n & 127);
        case 5: return 2 * (n & 31) + (n >> 5);
        default: return n;
    }
}
#define LAS __attribute__((address_space(3)))
typedef short bf16x8 __attribute__((ext_vector_type(8)));
namespace fg {
constexpr int BM = 256, BK = 64, HALF = 128, HTB = HALF * BK * 2, STAGE_BYTES = 8 * HTB, NXCD = 8, WGM = 8;
DI int lds_byte(int r, int c) { const int st = (r >> 4) * 2 + (c >> 5), rr = r & 15, cc = c & 31, ob = rr * 64 + cc * 2; return st * 1024 + (ob ^ (((ob >> 9) & 1) << 5)); }
DI void stage_rc(int b, int& R, int& C) { const int st = b / 1024, sb = b % 1024, swz = sb ^ (((sb >> 9) & 1) << 5); R = (st >> 1) * 16 + swz / 64; C = (st & 1) * 32 + (swz % 64) / 2; }
DI int perm32(int rho) { const int n = rho >> 4, i = rho & 15; return 8 * (i >> 2) + 4 * n + (i & 3); }
DI unsigned cvt_pk_bf16(float lo, float hi) { unsigned r; asm volatile("v_cvt_pk_bf16_f32 %0, %1, %2" : "=v"(r) : "v"(lo), "v"(hi)); return r; }
struct Unit { int pm, pn, e, r0, cnt; };

struct ProbDense {
    const char* A0; const char* B0; const char* A1; const char* B1; int nM, nN, nN0, K, lda, pool, G, c;
    static constexpr bool GATHER = false;
    DI bool next(int i, Unit& u) const {
        const long L = (long)i * G + c; const int nwg = nM * nN; if (L >= nwg) return false;
        int wgid = (int)L; { const int q = nwg / NXCD, r = nwg % NXCD, xcd = wgid % NXCD, off = wgid / NXCD; wgid = (xcd < r ? xcd * (q + 1) : r * (q + 1) + (xcd - r) * q) + off; }
        const int nig = WGM * nN, gid = wgid / nig, fm = gid * WGM, gsz = (nM - fm) < WGM ? (nM - fm) : WGM;
        u.pm = fm + ((wgid % nig) % gsz); u.pn = (wgid % nig) / gsz; u.e = 0; u.r0 = 0; u.cnt = 256; return true; }
    DI const char* aptr(const Unit& u) const { return (u.pn < nN0 ? A0 : A1) + (size_t)u.pm * 256 * lda * 2 + (pool ? (size_t)(u.pn >> 1) * 1024 : 0); }
    DI const char* bptr(const Unit& u) const { return u.pn < nN0 ? B0 + (size_t)u.pn * 256 * K * 2 : B1 + (size_t)(u.pn - nN0) * 256 * K * 2; }
    DI void avoff(const Unit&, int tid, unsigned (&vo)[2][2]) const {
        int R[2], C[2]; stage_rc(tid * 16, R[0], C[0]); stage_rc(tid * 16 + 8192, R[1], C[1]);
#pragma unroll
        for (int h = 0; h < 2; ++h)
#pragma unroll
            for (int i = 0; i < 2; ++i) vo[h][i] = (unsigned)((h * 128 + R[i]) * lda + C[i]) * 2u; }
};
struct ProbMoe {
    const char* A; const char* Bt; const int* list; const LAS int* pref; int npn, K, lda, gather, G, c; long estride;
    static constexpr bool GATHER = true;
    DI bool next(int i, Unit& u) const {
        const int nx = (G & 7) ? 1 : 8, q = i * (G / nx) + c / nx, t = q / npn; if (t >= pref[40]) return false;
        const int ent = pref[128 + t], e = ent & 255;
        u.pm = ent >> 16; u.pn = q % npn; u.e = e; u.r0 = ((ent >> 8) & 255) * 256; u.cnt = pref[64 + e]; return true; }
    DI const char* aptr(const Unit& u) const { return gather ? A : A + (size_t)u.pm * 256 * lda * 2; }
    DI const char* bptr(const Unit& u) const { return Bt + (size_t)u.e * estride + (size_t)u.pn * 256 * K * 2; }
    DI void avoff(const Unit& u, int tid, unsigned (&vo)[2][2]) const {
        int R[2], C[2]; stage_rc(tid * 16, R[0], C[0]); stage_rc(tid * 16 + 8192, R[1], C[1]);
#pragma unroll
        for (int h = 0; h < 2; ++h)
#pragma unroll
            for (int i = 0; i < 2; ++i) { const int row = h * 128 + R[i];
                if (gather) { const int ri = u.r0 + row; const int tok = ri < u.cnt ? (list[(size_t)u.e * CAP + ri] >> 1) : 0; vo[h][i] = (unsigned)(tok * lda + C[i]) * 2u; }
                else vo[h][i] = (unsigned)(row * lda + C[i]) * 2u; } }
};

typedef f32x4 Acc[2][2][4][2];
DI float quad_sum(float s) { s += SWZ_XOR(s, 16); return half_sum(s); }
DI float sq8(const f32x4& a, const f32x4& b) { return ((a.x * a.x + a.y * a.y) + (a.z * a.z + a.w * a.w)) + ((b.x * b.x + b.y * b.y) + (b.z * b.z + b.w * b.w)); }
DI u32x4 pack8(const f32x4& a, const f32x4& b) { u32x4 w; w.x = cvt_pk_bf16(a.x, a.y); w.y = cvt_pk_bf16(a.z, a.w); w.z = cvt_pk_bf16(b.x, b.y); w.w = cvt_pk_bf16(b.z, b.w); return w; }
template <int NP> DI float rs_from_parts(const float* part, int r, int fq, float inv_n) {
    float s;
    if (NP == 32) { const f32x4 a = *(const f32x4*)(part + (size_t)r * 32 + fq * 8), b = *(const f32x4*)(part + (size_t)r * 32 + fq * 8 + 4); s = ((a.x + a.y) + (a.z + a.w)) + ((b.x + b.y) + (b.z + b.w)); }
    else { const float* p = part + (size_t)r * 8 + fq * 2; s = p[0] + p[1]; }
    s = quad_sum(s); return rsqrtf(s * inv_n + EPS);
}
DI void rope8(f32x4& a, f32x4& b, const float* COS, const float* SIN, int r, int i0) {
    const f32x4 c = *(const f32x4*)(COS + (size_t)r * 32 + i0), s = *(const f32x4*)(SIN + (size_t)r * 32 + i0);
    const f32x4 a2 = {a.x * c.x - a.y * s.x, a.y * c.x + a.x * s.x, a.z * c.y - a.w * s.y, a.w * c.y + a.z * s.y};
    const f32x4 b2 = {b.x * c.z - b.y * s.z, b.y * c.z + b.x * s.z, b.z * c.w - b.w * s.w, b.w * c.w + b.z * s.w};
    a = a2; b = b2;
}
#define EPI_ROWS(ai, m) (ai * HALF + wr * 64 + m * 16 + fr)
DI void unpack8(const u32x4& w, f32x4& a, f32x4& b) {
    a = (f32x4){__uint_as_float(w.x << 16), __uint_as_float(w.x & 0xffff0000u), __uint_as_float(w.y << 16), __uint_as_float(w.y & 0xffff0000u)};
    b = (f32x4){__uint_as_float(w.z << 16), __uint_as_float(w.z & 0xffff0000u), __uint_as_float(w.w << 16), __uint_as_float(w.w & 0xffff0000u)}; }
DI void rope8r(f32x4& a, f32x4& b, const f32x4& c, const f32x4& s) {
    const f32x4 a2 = {a.x * c.x - a.y * s.x, a.y * c.x + a.x * s.x, a.z * c.y - a.w * s.y, a.w * c.y + a.z * s.y};
    const f32x4 b2 = {b.x * c.z - b.y * s.z, b.y * c.z + b.x * s.z, b.z * c.w - b.w * s.w, b.w * c.w + b.z * s.w};
    a = a2; b = b2;
}
template <bool STATS> struct EpiRes {
    bf16_t* HB; float* SSP; bf16_t* HBout = nullptr;
    DI void operator()(const Acc& acc, const Unit& u, int wr, int wc, int fr, int fq) const {
        const int cb = u.pn * BM + wc * 32 + 8 * fq;
#pragma unroll
        for (int ai = 0; ai < 2; ++ai) {
            u32x4 w[4][2];
#pragma unroll
            for (int m = 0; m < 4; ++m)
#pragma unroll
                for (int bj = 0; bj < 2; ++bj) w[m][bj] = *(const u32x4*)(HB + (size_t)(u.pm * BM + EPI_ROWS(ai, m)) * D + cb + bj * HALF);
#pragma unroll
            for (int m = 0; m < 4; ++m) { const int r = u.pm * BM + EPI_ROWS(ai, m); float ss = 0.f;
#pragma unroll
                for (int bj = 0; bj < 2; ++bj) { f32x4 h0, h1; unpack8(w[m][bj], h0, h1); h0 += acc[ai][bj][m][0]; h1 += acc[ai][bj][m][1];
                    *(u32x4*)((HBout ? HBout : HB) + (size_t)r * D + cb + bj * HALF) = pack8(h0, h1); if (STATS) ss += sq8(h0, h1); }
                if (STATS) { ss = quad_sum(ss); if (fq == 0) SSP[(size_t)r * 32 + u.pn * 4 + wc] = ss; } }
        }
    }
};
template <int MODE  > struct EpiBf16RS {
    bf16_t* O; int ldo; const float* rs;
    DI void operator()(const Acc& acc, const Unit& u, int wr, int wc, int fr, int fq) const {
        float sc[2][4];
#pragma unroll
        for (int ai = 0; ai < 2; ++ai)
#pragma unroll
            for (int m = 0; m < 4; ++m) { const int r = u.pm * BM + EPI_ROWS(ai, m); sc[ai][m] = MODE == 1 ? rs[r] : rs_from_parts<32>(rs, r, fq, 1.0f / D); }
#pragma unroll
        for (int ai = 0; ai < 2; ++ai)
#pragma unroll
            for (int m = 0; m < 4; ++m) { const int r = u.pm * BM + EPI_ROWS(ai, m);
#pragma unroll
                for (int bj = 0; bj < 2; ++bj) { const int c0 = u.pn * BM + bj * HALF + wc * 32 + 8 * fq;
                    *(u32x4*)(O + (size_t)r * ldo + c0) = pack8(acc[ai][bj][m][0] * sc[ai][m], acc[ai][bj][m][1] * sc[ai][m]); } }
    }
};
struct EpiDQ {
    bf16_t* CQ; bf16_t* CKV; bf16_t* KR; const float* RS0; float* LSQ; float* LSKV; const float* COS; const float* SIN;
    DI void operator()(const Acc& acc, const Unit& u, int wr, int wc, int fr, int fq) const {
        float sc[2][4];
#pragma unroll
        for (int ai = 0; ai < 2; ++ai)
#pragma unroll
            for (int m = 0; m < 4; ++m) sc[ai][m] = RS0[u.pm * BM + EPI_ROWS(ai, m)];
        if (u.pn < 4) {
#pragma unroll
            for (int ai = 0; ai < 2; ++ai)
#pragma unroll
                for (int m = 0; m < 4; ++m) { const int r = u.pm * BM + EPI_ROWS(ai, m); float ss = 0.f;
#pragma unroll
                    for (int bj = 0; bj < 2; ++bj) { const int cl = bj * HALF + wc * 32 + 8 * fq; const f32x4 v0 = acc[ai][bj][m][0] * sc[ai][m], v1 = acc[ai][bj][m][1] * sc[ai][m];
                        ss += sq8(v0, v1); *(u32x4*)((u.pn < 2 ? CQ : CKV) + (size_t)r * 512 + (u.pn & 1) * 256 + cl) = pack8(v0, v1); }
                    ss = quad_sum(ss); if (fq == 0) (u.pn < 2 ? LSQ : LSKV)[(size_t)r * 8 + (u.pn & 1) * 4 + wc] = ss; }
        } else if (wc < 2) {
            const int cl = wc * 32 + 8 * fq; f32x4 cs[2][4], sn[2][4];
#pragma unroll
            for (int ai = 0; ai < 2; ++ai)
#pragma unroll
                for (int m = 0; m < 4; ++m) { const int r = u.pm * BM + EPI_ROWS(ai, m); cs[ai][m] = *(const f32x4*)(COS + (unsigned)(r * 32 + (cl >> 1))); sn[ai][m] = *(const f32x4*)(SIN + (unsigned)(r * 32 + (cl >> 1))); }
#pragma unroll
            for (int ai = 0; ai < 2; ++ai)
#pragma unroll
                for (int m = 0; m < 4; ++m) { const int r = u.pm * BM + EPI_ROWS(ai, m); f32x4 v0 = acc[ai][0][m][0] * sc[ai][m], v1 = acc[ai][0][m][1] * sc[ai][m];
                    rope8r(v0, v1, cs[ai][m], sn[ai][m]); *(u32x4*)(KR + (size_t)r * 64 + cl) = pack8(v0, v1); }
        }
    }
};
struct EpiUQ {
    bf16_t* Q; bf16_t* KN; bf16_t* V; const float* LSQ; const float* LSKV; const float* COS; const float* SIN;
    DI void operator()(const Acc& acc, const Unit& u, int wr, int wc, int fr, int fq) const {
        const bool isq = u.pn < 12; float sc[2][4];
#pragma unroll
        for (int ai = 0; ai < 2; ++ai)
#pragma unroll
            for (int m = 0; m < 4; ++m) sc[ai][m] = rs_from_parts<8>(isq ? LSQ : LSKV, u.pm * BM + EPI_ROWS(ai, m), fq, 1.0f / 512.0f);
#pragma unroll
        for (int bj = 0; bj < 2; ++bj) {
            const int c0 = (isq ? u.pn : u.pn - 12) * BM + bj * HALF + wc * 32 + 8 * fq, hc = c0 % QKD; const bool rot = isq && hc >= NOPE;
#pragma unroll
            for (int ai = 0; ai < 2; ++ai) {
                f32x4 cs[4], sn[4];
                if (rot) {
#pragma unroll
                    for (int m = 0; m < 4; ++m) { const int r = u.pm * BM + EPI_ROWS(ai, m); cs[m] = *(const f32x4*)(COS + (unsigned)(r * 32 + ((hc - NOPE) >> 1))); sn[m] = *(const f32x4*)(SIN + (unsigned)(r * 32 + ((hc - NOPE) >> 1))); } }
#pragma unroll
                for (int m = 0; m < 4; ++m) { const int r = u.pm * BM + EPI_ROWS(ai, m); f32x4 v0 = acc[ai][bj][m][0] * sc[ai][m], v1 = acc[ai][bj][m][1] * sc[ai][m];
                    if (rot) rope8r(v0, v1, cs[m], sn[m]);
                    bf16_t* o = isq ? Q + (size_t)r * NQ + c0 : (c0 < 2048 ? KN + c0 : V + (c0 - 2048)) + (size_t)r * D;
                    *(u32x4*)o = pack8(v0, v1); }
            }
        }
    }
};
struct EpiMoe1 {
    bf16_t* HH; const float* RS2; const int* list;
    DI void operator()(const Acc& acc, const Unit& u, int wr, int wc, int fr, int fq) const {
        int tok[2][4]; float sc[2][4];
#pragma unroll
        for (int ai = 0; ai < 2; ++ai)
#pragma unroll
            for (int m = 0; m < 4; ++m) { const int ri = u.r0 + EPI_ROWS(ai, m); tok[ai][m] = ri < u.cnt ? (list[(size_t)u.e * CAP + ri] >> 1) : 0; }
#pragma unroll
        for (int ai = 0; ai < 2; ++ai)
#pragma unroll
            for (int m = 0; m < 4; ++m) sc[ai][m] = RS2[tok[ai][m]];
#pragma unroll
        for (int ai = 0; ai < 2; ++ai)
#pragma unroll
            for (int m = 0; m < 4; ++m) { const int lr = EPI_ROWS(ai, m);
                if (u.r0 + lr < u.cnt) { const float s_ = sc[ai][m];
                    const f32x4 g0 = acc[ai][0][m][0] * s_, g1 = acc[ai][0][m][1] * s_, u0 = acc[ai][1][m][0] * s_, u1 = acc[ai][1][m][1] * s_;
                    const f32x4 h0 = {silu(g0.x) * u0.x, silu(g0.y) * u0.y, silu(g0.z) * u0.z, silu(g0.w) * u0.w}, h1 = {silu(g1.x) * u1.x, silu(g1.y) * u1.y, silu(g1.z) * u1.z, silu(g1.w) * u1.w};
                    *(u32x4*)(HH + (size_t)(u.pm * BM + lr) * EFF + u.pn * 128 + wc * 32 + 8 * fq) = pack8(h0, h1); } }
    }
};
struct EpiMoe2 {
    bf16_t* Y; const float* GW; const int* list;
    DI void operator()(const Acc& acc, const Unit& u, int wr, int wc, int fr, int fq) const {
        int as[2][4]; float sc[2][4];
#pragma unroll
        for (int ai = 0; ai < 2; ++ai)
#pragma unroll
            for (int m = 0; m < 4; ++m) { const int ri = u.r0 + EPI_ROWS(ai, m); as[ai][m] = ri < u.cnt ? list[(size_t)u.e * CAP + ri] : 0; }
#pragma unroll
        for (int ai = 0; ai < 2; ++ai)
#pragma unroll
            for (int m = 0; m < 4; ++m) sc[ai][m] = GW[as[ai][m]];
#pragma unroll
        for (int ai = 0; ai < 2; ++ai)
#pragma unroll
            for (int m = 0; m < 4; ++m) { if (u.r0 + EPI_ROWS(ai, m) < u.cnt) {
#pragma unroll
                    for (int bj = 0; bj < 2; ++bj) { const int c0 = u.pn * BM + bj * HALF + wc * 32 + 8 * fq;
                        *(u32x4*)(Y + (size_t)as[ai][m] * D + c0) = pack8(acc[ai][bj][m][0] * sc[ai][m], acc[ai][bj][m][1] * sc[ai][m]); } } }
    }
};

template <class Epi, class Prob, bool DRY = false>
DI void gemm_phase(LAS unsigned char* lds, const Prob& P, const Epi& E) {
    const int tid = opaque_tid(), wid = __builtin_amdgcn_readfirstlane(tid >> 6), lane = tid & 63, wr = wid >> 2, wc = wid & 3, fr = lane & 15, fq = lane >> 4;
    const int K = P.K, nt = K / BK;
    int sR[2], sC[2]; unsigned voffB[2];
#pragma unroll
    for (int i = 0; i < 2; ++i) { stage_rc(tid * 16 + i * 8192, sR[i], sC[i]); const int Rb = (sR[i] & ~31) + perm32(sR[i] & 31); voffB[i] = (unsigned)(Rb * K + sC[i]) * 2u; }
    const size_t kstep = (size_t)(BK * 2), hstepB = (size_t)HALF * K * 2;
    const unsigned ldsw = (unsigned)wid * 1024u;
    const int aoff = lds_byte(wr * 64 + fr, fq * 8), boff = lds_byte(wc * 32 + fr, fq * 8);
#define PG8_SA(b, h) (((b) * 2 + (h)) * HTB)
#define PG8_SB(b, h) ((4 + (b) * 2 + (h)) * HTB)
#define PG8_STAGE(bufoff, gbase, voff) do { _Pragma("unroll") for (int _i = 0; _i < 2; ++_i) \
        __builtin_amdgcn_global_load_lds((const unsigned*)((const char*)(gbase) + (voff)[_i]), (LAS unsigned*)(lds + (bufoff) + ldsw + _i * 8192), 16, 0, 0); } while (0)
#define PG8_LDA(dst, b, h) do { _Pragma("unroll") for (int m = 0; m < 4; ++m) _Pragma("unroll") for (int k = 0; k < 2; ++k) dst[m][k] = *(const LAS bf16x8*)(lds + PG8_SA(b, h) + aoff + m * 2048 + k * 1024); } while (0)
#define PG8_LDB(dst, b, h) do { _Pragma("unroll") for (int n = 0; n < 2; ++n) _Pragma("unroll") for (int k = 0; k < 2; ++k) dst[n][k] = *(const LAS bf16x8*)(lds + PG8_SB(b, h) + boff + n * 2048 + k * 1024); } while (0)
#define PG8_MMA(ai, bj, At, Bt) do { __builtin_amdgcn_s_setprio(1); _Pragma("unroll") for (int m = 0; m < 4; ++m) _Pragma("unroll") for (int n = 0; n < 2; ++n) _Pragma("unroll") for (int k = 0; k < 2; ++k) \
        acc[ai][bj][m][n] = __builtin_amdgcn_mfma_f32_16x16x32_bf16(Bt[n][k], At[m][k], acc[ai][bj][m][n], 0, 0, 0); __builtin_amdgcn_s_setprio(0); } while (0)
#define PG8_WAIT_V(n) asm volatile("s_waitcnt vmcnt(" #n ")" ::: "memory")
#define PG8_WAIT_L(n) asm volatile("s_waitcnt lgkmcnt(" #n ")" ::: "memory")
#define PG8_BAR __builtin_amdgcn_s_barrier()
#define PG8_SCHED __builtin_amdgcn_sched_barrier(0)
    Unit cur, nxt; int ui = 0;
    if (!P.next(0, cur)) return;
    bool do0 = true, do1 = true;
    if constexpr (Prob::GATHER) { const int nv = cur.cnt - cur.r0; do0 = wr * 64 < nv; do1 = 128 + wr * 64 < nv; }
    if constexpr (DRY) { do0 = false; do1 = false; }
    f32x4 acc[2][2][4][2];
#pragma unroll
    for (int a = 0; a < 2; ++a)
#pragma unroll
        for (int b = 0; b < 2; ++b)
#pragma unroll
            for (int m = 0; m < 4; ++m)
#pragma unroll
                for (int n = 0; n < 2; ++n) acc[a][b][m][n] = (f32x4){0.f, 0.f, 0.f, 0.f};
    bf16x8 At[4][2], B0[2][2], B1[2][2];
    const char* cA = P.aptr(cur); const char* cB = P.bptr(cur);
    unsigned voA[2][2], vnA[2][2];
    P.avoff(cur, tid, voA);
    if constexpr (Prob::GATHER) asm volatile("s_waitcnt vmcnt(0)" ::: "memory");
    PG8_STAGE(PG8_SB(0, 0), cB, voffB); PG8_STAGE(PG8_SB(0, 1), cB + hstepB, voffB); PG8_STAGE(PG8_SA(0, 0), cA, voA[0]); PG8_STAGE(PG8_SA(0, 1), cA, voA[1]);
    if (wr == 1) PG8_BAR;
    PG8_WAIT_V(2); PG8_BAR;
    PG8_STAGE(PG8_SB(1, 0), cB + kstep, voffB); PG8_STAGE(PG8_SA(1, 0), cA + kstep, voA[0]); PG8_STAGE(PG8_SB(1, 1), cB + hstepB + kstep, voffB);
    PG8_WAIT_V(6); PG8_BAR;
    for (;;) {
        const bool has_next = P.next(ui + 1, nxt);
        const char* nA = has_next ? P.aptr(nxt) : cA; const char* nB = has_next ? P.bptr(nxt) : cB;
#pragma unroll
        for (int h = 0; h < 2; ++h)
#pragma unroll
            for (int i = 0; i < 2; ++i) vnA[h][i] = voA[h][i];
        for (int t = 0; t < nt; t += 2) {
            const bool last = (t == nt - 2);
            if constexpr (Prob::GATHER) { if (last && has_next) P.avoff(nxt, opaque_tid(), vnA); }
            const char* a1 = cA + (size_t)(t + 1) * kstep;
            const char* a2 = last ? nA : cA + (size_t)(t + 2) * kstep; const char* b2 = last ? nB : cB + (size_t)(t + 2) * kstep;
            const char* a3 = a2 + kstep; const char* b3 = b2 + kstep;
            unsigned w0[2], w1[2];
#pragma unroll
            for (int i = 0; i < 2; ++i) { w0[i] = last ? vnA[0][i] : voA[0][i]; w1[i] = last ? vnA[1][i] : voA[1][i]; }
            PG8_LDB(B0, 0, 0); PG8_LDB(B1, 0, 1); PG8_SCHED; PG8_LDA(At, 0, 0); PG8_STAGE(PG8_SA(1, 1), a1, voA[1]);
            PG8_WAIT_V(8); PG8_WAIT_L(0); PG8_BAR; if (do0) { PG8_MMA(0, 0, At, B0); PG8_MMA(0, 1, At, B1); } PG8_BAR; PG8_SCHED;
            PG8_LDA(At, 0, 1); PG8_STAGE(PG8_SB(0, 0), b2, voffB); PG8_STAGE(PG8_SB(0, 1), b2 + hstepB, voffB); PG8_STAGE(PG8_SA(0, 0), a2, w0);
            PG8_WAIT_V(8); PG8_WAIT_L(0); PG8_BAR; if (do1) { PG8_MMA(1, 0, At, B0); PG8_MMA(1, 1, At, B1); } PG8_BAR; PG8_SCHED;
            PG8_LDB(B0, 1, 0); PG8_LDB(B1, 1, 1); PG8_SCHED; PG8_LDA(At, 1, 0); PG8_STAGE(PG8_SA(0, 1), a2, w1);
            PG8_WAIT_V(8); PG8_WAIT_L(0); PG8_BAR; if (do0) { PG8_MMA(0, 0, At, B0); PG8_MMA(0, 1, At, B1); } PG8_BAR; PG8_SCHED;
            PG8_LDA(At, 1, 1); PG8_STAGE(PG8_SB(1, 0), b3, voffB); PG8_STAGE(PG8_SB(1, 1), b3 + hstepB, voffB); PG8_STAGE(PG8_SA(1, 0), a3, w0);
            PG8_WAIT_V(8); PG8_WAIT_L(0); PG8_BAR; if (do1) { PG8_MMA(1, 0, At, B0); PG8_MMA(1, 1, At, B1); } PG8_BAR; PG8_SCHED;
        }
        if (wr == 0) PG8_BAR;
        if constexpr (!DRY) { const int lz = opaque_tid() & 63; E(acc, cur, wr, wc, lz & 15, lz >> 4); }
        if (!has_next) break;
#pragma unroll
        for (int a = 0; a < 2; ++a)
#pragma unroll
            for (int b = 0; b < 2; ++b)
#pragma unroll
                for (int m = 0; m < 4; ++m)
#pragma unroll
                    for (int n = 0; n < 2; ++n) acc[a][b][m][n] = (f32x4){0.f, 0.f, 0.f, 0.f};
        cur = nxt; cA = nA; cB = nB; ++ui;
        if constexpr (Prob::GATHER) { const int nv = cur.cnt - cur.r0; do0 = wr * 64 < nv; do1 = 128 + wr * 64 < nv; }
        if constexpr (DRY) { do0 = false; do1 = false; }
#pragma unroll
        for (int h = 0; h < 2; ++h)
#pragma unroll
            for (int i = 0; i < 2; ++i) voA[h][i] = vnA[h][i];
        if (wr == 1) PG8_BAR;
    }
    PG8_WAIT_V(0);
    PG8_BAR;
#undef PG8_SA
#undef PG8_SB
#undef PG8_STAGE
#undef PG8_LDA
#undef PG8_LDB
#undef PG8_MMA
#undef PG8_WAIT_V
#undef PG8_WAIT_L
#undef PG8_BAR
#undef PG8_SCHED
}
}


namespace fa {
typedef float f32x16 __attribute__((ext_vector_type(16)));
typedef short s16x4 __attribute__((ext_vector_type(4)));
#define SBAR() __builtin_amdgcn_sched_barrier(0)
constexpr float THR = 8.f, LOG2E = 1.4426950408889634f;
DI int crow(int r, int hi) { return (r & 3) + 8 * (r >> 2) + 4 * hi; }
DI unsigned cvtpk(float lo, float hi) { unsigned r; asm volatile("v_cvt_pk_bf16_f32 %0, %1, %2" : "=v"(r) : "v"(lo), "v"(hi)); return r; }
DI void partialSM(f32x16& p0, f32x16& p1, float& m_reg, float& mn, float& alpha) {
    float pmax = p0[0];
#pragma unroll
    for (int r = 1; r < 16; ++r) pmax = fmaxf(pmax, p0[r]);
#pragma unroll
    for (int r = 0; r < 16; ++r) pmax = fmaxf(pmax, p1[r]);
    { auto rr = __builtin_amdgcn_permlane32_swap(__float_as_uint(pmax), __float_as_uint(pmax), false, false); pmax = fmaxf(__uint_as_float(rr[0]), __uint_as_float(rr[1])); }
    if (__builtin_expect(__all(pmax - m_reg <= THR), 1)) { mn = m_reg; alpha = 1.f; }
    else { mn = fmaxf(m_reg, pmax); alpha = __builtin_amdgcn_exp2f((m_reg - mn) * LOG2E); m_reg = mn; }
    const float mnC = -mn * LOG2E;
#pragma unroll
    for (int r = 0; r < 16; ++r) p0[r] = fmaf(p0[r], LOG2E, mnC);
#pragma unroll
    for (int r = 0; r < 16; ++r) p1[r] = fmaf(p1[r], LOG2E, mnC);
#pragma unroll
    for (int r = 0; r < 16; ++r) p0[r] = __builtin_amdgcn_exp2f(p0[r]);
}
DI void finishSM(f32x16& p0, f32x16& p1, float alpha, float& l_reg, bf16x8& pa0, bf16x8& pa1, bf16x8& pa2, bf16x8& pa3) {
#pragma unroll
    for (int r = 0; r < 16; ++r) p1[r] = __builtin_amdgcn_exp2f(p1[r]);
    float ps = 0;
#pragma unroll
    for (int r = 0; r < 16; ++r) ps += p0[r];
#pragma unroll
    for (int r = 0; r < 16; ++r) ps += p1[r];
    { auto rr = __builtin_amdgcn_permlane32_swap(__float_as_uint(ps), __float_as_uint(ps), false, false); ps = __uint_as_float(rr[0]) + __uint_as_float(rr[1]); }
    l_reg = l_reg * alpha + ps;
#define PK4(P, BASE, OUT) do { unsigned a0 = cvtpk(P[BASE + 0], P[BASE + 1]), a1 = cvtpk(P[BASE + 2], P[BASE + 3]);   \
    unsigned b0 = cvtpk(P[BASE + 4], P[BASE + 5]), b1 = cvtpk(P[BASE + 6], P[BASE + 7]);                              \
    auto r0 = __builtin_amdgcn_permlane32_swap(a0, b0, false, false); auto r1 = __builtin_amdgcn_permlane32_swap(a1, b1, false, false); \
    u32x4 w = {r0[0], r1[0], r0[1], r1[1]}; OUT = *reinterpret_cast<bf16x8*>(&w); } while (0)
    PK4(p0, 0, pa0); PK4(p0, 8, pa1); PK4(p1, 0, pa2); PK4(p1, 8, pa3);
#undef PK4
}
template <int DQK> DI void qkt(f32x16& p0, f32x16& p1, LAS const char* Ks, const int (&kb)[4], const bf16x8* qr) {
    constexpr int KROW = DQK * 2;
#pragma unroll
    for (int r = 0; r < 16; ++r) { p0[r] = 0.f; p1[r] = 0.f; }
#pragma unroll
    for (int d0 = 0; d0 < DQK / 16; ++d0) {
        const bf16x8 b0 = *(LAS const bf16x8*)(Ks + kb[d0 & 3] + (d0 >> 2) * 128);
        const bf16x8 b1 = *(LAS const bf16x8*)(Ks + kb[d0 & 3] + (d0 >> 2) * 128 + 32 * KROW);
        p0 = __builtin_amdgcn_mfma_f32_32x32x16_bf16(b0, qr[d0], p0, 0, 0, 0);
        p1 = __builtin_amdgcn_mfma_f32_32x32x16_bf16(b1, qr[d0], p1, 0, 0, 0); }
}
DI int v_rd_base(int lane) { return ((lane & 3) << 3) | (((lane >> 2) & 3) << 6) | (((lane >> 4) & 1) << 5) | (((lane >> 5) & 1) << 8); }
constexpr int v_rd_off(int d0, int ks, int half) { return d0 * 512 + ks * 4096 + half * 2048; }
template <int OFF> DI s16x4 tr_read(int vb) { s16x4 r; asm volatile("ds_read_b64_tr_b16 %0, %1 offset:%2" : "=&v"(r) : "v"(vb), "i"(OFF) : "memory"); return r; }
template <int D0> DI void pv_one(f32x16& od, int vb, bf16x8 pa0, bf16x8 pa1, bf16x8 pa2, bf16x8 pa3) {
    const s16x4 l0 = tr_read<v_rd_off(D0, 0, 0)>(vb), h0 = tr_read<v_rd_off(D0, 0, 1)>(vb), l1 = tr_read<v_rd_off(D0, 1, 0)>(vb), h1 = tr_read<v_rd_off(D0, 1, 1)>(vb);
    const s16x4 l2 = tr_read<v_rd_off(D0, 2, 0)>(vb), h2 = tr_read<v_rd_off(D0, 2, 1)>(vb), l3 = tr_read<v_rd_off(D0, 3, 0)>(vb), h3 = tr_read<v_rd_off(D0, 3, 1)>(vb);
    asm volatile("s_waitcnt lgkmcnt(0)" ::: "memory"); SBAR();
#define PK(L, H) (bf16x8){L[0], L[1], L[2], L[3], H[0], H[1], H[2], H[3]}
    od = __builtin_amdgcn_mfma_f32_32x32x16_bf16(pa0, PK(l0, h0), od, 0, 0, 0);
    od = __builtin_amdgcn_mfma_f32_32x32x16_bf16(pa1, PK(l1, h1), od, 0, 0, 0);
    od = __builtin_amdgcn_mfma_f32_32x32x16_bf16(pa2, PK(l2, h2), od, 0, 0, 0);
    od = __builtin_amdgcn_mfma_f32_32x32x16_bf16(pa3, PK(l3, h3), od, 0, 0, 0);
#undef PK
}
DI void pv_d0(f32x16* o, int vb, bf16x8 pa0, bf16x8 pa1, bf16x8 pa2, bf16x8 pa3) {
    pv_one<0>(o[0], vb, pa0, pa1, pa2, pa3); pv_one<1>(o[1], vb, pa0, pa1, pa2, pa3); pv_one<2>(o[2], vb, pa0, pa1, pa2, pa3); pv_one<3>(o[3], vb, pa0, pa1, pa2, pa3);
}
template <int DQK, bool CAUSAL>
DI void attn_unit(LAS char* lds, const bf16_t* Qb, int ldq, const bf16_t* K1, int ldk1, const bf16_t* K2, int ldk2, const bf16_t* Vb, int ldv, bf16_t* Ob, int ldo, int NT, int qtile0) {
    constexpr int KROW = DQK * 2, KT = 64 * KROW, BUF = KT + 16384, NKP = DQK / 64, ND0 = DQK / 16;
    const int tid = opaque_tid(), wid = __builtin_amdgcn_readfirstlane(tid >> 6), lane = tid & 63, r32 = lane & 31, hi = lane >> 5;
    LAS float* wsf = (LAS float*)(lds + 3 * BUF) + wid * 64; LAS float* li_l = wsf; LAS float* al_l = wsf + 32;
    const char* kp[NKP]; int kst[NKP]; const char* vp[2];
#pragma unroll
    for (int i = 0; i < NKP; ++i) { const int p = (wid * NKP + i) * 1024 + lane * 16, row = p / KROW, cbs = p % KROW, cb = cbs ^ ((row & 7) << 4);
        if (DQK == 128 || cb < 256) { kp[i] = (const char*)K1 + (size_t)row * ldk1 * 2 + cb; kst[i] = 64 * ldk1 * 2; }
        else { kp[i] = (const char*)K2 + (size_t)row * ldk2 * 2 + (cb - 256); kst[i] = 64 * ldk2 * 2; } }
#pragma unroll
    for (int i = 0; i < 2; ++i) { const int p = (wid * 2 + i) * 1024 + lane * 16, sub = p >> 9, q = (p & 511) >> 1, kk = (sub >> 2) * 8 + (q >> 5), k = (kk & ~0xC) | ((kk & 4) << 1) | ((kk & 8) >> 1), c = (sub & 3) * 32 + (q & 31);
        vp[i] = (const char*)Vb + ((size_t)k * ldv + c) * 2; }
    const int vstep = 64 * ldv * 2;
#define FA_DMA(bo) do { _Pragma("unroll") for (int _i = 0; _i < NKP; ++_i) { __builtin_amdgcn_global_load_lds((const unsigned*)kp[_i], (LAS unsigned*)(lds + (bo) + (wid * NKP + _i) * 1024), 16, 0, 0); kp[_i] += kst[_i]; } \
        _Pragma("unroll") for (int _i = 0; _i < 2; ++_i) { __builtin_amdgcn_global_load_lds((const unsigned*)vp[_i], (LAS unsigned*)(lds + (bo) + KT + (wid * 2 + _i) * 1024), 16, 0, 0); vp[_i] += vstep; } } while (0)
#define FA_SYNC() do { asm volatile("s_waitcnt vmcnt(0)" ::: "memory"); __builtin_amdgcn_s_barrier(); asm volatile("" ::: "memory"); } while (0)
    int bm1 = 0, bc = BUF, bp1 = 2 * BUF;
    FA_DMA(bm1); FA_DMA(bc);
    bf16x8 qr[ND0];
    { const bf16_t* Qw = Qb + (size_t)(wid * 32 + r32) * ldq + hi * 8;
#pragma unroll
      for (int d0 = 0; d0 < ND0; ++d0) qr[d0] = *(const bf16x8*)(Qw + d0 * 16); }
    int kb[4];
#pragma unroll
    for (int q = 0; q < 4; ++q) kb[q] = r32 * KROW + ((q * 32 + hi * 16) ^ ((r32 & 7) << 4));
    const int vb0 = (int)(uintptr_t)lds + KT + v_rd_base(lane);
    const int lim = CAUSAL ? qtile0 + (wid >> 1) : 0x7fffffff;
    float m_reg = -1e30f, l_reg = 0; f32x16 o[4];
#pragma unroll
    for (int d = 0; d < 4; ++d)
#pragma unroll
        for (int r = 0; r < 16; ++r) o[d][r] = 0.f;
    f32x16 pA0, pA1, pB0, pB1; float mnA, mnB, alA, alB; bf16x8 pa0, pa1, pa2, pa3;
#define FA_VIS(j) (!CAUSAL || (j) <= lim)
#define FA_MASK(P0, P1, j) do { if (CAUSAL && (j) > lim) { _Pragma("unroll") for (int _r = 0; _r < 16; ++_r) { P0[_r] = -1e30f; P1[_r] = -1e30f; } } } while (0)
#define FA_RESC(a) do { if (__any((a) < 1.f)) { if (hi == 0) al_l[r32] = (a); asm volatile("s_waitcnt lgkmcnt(0)" ::: "memory"); \
        _Pragma("unroll") for (int _d = 0; _d < 4; ++_d) _Pragma("unroll") for (int _r = 0; _r < 16; ++_r) o[_d][_r] *= al_l[crow(_r, hi)]; } } while (0)
#define FA_ROT() do { const int _t = bm1; bm1 = bc; bc = bp1; bp1 = _t; } while (0)
    FA_SYNC();
    FA_DMA(bp1);
    qkt<DQK>(pA0, pA1, lds + bm1, kb, qr); partialSM(pA0, pA1, m_reg, mnA, alA);
    for (int j = 1; j + 1 < NT; j += 2) {
        SBAR(); if (FA_VIS(j)) qkt<DQK>(pB0, pB1, lds + bc, kb, qr);
        finishSM(pA0, pA1, alA, l_reg, pa0, pa1, pa2, pa3); SBAR();
        if (FA_VIS(j - 1)) pv_d0(o, vb0 + bm1, pa0, pa1, pa2, pa3); FA_MASK(pB0, pB1, j); partialSM(pB0, pB1, m_reg, mnB, alB);
        FA_SYNC(); if (j + 2 < NT) FA_DMA(bm1);
        FA_RESC(alB); FA_ROT();
        SBAR(); if (FA_VIS(j + 1)) qkt<DQK>(pA0, pA1, lds + bc, kb, qr);
        finishSM(pB0, pB1, alB, l_reg, pa0, pa1, pa2, pa3); SBAR();
        if (FA_VIS(j)) pv_d0(o, vb0 + bm1, pa0, pa1, pa2, pa3); FA_MASK(pA0, pA1, j + 1); partialSM(pA0, pA1, m_reg, mnA, alA);
        FA_SYNC(); if (j + 3 < NT) FA_DMA(bm1);
        FA_RESC(alA); FA_ROT();
    }
    SBAR(); if (FA_VIS(NT - 1)) qkt<DQK>(pB0, pB1, lds + bc, kb, qr);
    finishSM(pA0, pA1, alA, l_reg, pa0, pa1, pa2, pa3); SBAR();
    if (FA_VIS(NT - 2)) pv_d0(o, vb0 + bm1, pa0, pa1, pa2, pa3); FA_MASK(pB0, pB1, NT - 1); partialSM(pB0, pB1, m_reg, mnB, alB);
    FA_RESC(alB);
    finishSM(pB0, pB1, alB, l_reg, pa0, pa1, pa2, pa3); SBAR();
    if (FA_VIS(NT - 1)) pv_d0(o, vb0 + bc, pa0, pa1, pa2, pa3);
    if (hi == 0) li_l[r32] = l_reg; asm volatile("s_waitcnt lgkmcnt(0)" ::: "memory");
    float rli[16];
#pragma unroll
    for (int r = 0; r < 16; ++r) rli[r] = __builtin_amdgcn_rcpf(li_l[crow(r, hi)]);
    FA_SYNC();
    LAS char* Ot = lds + wid * 8704;
#pragma unroll
    for (int r = 0; r < 16; ++r)
#pragma unroll
        for (int d0 = 0; d0 < 4; ++d0) *(LAS bf16_t*)(Ot + crow(r, hi) * 272 + (d0 * 32 + r32) * 2) = (bf16_t)f2bf(o[d0][r] * rli[r]);
    asm volatile("s_waitcnt lgkmcnt(0)" ::: "memory");
#pragma unroll
    for (int i = 0; i < 8; ++i) { const int idx = i * 64 + lane, row = idx >> 4, c16 = idx & 15;
        const u32x4 v = *(LAS const u32x4*)(Ot + row * 272 + c16 * 16); *(u32x4*)(Ob + (size_t)(wid * 32 + row) * ldo + c16 * 8) = v; }
    asm volatile("s_waitcnt lgkmcnt(0)" ::: "memory"); __builtin_amdgcn_s_barrier(); asm volatile("" ::: "memory");
#undef FA_DMA
#undef FA_SYNC
#undef FA_MASK
#undef FA_VIS
#undef FA_RESC
#undef FA_ROT
}
DI int vcu_of(int bx, int G) { return (G % 8 == 0) ? (bx % 8) * (G / 8) + bx / 8 : bx; }
DI void mla_phase(LAS char* lds, const bf16_t* Q, const bf16_t* KN, const bf16_t* KR, const bf16_t* V, bf16_t* AO, int G, int bx) {
    const int v = vcu_of(bx, G);
    for (int p = v; p < NB * HEADS * 8; p += G) { const int bh = p >> 3, i = p & 7, b = bh / HEADS, h = bh % HEADS;
#pragma unroll 1
        for (int s = 0; s < 2; ++s) { const int qb = s ? 15 - i : i; const size_t row0 = (size_t)b * S + qb * 256, key0 = (size_t)b * S;
            attn_unit<192, true>(lds, Q + row0 * NQ + h * QKD, NQ, KN + key0 * D + h * NOPE, D, KR + key0 * ROPE, ROPE, V + key0 * D + h * VD, D, AO + row0 * D + h * VD, D, 4 * qb + 4, 4 * qb); } }
}
DI void memattn_phase(LAS char* lds, const bf16_t* MQ, const bf16_t* MK, const bf16_t* MV, bf16_t* MO, int G, int bx) {
    for (int u = bx; u < NB * MH * (S / 256); u += G) { const int qb = u % (S / 256), h = (u / (S / 256)) % MH, b = u / (S / 256 * MH); const size_t row0 = (size_t)b * S + qb * 256, key0 = (size_t)b * MEMT;
        attn_unit<128, false>(lds, MQ + row0 * MI + h * MHD, MI, MK + key0 * MI + h * MHD, MI, nullptr, 0, MV + key0 * MI + h * MHD, MI, MO + row0 * MI + h * MHD, MI, MEMT / 64, 0); }
}
}

#ifndef H16
#define H16 1
#endif
#ifndef XCONV
#define XCONV 0
#endif
#ifndef XMLA
#define XMLA 0
#endif
#ifndef XMOE
#define XMOE 0
#endif
#ifndef XROUTER
#define XROUTER 0
#endif
#ifndef XDENSE
#define XDENSE 0
#endif
#ifndef XMEMATT
#define XMEMATT 0
#endif
#ifndef XCOMB
#define XCOMB 0
#endif
#ifndef XRES
#define XRES 0
#endif
#ifndef XUQ
#define XUQ 0
#endif
#ifndef XPOOL
#define XPOOL 0
#endif
constexpr int LDS_BYTES = 147456, LDS_MISC = 131072;
#define XB_TMO      128
#define XB_XCNT(j)  (256  + 64 * (j))
#define XB_XSUB(j)  (1280 + 64 * (j))
#define XB_XGEN(j)  (2304 + 64 * (j))
#define XB_TOP      3328
#define XB_TOPGEN   3392
#define XCD_BAR_WORDS 3456
#define XB_SPIN_CAP (1u << 18)
constexpr int CW_BAR = 4096;
DI unsigned xb_ld(unsigned* p)              { return __hip_atomic_load(p, __ATOMIC_RELAXED, __HIP_MEMORY_SCOPE_AGENT); }
DI unsigned xb_add(unsigned* p, unsigned v) { return __hip_atomic_fetch_add(p, v, __ATOMIC_RELAXED, __HIP_MEMORY_SCOPE_AGENT); }
DI unsigned xb_xcc_id() { return (unsigned)__builtin_amdgcn_s_getreg((3 << 11) | 20) & 0xFu; }
#define XB_SPIN(cond, bar) do { unsigned _sp = 0; while (cond) { __builtin_amdgcn_s_sleep(1); \
    if ((++_sp & 255u) == 0u) { if (xb_ld(&(bar)[XB_TMO])) break; if (_sp > XB_SPIN_CAP) { atomicAdd(&(bar)[XB_TMO], 1u); break; } } } } while (0)
struct XcdBarrier { unsigned* bar; unsigned x; volatile LAS unsigned* st; };
DI XcdBarrier xcd_barrier_post(unsigned* bar, volatile LAS unsigned* st) {
    XcdBarrier b; b.bar = bar; b.x = xb_xcc_id(); b.st = st;
    if (threadIdx.x == 0) (void)xb_add(&bar[XB_XCNT(b.x)], 1u);
    return b;
}
DI void xcd_barrier_complete(unsigned* bar, unsigned x, unsigned& nloc, unsigned& nx) {
    const unsigned G = gridDim.x * gridDim.y * gridDim.z;
    unsigned sum, cnt, mine, sp = 0u;
    for (;;) {
        sum = 0u; cnt = 0u; mine = 0u;
#pragma unroll
        for (unsigned j = 0; j < 16; ++j) { const unsigned c = xb_ld(&bar[XB_XCNT(j)]); sum += c; cnt += (c > 0u) ? 1u : 0u; mine = (j == x) ? c : mine; }
        if (sum == G) break;
        __builtin_amdgcn_s_sleep(1);
        if ((++sp & 255u) == 0u) { if (xb_ld(&bar[XB_TMO])) break; if (sp > XB_SPIN_CAP) { atomicAdd(&bar[XB_TMO], 1u); break; } }
    }
    nloc = mine > 0u ? mine : 1u; nx = cnt > 0u ? cnt : 1u;
}
DI void xcd_barrier(const XcdBarrier& b) {
    asm volatile("s_waitcnt vmcnt(0)" ::: "memory");
    __syncthreads();
    if (threadIdx.x == 0) {
        unsigned* bar = b.bar;
        __builtin_amdgcn_s_waitcnt(0);
        unsigned nloc = b.st[0], nx = b.st[1];
        if (nloc == 0u) { xcd_barrier_complete(bar, b.x, nloc, nx); b.st[0] = nloc; b.st[1] = nx; }
        const unsigned old = xb_add(&bar[XB_XSUB(b.x)], 1u);
        const unsigned gen = old / nloc;
        if (old + 1u == (gen + 1u) * nloc) {
            __builtin_amdgcn_fence(__ATOMIC_RELEASE, "agent");
            asm volatile("s_waitcnt vmcnt(0)" ::: "memory");
            const unsigned og = xb_add(&bar[XB_TOP], 1u);
            const unsigned tg = og / nx;
            if (og + 1u == (tg + 1u) * nx) xb_add(&bar[XB_TOPGEN], 1u);
            else XB_SPIN(xb_ld(&bar[XB_TOPGEN]) == tg, bar);
            __builtin_amdgcn_fence(__ATOMIC_ACQUIRE, "agent");
            xb_add(&bar[XB_XGEN(b.x)], 1u);
            asm volatile("s_waitcnt vmcnt(0)" ::: "memory");
        } else {
            XB_SPIN(xb_ld(&bar[XB_XGEN(b.x)]) == gen, bar);
            __builtin_amdgcn_fence(__ATOMIC_ACQUIRE, "agent");
            asm volatile("s_waitcnt vmcnt(0)" ::: "memory");
        }
    }
    __syncthreads();
}

#define LDS_WAIT() asm volatile("s_waitcnt lgkmcnt(0)" ::: "memory")
DI void wt_item(const float* W, int K, int N, bf16_t* WT, const float* kgain, const float* ngain, float scale, int perm, int row_off, LAS float* scr, int item, int lane) {
    const int nblk = N >> 5, kb = item / nblk, nb = item - kb * nblk, k0 = kb * 64, n0 = nb * 32, kr = lane >> 3, n4 = (lane & 7) * 4;
    f32x4 ng = {scale, scale, scale, scale}; if (ngain) ng = *(const f32x4*)(ngain + n0 + n4) * scale;
    f32x4 v[8];
#pragma unroll
    for (int i = 0; i < 8; ++i) v[i] = *(const f32x4*)(W + (size_t)(k0 + 8 * i + kr) * N + n0 + n4);
#pragma unroll
    for (int i = 0; i < 8; ++i) { const int k = 8 * i + kr; f32x4 x = v[i] * ng; if (kgain) x = x * kgain[k0 + k];
        scr[(n4 + 0) * 65 + k] = x.x; scr[(n4 + 1) * 65 + k] = x.y; scr[(n4 + 2) * 65 + k] = x.z; scr[(n4 + 3) * 65 + k] = x.w; }
    LDS_WAIT();
    const int kc = lane & 7;
#pragma unroll
    for (int q = 0; q < 4; ++q) { const int n = (lane >> 3) + 8 * q; const LAS float* sp = scr + n * 65 + 8 * kc;
        u32x4 o; o.x = pk2(sp[0], sp[1]); o.y = pk2(sp[2], sp[3]); o.z = pk2(sp[4], sp[5]); o.w = pk2(sp[6], sp[7]);
        *(u32x4*)(WT + (size_t)(row_off + permrow(perm, n0 + n)) * K + k0 + 8 * kc) = o; }
    LDS_WAIT();
}
struct MArgs { const void* in[32]; float* out; unsigned char* ws; int ph_lo, ph_hi, bar_region, pad; };
#define INF(i) ((const float*)P.in[i])
#define WSB(off) ((bf16_t*)(P.ws + (off)))
#define WSF(off) ((float*)(P.ws + (off)))
constexpr float SC_MEM = 0.08838834764831845f  , SC_MLA = 0.07216878364870323f  ;
DI void conv_phase(const MArgs& P, LAS unsigned char* lds, int gw, int NGW, int wave, int lane) {
    LAS float* scr = (LAS float*)(lds + wave * 16384);
    constexpr int I_POOL = 8 * 128, I_MQ = 4 * 512, I_MO = 4 * 512, I_E = 128 * 512, I_DQ = 512, I_KR = 64, I_UQ = 2 * 512, I_QR = 2 * 256, I_O = 2 * 2048, I_UK = 512;
    constexpr int NITEMS = I_POOL + 3 * I_MQ + I_MO + 3 * I_E + 3 * I_DQ + I_KR + I_UQ + I_QR + I_O + 2 * I_UK;
    for (int it = gw; it < NITEMS; it += NGW) {
        int r = it;
        if (r < I_E) { const int m = r >> 9; wt_item(INF(28) + (size_t)m * D * EFF, D, EFF, WSB(WS_WGU) + (size_t)m * 1024 * D, INF(6) + (m >> 5) * D, nullptr, 1.f, 3, 0, scr, r & 511, lane); continue; } r -= I_E;
        if (r < I_E) { const int m = r >> 9; wt_item(INF(29) + (size_t)m * D * EFF, D, EFF, WSB(WS_WGU) + (size_t)m * 1024 * D, INF(6) + (m >> 5) * D, nullptr, 1.f, 4, 0, scr, r & 511, lane); continue; } r -= I_E;
        if (r < I_E) { const int m = r >> 9; wt_item(INF(30) + (size_t)m * EFF * D, EFF, D, WSB(WS_WD) + (size_t)m * D * EFF, nullptr, nullptr, 1.f, 0, 0, scr, r & 511, lane); continue; } r -= I_E;
        if (r < I_POOL) { const int m = r >> 7; wt_item(INF(7) + (size_t)m * PG * PG, PG, PG, WSB(WS_WPOOL) + (size_t)(m >> 2) * D * PG, nullptr, INF(8) + (m >> 2) * D + (m & 3) * PG, 1.f, 0, (m & 3) * PG, scr, r & 127, lane); continue; } r -= I_POOL;
        if (r < I_MQ) { const int m = r >> 9; wt_item(INF(20) + (size_t)m * D * MI, D, MI, WSB(WS_WMQ) + (size_t)m * MI * D, INF(4) + m * D, nullptr, SC_MEM, 0, 0, scr, r & 511, lane); continue; } r -= I_MQ;
        if (r < I_MQ) { const int m = r >> 9; wt_item(INF(21) + (size_t)m * D * MI, D, MI, WSB(WS_WMK) + (size_t)m * MI * D, INF(5) + m * D, nullptr, 1.f, 0, 0, scr, r & 511, lane); continue; } r -= I_MQ;
        if (r < I_MQ) { const int m = r >> 9; wt_item(INF(22) + (size_t)m * D * MI, D, MI, WSB(WS_WMV) + (size_t)m * MI * D, INF(5) + m * D, nullptr, 1.f, 0, 0, scr, r & 511, lane); continue; } r -= I_MQ;
        if (r < I_MO) { const int m = r >> 9; wt_item(INF(23) + (size_t)m * MI * D, MI, D, WSB(WS_WMO) + (size_t)m * D * MI, nullptr, nullptr, 1.f, 0, 0, scr, r & 511, lane); continue; } r -= I_MO;
        if (r < I_DQ) { wt_item(INF(15), D, QR, WSB(WS_WDQ0), INF(3) + 2 * D, nullptr, 1.f, 0, 0, scr, r, lane); continue; } r -= I_DQ;
        if (r < I_DQ) { wt_item(INF(10), D, KVR, WSB(WS_WDQ0), INF(9), nullptr, 1.f, 0, 512, scr, r, lane); continue; } r -= I_DQ;
        if (r < I_KR) { wt_item(INF(12), D, ROPE, WSB(WS_WDQ0), INF(9), nullptr, 1.f, 5, 1024, scr, r, lane); continue; } r -= I_KR;
        if (r < I_DQ) { wt_item(INF(15) + (size_t)D * QR, D, QR, WSB(WS_WDQ1), INF(3) + 3 * D, nullptr, 1.f, 0, 0, scr, r, lane); continue; } r -= I_DQ;
        if (r < I_UQ) { const int m = r >> 9; wt_item(INF(17) + (size_t)m * QR * D, QR, HEADS * NOPE, WSB(WS_WUQ) + (size_t)m * NQ * QR, INF(16) + m * QR, nullptr, SC_MLA, 1, 0, scr, r & 511, lane); continue; } r -= I_UQ;
        if (r < I_QR) { const int m = r >> 8; wt_item(INF(18) + (size_t)m * QR * HEADS * ROPE, QR, HEADS * ROPE, WSB(WS_WUQ) + (size_t)m * NQ * QR, INF(16) + m * QR, nullptr, SC_MLA, 2, 0, scr, r & 255, lane); continue; } r -= I_QR;
        if (r < I_O) { const int m = r >> 11; wt_item(INF(19) + (size_t)m * D * D, D, D, WSB(WS_WO) + (size_t)m * D * D, nullptr, nullptr, 1.f, 0, 0, scr, r & 2047, lane); continue; } r -= I_O;
        if (r < I_UK) { wt_item(INF(13), KVR, D, WSB(WS_WUKV), INF(11), nullptr, 1.f, 0, 0, scr, r, lane); continue; } r -= I_UK;
        wt_item(INF(14), KVR, D, WSB(WS_WUKV), INF(11), nullptr, 1.f, 0, 2048, scr, r, lane);
    }
}
DI void tables_phase(const MArgs& P, int gtid, int NT_) {
    for (int idx = gtid; idx < T * 32; idx += NT_) { const int t = idx >> 5, i = idx & 31;
        const float inv = (float)(1.0 / pow(10000.0, (double)i / 32.0)); const float ang = (float)((const int*)P.in[2])[t] * inv;
        const double rev = (double)ang * 0.15915494309189533577; const float fr = (float)(rev - rint(rev));
        WSF(WS_COS)[idx] = __builtin_amdgcn_cosf(fr); WSF(WS_SIN)[idx] = __builtin_amdgcn_sinf(fr); }
    for (int idx = gtid; idx < DEPTH * 48 * D; idx += NT_) { const int l = idx / (48 * D), n = (idx / D) % 48, k = idx % D;
        float w = 0.f; if (n < 36) w = (n < 4 ? INF(24)[((size_t)l * D + k) * 4 + n] : INF(26)[((size_t)l * D + k) * 32 + (n - 4)]) * INF(6)[l * D + k];
        const unsigned hi = f2bf(w), lo = f2bf(w - __uint_as_float(hi << 16));
        WSB(WS_RWH)[((size_t)(l * 2 + 0) * 48 + n) * D + k] = (bf16_t)hi; WSB(WS_RWH)[((size_t)(l * 2 + 1) * 48 + n) * D + k] = (bf16_t)lo; }
    unsigned* z = (unsigned*)(WSB(WS_WDQ0) + (size_t)1088 * D);
    for (int idx = gtid; idx < (NDQ0 - 1088) * D / 2; idx += NT_) z[idx] = 0u;
}
DI void memprep_phase(const MArgs& P, int gw, int NGW, int lane) {
    for (int r = gw; r < NB * MEMT; r += NGW) { const f32x4* x = (const f32x4*)(INF(1) + (size_t)r * D) + lane; float ss = 0.f;
#pragma unroll
        for (int j = 0; j < 8; ++j) { const f32x4 v = x[64 * j]; ss += (v.x * v.x + v.y * v.y) + (v.z * v.z + v.w * v.w);
            u32x2 o; o.x = pk2(v.x, v.y); o.y = pk2(v.z, v.w); *((u32x2*)(WSB(WS_MEMB) + (size_t)r * D) + lane + 64 * j) = o; }
        ss = wave_sum(ss); if (lane == 0) WSF(WS_MEMRS)[r] = rsqrtf(ss * (1.0f / D) + EPS); }
}
DI void combine_phase(const float* src, const bf16_t* src16, const bf16_t* Y, float* H, bf16_t* HB, float* RS0, const float* gain, bf16_t* HN, float* out, int gw, int NGW, int lane) {
    for (int t = gw; t < T; t += NGW) {
        const f32x4* x = (const f32x4*)(src + (size_t)t * D) + lane; f32x4 v[8]; float ss = 0.f;
#pragma unroll
        for (int j = 0; j < 8; ++j) {
            if (src16) { const u32x2 h = *((const u32x2*)(src16 + (size_t)t * D) + lane + 64 * j); v[j] = (f32x4){__uint_as_float(h.x << 16), __uint_as_float(h.x & 0xffff0000u), __uint_as_float(h.y << 16), __uint_as_float(h.y & 0xffff0000u)}; }
            else v[j] = x[64 * j];
            if (Y) { const u32x2 a = *((const u32x2*)(Y + (size_t)(2 * t) * D) + lane + 64 * j), b = *((const u32x2*)(Y + (size_t)(2 * t + 1) * D) + lane + 64 * j);
                v[j].x = (v[j].x + __uint_as_float(a.x << 16)) + __uint_as_float(b.x << 16); v[j].y = (v[j].y + __uint_as_float(a.x & 0xffff0000u)) + __uint_as_float(b.x & 0xffff0000u);
                v[j].z = (v[j].z + __uint_as_float(a.y << 16)) + __uint_as_float(b.y << 16); v[j].w = (v[j].w + __uint_as_float(a.y & 0xffff0000u)) + __uint_as_float(b.y & 0xffff0000u); }
            ss += (v[j].x * v[j].x + v[j].y * v[j].y) + (v[j].z * v[j].z + v[j].w * v[j].w); }
        ss = wave_sum(ss); const float rs = rsqrtf(ss * (1.0f / D) + EPS);
        if (lane == 0 && RS0) RS0[t] = rs;
#pragma unroll
        for (int j = 0; j < 8; ++j) {
            if (H) *((f32x4*)(H + (size_t)t * D) + lane + 64 * j) = v[j];
            if (HB) { u32x2 o; o.x = pk2(v[j].x, v[j].y); o.y = pk2(v[j].z, v[j].w); *((u32x2*)(HB + (size_t)t * D) + lane + 64 * j) = o; }
            if (gain) { const f32x4 g = *((const f32x4*)gain + lane + 64 * j); const f32x4 n = v[j] * g * rs;
                if (HN) { u32x2 o; o.x = pk2(n.x, n.y); o.y = pk2(n.z, n.w); *((u32x2*)(HN + (size_t)t * D) + lane + 64 * j) = o; }
                if (out) *((f32x4*)(out + (size_t)t * D) + lane + 64 * j) = n; } }
    }
}
DI void pool_phase(const bf16_t* HN, bf16_t* U, int vcu, int G, int tid) {
    if (vcu < 0) return;
    for (int t = vcu * 2 + (tid >> 8); t < T; t += 2 * G) { const int c = (tid & 255) * 8, s = t & (S - 1), w = 2 << (c >> 9), n = (s + 1 < w) ? s + 1 : w;
        float acc[8] = {0.f, 0.f, 0.f, 0.f, 0.f, 0.f, 0.f, 0.f}, self[8] = {0.f, 0.f, 0.f, 0.f, 0.f, 0.f, 0.f, 0.f};
        for (int i = 0; i < n; ++i) { const u32x4 v = *(const u32x4*)(HN + (size_t)(t - i) * D + c);
            const float f[8] = {__uint_as_float(v.x << 16), __uint_as_float(v.x & 0xffff0000u), __uint_as_float(v.y << 16), __uint_as_float(v.y & 0xffff0000u),
                                __uint_as_float(v.z << 16), __uint_as_float(v.z & 0xffff0000u), __uint_as_float(v.w << 16), __uint_as_float(v.w & 0xffff0000u)};
#pragma unroll
            for (int q = 0; q < 8; ++q) { acc[q] += f[q]; if (i == 0) self[q] = f[q]; } }
        const float inv = 1.0f / (float)n; u32x4 o;
        o.x = pk2(acc[0] * inv - self[0], acc[1] * inv - self[1]); o.y = pk2(acc[2] * inv - self[2], acc[3] * inv - self[3]);
        o.z = pk2(acc[4] * inv - self[4], acc[5] * inv - self[5]); o.w = pk2(acc[6] * inv - self[6], acc[7] * inv - self[7]);
        *(u32x4*)(U + (size_t)t * D + c) = o; }
}
typedef float f32x4r __attribute__((ext_vector_type(4)));
DI void router_phase(const float* H, const bf16_t* HBs, const bf16_t* RWH, const float* rg_b, const float* re_b, float* RS2, int* cnt, int* list, float* gwt, LAS unsigned char* lds, int vcu, int G, int wave, int lane, bool commit = true) {
    LAS float* tile = (LAS float*)(lds + wave * 4096);
    const bf16_t* RWL = RWH + (size_t)48 * D;
    for (int t16 = wave * G + vcu; t16 < T / 16; t16 += 8 * G) {
        const int r16 = lane & 15, kq = lane >> 4;
        const float* hp = H + (size_t)(t16 * 16 + r16) * D + kq * 8; const bf16_t* hb = HBs + (size_t)(t16 * 16 + r16) * D + kq * 8;
        const bf16_t* wh = RWH + (size_t)r16 * D + kq * 8; const bf16_t* wl = RWL + (size_t)r16 * D + kq * 8;
        f32x4 acc[3]; float ss = 0.f;
#pragma unroll
        for (int q = 0; q < 3; ++q) acc[q] = (f32x4){0.f, 0.f, 0.f, 0.f};
        for (int k0 = 0; k0 < D; k0 += 128) {
            f32x4 xa[4], xb[4];
#pragma unroll
            for (int u = 0; u < 4; ++u) {
                if (H16) { const u32x4 w = *(const u32x4*)(hb + k0 + u * 32);
                    xa[u] = (f32x4){__uint_as_float(w.x << 16), __uint_as_float(w.x & 0xffff0000u), __uint_as_float(w.y << 16), __uint_as_float(w.y & 0xffff0000u)};
                    xb[u] = (f32x4){__uint_as_float(w.z << 16), __uint_as_float(w.z & 0xffff0000u), __uint_as_float(w.w << 16), __uint_as_float(w.w & 0xffff0000u)}; }
                else { xa[u] = *(const f32x4*)(hp + k0 + u * 32); xb[u] = *(const f32x4*)(hp + k0 + u * 32 + 4); } }
#pragma unroll
            for (int u = 0; u < 4; ++u) {
                const f32x4 a = xa[u], b = xb[u];
                ss += ((a.x * a.x + a.y * a.y) + (a.z * a.z + a.w * a.w)) + ((b.x * b.x + b.y * b.y) + (b.z * b.z + b.w * b.w));
                u32x4 h; h.x = fg::cvt_pk_bf16(a.x, a.y); h.y = fg::cvt_pk_bf16(a.z, a.w); h.z = fg::cvt_pk_bf16(b.x, b.y); h.w = fg::cvt_pk_bf16(b.z, b.w);
                u32x4 lo; lo.x = fg::cvt_pk_bf16(a.x - __uint_as_float(h.x << 16), a.y - __uint_as_float(h.x & 0xffff0000u)); lo.y = fg::cvt_pk_bf16(a.z - __uint_as_float(h.y << 16), a.w - __uint_as_float(h.y & 0xffff0000u));
                lo.z = fg::cvt_pk_bf16(b.x - __uint_as_float(h.z << 16), b.y - __uint_as_float(h.z & 0xffff0000u)); lo.w = fg::cvt_pk_bf16(b.z - __uint_as_float(h.w << 16), b.w - __uint_as_float(h.w & 0xffff0000u));
                const bf16x8 ah = *reinterpret_cast<const bf16x8*>(&h), al_ = *reinterpret_cast<const bf16x8*>(&lo);
#pragma unroll
                for (int q = 0; q < 3; ++q) { const bf16x8 bh = *(const bf16x8*)(wh + (size_t)q * 16 * D + k0 + u * 32), bl = *(const bf16x8*)(wl + (size_t)q * 16 * D + k0 + u * 32);
                    acc[q] = __builtin_amdgcn_mfma_f32_16x16x32_bf16(ah, bh, acc[q], 0, 0, 0);
                    if (!H16) acc[q] = __builtin_amdgcn_mfma_f32_16x16x32_bf16(al_, bh, acc[q], 0, 0, 0);
                    acc[q] = __builtin_amdgcn_mfma_f32_16x16x32_bf16(ah, bl, acc[q], 0, 0, 0); }
            }
        }
        ss = fg::quad_sum(ss);
        const float rs = rsqrtf(ss * (1.0f / D) + EPS);
#pragma unroll
        for (int q = 0; q < 3; ++q)
#pragma unroll
            for (int i = 0; i < 4; ++i) tile[(kq * 4 + i) * 49 + q * 16 + r16] = acc[q][i];
        LDS_WAIT();
        if (lane < 16) {
            const LAS float* tr = tile + lane * 49; const int t = t16 * 16 + lane;
            const float g0 = tr[0] * rs + rg_b[0], g1 = tr[1] * rs + rg_b[1], g2 = tr[2] * rs + rg_b[2], g3 = tr[3] * rs + rg_b[3];
            int gs = 0; float gm = g0; if (g1 > gm) { gm = g1; gs = 1; } if (g2 > gm) { gm = g2; gs = 2; } if (g3 > gm) { gm = g3; gs = 3; }
            const float gp = 1.0f / (__expf(g0 - gm) + __expf(g1 - gm) + __expf(g2 - gm) + __expf(g3 - gm));
            float ev[8];
#pragma unroll
            for (int i = 0; i < 8; ++i) ev[i] = tr[4 + gs * 8 + i] * rs + re_b[gs * 8 + i];
            int i0 = 0; float m0 = ev[0];
#pragma unroll
            for (int i = 1; i < 8; ++i) if (ev[i] > m0) { m0 = ev[i]; i0 = i; }
            int i1 = -1; float m1 = -3.0e38f;
#pragma unroll
            for (int i = 0; i < 8; ++i) if (i != i0 && ev[i] > m1) { m1 = ev[i]; i1 = i; }
            const float e1 = __expf(m1 - m0), w0 = gp / (1.0f + e1), w1 = gp * e1 / (1.0f + e1);
            if (commit || w0 < -1.f) { RS2[t] = rs; const int ea = gs * 8 + i0, eb = gs * 8 + i1;
                const int pa = atomicAdd(&cnt[ea], 1); list[(size_t)ea * CAP + pa] = 2 * t; gwt[2 * t] = w0;
                const int pb = atomicAdd(&cnt[eb], 1); list[(size_t)eb * CAP + pb] = 2 * t + 1; gwt[2 * t + 1] = w1; }
        }
        LDS_WAIT();
    }
}
namespace fg {
struct EpiMemKV {
    bf16_t* O; const float* rs;
    DI void operator()(const Acc& acc, const Unit& u, int wr, int wc, int fr, int fq) const {
        float sc[2][4];
#pragma unroll
        for (int ai = 0; ai < 2; ++ai)
#pragma unroll
            for (int m = 0; m < 4; ++m) sc[ai][m] = rs[u.pm * BM + EPI_ROWS(ai, m)];
#pragma unroll
        for (int ai = 0; ai < 2; ++ai)
#pragma unroll
            for (int m = 0; m < 4; ++m) { const int r = u.pm * BM + EPI_ROWS(ai, m);
#pragma unroll
                for (int bj = 0; bj < 2; ++bj) { const int c0 = (u.pn & 1) * BM + bj * HALF + wc * 32 + 8 * fq;
                    *(u32x4*)(O + (size_t)(u.pn >> 1) * (NB * MEMT * MI) + (size_t)r * MI + c0) = pack8(acc[ai][bj][m][0] * sc[ai][m], acc[ai][bj][m][1] * sc[ai][m]); } }
    }
};
}
DI int scan32(int v, int lane) {
#pragma unroll
    for (int o = 1; o < 32; o <<= 1) { const int t = __builtin_amdgcn_ds_bpermute(((lane - o) & 63) << 2, v); if ((lane & 31) >= o) v += t; }
    return v;
}
DI void moe_prefix(LAS unsigned char* lds, const int* cnt) {
    LAS int* pref = (LAS int*)(lds + LDS_MISC + 1024); const int tid = opaque_tid();
    if (tid < 64) {
        const int e = tid & 31, c = cnt[e], nt = (c + 255) >> 8, st = scan32(nt, tid);
        if (tid < 32) { pref[64 + e] = c; pref[e] = st - nt; if (e == 31) pref[32] = st; }
    }
    __syncthreads();
    if (tid == 0) {
        const int G = gridDim.x, nx = (G & 7) ? 1 : 8, x = blockIdx.x % nx; int n = 0;
        for (int e = x; e < NE; e += nx) { const int nt = (pref[64 + e] + 255) >> 8, base = pref[e]; for (int t = 0; t < nt; ++t) pref[128 + n++] = e | (t << 8) | ((base + t) << 16); }
        pref[40] = n; }
    __syncthreads();
}

__global__ void __launch_bounds__(512, 2) mk_fwd(MArgs a) {
    extern __shared__ __attribute__((aligned(16))) unsigned char lds_raw[];
    LAS unsigned char* lds = (LAS unsigned char*)lds_raw;
    const int G = gridDim.x, bx = blockIdx.x, vcu = fa::vcu_of(bx, G), NGW = G * 8;
    volatile LAS unsigned* MISC = (volatile LAS unsigned*)(lds + LDS_MISC);
    if (threadIdx.x < 64) MISC[threadIdx.x] = 0u;
    __syncthreads();
    unsigned char* ws = a.ws;
    XcdBarrier bar = xcd_barrier_post((unsigned*)(ws + WS_CTL) + CW_BAR + a.bar_region * XCD_BAR_WORDS, MISC + 8);
    const MArgs& P = a;
    int pid = 0; const int lo = a.ph_lo, hi = a.ph_hi;
#define PH_IF if (pid >= lo && pid < hi)
#define TL const int tid = opaque_tid(), lane = tid & 63, wave = __builtin_amdgcn_readfirstlane(tid >> 6), gw = vcu * 8 + wave; (void)lane; (void)gw
#define PH_END do { if (pid >= lo && pid + 1 < hi) xcd_barrier(bar); ++pid; } while (0)
    PH_IF { TL; conv_phase(P, lds, gw, NGW, wave, lane); if (XCONV) conv_phase(P, lds, gw, NGW, wave, lane); tables_phase(P, vcu * 512 + tid, G * 512); memprep_phase(P, gw, NGW, lane);
            combine_phase(INF(0), nullptr, nullptr, H16 ? nullptr : WSF(WS_H), WSB(WS_HB), WSF(WS_RS0), INF(3), WSB(WS_HN), nullptr, gw, NGW, lane); }
    PH_END;
    for (int l = 0; l < DEPTH; ++l) {
        const bool isA = l < NA; const int j = l - NA;
        if (l > 0) { PH_IF { TL; if (XCOMB) combine_phase(WSF(WS_H), H16 ? WSB(WS_HB) : nullptr, WSB(WS_Y), WSF(WS_Q), nullptr, nullptr, nullptr, nullptr, nullptr, gw, NGW, lane);
            combine_phase(WSF(WS_H), H16 ? WSB(WS_HB) : nullptr, WSB(WS_Y), H16 ? nullptr : WSF(WS_H), WSB(WS_HB), WSF(WS_RS0), isA ? INF(3) + l * D : nullptr, isA ? WSB(WS_HN) : nullptr, nullptr, gw, NGW, lane); } PH_END; }
        if (isA) {
            PH_IF { if (l == 0) { fg::ProbDense pr{(const char*)WSB(WS_MEMB), (const char*)WSB(WS_WMK), (const char*)WSB(WS_MEMB), (const char*)WSB(WS_WMK), NB * MEMT / 256, 16, 16, D, D, 0, G, bx}; fg::EpiMemKV E{WSB(WS_MK), WSF(WS_MEMRS)}; fg::gemm_phase(lds, pr, E); }
                    { TL; const bool split = (l == 0 && G > 64); pool_phase(WSB(WS_HN), WSB(WS_U), split ? bx - 64 : vcu, split ? G - 64 : G, tid); if (XPOOL) pool_phase(WSB(WS_HN), WSB(WS_U), vcu, G, tid); } }
            PH_END;
        } else {
            PH_IF { const int n = j == 0 ? NDQ0 : QR; const char* B = (const char*)(j == 0 ? WSB(WS_WDQ0) : WSB(WS_WDQ1));
                    fg::ProbDense pr{(const char*)WSB(WS_HB), B, (const char*)WSB(WS_HB), B, T / 256, n / 256, n / 256, D, D, 0, G, bx};
                    fg::EpiDQ E{WSB(WS_CQ), WSB(WS_CKV), WSB(WS_KR), WSF(WS_RS0), WSF(WS_LSQ), WSF(WS_LSKV), WSF(WS_COS), WSF(WS_SIN)}; fg::gemm_phase(lds, pr, E); if (XDENSE) fg::gemm_phase(lds, pr, E); }
            PH_END;
            PH_IF { fg::ProbDense pr{(const char*)WSB(WS_CQ), (const char*)(WSB(WS_WUQ) + (size_t)j * NQ * QR), (const char*)WSB(WS_CKV), (const char*)WSB(WS_WUKV), T / 256, (j == 0 ? NQ + 4096 : NQ) / 256, NQ / 256, QR, QR, 0, G, bx};
                    fg::EpiUQ E{WSB(WS_Q), WSB(WS_KN), WSB(WS_V), WSF(WS_LSQ), WSF(WS_LSKV), WSF(WS_COS), WSF(WS_SIN)}; fg::gemm_phase(lds, pr, E); if (XUQ) fg::gemm_phase(lds, pr, E); }
            PH_END;
            PH_IF { fa::mla_phase((LAS char*)lds, WSB(WS_Q), WSB(WS_KN), WSB(WS_KR), WSB(WS_V), WSB(WS_AO), G, bx); if (XMLA) fa::mla_phase((LAS char*)lds, WSB(WS_Q), WSB(WS_KN), WSB(WS_KR), WSB(WS_V), WSB(WS_AO), G, bx); }
            PH_END;
        }
        PH_IF { const char* A = (const char*)(isA ? WSB(WS_U) : WSB(WS_AO)); const char* B = (const char*)(isA ? WSB(WS_WPOOL) + (size_t)l * D * PG : WSB(WS_WO) + (size_t)j * D * D);
                fg::ProbDense pr{A, B, A, B, T / 256, D / 256, D / 256, isA ? PG : D, D, isA ? 1 : 0, G, bx}; fg::EpiRes<true> E{WSB(WS_HB), WSF(WS_SSP)}; if (XRES) { fg::EpiRes<true> E2{WSB(WS_HB), WSF(WS_SSP), WSB(WS_Y)}; fg::gemm_phase(lds, pr, E2); } fg::gemm_phase(lds, pr, E); }
        PH_END;
        PH_IF { const char* B = (const char*)(WSB(WS_WMQ) + (size_t)l * MI * D); fg::ProbDense pr{(const char*)WSB(WS_HB), B, (const char*)WSB(WS_HB), B, T / 256, MI / 256, MI / 256, D, D, 0, G, bx};
                fg::EpiBf16RS<2> E{WSB(WS_MQ), MI, WSF(WS_SSP)}; fg::gemm_phase(lds, pr, E); if (XDENSE) fg::gemm_phase(lds, pr, E); }
        PH_END;
        PH_IF { fa::memattn_phase((LAS char*)lds, WSB(WS_MQ), WSB(WS_MK) + (size_t)l * NB * MEMT * MI, WSB(WS_MV) + (size_t)l * NB * MEMT * MI, WSB(WS_MO), G, bx); if (XMEMATT) fa::memattn_phase((LAS char*)lds, WSB(WS_MQ), WSB(WS_MK) + (size_t)l * NB * MEMT * MI, WSB(WS_MV) + (size_t)l * NB * MEMT * MI, WSB(WS_MO), G, bx); }
        PH_END;
        PH_IF { const char* B = (const char*)(WSB(WS_WMO) + (size_t)l * D * MI); fg::ProbDense pr{(const char*)WSB(WS_MO), B, (const char*)WSB(WS_MO), B, T / 256, D / 256, D / 256, MI, MI, 0, G, bx};
                fg::EpiRes<false> E{WSB(WS_HB), nullptr}; if (XRES) { fg::EpiRes<false> E2{WSB(WS_HB), nullptr, WSB(WS_Y)}; fg::gemm_phase(lds, pr, E2); } fg::gemm_phase(lds, pr, E); }
        PH_END;
        PH_IF { TL; if (XROUTER) router_phase(WSF(WS_H), WSB(WS_HB), WSB(WS_RWH) + (size_t)l * 2 * 48 * D, INF(25) + l * NG, INF(27) + l * NE, WSF(WS_RS2), ((int*)(P.ws + WS_CTL + OFF_CNT)) + l * NE, ((int*)(P.ws + WS_LIST)), WSF(WS_GW), lds, vcu, G, wave, lane, false);
                router_phase(WSF(WS_H), WSB(WS_HB), WSB(WS_RWH) + (size_t)l * 2 * 48 * D, INF(25) + l * NG, INF(27) + l * NE, WSF(WS_RS2), ((int*)(P.ws + WS_CTL + OFF_CNT)) + l * NE, ((int*)(P.ws + WS_LIST)), WSF(WS_GW), lds, vcu, G, wave, lane); }
        PH_END;
        PH_IF { moe_prefix(lds, ((int*)(P.ws + WS_CTL + OFF_CNT)) + l * NE);
                fg::ProbMoe pr{(const char*)WSB(WS_HB), (const char*)(WSB(WS_WGU) + (size_t)l * NE * 1024 * D), ((int*)(P.ws + WS_LIST)), (const LAS int*)(lds + LDS_MISC + 1024), 4, D, D, 1, G, bx, (long)1024 * D * 2};
                fg::EpiMoe1 E{WSB(WS_HH), WSF(WS_RS2), ((int*)(P.ws + WS_LIST))}; fg::gemm_phase(lds, pr, E); if (XMOE == 1) fg::gemm_phase(lds, pr, E); if (XMOE == 2) fg::gemm_phase<decltype(E), decltype(pr), true>(lds, pr, E); }
        PH_END;
        PH_IF { moe_prefix(lds, ((int*)(P.ws + WS_CTL + OFF_CNT)) + l * NE);
                fg::ProbMoe pr{(const char*)WSB(WS_HH), (const char*)(WSB(WS_WD) + (size_t)l * NE * D * EFF), ((int*)(P.ws + WS_LIST)), (const LAS int*)(lds + LDS_MISC + 1024), 8, EFF, EFF, 0, G, bx, (long)D * EFF * 2};
                fg::EpiMoe2 E{WSB(WS_Y), WSF(WS_GW), ((int*)(P.ws + WS_LIST))}; fg::gemm_phase(lds, pr, E); if (XMOE == 1) fg::gemm_phase(lds, pr, E); if (XMOE == 2) fg::gemm_phase<decltype(E), decltype(pr), true>(lds, pr, E); }
        PH_END;
    }
    PH_IF { TL; combine_phase(WSF(WS_H), H16 ? WSB(WS_HB) : nullptr, WSB(WS_Y), nullptr, nullptr, nullptr, INF(31), nullptr, P.out, gw, NGW, lane); }
#undef PH_IF
#undef PH_END
}
constexpr int NPHASES = 1 + 8 + 9 + 11 + 11 + 1;

#ifndef MK_SPLIT
#define MK_SPLIT 0
#endif
extern "C" void kernel_launch(void* const* d_in, const int* in_sizes, int n_in, void* d_out, int out_size, void* d_ws, size_t ws_size, hipStream_t stream) {
    static int grid = 0;
    if (grid == 0) {
        if (n_in != 32 || in_sizes[0] != T * D || out_size != T * D || ws_size < WS_END) { fprintf(stderr, "kernel_launch: shape/ws mismatch (ws %zu need %zu)\n", ws_size, (size_t)WS_END); grid = -1; return; }
        int dev = 0, cus = 0;
        if (hipGetDevice(&dev) != hipSuccess || hipDeviceGetAttribute(&cus, hipDeviceAttributeMultiprocessorCount, dev) != hipSuccess || cus <= 0) { fprintf(stderr, "kernel_launch: device query failed\n"); grid = -1; return; }
        if (hipFuncSetAttribute((const void*)mk_fwd, hipFuncAttributeMaxDynamicSharedMemorySize, LDS_BYTES) != hipSuccess) { fprintf(stderr, "kernel_launch: hipFuncSetAttribute failed\n"); grid = -1; return; }
        int per_cu = 0;
        if (hipOccupancyMaxActiveBlocksPerMultiprocessor(&per_cu, (const void*)mk_fwd, 512, LDS_BYTES) != hipSuccess || per_cu < 1) fprintf(stderr, "kernel_launch: occupancy query says %d\n", per_cu);
        (void)hipGetLastError();
        grid = cus;
    }
    if (grid < 0) return;
    if (hipMemsetAsync((char*)d_ws + WS_CTL, 0, CTL_BYTES, stream) != hipSuccess) { fprintf(stderr, "kernel_launch: memset failed\n"); return; }
    MArgs a; memset(&a, 0, sizeof(a));
    for (int i = 0; i < 32; ++i) a.in[i] = d_in[i];
    a.out = (float*)d_out; a.ws = (unsigned char*)d_ws;
#if MK_SPLIT
    for (int p = 0; p < NPHASES; ++p) { a.ph_lo = p; a.ph_hi = p + 1; a.bar_region = 0; hipLaunchKernelGGL(mk_fwd, dim3(grid), dim3(512), LDS_BYTES, stream, a); }
#else
    a.ph_lo = 0; a.ph_hi = NPHASES; a.bar_region = 0; hipLaunchKernelGGL(mk_fwd, dim3(grid), dim3(512), LDS_BYTES, stream, a);
#endif
    const hipError_t le = hipPeekAtLastError();
    if (le != hipSuccess) fprintf(stderr, "kernel_launch: launch failed: %s\n", hipGetErrorName(le));
}
```

```cpp
#include <hip/hip_runtime.h>
#include <cstdio>
#include <cstdint>
#include <cstring>

typedef unsigned short bf16_t;
typedef float f32x4 __attribute__((ext_vector_type(4)));
typedef unsigned u32x4 __attribute__((ext_vector_type(4)));
typedef unsigned u32x2 __attribute__((ext_vector_type(2)));
#define DI __device__ __forceinline__

constexpr int D = 2048, NB = 4, S = 4096, T = NB * S, DEPTH = 4, NA = 2;
constexpr int CHUNK = 64;
constexpr int PG = 512;
constexpr int HEADS = 16, QR = 512, KVR = 512, NOPE = 128, ROPE = 64, VD = 128, QKD = NOPE + ROPE;
constexpr int MEMT = 256, MH = 4, MHD = 128, MI = 512;
constexpr int NG = 4, EPG = 8, NE = 32, EFF = 512;
constexpr float EPS = 1e-6f;
constexpr int CAP = T;
constexpr int MAXROWS = 2 * T + NE * 256;
constexpr int NQ = HEADS * QKD;
constexpr int NDQ0 = 1280;

constexpr size_t al(size_t x) { return (x + 255) & ~(size_t)255; }
constexpr size_t WS_CTL = 0, CTL_BYTES = 1u << 20;
constexpr size_t OFF_CNT = 65536;
constexpr size_t WS_WPOOL = WS_CTL + CTL_BYTES;
constexpr size_t WS_WMQ = WS_WPOOL + (size_t)NA * D * PG * 2;
constexpr size_t WS_WMK = WS_WMQ + (size_t)DEPTH * MI * D * 2;
constexpr size_t WS_WMV = WS_WMK + (size_t)DEPTH * MI * D * 2;
constexpr size_t WS_WMO = WS_WMV + (size_t)DEPTH * MI * D * 2;
constexpr size_t WS_WDQ0 = WS_WMO + (size_t)DEPTH * D * MI * 2;
constexpr size_t WS_WDQ1 = WS_WDQ0 + (size_t)NDQ0 * D * 2;
constexpr size_t WS_WUQ = WS_WDQ1 + (size_t)QR * D * 2;
constexpr size_t WS_WUKV = WS_WUQ + (size_t)2 * NQ * QR * 2;
constexpr size_t WS_WO = WS_WUKV + (size_t)4096 * KVR * 2;
constexpr size_t WS_RWT = WS_WO + (size_t)2 * D * D * 2;
constexpr size_t WS_WGU = al(WS_RWT + (size_t)DEPTH * 36 * D * 4);
constexpr size_t WS_WD = WS_WGU + (size_t)DEPTH * NE * 1024 * D * 2;
constexpr size_t WS_H = WS_WD + (size_t)DEPTH * NE * D * EFF * 2;
constexpr size_t WS_HB = WS_H + (size_t)T * D * 4;
constexpr size_t WS_Y = WS_HB + (size_t)T * D * 2;
constexpr size_t WS_HH = WS_Y + (size_t)2 * T * D * 2;
constexpr size_t WS_KN = WS_HH + (size_t)MAXROWS * EFF * 2;
constexpr size_t WS_V = WS_KN + (size_t)T * D * 2;
constexpr size_t WS_Q = WS_V + (size_t)T * D * 2;
constexpr size_t WS_HN = WS_Q;
constexpr size_t WS_U = WS_Q + (size_t)T * D * 2;
constexpr size_t WS_AO = WS_Q + (size_t)T * NQ * 2;
constexpr size_t WS_MQ = WS_AO + (size_t)T * D * 2;
constexpr size_t WS_MO = WS_MQ + (size_t)T * MI * 2;
constexpr size_t WS_CQ = WS_MO + (size_t)T * MI * 2;
constexpr size_t WS_CKV = WS_CQ + (size_t)T * QR * 2;
constexpr size_t WS_KR = WS_CKV + (size_t)T * KVR * 2;
constexpr size_t WS_MEMB = WS_KR + (size_t)T * ROPE * 2;
constexpr size_t WS_MK = WS_MEMB + (size_t)NB * MEMT * D * 2;
constexpr size_t WS_MV = WS_MK + (size_t)DEPTH * NB * MEMT * MI * 2;
constexpr size_t WS_SSP = WS_MV + (size_t)DEPTH * NB * MEMT * MI * 2;
constexpr size_t WS_LSQ = WS_SSP + (size_t)T * 32 * 4;
constexpr size_t WS_LSKV = WS_LSQ + (size_t)T * 8 * 4;
constexpr size_t WS_RS0 = WS_LSKV + (size_t)T * 8 * 4;
constexpr size_t WS_RS2 = WS_RS0 + (size_t)T * 4;
constexpr size_t WS_MEMRS = WS_RS2 + (size_t)T * 4;
constexpr size_t WS_COS = WS_MEMRS + 4096;
constexpr size_t WS_SIN = WS_COS + (size_t)T * 32 * 4;
constexpr size_t WS_GW = WS_SIN + (size_t)T * 32 * 4;
constexpr size_t WS_LIST = WS_GW + (size_t)2 * T * 4;
constexpr size_t WS_RWH = WS_LIST + (size_t)NE * CAP * 4;
constexpr size_t WS_END = WS_RWH + (size_t)DEPTH * 2 * 48 * D * 2;
static_assert(WS_U + (size_t)T * D * 2 <= WS_MQ, "U overlay inside Q|AO");

DI float bf2f(bf16_t b) { return __uint_as_float(((unsigned)b) << 16); }
DI unsigned f2bf(float f) { unsigned u = __float_as_uint(f); return (u + 0x7fffu + ((u >> 16) & 1u)) >> 16; }
DI unsigned pk2(float lo, float hi) { return f2bf(lo) | (f2bf(hi) << 16); }
#define SWZ_XOR(v, m) __int_as_float(__builtin_amdgcn_ds_swizzle(__float_as_int(v), (((m) << 10) | 0x1F)))
DI float half_sum(float s) { auto rr = __builtin_amdgcn_permlane32_swap(__float_as_uint(s), __float_as_uint(s), false, false); return __uint_as_float(rr[0]) + __uint_as_float(rr[1]); }
DI float wave_sum(float v) { v += SWZ_XOR(v, 1); v += SWZ_XOR(v, 2); v += SWZ_XOR(v, 4); v += SWZ_XOR(v, 8); v += SWZ_XOR(v, 16); return half_sum(v); }
DI int opaque_tid() { int t = threadIdx.x; asm volatile("" : "+v"(t)); return t; }
DI float silu(float x) { return x / (1.0f + __expf(-x)); }

DI int permrow(int perm, int n) {
    switch (perm) {
        case 1: return (n >> 7) * QKD + (n & 127);
        case 2: { const int h = n >> 6, r = n & 63; return h * QKD + NOPE + 2 * (r & 31) + (r >> 5); }
        case 3: return (n >> 7) * 256 + (n & 127);
        case 4: return (n >> 7) * 256 + 128 + (n & 127);
        case 5: return 2 * (n & 31) + (n >> 5);
        default: return n;
    }
}
#define LAS __attribute__((address_space(3)))
typedef short bf16x8 __attribute__((ext_vector_type(8)));
namespace fg {
constexpr int BM = 256, BK = 64, HALF = 128, HTB = HALF * BK * 2, STAGE_BYTES = 8 * HTB, NXCD = 8, WGM = 16;
DI int lds_byte(int r, int c) { const int st = (r >> 4) * 2 + (c >> 5), rr = r & 15, cc = c & 31, ob = rr * 64 + cc * 2; return st * 1024 + (ob ^ (((ob >> 9) & 1) << 5)); }
DI void stage_rc(int b, int& R, int& C) { const int st = b / 1024, sb = b % 1024, swz = sb ^ (((sb >> 9) & 1) << 5); R = (st >> 1) * 16 + swz / 64; C = (st & 1) * 32 + (swz % 64) / 2; }
DI int perm32(int rho) { const int n = rho >> 4, i = rho & 15; return 8 * (i >> 2) + 4 * n + (i & 3); }
DI unsigned cvt_pk_bf16(float lo, float hi) { unsigned r; asm volatile("v_cvt_pk_bf16_f32 %0, %1, %2" : "=v"(r) : "v"(lo), "v"(hi)); return r; }
struct Unit { int pm, pn, e, r0, cnt; };

struct ProbDense {
    const char* A0; const char* B0; const char* A1; const char* B1; int nM, nN, nN0, K, lda, pool, G, c;
    static constexpr bool GATHER = false;
    DI bool next(int i, Unit& u) const {
        const long L = (long)i * G + c; const int nwg = nM * nN; if (L >= nwg) return false;
        int wgid = (int)L; { const int q = nwg / NXCD, r = nwg % NXCD, xcd = wgid % NXCD, off = wgid / NXCD; wgid = (xcd < r ? xcd * (q + 1) : r * (q + 1) + (xcd - r) * q) + off; }
        const int nig = WGM * nN, gid = wgid / nig, fm = gid * WGM, gsz = (nM - fm) < WGM ? (nM - fm) : WGM;
        u.pm = fm + ((wgid % nig) % gsz); u.pn = (wgid % nig) / gsz; u.e = 0; u.r0 = 0; u.cnt = 256; return true; }
    DI const char* aptr(const Unit& u) const { return (u.pn < nN0 ? A0 : A1) + (size_t)u.pm * 256 * lda * 2 + (pool ? (size_t)(u.pn >> 1) * 1024 : 0); }
    DI const char* bptr(const Unit& u) const { return u.pn < nN0 ? B0 + (size_t)u.pn * 256 * K * 2 : B1 + (size_t)(u.pn - nN0) * 256 * K * 2; }
    DI void avoff(const Unit&, int tid, unsigned (&vo)[2][2]) const {
        int R[2], C[2]; stage_rc(tid * 16, R[0], C[0]); stage_rc(tid * 16 + 8192, R[1], C[1]);
#pragma unroll
        for (int h = 0; h < 2; ++h)
#pragma unroll
            for (int i = 0; i < 2; ++i) vo[h][i] = (unsigned)((h * 128 + R[i]) * lda + C[i]) * 2u; }
};
struct ProbMoe {
    const char* A; const char* Bt; const int* list; const LAS int* pref; int npn, K, lda, gather, G, c; long estride;
    static constexpr bool GATHER = true;
    DI bool next(int i, Unit& u) const {
        const int nx = (G & 7) ? 1 : 8, q = i * (G / nx) + c / nx, t = q / npn; if (t >= pref[40]) return false;
        const int ent = pref[128 + t], e = ent & 255;
        u.pm = ent >> 16; u.pn = q % npn; u.e = e; u.r0 = ((ent >> 8) & 255) * 256; u.cnt = pref[64 + e]; return true; }
    DI const char* aptr(const Unit& u) const { return gather ? A : A + (size_t)u.pm * 256 * lda * 2; }
    DI const char* bptr(const Unit& u) const { return Bt + (size_t)u.e * estride + (size_t)u.pn * 256 * K * 2; }
    DI void avoff(const Unit& u, int tid, unsigned (&vo)[2][2]) const {
        int R[2], C[2]; stage_rc(tid * 16, R[0], C[0]); stage_rc(tid * 16 + 8192, R[1], C[1]);
#pragma unroll
        for (int h = 0; h < 2; ++h)
#pragma unroll
            for (int i = 0; i < 2; ++i) { const int row = h * 128 + R[i];
                if (gather) { const int ri = u.r0 + row; const int tok = ri < u.cnt ? (list[(size_t)u.e * CAP + ri] >> 1) : 0; vo[h][i] = (unsigned)(tok * lda + C[i]) * 2u; }
                else vo[h][i] = (unsigned)(row * lda + C[i]) * 2u; } }
};

typedef f32x4 Acc[2][2][4][2];
DI float quad_sum(float s) { s += SWZ_XOR(s, 16); return half_sum(s); }
DI float sq8(const f32x4& a, const f32x4& b) { return ((a.x * a.x + a.y * a.y) + (a.z * a.z + a.w * a.w)) + ((b.x * b.x + b.y * b.y) + (b.z * b.z + b.w * b.w)); }
DI u32x4 pack8(const f32x4& a, const f32x4& b) { u32x4 w; w.x = cvt_pk_bf16(a.x, a.y); w.y = cvt_pk_bf16(a.z, a.w); w.z = cvt_pk_bf16(b.x, b.y); w.w = cvt_pk_bf16(b.z, b.w); return w; }
template <int NP> DI float rs_from_parts(const float* part, int r, int fq, float inv_n) {
    float s;
    if (NP == 32) { const f32x4 a = *(const f32x4*)(part + (size_t)r * 32 + fq * 8), b = *(const f32x4*)(part + (size_t)r * 32 + fq * 8 + 4); s = ((a.x + a.y) + (a.z + a.w)) + ((b.x + b.y) + (b.z + b.w)); }
    else { const float* p = part + (size_t)r * 8 + fq * 2; s = p[0] + p[1]; }
    s = quad_sum(s); return rsqrtf(s * inv_n + EPS);
}
DI void rope8(f32x4& a, f32x4& b, const float* COS, const float* SIN, int r, int i0) {
    const f32x4 c = *(const f32x4*)(COS + (size_t)r * 32 + i0), s = *(const f32x4*)(SIN + (size_t)r * 32 + i0);
    const f32x4 a2 = {a.x * c.x - a.y * s.x, a.y * c.x + a.x * s.x, a.z * c.y - a.w * s.y, a.w * c.y + a.z * s.y};
    const f32x4 b2 = {b.x * c.z - b.y * s.z, b.y * c.z + b.x * s.z, b.z * c.w - b.w * s.w, b.w * c.w + b.z * s.w};
    a = a2; b = b2;
}
#define EPI_ROWS(ai, m) (ai * HALF + wr * 64 + m * 16 + fr)
DI void unpack8(const u32x4& w, f32x4& a, f32x4& b) {
    a = (f32x4){__uint_as_float(w.x << 16), __uint_as_float(w.x & 0xffff0000u), __uint_as_float(w.y << 16), __uint_as_float(w.y & 0xffff0000u)};
    b = (f32x4){__uint_as_float(w.z << 16), __uint_as_float(w.z & 0xffff0000u), __uint_as_float(w.w << 16), __uint_as_float(w.w & 0xffff0000u)}; }
DI void rope8r(f32x4& a, f32x4& b, const f32x4& c, const f32x4& s) {
    const f32x4 a2 = {a.x * c.x - a.y * s.x, a.y * c.x + a.x * s.x, a.z * c.y - a.w * s.y, a.w * c.y + a.z * s.y};
    const f32x4 b2 = {b.x * c.z - b.y * s.z, b.y * c.z + b.x * s.z, b.z * c.w - b.w * s.w, b.w * c.w + b.z * s.w};
    a = a2; b = b2;
}
template <bool STATS> struct EpiRes {
    bf16_t* HB; float* SSP; bf16_t* HBout = nullptr;
    DI void operator()(const Acc& acc, const Unit& u, int wr, int wc, int fr, int fq) const {
        const int cb = u.pn * BM + wc * 32 + 8 * fq;
#pragma unroll
        for (int ai = 0; ai < 2; ++ai) {
            u32x4 w[4][2];
#pragma unroll
            for (int m = 0; m < 4; ++m)
#pragma unroll
                for (int bj = 0; bj < 2; ++bj) w[m][bj] = *(const u32x4*)(HB + (size_t)(u.pm * BM + EPI_ROWS(ai, m)) * D + cb + bj * HALF);
#pragma unroll
            for (int m = 0; m < 4; ++m) { const int r = u.pm * BM + EPI_ROWS(ai, m); float ss = 0.f;
#pragma unroll
                for (int bj = 0; bj < 2; ++bj) { f32x4 h0, h1; unpack8(w[m][bj], h0, h1); h0 += acc[ai][bj][m][0]; h1 += acc[ai][bj][m][1];
                    *(u32x4*)((HBout ? HBout : HB) + (size_t)r * D + cb + bj * HALF) = pack8(h0, h1); if (STATS) ss += sq8(h0, h1); }
                if (STATS) { ss = quad_sum(ss); if (fq == 0) SSP[(size_t)r * 32 + u.pn * 4 + wc] = ss; } }
        }
    }
};
template <int MODE  > struct EpiBf16RS {
    bf16_t* O; int ldo; const float* rs;
    DI void operator()(const Acc& acc, const Unit& u, int wr, int wc, int fr, int fq) const {
        float sc[2][4];
#pragma unroll
        for (int ai = 0; ai < 2; ++ai)
#pragma unroll
            for (int m = 0; m < 4; ++m) { const int r = u.pm * BM + EPI_ROWS(ai, m); sc[ai][m] = MODE == 1 ? rs[r] : rs_from_parts<32>(rs, r, fq, 1.0f / D); }
#pragma unroll
        for (int ai = 0; ai < 2; ++ai)
#pragma unroll
            for (int m = 0; m < 4; ++m) { const int r = u.pm * BM + EPI_ROWS(ai, m);
#pragma unroll
                for (int bj = 0; bj < 2; ++bj) { const int c0 = u.pn * BM + bj * HALF + wc * 32 + 8 * fq;
                    *(u32x4*)(O + (size_t)r * ldo + c0) = pack8(acc[ai][bj][m][0] * sc[ai][m], acc[ai][bj][m][1] * sc[ai][m]); } }
    }
};
struct EpiDQ {
    bf16_t* CQ; bf16_t* CKV; bf16_t* KR; const float* RS0; float* LSQ; float* LSKV; const float* COS; const float* SIN;
    DI void operator()(const Acc& acc, const Unit& u, int wr, int wc, int fr, int fq) const {
        float sc[2][4];
#pragma unroll
        for (int ai = 0; ai < 2; ++ai)
#pragma unroll
            for (int m = 0; m < 4; ++m) sc[ai][m] = RS0[u.pm * BM + EPI_ROWS(ai, m)];
        if (u.pn < 4) {
#pragma unroll
            for (int ai = 0; ai < 2; ++ai)
#pragma unroll
                for (int m = 0; m < 4; ++m) { const int r = u.pm * BM + EPI_ROWS(ai, m); float ss = 0.f;
#pragma unroll
                    for (int bj = 0; bj < 2; ++bj) { const int cl = bj * HALF + wc * 32 + 8 * fq; const f32x4 v0 = acc[ai][bj][m][0] * sc[ai][m], v1 = acc[ai][bj][m][1] * sc[ai][m];
                        ss += sq8(v0, v1); *(u32x4*)((u.pn < 2 ? CQ : CKV) + (size_t)r * 512 + (u.pn & 1) * 256 + cl) = pack8(v0, v1); }
                    ss = quad_sum(ss); if (fq == 0) (u.pn < 2 ? LSQ : LSKV)[(size_t)r * 8 + (u.pn & 1) * 4 + wc] = ss; }
        } else if (wc < 2) {
            const int cl = wc * 32 + 8 * fq; f32x4 cs[2][4], sn[2][4];
#pragma unroll
            for (int ai = 0; ai < 2; ++ai)
#pragma unroll
                for (int m = 0; m < 4; ++m) { const int r = u.pm * BM + EPI_ROWS(ai, m); cs[ai][m] = *(const f32x4*)(COS + (unsigned)(r * 32 + (cl >> 1))); sn[ai][m] = *(const f32x4*)(SIN + (unsigned)(r * 32 + (cl >> 1))); }
#pragma unroll
            for (int ai = 0; ai < 2; ++ai)
#pragma unroll
                for (int m = 0; m < 4; ++m) { const int r = u.pm * BM + EPI_ROWS(ai, m); f32x4 v0 = acc[ai][0][m][0] * sc[ai][m], v1 = acc[ai][0][m][1] * sc[ai][m];
                    rope8r(v0, v1, cs[ai][m], sn[ai][m]); *(u32x4*)(KR + (size_t)r * 64 + cl) = pack8(v0, v1); }
        }
    }
};
struct EpiUQ {
    bf16_t* Q; bf16_t* KN; bf16_t* V; const float* LSQ; const float* LSKV; const float* COS; const float* SIN;
    DI void operator()(const Acc& acc, const Unit& u, int wr, int wc, int fr, int fq) const {
        const bool isq = u.pn < 12; float sc[2][4];
#pragma unroll
        for (int ai = 0; ai < 2; ++ai)
#pragma unroll
            for (int m = 0; m < 4; ++m) sc[ai][m] = rs_from_parts<8>(isq ? LSQ : LSKV, u.pm * BM + EPI_ROWS(ai, m), fq, 1.0f / 512.0f);
#pragma unroll
        for (int bj = 0; bj < 2; ++bj) {
            const int c0 = (isq ? u.pn : u.pn - 12) * BM + bj * HALF + wc * 32 + 8 * fq, hc = c0 % QKD; const bool rot = isq && hc >= NOPE;
#pragma unroll
            for (int ai = 0; ai < 2; ++ai) {
                f32x4 cs[4], sn[4];
                if (rot) {
#pragma unroll
                    for (int m = 0; m < 4; ++m) { const int r = u.pm * BM + EPI_ROWS(ai, m); cs[m] = *(const f32x4*)(COS + (unsigned)(r * 32 + ((hc - NOPE) >> 1))); sn[m] = *(const f32x4*)(SIN + (unsigned)(r * 32 + ((hc - NOPE) >> 1))); } }
#pragma unroll
                for (int m = 0; m < 4; ++m) { const int r = u.pm * BM + EPI_ROWS(ai, m); f32x4 v0 = acc[ai][bj][m][0] * sc[ai][m], v1 = acc[ai][bj][m][1] * sc[ai][m];
                    if (rot) rope8r(v0, v1, cs[m], sn[m]);
                    bf16_t* o = isq ? Q + (size_t)r * NQ + c0 : (c0 < 2048 ? KN + c0 : V + (c0 - 2048)) + (size_t)r * D;
                    *(u32x4*)o = pack8(v0, v1); }
            }
        }
    }
};
struct EpiMoe1 {
    bf16_t* HH; const float* RS2; const int* list;
    DI void operator()(const Acc& acc, const Unit& u, int wr, int wc, int fr, int fq) const {
        int tok[2][4]; float sc[2][4];
#pragma unroll
        for (int ai = 0; ai < 2; ++ai)
#pragma unroll
            for (int m = 0; m < 4; ++m) { const int ri = u.r0 + EPI_ROWS(ai, m); tok[ai][m] = ri < u.cnt ? (list[(size_t)u.e * CAP + ri] >> 1) : 0; }
#pragma unroll
        for (int ai = 0; ai < 2; ++ai)
#pragma unroll
            for (int m = 0; m < 4; ++m) sc[ai][m] = RS2[tok[ai][m]];
#pragma unroll
        for (int ai = 0; ai < 2; ++ai)
#pragma unroll
            for (int m = 0; m < 4; ++m) { const int lr = EPI_ROWS(ai, m);
                if (u.r0 + lr < u.cnt) { const float s_ = sc[ai][m];
                    const f32x4 g0 = acc[ai][0][m][0] * s_, g1 = acc[ai][0][m][1] * s_, u0 = acc[ai][1][m][0] * s_, u1 = acc[ai][1][m][1] * s_;
                    const f32x4 h0 = {silu(g0.x) * u0.x, silu(g0.y) * u0.y, silu(g0.z) * u0.z, silu(g0.w) * u0.w}, h1 = {silu(g1.x) * u1.x, silu(g1.y) * u1.y, silu(g1.z) * u1.z, silu(g1.w) * u1.w};
                    *(u32x4*)(HH + (size_t)(u.pm * BM + lr) * EFF + u.pn * 128 + wc * 32 + 8 * fq) = pack8(h0, h1); } }
    }
};
struct EpiMoe2 {
    bf16_t* Y; const float* GW; const int* list;
    DI void operator()(const Acc& acc, const Unit& u, int wr, int wc, int fr, int fq) const {
        int as[2][4]; float sc[2][4];
#pragma unroll
        for (int ai = 0; ai < 2; ++ai)
#pragma unroll
            for (int m = 0; m < 4; ++m) { const int ri = u.r0 + EPI_ROWS(ai, m); as[ai][m] = ri < u.cnt ? list[(size_t)u.e * CAP + ri] : 0; }
#pragma unroll
        for (int ai = 0; ai < 2; ++ai)
#pragma unroll
            for (int m = 0; m < 4; ++m) sc[ai][m] = GW[as[ai][m]];
#pragma unroll
        for (int ai = 0; ai < 2; ++ai)
#pragma unroll
            for (int m = 0; m < 4; ++m) { if (u.r0 + EPI_ROWS(ai, m) < u.cnt) {
#pragma unroll
                    for (int bj = 0; bj < 2; ++bj) { const int c0 = u.pn * BM + bj * HALF + wc * 32 + 8 * fq;
                        *(u32x4*)(Y + (size_t)as[ai][m] * D + c0) = pack8(acc[ai][bj][m][0] * sc[ai][m], acc[ai][bj][m][1] * sc[ai][m]); } } }
    }
};

template <class Epi, class Prob, bool DRY = false>
DI void gemm_phase(LAS unsigned char* lds, const Prob& P, const Epi& E) {
    const int tid = opaque_tid(), wid = __builtin_amdgcn_readfirstlane(tid >> 6), lane = tid & 63, wr = wid >> 2, wc = wid & 3, fr = lane & 15, fq = lane >> 4;
    const int K = P.K, nt = K / BK;
    int sR[2], sC[2]; unsigned voffB[2];
#pragma unroll
    for (int i = 0; i < 2; ++i) { stage_rc(tid * 16 + i * 8192, sR[i], sC[i]); const int Rb = (sR[i] & ~31) + perm32(sR[i] & 31); voffB[i] = (unsigned)(Rb * K + sC[i]) * 2u; }
    const size_t kstep = (size_t)(BK * 2), hstepB = (size_t)HALF * K * 2;
    const unsigned ldsw = (unsigned)wid * 1024u;
    const int aoff = lds_byte(wr * 64 + fr, fq * 8), boff = lds_byte(wc * 32 + fr, fq * 8);
#define PG8_SA(b, h) (((b) * 2 + (h)) * HTB)
#define PG8_SB(b, h) ((4 + (b) * 2 + (h)) * HTB)
#define PG8_STAGE(bufoff, gbase, voff) do { _Pragma("unroll") for (int _i = 0; _i < 2; ++_i) \
        __builtin_amdgcn_global_load_lds((const unsigned*)((const char*)(gbase) + (voff)[_i]), (LAS unsigned*)(lds + (bufoff) + ldsw + _i * 8192), 16, 0, 0); } while (0)
#define PG8_LDA(dst, b, h) do { _Pragma("unroll") for (int m = 0; m < 4; ++m) _Pragma("unroll") for (int k = 0; k < 2; ++k) dst[m][k] = *(const LAS bf16x8*)(lds + PG8_SA(b, h) + aoff + m * 2048 + k * 1024); } while (0)
#define PG8_LDB(dst, b, h) do { _Pragma("unroll") for (int n = 0; n < 2; ++n) _Pragma("unroll") for (int k = 0; k < 2; ++k) dst[n][k] = *(const LAS bf16x8*)(lds + PG8_SB(b, h) + boff + n * 2048 + k * 1024); } while (0)
#define PG8_MMA(ai, bj, At, Bt) do { __builtin_amdgcn_s_setprio(1); _Pragma("unroll") for (int m = 0; m < 4; ++m) _Pragma("unroll") for (int n = 0; n < 2; ++n) _Pragma("unroll") for (int k = 0; k < 2; ++k) \
        acc[ai][bj][m][n] = __builtin_amdgcn_mfma_f32_16x16x32_bf16(Bt[n][k], At[m][k], acc[ai][bj][m][n], 0, 0, 0); __builtin_amdgcn_s_setprio(0); } while (0)
#define PG8_WAIT_V(n) asm volatile("s_waitcnt vmcnt(" #n ")" ::: "memory")
#define PG8_WAIT_L(n) asm volatile("s_waitcnt lgkmcnt(" #n ")" ::: "memory")
#define PG8_BAR __builtin_amdgcn_s_barrier()
#define PG8_SCHED __builtin_amdgcn_sched_barrier(0)
    Unit cur, nxt; int ui = 0;
    if (!P.next(0, cur)) return;
    bool do0 = true, do1 = true;
    if constexpr (Prob::GATHER) { const int nv = cur.cnt - cur.r0; do0 = wr * 64 < nv; do1 = 128 + wr * 64 < nv; }
    if constexpr (DRY) { do0 = false; do1 = false; }
    f32x4 acc[2][2][4][2];
#pragma unroll
    for (int a = 0; a < 2; ++a)
#pragma unroll
        for (int b = 0; b < 2; ++b)
#pragma unroll
            for (int m = 0; m < 4; ++m)
#pragma unroll
                for (int n = 0; n < 2; ++n) acc[a][b][m][n] = (f32x4){0.f, 0.f, 0.f, 0.f};
    bf16x8 At[4][2], B0[2][2], B1[2][2];
    const char* cA = P.aptr(cur); const char* cB = P.bptr(cur);
    unsigned voA[2][2], vnA[2][2];
    P.avoff(cur, tid, voA);
    if constexpr (Prob::GATHER) asm volatile("s_waitcnt vmcnt(0)" ::: "memory");
    PG8_STAGE(PG8_SB(0, 0), cB, voffB); PG8_STAGE(PG8_SB(0, 1), cB + hstepB, voffB); PG8_STAGE(PG8_SA(0, 0), cA, voA[0]); PG8_STAGE(PG8_SA(0, 1), cA, voA[1]);
    if (wr == 1) PG8_BAR;
    PG8_WAIT_V(2); PG8_BAR;
    PG8_STAGE(PG8_SB(1, 0), cB + kstep, voffB); PG8_STAGE(PG8_SA(1, 0), cA + kstep, voA[0]); PG8_STAGE(PG8_SB(1, 1), cB + hstepB + kstep, voffB);
    PG8_WAIT_V(6); PG8_BAR;
    for (;;) {
        const bool has_next = P.next(ui + 1, nxt);
        const char* nA = has_next ? P.aptr(nxt) : cA; const char* nB = has_next ? P.bptr(nxt) : cB;
#pragma unroll
        for (int h = 0; h < 2; ++h)
#pragma unroll
            for (int i = 0; i < 2; ++i) vnA[h][i] = voA[h][i];
        for (int t = 0; t < nt; t += 2) {
            const bool last = (t == nt - 2);
            if constexpr (Prob::GATHER) { if (last && has_next) P.avoff(nxt, opaque_tid(), vnA); }
            const char* a1 = cA + (size_t)(t + 1) * kstep;
            const char* a2 = last ? nA : cA + (size_t)(t + 2) * kstep; const char* b2 = last ? nB : cB + (size_t)(t + 2) * kstep;
            const char* a3 = a2 + kstep; const char* b3 = b2 + kstep;
            unsigned w0[2], w1[2];
#pragma unroll
            for (int i = 0; i < 2; ++i) { w0[i] = last ? vnA[0][i] : voA[0][i]; w1[i] = last ? vnA[1][i] : voA[1][i]; }
            PG8_LDB(B0, 0, 0); PG8_LDB(B1, 0, 1); PG8_SCHED; PG8_LDA(At, 0, 0); PG8_STAGE(PG8_SA(1, 1), a1, voA[1]);
            PG8_WAIT_V(8); PG8_WAIT_L(0); PG8_BAR; if (do0) { PG8_MMA(0, 0, At, B0); PG8_MMA(0, 1, At, B1); } PG8_BAR; PG8_SCHED;
            PG8_LDA(At, 0, 1); PG8_STAGE(PG8_SB(0, 0), b2, voffB); PG8_STAGE(PG8_SB(0, 1), b2 + hstepB, voffB); PG8_STAGE(PG8_SA(0, 0), a2, w0);
            PG8_WAIT_V(8); PG8_WAIT_L(0); PG8_BAR; if (do1) { PG8_MMA(1, 0, At, B0); PG8_MMA(1, 1, At, B1); } PG8_BAR; PG8_SCHED;
            PG8_LDB(B0, 1, 0); PG8_LDB(B1, 1, 1); PG8_SCHED; PG8_LDA(At, 1, 0); PG8_STAGE(PG8_SA(0, 1), a2, w1);
            PG8_WAIT_V(8); PG8_WAIT_L(0); PG8_BAR; if (do0) { PG8_MMA(0, 0, At, B0); PG8_MMA(0, 1, At, B1); } PG8_BAR; PG8_SCHED;
            PG8_LDA(At, 1, 1); PG8_STAGE(PG8_SB(1, 0), b3, voffB); PG8_STAGE(PG8_SB(1, 1), b3 + hstepB, voffB); PG8_STAGE(PG8_SA(1, 0), a3, w0);
            PG8_WAIT_V(8); PG8_WAIT_L(0); PG8_BAR; if (do1) { PG8_MMA(1, 0, At, B0); PG8_MMA(1, 1, At, B1); } PG8_BAR; PG8_SCHED;
        }
        if (wr == 0) PG8_BAR;
        if constexpr (!DRY) { const int lz = opaque_tid() & 63; E(acc, cur, wr, wc, lz & 15, lz >> 4); }
        if (!has_next) break;
#pragma unroll
        for (int a = 0; a < 2; ++a)
#pragma unroll
            for (int b = 0; b < 2; ++b)
#pragma unroll
                for (int m = 0; m < 4; ++m)
#pragma unroll
                    for (int n = 0; n < 2; ++n) acc[a][b][m][n] = (f32x4){0.f, 0.f, 0.f, 0.f};
        cur = nxt; cA = nA; cB = nB; ++ui;
        if constexpr (Prob::GATHER) { const int nv = cur.cnt - cur.r0; do0 = wr * 64 < nv; do1 = 128 + wr * 64 < nv; }
        if constexpr (DRY) { do0 = false; do1 = false; }
#pragma unroll
        for (int h = 0; h < 2; ++h)
#pragma unroll
            for (int i = 0; i < 2; ++i) voA[h][i] = vnA[h][i];
        if (wr == 1) PG8_BAR;
    }
    PG8_WAIT_V(0);
    PG8_BAR;
#undef PG8_SA
#undef PG8_SB
#undef PG8_STAGE
#undef PG8_LDA
#undef PG8_LDB
#undef PG8_MMA
#undef PG8_WAIT_V
#undef PG8_WAIT_L
#undef PG8_BAR
#undef PG8_SCHED
}
}


namespace fa {
typedef float f32x16 __attribute__((ext_vector_type(16)));
typedef short s16x4 __attribute__((ext_vector_type(4)));
#define SBAR() __builtin_amdgcn_sched_barrier(0)
constexpr float THR = 8.f, LOG2E = 1.4426950408889634f;
DI int crow(int r, int hi) { return (r & 3) + 8 * (r >> 2) + 4 * hi; }
DI unsigned cvtpk(float lo, float hi) { unsigned r; asm volatile("v_cvt_pk_bf16_f32 %0, %1, %2" : "=v"(r) : "v"(lo), "v"(hi)); return r; }
DI void partialSM(f32x16& p0, f32x16& p1, float& m_reg, float& mn, float& alpha) {
    float pmax = p0[0];
#pragma unroll
    for (int r = 1; r < 16; ++r) pmax = fmaxf(pmax, p0[r]);
#pragma unroll
    for (int r = 0; r < 16; ++r) pmax = fmaxf(pmax, p1[r]);
    { auto rr = __builtin_amdgcn_permlane32_swap(__float_as_uint(pmax), __float_as_uint(pmax), false, false); pmax = fmaxf(__uint_as_float(rr[0]), __uint_as_float(rr[1])); }
    if (__builtin_expect(__all(pmax - m_reg <= THR), 1)) { mn = m_reg; alpha = 1.f; }
    else { mn = fmaxf(m_reg, pmax); alpha = __builtin_amdgcn_exp2f((m_reg - mn) * LOG2E); m_reg = mn; }
    const float mnC = -mn * LOG2E;
#pragma unroll
    for (int r = 0; r < 16; ++r) p0[r] = fmaf(p0[r], LOG2E, mnC);
#pragma unroll
    for (int r = 0; r < 16; ++r) p1[r] = fmaf(p1[r], LOG2E, mnC);
#pragma unroll
    for (int r = 0; r < 16; ++r) p0[r] = __builtin_amdgcn_exp2f(p0[r]);
}
DI void finishSM(f32x16& p0, f32x16& p1, float alpha, float& l_reg, bf16x8& pa0, bf16x8& pa1, bf16x8& pa2, bf16x8& pa3) {
#pragma unroll
    for (int r = 0; r < 16; ++r) p1[r] = __builtin_amdgcn_exp2f(p1[r]);
    float ps = 0;
#pragma unroll
    for (int r = 0; r < 16; ++r) ps += p0[r];
#pragma unroll
    for (int r = 0; r < 16; ++r) ps += p1[r];
    { auto rr = __builtin_amdgcn_permlane32_swap(__float_as_uint(ps), __float_as_uint(ps), false, false); ps = __uint_as_float(rr[0]) + __uint_as_float(rr[1]); }
    l_reg = l_reg * alpha + ps;
#define PK4(P, BASE, OUT) do { unsigned a0 = cvtpk(P[BASE + 0], P[BASE + 1]), a1 = cvtpk(P[BASE + 2], P[BASE + 3]);   \
    unsigned b0 = cvtpk(P[BASE + 4], P[BASE + 5]), b1 = cvtpk(P[BASE + 6], P[BASE + 7]);                              \
    auto r0 = __builtin_amdgcn_permlane32_swap(a0, b0, false, false); auto r1 = __builtin_amdgcn_permlane32_swap(a1, b1, false, false); \
    u32x4 w = {r0[0], r1[0], r0[1], r1[1]}; OUT = *reinterpret_cast<bf16x8*>(&w); } while (0)
    PK4(p0, 0, pa0); PK4(p0, 8, pa1); PK4(p1, 0, pa2); PK4(p1, 8, pa3);
#undef PK4
}
template <int DQK> DI void qkt(f32x16& p0, f32x16& p1, LAS const char* Ks, const int (&kb)[4], const bf16x8* qr) {
    constexpr int KROW = DQK * 2;
#pragma unroll
    for (int r = 0; r < 16; ++r) { p0[r] = 0.f; p1[r] = 0.f; }
    __builtin_amdgcn_s_setprio(1);
#pragma unroll
    for (int d0 = 0; d0 < DQK / 16; ++d0) {
        const bf16x8 b0 = *(LAS const bf16x8*)(Ks + kb[d0 & 3] + (d0 >> 2) * 128);
        const bf16x8 b1 = *(LAS const bf16x8*)(Ks + kb[d0 & 3] + (d0 >> 2) * 128 + 32 * KROW);
        p0 = __builtin_amdgcn_mfma_f32_32x32x16_bf16(b0, qr[d0], p0, 0, 0, 0);
        p1 = __builtin_amdgcn_mfma_f32_32x32x16_bf16(b1, qr[d0], p1, 0, 0, 0); }
    __builtin_amdgcn_s_setprio(0);
}
DI int v_rd_base(int lane) { return ((lane & 3) << 3) | (((lane >> 2) & 3) << 6) | (((lane >> 4) & 1) << 5) | (((lane >> 5) & 1) << 8); }
constexpr int v_rd_off(int d0, int ks, int half) { return d0 * 512 + ks * 4096 + half * 2048; }
template <int OFF> DI s16x4 tr_read(int vb) { s16x4 r; asm volatile("ds_read_b64_tr_b16 %0, %1 offset:%2" : "=&v"(r) : "v"(vb), "i"(OFF) : "memory"); return r; }
template <int D0> DI void pv_one(f32x16& od, int vb, bf16x8 pa0, bf16x8 pa1, bf16x8 pa2, bf16x8 pa3) {
    const s16x4 l0 = tr_read<v_rd_off(D0, 0, 0)>(vb), h0 = tr_read<v_rd_off(D0, 0, 1)>(vb), l1 = tr_read<v_rd_off(D0, 1, 0)>(vb), h1 = tr_read<v_rd_off(D0, 1, 1)>(vb);
    const s16x4 l2 = tr_read<v_rd_off(D0, 2, 0)>(vb), h2 = tr_read<v_rd_off(D0, 2, 1)>(vb), l3 = tr_read<v_rd_off(D0, 3, 0)>(vb), h3 = tr_read<v_rd_off(D0, 3, 1)>(vb);
    asm volatile("s_waitcnt lgkmcnt(0)" ::: "memory"); SBAR();
#define PK(L, H) (bf16x8){L[0], L[1], L[2], L[3], H[0], H[1], H[2], H[3]}
    __builtin_amdgcn_s_setprio(1);
    od = __builtin_amdgcn_mfma_f32_32x32x16_bf16(pa0, PK(l0, h0), od, 0, 0, 0);
    od = __builtin_amdgcn_mfma_f32_32x32x16_bf16(pa1, PK(l1, h1), od, 0, 0, 0);
    od = __builtin_amdgcn_mfma_f32_32x32x16_bf16(pa2, PK(l2, h2), od, 0, 0, 0);
    od = __builtin_amdgcn_mfma_f32_32x32x16_bf16(pa3, PK(l3, h3), od, 0, 0, 0);
    __builtin_amdgcn_s_setprio(0);
#undef PK
}
DI void pv_d0(f32x16* o, int vb, bf16x8 pa0, bf16x8 pa1, bf16x8 pa2, bf16x8 pa3) {
    pv_one<0>(o[0], vb, pa0, pa1, pa2, pa3); pv_one<1>(o[1], vb, pa0, pa1, pa2, pa3); pv_one<2>(o[2], vb, pa0, pa1, pa2, pa3); pv_one<3>(o[3], vb, pa0, pa1, pa2, pa3);
}
template <int DQK, bool CAUSAL>
DI void attn_unit(LAS char* lds, const bf16_t* Qb, int ldq, const bf16_t* K1, int ldk1, const bf16_t* K2, int ldk2, const bf16_t* Vb, int ldv, bf16_t* Ob, int ldo, int NT, int qtile0) {
    constexpr int KROW = DQK * 2, KT = 64 * KROW, BUF = KT + 16384, NKP = DQK / 64, ND0 = DQK / 16;
    const int tid = opaque_tid(), wid = __builtin_amdgcn_readfirstlane(tid >> 6), lane = tid & 63, r32 = lane & 31, hi = lane >> 5;
    LAS float* wsf = (LAS float*)(lds + 3 * BUF) + wid * 64; LAS float* li_l = wsf; LAS float* al_l = wsf + 32;
    const char* kp[NKP]; int kst[NKP]; const char* vp[2];
#pragma unroll
    for (int i = 0; i < NKP; ++i) { const int p = (wid * NKP + i) * 1024 + lane * 16, row = p / KROW, cbs = p % KROW, cb = cbs ^ ((row & 7) << 4);
        if (DQK == 128 || cb < 256) { kp[i] = (const char*)K1 + (size_t)row * ldk1 * 2 + cb; kst[i] = 64 * ldk1 * 2; }
        else { kp[i] = (const char*)K2 + (size_t)row * ldk2 * 2 + (cb - 256); kst[i] = 64 * ldk2 * 2; } }
#pragma unroll
    for (int i = 0; i < 2; ++i) { const int p = (wid * 2 + i) * 1024 + lane * 16, sub = p >> 9, q = (p & 511) >> 1, kk = (sub >> 2) * 8 + (q >> 5), k = (kk & ~0xC) | ((kk & 4) << 1) | ((kk & 8) >> 1), c = (sub & 3) * 32 + (q & 31);
        vp[i] = (const char*)Vb + ((size_t)k * ldv + c) * 2; }
    const int vstep = 64 * ldv * 2;
#define FA_DMA(bo) do { _Pragma("unroll") for (int _i = 0; _i < NKP; ++_i) { __builtin_amdgcn_global_load_lds((const unsigned*)kp[_i], (LAS unsigned*)(lds + (bo) + (wid * NKP + _i) * 1024), 16, 0, 0); kp[_i] += kst[_i]; } \
        _Pragma("unroll") for (int _i = 0; _i < 2; ++_i) { __builtin_amdgcn_global_load_lds((const unsigned*)vp[_i], (LAS unsigned*)(lds + (bo) + KT + (wid * 2 + _i) * 1024), 16, 0, 0); vp[_i] += vstep; } } while (0)
#define FA_SYNC() do { asm volatile("s_waitcnt vmcnt(0)" ::: "memory"); __builtin_amdgcn_s_barrier(); asm volatile("" ::: "memory"); } while (0)
    int bm1 = 0, bc = BUF, bp1 = 2 * BUF;
    FA_DMA(bm1); FA_DMA(bc);
    bf16x8 qr[ND0];
    { const bf16_t* Qw = Qb + (size_t)(wid * 32 + r32) * ldq + hi * 8;
#pragma unroll
      for (int d0 = 0; d0 < ND0; ++d0) qr[d0] = *(const bf16x8*)(Qw + d0 * 16); }
    int kb[4];
#pragma unroll
    for (int q = 0; q < 4; ++q) kb[q] = r32 * KROW + ((q * 32 + hi * 16) ^ ((r32 & 7) << 4));
    const int vb0 = (int)(uintptr_t)lds + KT + v_rd_base(lane);
    const int lim = CAUSAL ? qtile0 + (wid >> 1) : 0x7fffffff;
    float m_reg = -1e30f, l_reg = 0; f32x16 o[4];
#pragma unroll
    for (int d = 0; d < 4; ++d)
#pragma unroll
        for (int r = 0; r < 16; ++r) o[d][r] = 0.f;
    f32x16 pA0, pA1, pB0, pB1; float mnA, mnB, alA, alB; bf16x8 pa0, pa1, pa2, pa3;
#define FA_VIS(j) (!CAUSAL || (j) <= lim)
#define FA_MASK(P0, P1, j) do { if (CAUSAL && (j) > lim) { _Pragma("unroll") for (int _r = 0; _r < 16; ++_r) { P0[_r] = -1e30f; P1[_r] = -1e30f; } } } while (0)
#define FA_RESC(a) do { if (__any((a) < 1.f)) { if (hi == 0) al_l[r32] = (a); asm volatile("s_waitcnt lgkmcnt(0)" ::: "memory"); \
        _Pragma("unroll") for (int _d = 0; _d < 4; ++_d) _Pragma("unroll") for (int _r = 0; _r < 16; ++_r) o[_d][_r] *= al_l[crow(_r, hi)]; } } while (0)
#define FA_ROT() do { const int _t = bm1; bm1 = bc; bc = bp1; bp1 = _t; } while (0)
    FA_SYNC();
    FA_DMA(bp1);
    qkt<DQK>(pA0, pA1, lds + bm1, kb, qr); partialSM(pA0, pA1, m_reg, mnA, alA);
    for (int j = 1; j + 1 < NT; j += 2) {
        SBAR(); if (FA_VIS(j)) qkt<DQK>(pB0, pB1, lds + bc, kb, qr);
        finishSM(pA0, pA1, alA, l_reg, pa0, pa1, pa2, pa3); SBAR();
        if (FA_VIS(j - 1)) pv_d0(o, vb0 + bm1, pa0, pa1, pa2, pa3); FA_MASK(pB0, pB1, j); partialSM(pB0, pB1, m_reg, mnB, alB);
        FA_SYNC(); if (j + 2 < NT) FA_DMA(bm1);
        FA_RESC(alB); FA_ROT();
        SBAR(); if (FA_VIS(j + 1)) qkt<DQK>(pA0, pA1, lds + bc, kb, qr);
        finishSM(pB0, pB1, alB, l_reg, pa0, pa1, pa2, pa3); SBAR();
        if (FA_VIS(j)) pv_d0(o, vb0 + bm1, pa0, pa1, pa2, pa3); FA_MASK(pA0, pA1, j + 1); partialSM(pA0, pA1, m_reg, mnA, alA);
        FA_SYNC(); if (j + 3 < NT) FA_DMA(bm1);
        FA_RESC(alA); FA_ROT();
    }
    SBAR(); if (FA_VIS(NT - 1)) qkt<DQK>(pB0, pB1, lds + bc, kb, qr);
    finishSM(pA0, pA1, alA, l_reg, pa0, pa1, pa2, pa3); SBAR();
    if (FA_VIS(NT - 2)) pv_d0(o, vb0 + bm1, pa0, pa1, pa2, pa3); FA_MASK(pB0, pB1, NT - 1); partialSM(pB0, pB1, m_reg, mnB, alB);
    FA_RESC(alB);
    finishSM(pB0, pB1, alB, l_reg, pa0, pa1, pa2, pa3); SBAR();
    if (FA_VIS(NT - 1)) pv_d0(o, vb0 + bc, pa0, pa1, pa2, pa3);
    if (hi == 0) li_l[r32] = l_reg; asm volatile("s_waitcnt lgkmcnt(0)" ::: "memory");
    float rli[16];
#pragma unroll
    for (int r = 0; r < 16; ++r) rli[r] = __builtin_amdgcn_rcpf(li_l[crow(r, hi)]);
    FA_SYNC();
    LAS char* Ot = lds + wid * 8704;
#pragma unroll
    for (int r = 0; r < 16; ++r)
#pragma unroll
        for (int d0 = 0; d0 < 4; ++d0) *(LAS bf16_t*)(Ot + crow(r, hi) * 272 + (d0 * 32 + r32) * 2) = (bf16_t)f2bf(o[d0][r] * rli[r]);
    asm volatile("s_waitcnt lgkmcnt(0)" ::: "memory");
#pragma unroll
    for (int i = 0; i < 8; ++i) { const int idx = i * 64 + lane, row = idx >> 4, c16 = idx & 15;
        const u32x4 v = *(LAS const u32x4*)(Ot + row * 272 + c16 * 16); *(u32x4*)(Ob + (size_t)(wid * 32 + row) * ldo + c16 * 8) = v; }
    asm volatile("s_waitcnt lgkmcnt(0)" ::: "memory"); __builtin_amdgcn_s_barrier(); asm volatile("" ::: "memory");
#undef FA_DMA
#undef FA_SYNC
#undef FA_MASK
#undef FA_VIS
#undef FA_RESC
#undef FA_ROT
}
DI int vcu_of(int bx, int G) { return (G % 8 == 0) ? (bx % 8) * (G / 8) + bx / 8 : bx; }
DI void mla_phase(LAS char* lds, const bf16_t* Q, const bf16_t* KN, const bf16_t* KR, const bf16_t* V, bf16_t* AO, int G, int bx) {
    const int v = vcu_of(bx, G);
    for (int p = v; p < NB * HEADS * 8; p += G) { const int bh = p >> 3, i = p & 7, b = bh / HEADS, h = bh % HEADS;
#pragma unroll 1
        for (int s = 0; s < 2; ++s) { const int qb = s ? 15 - i : i; const size_t row0 = (size_t)b * S + qb * 256, key0 = (size_t)b * S;
            attn_unit<192, true>(lds, Q + row0 * NQ + h * QKD, NQ, KN + key0 * D + h * NOPE, D, KR + key0 * ROPE, ROPE, V + key0 * D + h * VD, D, AO + row0 * D + h * VD, D, 4 * qb + 4, 4 * qb); } }
}
DI void memattn_phase(LAS char* lds, const bf16_t* MQ, const bf16_t* MK, const bf16_t* MV, bf16_t* MO, int G, int bx) {
    for (int u = bx; u < NB * MH * (S / 256); u += G) { const int qb = u % (S / 256), h = (u / (S / 256)) % MH, b = u / (S / 256 * MH); const size_t row0 = (size_t)b * S + qb * 256, key0 = (size_t)b * MEMT;
        attn_unit<128, false>(lds, MQ + row0 * MI + h * MHD, MI, MK + key0 * MI + h * MHD, MI, nullptr, 0, MV + key0 * MI + h * MHD, MI, MO + row0 * MI + h * MHD, MI, MEMT / 64, 0); }
}
}

#ifndef H16
#define H16 1
#endif
#ifndef JIT
#define JIT 1
#endif
#ifndef XCONV
#define XCONV 0
#endif
#ifndef XMLA
#define XMLA 0
#endif
#ifndef XMOE
#define XMOE 0
#endif
#ifndef XROUTER
#define XROUTER 0
#endif
#ifndef XDENSE
#define XDENSE 0
#endif
#ifndef XMEMATT
#define XMEMATT 0
#endif
#ifndef XCOMB
#define XCOMB 0
#endif
#ifndef XRES
#define XRES 0
#endif
#ifndef XUQ
#define XUQ 0
#endif
#ifndef XPOOL
#define XPOOL 0
#endif
constexpr int LDS_BYTES = 147456, LDS_MISC = 131072;
#define XB_TMO      128
#define XB_XCNT(j)  (256  + 64 * (j))
#define XB_XSUB(j)  (1280 + 64 * (j))
#define XB_XGEN(j)  (2304 + 64 * (j))
#define XB_TOP      3328
#define XB_TOPGEN   3392
#define XCD_BAR_WORDS 3456
#define XB_SPIN_CAP (1u << 18)
constexpr int CW_BAR = 4096;
DI unsigned xb_ld(unsigned* p)              { return __hip_atomic_load(p, __ATOMIC_RELAXED, __HIP_MEMORY_SCOPE_AGENT); }
DI unsigned xb_add(unsigned* p, unsigned v) { return __hip_atomic_fetch_add(p, v, __ATOMIC_RELAXED, __HIP_MEMORY_SCOPE_AGENT); }
DI unsigned xb_xcc_id() { return (unsigned)__builtin_amdgcn_s_getreg((3 << 11) | 20) & 0xFu; }
#define XB_SPIN(cond, bar) do { unsigned _sp = 0; while (cond) { __builtin_amdgcn_s_sleep(1); \
    if ((++_sp & 255u) == 0u) { if (xb_ld(&(bar)[XB_TMO])) break; if (_sp > XB_SPIN_CAP) { atomicAdd(&(bar)[XB_TMO], 1u); break; } } } } while (0)
struct XcdBarrier { unsigned* bar; unsigned x; volatile LAS unsigned* st; };
DI XcdBarrier xcd_barrier_post(unsigned* bar, volatile LAS unsigned* st) {
    XcdBarrier b; b.bar = bar; b.x = xb_xcc_id(); b.st = st;
    if (threadIdx.x == 0) (void)xb_add(&bar[XB_XCNT(b.x)], 1u);
    return b;
}
DI void xcd_barrier_complete(unsigned* bar, unsigned x, unsigned& nloc, unsigned& nx) {
    const unsigned G = gridDim.x * gridDim.y * gridDim.z;
    unsigned sum, cnt, mine, sp = 0u;
    for (;;) {
        sum = 0u; cnt = 0u; mine = 0u;
#pragma unroll
        for (unsigned j = 0; j < 16; ++j) { const unsigned c = xb_ld(&bar[XB_XCNT(j)]); sum += c; cnt += (c > 0u) ? 1u : 0u; mine = (j == x) ? c : mine; }
        if (sum == G) break;
        __builtin_amdgcn_s_sleep(1);
        if ((++sp & 255u) == 0u) { if (xb_ld(&bar[XB_TMO])) break; if (sp > XB_SPIN_CAP) { atomicAdd(&bar[XB_TMO], 1u); break; } }
    }
    nloc = mine > 0u ? mine : 1u; nx = cnt > 0u ? cnt : 1u;
}
DI void xcd_barrier(const XcdBarrier& b) {
    asm volatile("s_waitcnt vmcnt(0)" ::: "memory");
    __syncthreads();
    if (threadIdx.x == 0) {
        unsigned* bar = b.bar;
        __builtin_amdgcn_s_waitcnt(0);
        unsigned nloc = b.st[0], nx = b.st[1];
        if (nloc == 0u) { xcd_barrier_complete(bar, b.x, nloc, nx); b.st[0] = nloc; b.st[1] = nx; }
        const unsigned old = xb_add(&bar[XB_XSUB(b.x)], 1u);
        const unsigned gen = old / nloc;
        if (old + 1u == (gen + 1u) * nloc) {
            __builtin_amdgcn_fence(__ATOMIC_RELEASE, "agent");
            asm volatile("s_waitcnt vmcnt(0)" ::: "memory");
            const unsigned og = xb_add(&bar[XB_TOP], 1u);
            const unsigned tg = og / nx;
            if (og + 1u == (tg + 1u) * nx) xb_add(&bar[XB_TOPGEN], 1u);
            else XB_SPIN(xb_ld(&bar[XB_TOPGEN]) == tg, bar);
            __builtin_amdgcn_fence(__ATOMIC_ACQUIRE, "agent");
            xb_add(&bar[XB_XGEN(b.x)], 1u);
            asm volatile("s_waitcnt vmcnt(0)" ::: "memory");
        } else {
            XB_SPIN(xb_ld(&bar[XB_XGEN(b.x)]) == gen, bar);
            __builtin_amdgcn_fence(__ATOMIC_ACQUIRE, "agent");
            asm volatile("s_waitcnt vmcnt(0)" ::: "memory");
        }
    }
    __syncthreads();
}

#define LDS_WAIT() asm volatile("s_waitcnt lgkmcnt(0)" ::: "memory")
DI void wt_item(const float* W, int K, int N, bf16_t* WT, const float* kgain, const float* ngain, float scale, int perm, int row_off, LAS float* scr, int item, int lane) {
    const int nblk = N >> 5, kb = item / nblk, nb = item - kb * nblk, k0 = kb * 64, n0 = nb * 32, kr = lane >> 3, n4 = (lane & 7) * 4;
    f32x4 ng = {scale, scale, scale, scale}; if (ngain) ng = *(const f32x4*)(ngain + n0 + n4) * scale;
    f32x4 v[8];
#pragma unroll
    for (int i = 0; i < 8; ++i) v[i] = *(const f32x4*)(W + (size_t)(k0 + 8 * i + kr) * N + n0 + n4);
#pragma unroll
    for (int i = 0; i < 8; ++i) { const int k = 8 * i + kr; f32x4 x = v[i] * ng; if (kgain) x = x * kgain[k0 + k];
        scr[(n4 + 0) * 65 + k] = x.x; scr[(n4 + 1) * 65 + k] = x.y; scr[(n4 + 2) * 65 + k] = x.z; scr[(n4 + 3) * 65 + k] = x.w; }
    LDS_WAIT();
    const int kc = lane & 7;
#pragma unroll
    for (int q = 0; q < 4; ++q) { const int n = (lane >> 3) + 8 * q; const LAS float* sp = scr + n * 65 + 8 * kc;
        u32x4 o; o.x = pk2(sp[0], sp[1]); o.y = pk2(sp[2], sp[3]); o.z = pk2(sp[4], sp[5]); o.w = pk2(sp[6], sp[7]);
        *(u32x4*)(WT + (size_t)(row_off + permrow(perm, n0 + n)) * K + k0 + 8 * kc) = o; }
    LDS_WAIT();
}
struct MArgs { const void* in[32]; float* out; unsigned char* ws; int ph_lo, ph_hi, bar_region, pad; };
#define INF(i) ((const float*)P.in[i])
#define WSB(off) ((bf16_t*)(P.ws + (off)))
#define WSF(off) ((float*)(P.ws + (off)))
constexpr float SC_MEM = 0.08838834764831845f  , SC_MLA = 0.07216878364870323f  ;
DI void conv_phase(const MArgs& P, LAS unsigned char* lds, int gw, int NGW, int wave, int lane) {
    LAS float* scr = (LAS float*)(lds + wave * 16384);
    constexpr int I_POOL = 8 * 128, I_MQ = 4 * 512, I_MO = 4 * 512, I_E = (JIT ? 0 : 128) * 512, I_DQ = 512, I_KR = 64, I_UQ = 2 * 512, I_QR = 2 * 256, I_O = 2 * 2048, I_UK = 512;
    constexpr int NITEMS = I_POOL + 3 * I_MQ + I_MO + 3 * I_E + 3 * I_DQ + I_KR + I_UQ + I_QR + I_O + 2 * I_UK;
    for (int it = gw; it < NITEMS; it += NGW) {
        int r = it;
        if (r < I_E) { const int m = r >> 9; wt_item(INF(28) + (size_t)m * D * EFF, D, EFF, WSB(WS_WGU) + (size_t)m * 1024 * D, INF(6) + (m >> 5) * D, nullptr, 1.f, 3, 0, scr, r & 511, lane); continue; } r -= I_E;
        if (r < I_E) { const int m = r >> 9; wt_item(INF(29) + (size_t)m * D * EFF, D, EFF, WSB(WS_WGU) + (size_t)m * 1024 * D, INF(6) + (m >> 5) * D, nullptr, 1.f, 4, 0, scr, r & 511, lane); continue; } r -= I_E;
        if (r < I_E) { const int m = r >> 9; wt_item(INF(30) + (size_t)m * EFF * D, EFF, D, WSB(WS_WD) + (size_t)m * D * EFF, nullptr, nullptr, 1.f, 0, 0, scr, r & 511, lane); continue; } r -= I_E;
        if (r < I_POOL) { const int m = r >> 7; wt_item(INF(7) + (size_t)m * PG * PG, PG, PG, WSB(WS_WPOOL) + (size_t)(m >> 2) * D * PG, nullptr, INF(8) + (m >> 2) * D + (m & 3) * PG, 1.f, 0, (m & 3) * PG, scr, r & 127, lane); continue; } r -= I_POOL;
        if (r < I_MQ) { const int m = r >> 9; wt_item(INF(20) + (size_t)m * D * MI, D, MI, WSB(WS_WMQ) + (size_t)m * MI * D, INF(4) + m * D, nullptr, SC_MEM, 0, 0, scr, r & 511, lane); continue; } r -= I_MQ;
        if (r < I_MQ) { const int m = r >> 9; wt_item(INF(21) + (size_t)m * D * MI, D, MI, WSB(WS_WMK) + (size_t)m * MI * D, INF(5) + m * D, nullptr, 1.f, 0, 0, scr, r & 511, lane); continue; } r -= I_MQ;
        if (r < I_MQ) { const int m = r >> 9; wt_item(INF(22) + (size_t)m * D * MI, D, MI, WSB(WS_WMV) + (size_t)m * MI * D, INF(5) + m * D, nullptr, 1.f, 0, 0, scr, r & 511, lane); continue; } r -= I_MQ;
        if (r < I_MO) { const int m = r >> 9; wt_item(INF(23) + (size_t)m * MI * D, MI, D, WSB(WS_WMO) + (size_t)m * D * MI, nullptr, nullptr, 1.f, 0, 0, scr, r & 511, lane); continue; } r -= I_MO;
        if (r < I_DQ) { wt_item(INF(15), D, QR, WSB(WS_WDQ0), INF(3) + 2 * D, nullptr, 1.f, 0, 0, scr, r, lane); continue; } r -= I_DQ;
        if (r < I_DQ) { wt_item(INF(10), D, KVR, WSB(WS_WDQ0), INF(9), nullptr, 1.f, 0, 512, scr, r, lane); continue; } r -= I_DQ;
        if (r < I_KR) { wt_item(INF(12), D, ROPE, WSB(WS_WDQ0), INF(9), nullptr, 1.f, 5, 1024, scr, r, lane); continue; } r -= I_KR;
        if (r < I_DQ) { wt_item(INF(15) + (size_t)D * QR, D, QR, WSB(WS_WDQ1), INF(3) + 3 * D, nullptr, 1.f, 0, 0, scr, r, lane); continue; } r -= I_DQ;
        if (r < I_UQ) { const int m = r >> 9; wt_item(INF(17) + (size_t)m * QR * D, QR, HEADS * NOPE, WSB(WS_WUQ) + (size_t)m * NQ * QR, INF(16) + m * QR, nullptr, SC_MLA, 1, 0, scr, r & 511, lane); continue; } r -= I_UQ;
        if (r < I_QR) { const int m = r >> 8; wt_item(INF(18) + (size_t)m * QR * HEADS * ROPE, QR, HEADS * ROPE, WSB(WS_WUQ) + (size_t)m * NQ * QR, INF(16) + m * QR, nullptr, SC_MLA, 2, 0, scr, r & 255, lane); continue; } r -= I_QR;
        if (r < I_O) { const int m = r >> 11; wt_item(INF(19) + (size_t)m * D * D, D, D, WSB(WS_WO) + (size_t)m * D * D, nullptr, nullptr, 1.f, 0, 0, scr, r & 2047, lane); continue; } r -= I_O;
        if (r < I_UK) { wt_item(INF(13), KVR, D, WSB(WS_WUKV), INF(11), nullptr, 1.f, 0, 0, scr, r, lane); continue; } r -= I_UK;
        wt_item(INF(14), KVR, D, WSB(WS_WUKV), INF(11), nullptr, 1.f, 0, 2048, scr, r, lane);
    }
}
DI void conv_experts(const MArgs& P, int l, LAS unsigned char* lds, int gw, int NGW, int wave, int lane) {
    LAS float* scr = (LAS float*)(lds + wave * 16384);
    for (int it = gw; it < 3 * NE * 512; it += NGW) { const int fam = it >> 14, m = l * NE + ((it >> 9) & 31), r = it & 511;
        if (fam == 0) wt_item(INF(28) + (size_t)m * D * EFF, D, EFF, WSB(WS_WGU) + (size_t)m * 1024 * D, INF(6) + l * D, nullptr, 1.f, 3, 0, scr, r, lane);
        else if (fam == 1) wt_item(INF(29) + (size_t)m * D * EFF, D, EFF, WSB(WS_WGU) + (size_t)m * 1024 * D, INF(6) + l * D, nullptr, 1.f, 4, 0, scr, r, lane);
        else wt_item(INF(30) + (size_t)m * EFF * D, EFF, D, WSB(WS_WD) + (size_t)m * D * EFF, nullptr, nullptr, 1.f, 0, 0, scr, r, lane); }
}
DI void tables_phase(const MArgs& P, int gtid, int NT_) {
    for (int idx = gtid; idx < T * 32; idx += NT_) { const int t = idx >> 5, i = idx & 31;
        const float inv = (float)(1.0 / pow(10000.0, (double)i / 32.0)); const float ang = (float)((const int*)P.in[2])[t] * inv;
        const double rev = (double)ang * 0.15915494309189533577; const float fr = (float)(rev - rint(rev));
        WSF(WS_COS)[idx] = __builtin_amdgcn_cosf(fr); WSF(WS_SIN)[idx] = __builtin_amdgcn_sinf(fr); }
    for (int idx = gtid; idx < DEPTH * 48 * D; idx += NT_) { const int l = idx / (48 * D), n = (idx / D) % 48, k = idx % D;
        float w = 0.f; if (n < 36) w = (n < 4 ? INF(24)[((size_t)l * D + k) * 4 + n] : INF(26)[((size_t)l * D + k) * 32 + (n - 4)]) * INF(6)[l * D + k];
        const unsigned hi = f2bf(w), lo = f2bf(w - __uint_as_float(hi << 16));
        WSB(WS_RWH)[((size_t)(l * 2 + 0) * 48 + n) * D + k] = (bf16_t)hi; WSB(WS_RWH)[((size_t)(l * 2 + 1) * 48 + n) * D + k] = (bf16_t)lo; }
    unsigned* z = (unsigned*)(WSB(WS_WDQ0) + (size_t)1088 * D);
    for (int idx = gtid; idx < (NDQ0 - 1088) * D / 2; idx += NT_) z[idx] = 0u;
}
DI void memprep_phase(const MArgs& P, int gw, int NGW, int lane) {
    for (int r = gw; r < NB * MEMT; r += NGW) { const f32x4* x = (const f32x4*)(INF(1) + (size_t)r * D) + lane; float ss = 0.f;
#pragma unroll
        for (int j = 0; j < 8; ++j) { const f32x4 v = x[64 * j]; ss += (v.x * v.x + v.y * v.y) + (v.z * v.z + v.w * v.w);
            u32x2 o; o.x = pk2(v.x, v.y); o.y = pk2(v.z, v.w); *((u32x2*)(WSB(WS_MEMB) + (size_t)r * D) + lane + 64 * j) = o; }
        ss = wave_sum(ss); if (lane == 0) WSF(WS_MEMRS)[r] = rsqrtf(ss * (1.0f / D) + EPS); }
}
DI void combine_phase(const float* src, const bf16_t* src16, const bf16_t* Y, float* H, bf16_t* HB, float* RS0, const float* gain, bf16_t* HN, float* out, int gw, int NGW, int lane) {
    for (int t = gw; t < T; t += NGW) {
        const f32x4* x = (const f32x4*)(src + (size_t)t * D) + lane; f32x4 v[8]; float ss = 0.f;
#pragma unroll
        for (int j = 0; j < 8; ++j) {
            if (src16) { const u32x2 h = *((const u32x2*)(src16 + (size_t)t * D) + lane + 64 * j); v[j] = (f32x4){__uint_as_float(h.x << 16), __uint_as_float(h.x & 0xffff0000u), __uint_as_float(h.y << 16), __uint_as_float(h.y & 0xffff0000u)}; }
            else v[j] = x[64 * j];
            if (Y) { const u32x2 a = *((const u32x2*)(Y + (size_t)(2 * t) * D) + lane + 64 * j), b = *((const u32x2*)(Y + (size_t)(2 * t + 1) * D) + lane + 64 * j);
                v[j].x = (v[j].x + __uint_as_float(a.x << 16)) + __uint_as_float(b.x << 16); v[j].y = (v[j].y + __uint_as_float(a.x & 0xffff0000u)) + __uint_as_float(b.x & 0xffff0000u);
                v[j].z = (v[j].z + __uint_as_float(a.y << 16)) + __uint_as_float(b.y << 16); v[j].w = (v[j].w + __uint_as_float(a.y & 0xffff0000u)) + __uint_as_float(b.y & 0xffff0000u); }
            ss += (v[j].x * v[j].x + v[j].y * v[j].y) + (v[j].z * v[j].z + v[j].w * v[j].w); }
        ss = wave_sum(ss); const float rs = rsqrtf(ss * (1.0f / D) + EPS);
        if (lane == 0 && RS0) RS0[t] = rs;
#pragma unroll
        for (int j = 0; j < 8; ++j) {
            if (H) *((f32x4*)(H + (size_t)t * D) + lane + 64 * j) = v[j];
            if (HB) { u32x2 o; o.x = pk2(v[j].x, v[j].y); o.y = pk2(v[j].z, v[j].w); *((u32x2*)(HB + (size_t)t * D) + lane + 64 * j) = o; }
            if (gain) { const f32x4 g = *((const f32x4*)gain + lane + 64 * j); const f32x4 n = v[j] * g * rs;
                if (HN) { u32x2 o; o.x = pk2(n.x, n.y); o.y = pk2(n.z, n.w); *((u32x2*)(HN + (size_t)t * D) + lane + 64 * j) = o; }
                if (out) *((f32x4*)(out + (size_t)t * D) + lane + 64 * j) = n; } }
    }
}
DI void pool_phase(const bf16_t* HN, bf16_t* U, int vcu, int G, int tid) {
    if (vcu < 0) return;
    for (int t = vcu * 2 + (tid >> 8); t < T; t += 2 * G) { const int c = (tid & 255) * 8, s = t & (S - 1), w = 2 << (c >> 9), n = (s + 1 < w) ? s + 1 : w;
        float acc[8] = {0.f, 0.f, 0.f, 0.f, 0.f, 0.f, 0.f, 0.f}, self[8] = {0.f, 0.f, 0.f, 0.f, 0.f, 0.f, 0.f, 0.f};
        for (int i = 0; i < n; ++i) { const u32x4 v = *(const u32x4*)(HN + (size_t)(t - i) * D + c);
            const float f[8] = {__uint_as_float(v.x << 16), __uint_as_float(v.x & 0xffff0000u), __uint_as_float(v.y << 16), __uint_as_float(v.y & 0xffff0000u),
                                __uint_as_float(v.z << 16), __uint_as_float(v.z & 0xffff0000u), __uint_as_float(v.w << 16), __uint_as_float(v.w & 0xffff0000u)};
#pragma unroll
            for (int q = 0; q < 8; ++q) { acc[q] += f[q]; if (i == 0) self[q] = f[q]; } }
        const float inv = 1.0f / (float)n; u32x4 o;
        o.x = pk2(acc[0] * inv - self[0], acc[1] * inv - self[1]); o.y = pk2(acc[2] * inv - self[2], acc[3] * inv - self[3]);
        o.z = pk2(acc[4] * inv - self[4], acc[5] * inv - self[5]); o.w = pk2(acc[6] * inv - self[6], acc[7] * inv - self[7]);
        *(u32x4*)(U + (size_t)t * D + c) = o; }
}
typedef float f32x4r __attribute__((ext_vector_type(4)));
DI void router_phase(const float* H, const bf16_t* HBs, const bf16_t* RWH, const float* rg_b, const float* re_b, float* RS2, int* cnt, int* list, float* gwt, LAS unsigned char* lds, int vcu, int G, int wave, int lane, bool commit = true) {
    LAS float* tile = (LAS float*)(lds + wave * 4096);
    const bf16_t* RWL = RWH + (size_t)48 * D;
    for (int t16 = wave * G + vcu; t16 < T / 16; t16 += 8 * G) {
        const int r16 = lane & 15, kq = lane >> 4;
        const float* hp = H + (size_t)(t16 * 16 + r16) * D + kq * 8; const bf16_t* hb = HBs + (size_t)(t16 * 16 + r16) * D + kq * 8;
        const bf16_t* wh = RWH + (size_t)r16 * D + kq * 8; const bf16_t* wl = RWL + (size_t)r16 * D + kq * 8;
        f32x4 acc[3]; float ss = 0.f;
#pragma unroll
        for (int q = 0; q < 3; ++q) acc[q] = (f32x4){0.f, 0.f, 0.f, 0.f};
        for (int k0 = 0; k0 < D; k0 += 128) {
            f32x4 xa[4], xb[4];
#pragma unroll
            for (int u = 0; u < 4; ++u) {
                if (H16) { const u32x4 w = *(const u32x4*)(hb + k0 + u * 32);
                    xa[u] = (f32x4){__uint_as_float(w.x << 16), __uint_as_float(w.x & 0xffff0000u), __uint_as_float(w.y << 16), __uint_as_float(w.y & 0xffff0000u)};
                    xb[u] = (f32x4){__uint_as_float(w.z << 16), __uint_as_float(w.z & 0xffff0000u), __uint_as_float(w.w << 16), __uint_as_float(w.w & 0xffff0000u)}; }
                else { xa[u] = *(const f32x4*)(hp + k0 + u * 32); xb[u] = *(const f32x4*)(hp + k0 + u * 32 + 4); } }
#pragma unroll
            for (int u = 0; u < 4; ++u) {
                const f32x4 a = xa[u], b = xb[u];
                ss += ((a.x * a.x + a.y * a.y) + (a.z * a.z + a.w * a.w)) + ((b.x * b.x + b.y * b.y) + (b.z * b.z + b.w * b.w));
                u32x4 h; h.x = fg::cvt_pk_bf16(a.x, a.y); h.y = fg::cvt_pk_bf16(a.z, a.w); h.z = fg::cvt_pk_bf16(b.x, b.y); h.w = fg::cvt_pk_bf16(b.z, b.w);
                u32x4 lo; lo.x = fg::cvt_pk_bf16(a.x - __uint_as_float(h.x << 16), a.y - __uint_as_float(h.x & 0xffff0000u)); lo.y = fg::cvt_pk_bf16(a.z - __uint_as_float(h.y << 16), a.w - __uint_as_float(h.y & 0xffff0000u));
                lo.z = fg::cvt_pk_bf16(b.x - __uint_as_float(h.z << 16), b.y - __uint_as_float(h.z & 0xffff0000u)); lo.w = fg::cvt_pk_bf16(b.z - __uint_as_float(h.w << 16), b.w - __uint_as_float(h.w & 0xffff0000u));
                const bf16x8 ah = *reinterpret_cast<const bf16x8*>(&h), al_ = *reinterpret_cast<const bf16x8*>(&lo);
#pragma unroll
                for (int q = 0; q < 3; ++q) { const bf16x8 bh = *(const bf16x8*)(wh + (size_t)q * 16 * D + k0 + u * 32), bl = *(const bf16x8*)(wl + (size_t)q * 16 * D + k0 + u * 32);
                    acc[q] = __builtin_amdgcn_mfma_f32_16x16x32_bf16(ah, bh, acc[q], 0, 0, 0);
                    if (!H16) acc[q] = __builtin_amdgcn_mfma_f32_16x16x32_bf16(al_, bh, acc[q], 0, 0, 0);
                    acc[q] = __builtin_amdgcn_mfma_f32_16x16x32_bf16(ah, bl, acc[q], 0, 0, 0); }
            }
        }
        ss = fg::quad_sum(ss);
        const float rs = rsqrtf(ss * (1.0f / D) + EPS);
#pragma unroll
        for (int q = 0; q < 3; ++q)
#pragma unroll
            for (int i = 0; i < 4; ++i) tile[(kq * 4 + i) * 49 + q * 16 + r16] = acc[q][i];
        LDS_WAIT();
        if (lane < 16) {
            const LAS float* tr = tile + lane * 49; const int t = t16 * 16 + lane;
            const float g0 = tr[0] * rs + rg_b[0], g1 = tr[1] * rs + rg_b[1], g2 = tr[2] * rs + rg_b[2], g3 = tr[3] * rs + rg_b[3];
            int gs = 0; float gm = g0; if (g1 > gm) { gm = g1; gs = 1; } if (g2 > gm) { gm = g2; gs = 2; } if (g3 > gm) { gm = g3; gs = 3; }
            const float gp = 1.0f / (__expf(g0 - gm) + __expf(g1 - gm) + __expf(g2 - gm) + __expf(g3 - gm));
            float ev[8];
#pragma unroll
            for (int i = 0; i < 8; ++i) ev[i] = tr[4 + gs * 8 + i] * rs + re_b[gs * 8 + i];
            int i0 = 0; float m0 = ev[0];
#pragma unroll
            for (int i = 1; i < 8; ++i) if (ev[i] > m0) { m0 = ev[i]; i0 = i; }
            int i1 = -1; float m1 = -3.0e38f;
#pragma unroll
            for (int i = 0; i < 8; ++i) if (i != i0 && ev[i] > m1) { m1 = ev[i]; i1 = i; }
            const float e1 = __expf(m1 - m0), w0 = gp / (1.0f + e1), w1 = gp * e1 / (1.0f + e1);
            if (commit || w0 < -1.f) { RS2[t] = rs; const int ea = gs * 8 + i0, eb = gs * 8 + i1;
                const int pa = atomicAdd(&cnt[ea], 1); list[(size_t)ea * CAP + pa] = 2 * t; gwt[2 * t] = w0;
                const int pb = atomicAdd(&cnt[eb], 1); list[(size_t)eb * CAP + pb] = 2 * t + 1; gwt[2 * t + 1] = w1; }
        }
        LDS_WAIT();
    }
}
namespace fg {
struct EpiMemKV {
    bf16_t* O; const float* rs;
    DI void operator()(const Acc& acc, const Unit& u, int wr, int wc, int fr, int fq) const {
        float sc[2][4];
#pragma unroll
        for (int ai = 0; ai < 2; ++ai)
#pragma unroll
            for (int m = 0; m < 4; ++m) sc[ai][m] = rs[u.pm * BM + EPI_ROWS(ai, m)];
#pragma unroll
        for (int ai = 0; ai < 2; ++ai)
#pragma unroll
            for (int m = 0; m < 4; ++m) { const int r = u.pm * BM + EPI_ROWS(ai, m);
#pragma unroll
                for (int bj = 0; bj < 2; ++bj) { const int c0 = (u.pn & 1) * BM + bj * HALF + wc * 32 + 8 * fq;
                    *(u32x4*)(O + (size_t)(u.pn >> 1) * (NB * MEMT * MI) + (size_t)r * MI + c0) = pack8(acc[ai][bj][m][0] * sc[ai][m], acc[ai][bj][m][1] * sc[ai][m]); } }
    }
};
}
DI int scan32(int v, int lane) {
#pragma unroll
    for (int o = 1; o < 32; o <<= 1) { const int t = __builtin_amdgcn_ds_bpermute(((lane - o) & 63) << 2, v); if ((lane & 31) >= o) v += t; }
    return v;
}
DI void moe_prefix(LAS unsigned char* lds, const int* cnt) {
    LAS int* pref = (LAS int*)(lds + LDS_MISC + 1024); const int tid = opaque_tid();
    if (tid < 64) {
        const int e = tid & 31, c = cnt[e], nt = (c + 255) >> 8, st = scan32(nt, tid);
        if (tid < 32) { pref[64 + e] = c; pref[e] = st - nt; if (e == 31) pref[32] = st; }
    }
    __syncthreads();
    if (tid == 0) {
        const int G = gridDim.x, nx = (G & 7) ? 1 : 8, x = blockIdx.x % nx; int n = 0;
        for (int e = x; e < NE; e += nx) { const int nt = (pref[64 + e] + 255) >> 8, base = pref[e]; for (int t = 0; t < nt; ++t) pref[128 + n++] = e | (t << 8) | ((base + t) << 16); }
        pref[40] = n; }
    __syncthreads();
}

__global__ void __launch_bounds__(512, 2) mk_fwd(MArgs a) {
    extern __shared__ __attribute__((aligned(16))) unsigned char lds_raw[];
    LAS unsigned char* lds = (LAS unsigned char*)lds_raw;
    const int G = gridDim.x, bx = blockIdx.x, vcu = fa::vcu_of(bx, G), NGW = G * 8;
    volatile LAS unsigned* MISC = (volatile LAS unsigned*)(lds + LDS_MISC);
    if (threadIdx.x < 64) MISC[threadIdx.x] = 0u;
    __syncthreads();
    unsigned char* ws = a.ws;
    XcdBarrier bar = xcd_barrier_post((unsigned*)(ws + WS_CTL) + CW_BAR + a.bar_region * XCD_BAR_WORDS, MISC + 8);
    const MArgs& P = a;
    int pid = 0; const int lo = a.ph_lo, hi = a.ph_hi;
#define PH_IF if (pid >= lo && pid < hi)
#define TL const int tid = opaque_tid(), lane = tid & 63, wave = __builtin_amdgcn_readfirstlane(tid >> 6), gw = vcu * 8 + wave; (void)lane; (void)gw
#define PH_END do { if (pid >= lo && pid + 1 < hi) xcd_barrier(bar); ++pid; } while (0)
    PH_IF { TL; conv_phase(P, lds, gw, NGW, wave, lane); if (XCONV) conv_phase(P, lds, gw, NGW, wave, lane); tables_phase(P, vcu * 512 + tid, G * 512); memprep_phase(P, gw, NGW, lane);
            combine_phase(INF(0), nullptr, nullptr, H16 ? nullptr : WSF(WS_H), WSB(WS_HB), WSF(WS_RS0), INF(3), WSB(WS_HN), nullptr, gw, NGW, lane); }
    PH_END;
    for (int l = 0; l < DEPTH; ++l) {
        const bool isA = l < NA; const int j = l - NA;
        if (l > 0) { PH_IF { TL; if (XCOMB) combine_phase(WSF(WS_H), H16 ? WSB(WS_HB) : nullptr, WSB(WS_Y), WSF(WS_Q), nullptr, nullptr, nullptr, nullptr, nullptr, gw, NGW, lane);
            combine_phase(WSF(WS_H), H16 ? WSB(WS_HB) : nullptr, WSB(WS_Y), H16 ? nullptr : WSF(WS_H), WSB(WS_HB), WSF(WS_RS0), isA ? INF(3) + l * D : nullptr, isA ? WSB(WS_HN) : nullptr, nullptr, gw, NGW, lane); } PH_END; }
        if (isA) {
            PH_IF { if (l == 0) { fg::ProbDense pr{(const char*)WSB(WS_MEMB), (const char*)WSB(WS_WMK), (const char*)WSB(WS_MEMB), (const char*)WSB(WS_WMK), NB * MEMT / 256, 16, 16, D, D, 0, G, bx}; fg::EpiMemKV E{WSB(WS_MK), WSF(WS_MEMRS)}; fg::gemm_phase(lds, pr, E); }
                    { TL; const bool split = (l == 0 && G > 64); pool_phase(WSB(WS_HN), WSB(WS_U), split ? bx - 64 : vcu, split ? G - 64 : G, tid); if (XPOOL) pool_phase(WSB(WS_HN), WSB(WS_U), vcu, G, tid); } }
            PH_END;
        } else {
            PH_IF { const int n = j == 0 ? NDQ0 : QR; const char* B = (const char*)(j == 0 ? WSB(WS_WDQ0) : WSB(WS_WDQ1));
                    fg::ProbDense pr{(const char*)WSB(WS_HB), B, (const char*)WSB(WS_HB), B, T / 256, n / 256, n / 256, D, D, 0, G, bx};
                    fg::EpiDQ E{WSB(WS_CQ), WSB(WS_CKV), WSB(WS_KR), WSF(WS_RS0), WSF(WS_LSQ), WSF(WS_LSKV), WSF(WS_COS), WSF(WS_SIN)}; fg::gemm_phase(lds, pr, E); if (XDENSE) fg::gemm_phase(lds, pr, E); }
            PH_END;
            PH_IF { fg::ProbDense pr{(const char*)WSB(WS_CQ), (const char*)(WSB(WS_WUQ) + (size_t)j * NQ * QR), (const char*)WSB(WS_CKV), (const char*)WSB(WS_WUKV), T / 256, (j == 0 ? NQ + 4096 : NQ) / 256, NQ / 256, QR, QR, 0, G, bx};
                    fg::EpiUQ E{WSB(WS_Q), WSB(WS_KN), WSB(WS_V), WSF(WS_LSQ), WSF(WS_LSKV), WSF(WS_COS), WSF(WS_SIN)}; fg::gemm_phase(lds, pr, E); if (XUQ) fg::gemm_phase(lds, pr, E); }
            PH_END;
            PH_IF { fa::mla_phase((LAS char*)lds, WSB(WS_Q), WSB(WS_KN), WSB(WS_KR), WSB(WS_V), WSB(WS_AO), G, bx); if (XMLA) fa::mla_phase((LAS char*)lds, WSB(WS_Q), WSB(WS_KN), WSB(WS_KR), WSB(WS_V), WSB(WS_AO), G, bx); }
            PH_END;
        }
        PH_IF { const char* A = (const char*)(isA ? WSB(WS_U) : WSB(WS_AO)); const char* B = (const char*)(isA ? WSB(WS_WPOOL) + (size_t)l * D * PG : WSB(WS_WO) + (size_t)j * D * D);
                fg::ProbDense pr{A, B, A, B, T / 256, D / 256, D / 256, isA ? PG : D, D, isA ? 1 : 0, G, bx}; fg::EpiRes<true> E{WSB(WS_HB), WSF(WS_SSP)}; if (XRES) { fg::EpiRes<true> E2{WSB(WS_HB), WSF(WS_SSP), WSB(WS_Y)}; fg::gemm_phase(lds, pr, E2); } fg::gemm_phase(lds, pr, E); }
        PH_END;
        PH_IF { const char* B = (const char*)(WSB(WS_WMQ) + (size_t)l * MI * D); fg::ProbDense pr{(const char*)WSB(WS_HB), B, (const char*)WSB(WS_HB), B, T / 256, MI / 256, MI / 256, D, D, 0, G, bx};
                fg::EpiBf16RS<2> E{WSB(WS_MQ), MI, WSF(WS_SSP)}; fg::gemm_phase(lds, pr, E); if (XDENSE) fg::gemm_phase(lds, pr, E); }
        PH_END;
        PH_IF { fa::memattn_phase((LAS char*)lds, WSB(WS_MQ), WSB(WS_MK) + (size_t)l * NB * MEMT * MI, WSB(WS_MV) + (size_t)l * NB * MEMT * MI, WSB(WS_MO), G, bx); if (XMEMATT) fa::memattn_phase((LAS char*)lds, WSB(WS_MQ), WSB(WS_MK) + (size_t)l * NB * MEMT * MI, WSB(WS_MV) + (size_t)l * NB * MEMT * MI, WSB(WS_MO), G, bx); }
        PH_END;
        PH_IF { const char* B = (const char*)(WSB(WS_WMO) + (size_t)l * D * MI); fg::ProbDense pr{(const char*)WSB(WS_MO), B, (const char*)WSB(WS_MO), B, T / 256, D / 256, D / 256, MI, MI, 0, G, bx};
                fg::EpiRes<false> E{WSB(WS_HB), nullptr}; if (XRES) { fg::EpiRes<false> E2{WSB(WS_HB), nullptr, WSB(WS_Y)}; fg::gemm_phase(lds, pr, E2); } fg::gemm_phase(lds, pr, E); }
        PH_END;
        PH_IF { TL; if (XROUTER) router_phase(WSF(WS_H), WSB(WS_HB), WSB(WS_RWH) + (size_t)l * 2 * 48 * D, INF(25) + l * NG, INF(27) + l * NE, WSF(WS_RS2), ((int*)(P.ws + WS_CTL + OFF_CNT)) + l * NE, ((int*)(P.ws + WS_LIST)), WSF(WS_GW), lds, vcu, G, wave, lane, false);
                router_phase(WSF(WS_H), WSB(WS_HB), WSB(WS_RWH) + (size_t)l * 2 * 48 * D, INF(25) + l * NG, INF(27) + l * NE, WSF(WS_RS2), ((int*)(P.ws + WS_CTL + OFF_CNT)) + l * NE, ((int*)(P.ws + WS_LIST)), WSF(WS_GW), lds, vcu, G, wave, lane);
                if (JIT) { __syncthreads(); conv_experts(P, l, lds, gw, NGW, wave, lane); } }
        PH_END;
        PH_IF { moe_prefix(lds, ((int*)(P.ws + WS_CTL + OFF_CNT)) + l * NE);
                fg::ProbMoe pr{(const char*)WSB(WS_HB), (const char*)(WSB(WS_WGU) + (size_t)l * NE * 1024 * D), ((int*)(P.ws + WS_LIST)), (const LAS int*)(lds + LDS_MISC + 1024), 4, D, D, 1, G, bx, (long)1024 * D * 2};
                fg::EpiMoe1 E{WSB(WS_HH), WSF(WS_RS2), ((int*)(P.ws + WS_LIST))}; fg::gemm_phase(lds, pr, E); if (XMOE == 1) fg::gemm_phase(lds, pr, E); if (XMOE == 2) fg::gemm_phase<decltype(E), decltype(pr), true>(lds, pr, E); }
        PH_END;
        PH_IF { moe_prefix(lds, ((int*)(P.ws + WS_CTL + OFF_CNT)) + l * NE);
                fg::ProbMoe pr{(const char*)WSB(WS_HH), (const char*)(WSB(WS_WD) + (size_t)l * NE * D * EFF), ((int*)(P.ws + WS_LIST)), (const LAS int*)(lds + LDS_MISC + 1024), 8, EFF, EFF, 0, G, bx, (long)D * EFF * 2};
                fg::EpiMoe2 E{WSB(WS_Y), WSF(WS_GW), ((int*)(P.ws + WS_LIST))}; fg::gemm_phase(lds, pr, E); if (XMOE == 1) fg::gemm_phase(lds, pr, E); if (XMOE == 2) fg::gemm_phase<decltype(E), decltype(pr), true>(lds, pr, E); }
        PH_END;
    }
    PH_IF { TL; combine_phase(WSF(WS_H), H16 ? WSB(WS_HB) : nullptr, WSB(WS_Y), nullptr, nullptr, nullptr, INF(31), nullptr, P.out, gw, NGW, lane); }
#undef PH_IF
#undef PH_END
}
constexpr int NPHASES = 1 + 8 + 9 + 11 + 11 + 1;

#ifndef MK_SPLIT
#define MK_SPLIT 0
#endif
extern "C" void kernel_launch(void* const* d_in, const int* in_sizes, int n_in, void* d_out, int out_size, void* d_ws, size_t ws_size, hipStream_t stream) {
    static int grid = 0;
    if (grid == 0) {
        if (n_in != 32 || in_sizes[0] != T * D || out_size != T * D || ws_size < WS_END) { fprintf(stderr, "kernel_launch: shape/ws mismatch (ws %zu need %zu)\n", ws_size, (size_t)WS_END); grid = -1; return; }
        int dev = 0, cus = 0;
        if (hipGetDevice(&dev) != hipSuccess || hipDeviceGetAttribute(&cus, hipDeviceAttributeMultiprocessorCount, dev) != hipSuccess || cus <= 0) { fprintf(stderr, "kernel_launch: device query failed\n"); grid = -1; return; }
        if (hipFuncSetAttribute((const void*)mk_fwd, hipFuncAttributeMaxDynamicSharedMemorySize, LDS_BYTES) != hipSuccess) { fprintf(stderr, "kernel_launch: hipFuncSetAttribute failed\n"); grid = -1; return; }
        int per_cu = 0;
        if (hipOccupancyMaxActiveBlocksPerMultiprocessor(&per_cu, (const void*)mk_fwd, 512, LDS_BYTES) != hipSuccess || per_cu < 1) fprintf(stderr, "kernel_launch: occupancy query says %d\n", per_cu);
        (void)hipGetLastError();
        grid = cus;
    }
    if (grid < 0) return;
    if (hipMemsetAsync((char*)d_ws + WS_CTL, 0, CTL_BYTES, stream) != hipSuccess) { fprintf(stderr, "kernel_launch: memset failed\n"); return; }
    MArgs a; memset(&a, 0, sizeof(a));
    for (int i = 0; i < 32; ++i) a.in[i] = d_in[i];
    a.out = (float*)d_out; a.ws = (unsigned char*)d_ws;
#if MK_SPLIT
    for (int p = 0; p < NPHASES; ++p) { a.ph_lo = p; a.ph_hi = p + 1; a.bar_region = 0; hipLaunchKernelGGL(mk_fwd, dim3(grid), dim3(512), LDS_BYTES, stream, a); }
#else
    a.ph_lo = 0; a.ph_hi = NPHASES; a.bar_region = 0; hipLaunchKernelGGL(mk_fwd, dim3(grid), dim3(512), LDS_BYTES, stream, a);
#endif
    const hipError_t le = hipPeekAtLastError();
    if (le != hipSuccess) fprintf(stderr, "kernel_launch: launch failed: %s\n", hipGetErrorName(le));
}
```

```cpp
#include <hip/hip_runtime.h>
#include <cstdio>
#include <cstdint>
#include <cstring>

typedef unsigned short bf16_t;
typedef float f32x4 __attribute__((ext_vector_type(4)));
typedef unsigned u32x4 __attribute__((ext_vector_type(4)));
typedef unsigned u32x2 __attribute__((ext_vector_type(2)));
#define DI __device__ __forceinline__

constexpr int D = 2048, NB = 4, S = 4096, T = NB * S, DEPTH = 4, NA = 2;
constexpr int CHUNK = 64;
constexpr int PG = 512;
constexpr int HEADS = 16, QR = 512, KVR = 512, NOPE = 128, ROPE = 64, VD = 128, QKD = NOPE + ROPE;
constexpr int MEMT = 256, MH = 4, MHD = 128, MI = 512;
constexpr int NG = 4, EPG = 8, NE = 32, EFF = 512;
constexpr float EPS = 1e-6f;
constexpr int CAP = T;
constexpr int MAXROWS = 2 * T + NE * 256;
constexpr int NQ = HEADS * QKD;
constexpr int NDQ0 = 1280;

constexpr size_t al(size_t x) { return (x + 255) & ~(size_t)255; }
constexpr size_t WS_CTL = 0, CTL_BYTES = 1u << 20;
constexpr size_t OFF_CNT = 65536;
constexpr size_t WS_WPOOL = WS_CTL + CTL_BYTES;
constexpr size_t WS_WMQ = WS_WPOOL + (size_t)NA * D * PG * 2;
constexpr size_t WS_WMK = WS_WMQ + (size_t)DEPTH * MI * D * 2;
constexpr size_t WS_WMV = WS_WMK + (size_t)DEPTH * MI * D * 2;
constexpr size_t WS_WMO = WS_WMV + (size_t)DEPTH * MI * D * 2;
constexpr size_t WS_WDQ0 = WS_WMO + (size_t)DEPTH * D * MI * 2;
constexpr size_t WS_WDQ1 = WS_WDQ0 + (size_t)NDQ0 * D * 2;
constexpr size_t WS_WUQ = WS_WDQ1 + (size_t)QR * D * 2;
constexpr size_t WS_WUKV = WS_WUQ + (size_t)2 * NQ * QR * 2;
constexpr size_t WS_WO = WS_WUKV + (size_t)4096 * KVR * 2;
constexpr size_t WS_RWT = WS_WO + (size_t)2 * D * D * 2;
constexpr size_t WS_WGU = al(WS_RWT + (size_t)DEPTH * 36 * D * 4);
constexpr size_t WS_WD = WS_WGU + (size_t)DEPTH * NE * 1024 * D * 2;
constexpr size_t WS_H = WS_WD + (size_t)DEPTH * NE * D * EFF * 2;
constexpr size_t WS_HB = WS_H + (size_t)T * D * 4;
constexpr size_t WS_Y = WS_HB + (size_t)T * D * 2;
constexpr size_t WS_HH = WS_Y + (size_t)2 * T * D * 2;
constexpr size_t WS_KN = WS_HH + (size_t)MAXROWS * EFF * 2;
constexpr size_t WS_V = WS_KN + (size_t)T * D * 2;
constexpr size_t WS_Q = WS_V + (size_t)T * D * 2;
constexpr size_t WS_HN = WS_Q;
constexpr size_t WS_U = WS_Q + (size_t)T * D * 2;
constexpr size_t WS_AO = WS_Q + (size_t)T * NQ * 2;
constexpr size_t WS_MQ = WS_AO + (size_t)T * D * 2;
constexpr size_t WS_MO = WS_MQ + (size_t)T * MI * 2;
constexpr size_t WS_CQ = WS_MO + (size_t)T * MI * 2;
constexpr size_t WS_CKV = WS_CQ + (size_t)T * QR * 2;
constexpr size_t WS_KR = WS_CKV + (size_t)T * KVR * 2;
constexpr size_t WS_MEMB = WS_KR + (size_t)T * ROPE * 2;
constexpr size_t WS_MK = WS_MEMB + (size_t)NB * MEMT * D * 2;
constexpr size_t WS_MV = WS_MK + (size_t)DEPTH * NB * MEMT * MI * 2;
constexpr size_t WS_SSP = WS_MV + (size_t)DEPTH * NB * MEMT * MI * 2;
constexpr size_t WS_LSQ = WS_SSP + (size_t)T * 32 * 4;
constexpr size_t WS_LSKV = WS_LSQ + (size_t)T * 8 * 4;
constexpr size_t WS_RS0 = WS_LSKV + (size_t)T * 8 * 4;
constexpr size_t WS_RS2 = WS_RS0 + (size_t)T * 4;
constexpr size_t WS_MEMRS = WS_RS2 + (size_t)T * 4;
constexpr size_t WS_COS = WS_MEMRS + 4096;
constexpr size_t WS_SIN = WS_COS + (size_t)T * 32 * 4;
constexpr size_t WS_GW = WS_SIN + (size_t)T * 32 * 4;
constexpr size_t WS_LIST = WS_GW + (size_t)2 * T * 4;
constexpr size_t WS_RWH = WS_LIST + (size_t)NE * CAP * 4;
constexpr size_t WS_END = WS_RWH + (size_t)DEPTH * 2 * 48 * D * 2;
static_assert(WS_U + (size_t)T * D * 2 <= WS_MQ, "U overlay inside Q|AO");

DI float bf2f(bf16_t b) { return __uint_as_float(((unsigned)b) << 16); }
DI unsigned f2bf(float f) { unsigned u = __float_as_uint(f); return (u + 0x7fffu + ((u >> 16) & 1u)) >> 16; }
DI unsigned pk2(float lo, float hi) { return f2bf(lo) | (f2bf(hi) << 16); }
#define SWZ_XOR(v, m) __int_as_float(__builtin_amdgcn_ds_swizzle(__float_as_int(v), (((m) << 10) | 0x1F)))
DI float half_sum(float s) { auto rr = __builtin_amdgcn_permlane32_swap(__float_as_uint(s), __float_as_uint(s), false, false); return __uint_as_float(rr[0]) + __uint_as_float(rr[1]); }
DI float wave_sum(float v) { v += SWZ_XOR(v, 1); v += SWZ_XOR(v, 2); v += SWZ_XOR(v, 4); v += SWZ_XOR(v, 8); v += SWZ_XOR(v, 16); return half_sum(v); }
DI int opaque_tid() { int t = threadIdx.x; asm volatile("" : "+v"(t)); return t; }
DI float silu(float x) { return x / (1.0f + __expf(-x)); }

DI int permrow(int perm, int n) {
    switch (perm) {
        case 1: return (n >> 7) * QKD + (n & 127);
        case 2: { const int h = n >> 6, r = n & 63; return h * QKD + NOPE + 2 * (r & 31) + (r >> 5); }
        case 3: return (n >> 7) * 256 + (n & 127);
        case 4: return (n >> 7) * 256 + 128 + (n & 127);
        case 5: return 2 * (n & 31) + (n >> 5);
        default: return n;
    }
}
#define LAS __attribute__((address_space(3)))
typedef short bf16x8 __attribute__((ext_vector_type(8)));
namespace fg {
constexpr int BM = 256, BK = 64, HALF = 128, HTB = HALF * BK * 2, STAGE_BYTES = 8 * HTB, NXCD = 8, WGM = 16;
DI int lds_byte(int r, int c) { const int st = (r >> 4) * 2 + (c >> 5), rr = r & 15, cc = c & 31, ob = rr * 64 + cc * 2; return st * 1024 + (ob ^ (((ob >> 9) & 1) << 5)); }
DI void stage_rc(int b, int& R, int& C) { const int st = b / 1024, sb = b % 1024, swz = sb ^ (((sb >> 9) & 1) << 5); R = (st >> 1) * 16 + swz / 64; C = (st & 1) * 32 + (swz % 64) / 2; }
DI int perm32(int rho) { const int n = rho >> 4, i = rho & 15; return 8 * (i >> 2) + 4 * n + (i & 3); }
DI unsigned cvt_pk_bf16(float lo, float hi) { unsigned r; asm volatile("v_cvt_pk_bf16_f32 %0, %1, %2" : "=v"(r) : "v"(lo), "v"(hi)); return r; }
struct Unit { int pm, pn, e, r0, cnt; };

struct ProbDense {
    const char* A0; const char* B0; const char* A1; const char* B1; int nM, nN, nN0, K, lda, pool, G, c;
    static constexpr bool GATHER = false;
    DI bool next(int i, Unit& u) const {
        const long L = (long)i * G + c; const int nwg = nM * nN; if (L >= nwg) return false;
        int wgid = (int)L; { const int q = nwg / NXCD, r = nwg % NXCD, xcd = wgid % NXCD, off = wgid / NXCD; wgid = (xcd < r ? xcd * (q + 1) : r * (q + 1) + (xcd - r) * q) + off; }
        const int nig = WGM * nN, gid = wgid / nig, fm = gid * WGM, gsz = (nM - fm) < WGM ? (nM - fm) : WGM;
        u.pm = fm + ((wgid % nig) % gsz); u.pn = (wgid % nig) / gsz; u.e = 0; u.r0 = 0; u.cnt = 256; return true; }
    DI const char* aptr(const Unit& u) const { return (u.pn < nN0 ? A0 : A1) + (size_t)u.pm * 256 * lda * 2 + (pool ? (size_t)(u.pn >> 1) * 1024 : 0); }
    DI const char* bptr(const Unit& u) const { return u.pn < nN0 ? B0 + (size_t)u.pn * 256 * K * 2 : B1 + (size_t)(u.pn - nN0) * 256 * K * 2; }
    DI void avoff(const Unit&, int tid, unsigned (&vo)[2][2]) const {
        int R[2], C[2]; stage_rc(tid * 16, R[0], C[0]); stage_rc(tid * 16 + 8192, R[1], C[1]);
#pragma unroll
        for (int h = 0; h < 2; ++h)
#pragma unroll
            for (int i = 0; i < 2; ++i) vo[h][i] = (unsigned)((h * 128 + R[i]) * lda + C[i]) * 2u; }
};
struct ProbMoe {
    const char* A; const char* Bt; const int* list; const LAS int* pref; int npn, K, lda, gather, G, c; long estride;
    static constexpr bool GATHER = true;
    DI bool next(int i, Unit& u) const {
        const int nx = (G & 7) ? 1 : 8, q = i * (G / nx) + c / nx, t = q / npn; if (t >= pref[40]) return false;
        const int ent = pref[128 + t], e = ent & 255;
        u.pm = ent >> 16; u.pn = q % npn; u.e = e; u.r0 = ((ent >> 8) & 255) * 256; u.cnt = pref[64 + e]; return true; }
    DI const char* aptr(const Unit& u) const { return gather ? A : A + (size_t)u.pm * 256 * lda * 2; }
    DI const char* bptr(const Unit& u) const { return Bt + (size_t)u.e * estride + (size_t)u.pn * 256 * K * 2; }
    DI void avoff(const Unit& u, int tid, unsigned (&vo)[2][2]) const {
        int R[2], C[2]; stage_rc(tid * 16, R[0], C[0]); stage_rc(tid * 16 + 8192, R[1], C[1]);
#pragma unroll
        for (int h = 0; h < 2; ++h)
#pragma unroll
            for (int i = 0; i < 2; ++i) { const int row = h * 128 + R[i];
                if (gather) { const int ri = u.r0 + row; const int tok = ri < u.cnt ? (list[(size_t)u.e * CAP + ri] >> 1) : 0; vo[h][i] = (unsigned)(tok * lda + C[i]) * 2u; }
                else vo[h][i] = (unsigned)(row * lda + C[i]) * 2u; } }
};

typedef f32x4 Acc[2][2][4][2];
DI float quad_sum(float s) { s += SWZ_XOR(s, 16); return half_sum(s); }
DI float sq8(const f32x4& a, const f32x4& b) { return ((a.x * a.x + a.y * a.y) + (a.z * a.z + a.w * a.w)) + ((b.x * b.x + b.y * b.y) + (b.z * b.z + b.w * b.w)); }
DI u32x4 pack8(const f32x4& a, const f32x4& b) { u32x4 w; w.x = cvt_pk_bf16(a.x, a.y); w.y = cvt_pk_bf16(a.z, a.w); w.z = cvt_pk_bf16(b.x, b.y); w.w = cvt_pk_bf16(b.z, b.w); return w; }
template <int NP> DI float rs_from_parts(const float* part, int r, int fq, float inv_n) {
    float s;
    if (NP == 32) { const f32x4 a = *(const f32x4*)(part + (size_t)r * 32 + fq * 8), b = *(const f32x4*)(part + (size_t)r * 32 + fq * 8 + 4); s = ((a.x + a.y) + (a.z + a.w)) + ((b.x + b.y) + (b.z + b.w)); }
    else { const float* p = part + (size_t)r * 8 + fq * 2; s = p[0] + p[1]; }
    s = quad_sum(s); return rsqrtf(s * inv_n + EPS);
}
DI void rope8(f32x4& a, f32x4& b, const float* COS, const float* SIN, int r, int i0) {
    const f32x4 c = *(const f32x4*)(COS + (size_t)r * 32 + i0), s = *(const f32x4*)(SIN + (size_t)r * 32 + i0);
    const f32x4 a2 = {a.x * c.x - a.y * s.x, a.y * c.x + a.x * s.x, a.z * c.y - a.w * s.y, a.w * c.y + a.z * s.y};
    const f32x4 b2 = {b.x * c.z - b.y * s.z, b.y * c.z + b.x * s.z, b.z * c.w - b.w * s.w, b.w * c.w + b.z * s.w};
    a = a2; b = b2;
}
#define EPI_ROWS(ai, m) (ai * HALF + wr * 64 + m * 16 + fr)
DI void unpack8(const u32x4& w, f32x4& a, f32x4& b) {
    a = (f32x4){__uint_as_float(w.x << 16), __uint_as_float(w.x & 0xffff0000u), __uint_as_float(w.y << 16), __uint_as_float(w.y & 0xffff0000u)};
    b = (f32x4){__uint_as_float(w.z << 16), __uint_as_float(w.z & 0xffff0000u), __uint_as_float(w.w << 16), __uint_as_float(w.w & 0xffff0000u)}; }
DI void rope8r(f32x4& a, f32x4& b, const f32x4& c, const f32x4& s) {
    const f32x4 a2 = {a.x * c.x - a.y * s.x, a.y * c.x + a.x * s.x, a.z * c.y - a.w * s.y, a.w * c.y + a.z * s.y};
    const f32x4 b2 = {b.x * c.z - b.y * s.z, b.y * c.z + b.x * s.z, b.z * c.w - b.w * s.w, b.w * c.w + b.z * s.w};
    a = a2; b = b2;
}
template <bool STATS> struct EpiRes {
    bf16_t* HB; float* SSP; bf16_t* HBout = nullptr;
    DI void operator()(const Acc& acc, const Unit& u, int wr, int wc, int fr, int fq) const {
        const int cb = u.pn * BM + wc * 32 + 8 * fq;
#pragma unroll
        for (int ai = 0; ai < 2; ++ai) {
            u32x4 w[4][2];
#pragma unroll
            for (int m = 0; m < 4; ++m)
#pragma unroll
                for (int bj = 0; bj < 2; ++bj) w[m][bj] = *(const u32x4*)(HB + (size_t)(u.pm * BM + EPI_ROWS(ai, m)) * D + cb + bj * HALF);
#pragma unroll
            for (int m = 0; m < 4; ++m) { const int r = u.pm * BM + EPI_ROWS(ai, m); float ss = 0.f;
#pragma unroll
                for (int bj = 0; bj < 2; ++bj) { f32x4 h0, h1; unpack8(w[m][bj], h0, h1); h0 += acc[ai][bj][m][0]; h1 += acc[ai][bj][m][1];
                    *(u32x4*)((HBout ? HBout : HB) + (size_t)r * D + cb + bj * HALF) = pack8(h0, h1); if (STATS) ss += sq8(h0, h1); }
                if (STATS) { ss = quad_sum(ss); if (fq == 0) SSP[(size_t)r * 32 + u.pn * 4 + wc] = ss; } }
        }
    }
};
template <int MODE  > struct EpiBf16RS {
    bf16_t* O; int ldo; const float* rs;
    DI void operator()(const Acc& acc, const Unit& u, int wr, int wc, int fr, int fq) const {
        float sc[2][4];
#pragma unroll
        for (int ai = 0; ai < 2; ++ai)
#pragma unroll
            for (int m = 0; m < 4; ++m) { const int r = u.pm * BM + EPI_ROWS(ai, m); sc[ai][m] = MODE == 1 ? rs[r] : rs_from_parts<32>(rs, r, fq, 1.0f / D); }
#pragma unroll
        for (int ai = 0; ai < 2; ++ai)
#pragma unroll
            for (int m = 0; m < 4; ++m) { const int r = u.pm * BM + EPI_ROWS(ai, m);
#pragma unroll
                for (int bj = 0; bj < 2; ++bj) { const int c0 = u.pn * BM + bj * HALF + wc * 32 + 8 * fq;
                    *(u32x4*)(O + (size_t)r * ldo + c0) = pack8(acc[ai][bj][m][0] * sc[ai][m], acc[ai][bj][m][1] * sc[ai][m]); } }
    }
};
struct EpiDQ {
    bf16_t* CQ; bf16_t* CKV; bf16_t* KR; const float* RS0; float* LSQ; float* LSKV; const float* COS; const float* SIN;
    DI void operator()(const Acc& acc, const Unit& u, int wr, int wc, int fr, int fq) const {
        float sc[2][4];
#pragma unroll
        for (int ai = 0; ai < 2; ++ai)
#pragma unroll
            for (int m = 0; m < 4; ++m) sc[ai][m] = RS0[u.pm * BM + EPI_ROWS(ai, m)];
        if (u.pn < 4) {
#pragma unroll
            for (int ai = 0; ai < 2; ++ai)
#pragma unroll
                for (int m = 0; m < 4; ++m) { const int r = u.pm * BM + EPI_ROWS(ai, m); float ss = 0.f;
#pragma unroll
                    for (int bj = 0; bj < 2; ++bj) { const int cl = bj * HALF + wc * 32 + 8 * fq; const f32x4 v0 = acc[ai][bj][m][0] * sc[ai][m], v1 = acc[ai][bj][m][1] * sc[ai][m];
                        ss += sq8(v0, v1); *(u32x4*)((u.pn < 2 ? CQ : CKV) + (size_t)r * 512 + (u.pn & 1) * 256 + cl) = pack8(v0, v1); }
                    ss = quad_sum(ss); if (fq == 0) (u.pn < 2 ? LSQ : LSKV)[(size_t)r * 8 + (u.pn & 1) * 4 + wc] = ss; }
        } else if (wc < 2) {
            const int cl = wc * 32 + 8 * fq; f32x4 cs[2][4], sn[2][4];
#pragma unroll
            for (int ai = 0; ai < 2; ++ai)
#pragma unroll
                for (int m = 0; m < 4; ++m) { const int r = u.pm * BM + EPI_ROWS(ai, m); cs[ai][m] = *(const f32x4*)(COS + (unsigned)(r * 32 + (cl >> 1))); sn[ai][m] = *(const f32x4*)(SIN + (unsigned)(r * 32 + (cl >> 1))); }
#pragma unroll
            for (int ai = 0; ai < 2; ++ai)
#pragma unroll
                for (int m = 0; m < 4; ++m) { const int r = u.pm * BM + EPI_ROWS(ai, m); f32x4 v0 = acc[ai][0][m][0] * sc[ai][m], v1 = acc[ai][0][m][1] * sc[ai][m];
                    rope8r(v0, v1, cs[ai][m], sn[ai][m]); *(u32x4*)(KR + (size_t)r * 64 + cl) = pack8(v0, v1); }
        }
    }
};
struct EpiUQ {
    bf16_t* Q; bf16_t* KN; bf16_t* V; const float* LSQ; const float* LSKV; const float* COS; const float* SIN;
    DI void operator()(const Acc& acc, const Unit& u, int wr, int wc, int fr, int fq) const {
        const bool isq = u.pn < 12; float sc[2][4];
#pragma unroll
        for (int ai = 0; ai < 2; ++ai)
#pragma unroll
            for (int m = 0; m < 4; ++m) sc[ai][m] = rs_from_parts<8>(isq ? LSQ : LSKV, u.pm * BM + EPI_ROWS(ai, m), fq, 1.0f / 512.0f);
#pragma unroll
        for (int bj = 0; bj < 2; ++bj) {
            const int c0 = (isq ? u.pn : u.pn - 12) * BM + bj * HALF + wc * 32 + 8 * fq, hc = c0 % QKD; const bool rot = isq && hc >= NOPE;
#pragma unroll
            for (int ai = 0; ai < 2; ++ai) {
                f32x4 cs[4], sn[4];
                if (rot) {
#pragma unroll
                    for (int m = 0; m < 4; ++m) { const int r = u.pm * BM + EPI_ROWS(ai, m); cs[m] = *(const f32x4*)(COS + (unsigned)(r * 32 + ((hc - NOPE) >> 1))); sn[m] = *(const f32x4*)(SIN + (unsigned)(r * 32 + ((hc - NOPE) >> 1))); } }
#pragma unroll
                for (int m = 0; m < 4; ++m) { const int r = u.pm * BM + EPI_ROWS(ai, m); f32x4 v0 = acc[ai][bj][m][0] * sc[ai][m], v1 = acc[ai][bj][m][1] * sc[ai][m];
                    if (rot) rope8r(v0, v1, cs[m], sn[m]);
                    bf16_t* o = isq ? Q + (size_t)r * NQ + c0 : (c0 < 2048 ? KN + c0 : V + (c0 - 2048)) + (size_t)r * D;
                    *(u32x4*)o = pack8(v0, v1); }
            }
        }
    }
};
struct EpiMoe1 {
    bf16_t* HH; const float* RS2; const int* list;
    DI void operator()(const Acc& acc, const Unit& u, int wr, int wc, int fr, int fq) const {
        int tok[2][4]; float sc[2][4];
#pragma unroll
        for (int ai = 0; ai < 2; ++ai)
#pragma unroll
            for (int m = 0; m < 4; ++m) { const int ri = u.r0 + EPI_ROWS(ai, m); tok[ai][m] = ri < u.cnt ? (list[(size_t)u.e * CAP + ri] >> 1) : 0; }
#pragma unroll
        for (int ai = 0; ai < 2; ++ai)
#pragma unroll
            for (int m = 0; m < 4; ++m) sc[ai][m] = RS2[tok[ai][m]];
#pragma unroll
        for (int ai = 0; ai < 2; ++ai)
#pragma unroll
            for (int m = 0; m < 4; ++m) { const int lr = EPI_ROWS(ai, m);
                if (u.r0 + lr < u.cnt) { const float s_ = sc[ai][m];
                    const f32x4 g0 = acc[ai][0][m][0] * s_, g1 = acc[ai][0][m][1] * s_, u0 = acc[ai][1][m][0] * s_, u1 = acc[ai][1][m][1] * s_;
                    const f32x4 h0 = {silu(g0.x) * u0.x, silu(g0.y) * u0.y, silu(g0.z) * u0.z, silu(g0.w) * u0.w}, h1 = {silu(g1.x) * u1.x, silu(g1.y) * u1.y, silu(g1.z) * u1.z, silu(g1.w) * u1.w};
                    *(u32x4*)(HH + (size_t)(u.pm * BM + lr) * EFF + u.pn * 128 + wc * 32 + 8 * fq) = pack8(h0, h1); } }
    }
};
struct EpiMoe2 {
    bf16_t* Y; const float* GW; const int* list;
    DI void operator()(const Acc& acc, const Unit& u, int wr, int wc, int fr, int fq) const {
        int as[2][4]; float sc[2][4];
#pragma unroll
        for (int ai = 0; ai < 2; ++ai)
#pragma unroll
            for (int m = 0; m < 4; ++m) { const int ri = u.r0 + EPI_ROWS(ai, m); as[ai][m] = ri < u.cnt ? list[(size_t)u.e * CAP + ri] : 0; }
#pragma unroll
        for (int ai = 0; ai < 2; ++ai)
#pragma unroll
            for (int m = 0; m < 4; ++m) sc[ai][m] = GW[as[ai][m]];
#pragma unroll
        for (int ai = 0; ai < 2; ++ai)
#pragma unroll
            for (int m = 0; m < 4; ++m) { if (u.r0 + EPI_ROWS(ai, m) < u.cnt) {
#pragma unroll
                    for (int bj = 0; bj < 2; ++bj) { const int c0 = u.pn * BM + bj * HALF + wc * 32 + 8 * fq;
                        *(u32x4*)(Y + (size_t)as[ai][m] * D + c0) = pack8(acc[ai][bj][m][0] * sc[ai][m], acc[ai][bj][m][1] * sc[ai][m]); } } }
    }
};

template <class Epi, class Prob, bool DRY = false>
DI void gemm_phase(LAS unsigned char* lds, const Prob& P, const Epi& E) {
    const int tid = opaque_tid(), wid = __builtin_amdgcn_readfirstlane(tid >> 6), lane = tid & 63, wr = wid >> 2, wc = wid & 3, fr = lane & 15, fq = lane >> 4;
    const int K = P.K, nt = K / BK;
    int sR[2], sC[2]; unsigned voffB[2];
#pragma unroll
    for (int i = 0; i < 2; ++i) { stage_rc(tid * 16 + i * 8192, sR[i], sC[i]); const int Rb = (sR[i] & ~31) + perm32(sR[i] & 31); voffB[i] = (unsigned)(Rb * K + sC[i]) * 2u; }
    const size_t kstep = (size_t)(BK * 2), hstepB = (size_t)HALF * K * 2;
    const unsigned ldsw = (unsigned)wid * 1024u;
    const int aoff = lds_byte(wr * 64 + fr, fq * 8), boff = lds_byte(wc * 32 + fr, fq * 8);
#define PG8_SA(b, h) (((b) * 2 + (h)) * HTB)
#define PG8_SB(b, h) ((4 + (b) * 2 + (h)) * HTB)
#define PG8_STAGE(bufoff, gbase, voff) do { _Pragma("unroll") for (int _i = 0; _i < 2; ++_i) \
        __builtin_amdgcn_global_load_lds((const unsigned*)((const char*)(gbase) + (voff)[_i]), (LAS unsigned*)(lds + (bufoff) + ldsw + _i * 8192), 16, 0, 0); } while (0)
#define PG8_LDA(dst, b, h) do { _Pragma("unroll") for (int m = 0; m < 4; ++m) _Pragma("unroll") for (int k = 0; k < 2; ++k) dst[m][k] = *(const LAS bf16x8*)(lds + PG8_SA(b, h) + aoff + m * 2048 + k * 1024); } while (0)
#define PG8_LDB(dst, b, h) do { _Pragma("unroll") for (int n = 0; n < 2; ++n) _Pragma("unroll") for (int k = 0; k < 2; ++k) dst[n][k] = *(const LAS bf16x8*)(lds + PG8_SB(b, h) + boff + n * 2048 + k * 1024); } while (0)
#define PG8_MMA(ai, bj, At, Bt) do { __builtin_amdgcn_s_setprio(1); _Pragma("unroll") for (int m = 0; m < 4; ++m) _Pragma("unroll") for (int n = 0; n < 2; ++n) _Pragma("unroll") for (int k = 0; k < 2; ++k) \
        acc[ai][bj][m][n] = __builtin_amdgcn_mfma_f32_16x16x32_bf16(Bt[n][k], At[m][k], acc[ai][bj][m][n], 0, 0, 0); __builtin_amdgcn_s_setprio(0); } while (0)
#define PG8_WAIT_V(n) asm volatile("s_waitcnt vmcnt(" #n ")" ::: "memory")
#define PG8_WAIT_L(n) asm volatile("s_waitcnt lgkmcnt(" #n ")" ::: "memory")
#define PG8_BAR __builtin_amdgcn_s_barrier()
#define PG8_SCHED __builtin_amdgcn_sched_barrier(0)
    Unit cur, nxt; int ui = 0;
    if (!P.next(0, cur)) return;
    bool do0 = true, do1 = true;
    if constexpr (Prob::GATHER) { const int nv = cur.cnt - cur.r0; do0 = wr * 64 < nv; do1 = 128 + wr * 64 < nv; }
    if constexpr (DRY) { do0 = false; do1 = false; }
    f32x4 acc[2][2][4][2];
#pragma unroll
    for (int a = 0; a < 2; ++a)
#pragma unroll
        for (int b = 0; b < 2; ++b)
#pragma unroll
            for (int m = 0; m < 4; ++m)
#pragma unroll
                for (int n = 0; n < 2; ++n) acc[a][b][m][n] = (f32x4){0.f, 0.f, 0.f, 0.f};
    bf16x8 At[4][2], B0[2][2], B1[2][2];
    const char* cA = P.aptr(cur); const char* cB = P.bptr(cur);
    unsigned voA[2][2], vnA[2][2];
    P.avoff(cur, tid, voA);
    if constexpr (Prob::GATHER) asm volatile("s_waitcnt vmcnt(0)" ::: "memory");
    PG8_STAGE(PG8_SB(0, 0), cB, voffB); PG8_STAGE(PG8_SB(0, 1), cB + hstepB, voffB); PG8_STAGE(PG8_SA(0, 0), cA, voA[0]); PG8_STAGE(PG8_SA(0, 1), cA, voA[1]);
    if (wr == 1) PG8_BAR;
    PG8_WAIT_V(2); PG8_BAR;
    PG8_STAGE(PG8_SB(1, 0), cB + kstep, voffB); PG8_STAGE(PG8_SA(1, 0), cA + kstep, voA[0]); PG8_STAGE(PG8_SB(1, 1), cB + hstepB + kstep, voffB);
    PG8_WAIT_V(6); PG8_BAR;
    for (;;) {
        const bool has_next = P.next(ui + 1, nxt);
        const char* nA = has_next ? P.aptr(nxt) : cA; const char* nB = has_next ? P.bptr(nxt) : cB;
#pragma unroll
        for (int h = 0; h < 2; ++h)
#pragma unroll
            for (int i = 0; i < 2; ++i) vnA[h][i] = voA[h][i];
        for (int t = 0; t < nt; t += 2) {
            const bool last = (t == nt - 2);
            if constexpr (Prob::GATHER) { if (last && has_next) P.avoff(nxt, opaque_tid(), vnA); }
            const char* a1 = cA + (size_t)(t + 1) * kstep;
            const char* a2 = last ? nA : cA + (size_t)(t + 2) * kstep; const char* b2 = last ? nB : cB + (size_t)(t + 2) * kstep;
            const char* a3 = a2 + kstep; const char* b3 = b2 + kstep;
            unsigned w0[2], w1[2];
#pragma unroll
            for (int i = 0; i < 2; ++i) { w0[i] = last ? vnA[0][i] : voA[0][i]; w1[i] = last ? vnA[1][i] : voA[1][i]; }
            PG8_LDB(B0, 0, 0); PG8_LDB(B1, 0, 1); PG8_SCHED; PG8_LDA(At, 0, 0); PG8_STAGE(PG8_SA(1, 1), a1, voA[1]);
            PG8_WAIT_V(8); PG8_WAIT_L(0); PG8_BAR; if (do0) { PG8_MMA(0, 0, At, B0); PG8_MMA(0, 1, At, B1); } PG8_BAR; PG8_SCHED;
            PG8_LDA(At, 0, 1); PG8_STAGE(PG8_SB(0, 0), b2, voffB); PG8_STAGE(PG8_SB(0, 1), b2 + hstepB, voffB); PG8_STAGE(PG8_SA(0, 0), a2, w0);
            PG8_WAIT_V(8); PG8_WAIT_L(0); PG8_BAR; if (do1) { PG8_MMA(1, 0, At, B0); PG8_MMA(1, 1, At, B1); } PG8_BAR; PG8_SCHED;
            PG8_LDB(B0, 1, 0); PG8_LDB(B1, 1, 1); PG8_SCHED; PG8_LDA(At, 1, 0); PG8_STAGE(PG8_SA(0, 1), a2, w1);
            PG8_WAIT_V(8); PG8_WAIT_L(0); PG8_BAR; if (do0) { PG8_MMA(0, 0, At, B0); PG8_MMA(0, 1, At, B1); } PG8_BAR; PG8_SCHED;
            PG8_LDA(At, 1, 1); PG8_STAGE(PG8_SB(1, 0), b3, voffB); PG8_STAGE(PG8_SB(1, 1), b3 + hstepB, voffB); PG8_STAGE(PG8_SA(1, 0), a3, w0);
            PG8_WAIT_V(8); PG8_WAIT_L(0); PG8_BAR; if (do1) { PG8_MMA(1, 0, At, B0); PG8_MMA(1, 1, At, B1); } PG8_BAR; PG8_SCHED;
        }
        if (wr == 0) PG8_BAR;
        if constexpr (!DRY) { const int lz = opaque_tid() & 63; E(acc, cur, wr, wc, lz & 15, lz >> 4); }
        if (!has_next) break;
#pragma unroll
        for (int a = 0; a < 2; ++a)
#pragma unroll
            for (int b = 0; b < 2; ++b)
#pragma unroll
                for (int m = 0; m < 4; ++m)
#pragma unroll
                    for (int n = 0; n < 2; ++n) acc[a][b][m][n] = (f32x4){0.f, 0.f, 0.f, 0.f};
        cur = nxt; cA = nA; cB = nB; ++ui;
        if constexpr (Prob::GATHER) { const int nv = cur.cnt - cur.r0; do0 = wr * 64 < nv; do1 = 128 + wr * 64 < nv; }
        if constexpr (DRY) { do0 = false; do1 = false; }
#pragma unroll
        for (int h = 0; h < 2; ++h)
#pragma unroll
            for (int i = 0; i < 2; ++i) voA[h][i] = vnA[h][i];
        if (wr == 1) PG8_BAR;
    }
    PG8_WAIT_V(0);
    PG8_BAR;
#undef PG8_SA
#undef PG8_SB
#undef PG8_STAGE
#undef PG8_LDA
#undef PG8_LDB
#undef PG8_MMA
#undef PG8_WAIT_V
#undef PG8_WAIT_L
#undef PG8_BAR
#undef PG8_SCHED
}
}


namespace fa {
typedef float f32x16 __attribute__((ext_vector_type(16)));
typedef short s16x4 __attribute__((ext_vector_type(4)));
#define SBAR() __builtin_amdgcn_sched_barrier(0)
constexpr float THR = 8.f, LOG2E = 1.4426950408889634f;
DI int crow(int r, int hi) { return (r & 3) + 8 * (r >> 2) + 4 * hi; }
DI unsigned cvtpk(float lo, float hi) { unsigned r; asm volatile("v_cvt_pk_bf16_f32 %0, %1, %2" : "=v"(r) : "v"(lo), "v"(hi)); return r; }
DI void partialSM(f32x16& p0, f32x16& p1, float& m_reg, float& mn, float& alpha) {
    float pmax = p0[0];
#pragma unroll
    for (int r = 1; r < 16; ++r) pmax = fmaxf(pmax, p0[r]);
#pragma unroll
    for (int r = 0; r < 16; ++r) pmax = fmaxf(pmax, p1[r]);
    { auto rr = __builtin_amdgcn_permlane32_swap(__float_as_uint(pmax), __float_as_uint(pmax), false, false); pmax = fmaxf(__uint_as_float(rr[0]), __uint_as_float(rr[1])); }
    if (__builtin_expect(__all(pmax - m_reg <= THR), 1)) { mn = m_reg; alpha = 1.f; }
    else { mn = fmaxf(m_reg, pmax); alpha = __builtin_amdgcn_exp2f((m_reg - mn) * LOG2E); m_reg = mn; }
    const float mnC = -mn * LOG2E;
#pragma unroll
    for (int r = 0; r < 16; ++r) p0[r] = fmaf(p0[r], LOG2E, mnC);
#pragma unroll
    for (int r = 0; r < 16; ++r) p1[r] = fmaf(p1[r], LOG2E, mnC);
#pragma unroll
    for (int r = 0; r < 16; ++r) p0[r] = __builtin_amdgcn_exp2f(p0[r]);
}
DI void finishSM(f32x16& p0, f32x16& p1, float alpha, float& l_reg, bf16x8& pa0, bf16x8& pa1, bf16x8& pa2, bf16x8& pa3) {
#pragma unroll
    for (int r = 0; r < 16; ++r) p1[r] = __builtin_amdgcn_exp2f(p1[r]);
    float ps = 0;
#pragma unroll
    for (int r = 0; r < 16; ++r) ps += p0[r];
#pragma unroll
    for (int r = 0; r < 16; ++r) ps += p1[r];
    { auto rr = __builtin_amdgcn_permlane32_swap(__float_as_uint(ps), __float_as_uint(ps), false, false); ps = __uint_as_float(rr[0]) + __uint_as_float(rr[1]); }
    l_reg = l_reg * alpha + ps;
#define PK4(P, BASE, OUT) do { unsigned a0 = cvtpk(P[BASE + 0], P[BASE + 1]), a1 = cvtpk(P[BASE + 2], P[BASE + 3]);   \
    unsigned b0 = cvtpk(P[BASE + 4], P[BASE + 5]), b1 = cvtpk(P[BASE + 6], P[BASE + 7]);                              \
    auto r0 = __builtin_amdgcn_permlane32_swap(a0, b0, false, false); auto r1 = __builtin_amdgcn_permlane32_swap(a1, b1, false, false); \
    u32x4 w = {r0[0], r1[0], r0[1], r1[1]}; OUT = *reinterpret_cast<bf16x8*>(&w); } while (0)
    PK4(p0, 0, pa0); PK4(p0, 8, pa1); PK4(p1, 0, pa2); PK4(p1, 8, pa3);
#undef PK4
}
template <int DQK> DI void qkt(f32x16& p0, f32x16& p1, LAS const char* Ks, const int (&kb)[4], const bf16x8* qr) {
    constexpr int KROW = DQK * 2;
#pragma unroll
    for (int r = 0; r < 16; ++r) { p0[r] = 0.f; p1[r] = 0.f; }
    __builtin_amdgcn_s_setprio(1);
#pragma unroll
    for (int d0 = 0; d0 < DQK / 16; ++d0) {
        const bf16x8 b0 = *(LAS const bf16x8*)(Ks + kb[d0 & 3] + (d0 >> 2) * 128);
        const bf16x8 b1 = *(LAS const bf16x8*)(Ks + kb[d0 & 3] + (d0 >> 2) * 128 + 32 * KROW);
        p0 = __builtin_amdgcn_mfma_f32_32x32x16_bf16(b0, qr[d0], p0, 0, 0, 0);
        p1 = __builtin_amdgcn_mfma_f32_32x32x16_bf16(b1, qr[d0], p1, 0, 0, 0); }
    __builtin_amdgcn_s_setprio(0);
}
DI int v_rd_base(int lane) { return ((lane & 3) << 3) | (((lane >> 2) & 3) << 6) | (((lane >> 4) & 1) << 5) | (((lane >> 5) & 1) << 8); }
constexpr int v_rd_off(int d0, int ks, int half) { return d0 * 512 + ks * 4096 + half * 2048; }
template <int OFF> DI s16x4 tr_read(int vb) { s16x4 r; asm volatile("ds_read_b64_tr_b16 %0, %1 offset:%2" : "=&v"(r) : "v"(vb), "i"(OFF) : "memory"); return r; }
template <int D0> DI void pv_one(f32x16& od, int vb, bf16x8 pa0, bf16x8 pa1, bf16x8 pa2, bf16x8 pa3) {
    const s16x4 l0 = tr_read<v_rd_off(D0, 0, 0)>(vb), h0 = tr_read<v_rd_off(D0, 0, 1)>(vb), l1 = tr_read<v_rd_off(D0, 1, 0)>(vb), h1 = tr_read<v_rd_off(D0, 1, 1)>(vb);
    const s16x4 l2 = tr_read<v_rd_off(D0, 2, 0)>(vb), h2 = tr_read<v_rd_off(D0, 2, 1)>(vb), l3 = tr_read<v_rd_off(D0, 3, 0)>(vb), h3 = tr_read<v_rd_off(D0, 3, 1)>(vb);
    asm volatile("s_waitcnt lgkmcnt(0)" ::: "memory"); SBAR();
#define PK(L, H) (bf16x8){L[0], L[1], L[2], L[3], H[0], H[1], H[2], H[3]}
    __builtin_amdgcn_s_setprio(1);
    od = __builtin_amdgcn_mfma_f32_32x32x16_bf16(pa0, PK(l0, h0), od, 0, 0, 0);
    od = __builtin_amdgcn_mfma_f32_32x32x16_bf16(pa1, PK(l1, h1), od, 0, 0, 0);
    od = __builtin_amdgcn_mfma_f32_32x32x16_bf16(pa2, PK(l2, h2), od, 0, 0, 0);
    od = __builtin_amdgcn_mfma_f32_32x32x16_bf16(pa3, PK(l3, h3), od, 0, 0, 0);
    __builtin_amdgcn_s_setprio(0);
#undef PK
}
DI void pv_d0(f32x16* o, int vb, bf16x8 pa0, bf16x8 pa1, bf16x8 pa2, bf16x8 pa3) {
    pv_one<0>(o[0], vb, pa0, pa1, pa2, pa3); pv_one<1>(o[1], vb, pa0, pa1, pa2, pa3); pv_one<2>(o[2], vb, pa0, pa1, pa2, pa3); pv_one<3>(o[3], vb, pa0, pa1, pa2, pa3);
}
template <int DQK, bool CAUSAL>
DI void attn_unit(LAS char* lds, const bf16_t* Qb, int ldq, const bf16_t* K1, int ldk1, const bf16_t* K2, int ldk2, const bf16_t* Vb, int ldv, bf16_t* Ob, int ldo, int NT, int qtile0) {
    constexpr int KROW = DQK * 2, KT = 64 * KROW, BUF = KT + 16384, NKP = DQK / 64, ND0 = DQK / 16;
    const int tid = opaque_tid(), wid = __builtin_amdgcn_readfirstlane(tid >> 6), lane = tid & 63, r32 = lane & 31, hi = lane >> 5;
    LAS float* wsf = (LAS float*)(lds + 3 * BUF) + wid * 64; LAS float* li_l = wsf; LAS float* al_l = wsf + 32;
    const char* kp[NKP]; int kst[NKP]; const char* vp[2];
#pragma unroll
    for (int i = 0; i < NKP; ++i) { const int p = (wid * NKP + i) * 1024 + lane * 16, row = p / KROW, cbs = p % KROW, cb = cbs ^ ((row & 7) << 4);
        if (DQK == 128 || cb < 256) { kp[i] = (const char*)K1 + (size_t)row * ldk1 * 2 + cb; kst[i] = 64 * ldk1 * 2; }
        else { kp[i] = (const char*)K2 + (size_t)row * ldk2 * 2 + (cb - 256); kst[i] = 64 * ldk2 * 2; } }
#pragma unroll
    for (int i = 0; i < 2; ++i) { const int p = (wid * 2 + i) * 1024 + lane * 16, sub = p >> 9, q = (p & 511) >> 1, kk = (sub >> 2) * 8 + (q >> 5), k = (kk & ~0xC) | ((kk & 4) << 1) | ((kk & 8) >> 1), c = (sub & 3) * 32 + (q & 31);
        vp[i] = (const char*)Vb + ((size_t)k * ldv + c) * 2; }
    const int vstep = 64 * ldv * 2;
#define FA_DMA(bo) do { _Pragma("unroll") for (int _i = 0; _i < NKP; ++_i) { __builtin_amdgcn_global_load_lds((const unsigned*)kp[_i], (LAS unsigned*)(lds + (bo) + (wid * NKP + _i) * 1024), 16, 0, 0); kp[_i] += kst[_i]; } \
        _Pragma("unroll") for (int _i = 0; _i < 2; ++_i) { __builtin_amdgcn_global_load_lds((const unsigned*)vp[_i], (LAS unsigned*)(lds + (bo) + KT + (wid * 2 + _i) * 1024), 16, 0, 0); vp[_i] += vstep; } } while (0)
#define FA_SYNC() do { asm volatile("s_waitcnt vmcnt(0)" ::: "memory"); __builtin_amdgcn_s_barrier(); asm volatile("" ::: "memory"); } while (0)
    int bm1 = 0, bc = BUF, bp1 = 2 * BUF;
    FA_DMA(bm1); FA_DMA(bc);
    bf16x8 qr[ND0];
    { const bf16_t* Qw = Qb + (size_t)(wid * 32 + r32) * ldq + hi * 8;
#pragma unroll
      for (int d0 = 0; d0 < ND0; ++d0) qr[d0] = *(const bf16x8*)(Qw + d0 * 16); }
    int kb[4];
#pragma unroll
    for (int q = 0; q < 4; ++q) kb[q] = r32 * KROW + ((q * 32 + hi * 16) ^ ((r32 & 7) << 4));
    const int vb0 = (int)(uintptr_t)lds + KT + v_rd_base(lane);
    const int lim = CAUSAL ? qtile0 + (wid >> 1) : 0x7fffffff;
    float m_reg = -1e30f, l_reg = 0; f32x16 o[4];
#pragma unroll
    for (int d = 0; d < 4; ++d)
#pragma unroll
        for (int r = 0; r < 16; ++r) o[d][r] = 0.f;
    f32x16 pA0, pA1, pB0, pB1; float mnA, mnB, alA, alB; bf16x8 pa0, pa1, pa2, pa3;
#define FA_VIS(j) (!CAUSAL || (j) <= lim)
#define FA_MASK(P0, P1, j) do { if (CAUSAL && (j) > lim) { _Pragma("unroll") for (int _r = 0; _r < 16; ++_r) { P0[_r] = -1e30f; P1[_r] = -1e30f; } } } while (0)
#define FA_RESC(a) do { if (__any((a) < 1.f)) { if (hi == 0) al_l[r32] = (a); asm volatile("s_waitcnt lgkmcnt(0)" ::: "memory"); \
        _Pragma("unroll") for (int _d = 0; _d < 4; ++_d) _Pragma("unroll") for (int _r = 0; _r < 16; ++_r) o[_d][_r] *= al_l[crow(_r, hi)]; } } while (0)
#define FA_ROT() do { const int _t = bm1; bm1 = bc; bc = bp1; bp1 = _t; } while (0)
    FA_SYNC();
    FA_DMA(bp1);
    qkt<DQK>(pA0, pA1, lds + bm1, kb, qr); partialSM(pA0, pA1, m_reg, mnA, alA);
    for (int j = 1; j + 1 < NT; j += 2) {
        SBAR(); if (FA_VIS(j)) qkt<DQK>(pB0, pB1, lds + bc, kb, qr);
        finishSM(pA0, pA1, alA, l_reg, pa0, pa1, pa2, pa3); SBAR();
        if (FA_VIS(j - 1)) pv_d0(o, vb0 + bm1, pa0, pa1, pa2, pa3); FA_MASK(pB0, pB1, j); partialSM(pB0, pB1, m_reg, mnB, alB);
        FA_SYNC(); if (j + 2 < NT) FA_DMA(bm1);
        FA_RESC(alB); FA_ROT();
        SBAR(); if (FA_VIS(j + 1)) qkt<DQK>(pA0, pA1, lds + bc, kb, qr);
        finishSM(pB0, pB1, alB, l_reg, pa0, pa1, pa2, pa3); SBAR();
        if (FA_VIS(j)) pv_d0(o, vb0 + bm1, pa0, pa1, pa2, pa3); FA_MASK(pA0, pA1, j + 1); partialSM(pA0, pA1, m_reg, mnA, alA);
        FA_SYNC(); if (j + 3 < NT) FA_DMA(bm1);
        FA_RESC(alA); FA_ROT();
    }
    SBAR(); if (FA_VIS(NT - 1)) qkt<DQK>(pB0, pB1, lds + bc, kb, qr);
    finishSM(pA0, pA1, alA, l_reg, pa0, pa1, pa2, pa3); SBAR();
    if (FA_VIS(NT - 2)) pv_d0(o, vb0 + bm1, pa0, pa1, pa2, pa3); FA_MASK(pB0, pB1, NT - 1); partialSM(pB0, pB1, m_reg, mnB, alB);
    FA_RESC(alB);
    finishSM(pB0, pB1, alB, l_reg, pa0, pa1, pa2, pa3); SBAR();
    if (FA_VIS(NT - 1)) pv_d0(o, vb0 + bc, pa0, pa1, pa2, pa3);
    if (hi == 0) li_l[r32] = l_reg; asm volatile("s_waitcnt lgkmcnt(0)" ::: "memory");
    float rli[16];
#pragma unroll
    for (int r = 0; r < 16; ++r) rli[r] = __builtin_amdgcn_rcpf(li_l[crow(r, hi)]);
    FA_SYNC();
    LAS char* Ot = lds + wid * 8704;
#pragma unroll
    for (int r = 0; r < 16; ++r)
#pragma unroll
        for (int d0 = 0; d0 < 4; ++d0) *(LAS bf16_t*)(Ot + crow(r, hi) * 272 + (d0 * 32 + r32) * 2) = (bf16_t)f2bf(o[d0][r] * rli[r]);
    asm volatile("s_waitcnt lgkmcnt(0)" ::: "memory");
#pragma unroll
    for (int i = 0; i < 8; ++i) { const int idx = i * 64 + lane, row = idx >> 4, c16 = idx & 15;
        const u32x4 v = *(LAS const u32x4*)(Ot + row * 272 + c16 * 16); *(u32x4*)(Ob + (size_t)(wid * 32 + row) * ldo + c16 * 8) = v; }
    asm volatile("s_waitcnt lgkmcnt(0)" ::: "memory"); __builtin_amdgcn_s_barrier(); asm volatile("" ::: "memory");
#undef FA_DMA
#undef FA_SYNC
#undef FA_MASK
#undef FA_VIS
#undef FA_RESC
#undef FA_ROT
}
DI int vcu_of(int bx, int G) { return (G % 8 == 0) ? (bx % 8) * (G / 8) + bx / 8 : bx; }
DI void mla_phase(LAS char* lds, const bf16_t* Q, const bf16_t* KN, const bf16_t* KR, const bf16_t* V, bf16_t* AO, int G, int bx) {
    const int v = vcu_of(bx, G);
    for (int p = v; p < NB * HEADS * 8; p += G) { const int bh = p >> 3, i = p & 7, b = bh / HEADS, h = bh % HEADS;
#pragma unroll 1
        for (int s = 0; s < 2; ++s) { const int qb = s ? 15 - i : i; const size_t row0 = (size_t)b * S + qb * 256, key0 = (size_t)b * S;
            attn_unit<192, true>(lds, Q + row0 * NQ + h * QKD, NQ, KN + key0 * D + h * NOPE, D, KR + key0 * ROPE, ROPE, V + key0 * D + h * VD, D, AO + row0 * D + h * VD, D, 4 * qb + 4, 4 * qb); } }
}
DI void memattn_phase(LAS char* lds, const bf16_t* MQ, const bf16_t* MK, const bf16_t* MV, bf16_t* MO, int G, int bx) {
    for (int u = bx; u < NB * MH * (S / 256); u += G) { const int qb = u % (S / 256), h = (u / (S / 256)) % MH, b = u / (S / 256 * MH); const size_t row0 = (size_t)b * S + qb * 256, key0 = (size_t)b * MEMT;
        attn_unit<128, false>(lds, MQ + row0 * MI + h * MHD, MI, MK + key0 * MI + h * MHD, MI, nullptr, 0, MV + key0 * MI + h * MHD, MI, MO + row0 * MI + h * MHD, MI, MEMT / 64, 0); }
}
}

#ifndef H16
#define H16 1
#endif
#ifndef JIT
#define JIT 1
#endif
#ifndef XCONV
#define XCONV 0
#endif
#ifndef XMLA
#define XMLA 0
#endif
#ifndef XMOE
#define XMOE 0
#endif
#ifndef XROUTER
#define XROUTER 0
#endif
#ifndef XDENSE
#define XDENSE 0
#endif
#ifndef XMEMATT
#define XMEMATT 0
#endif
#ifndef XCOMB
#define XCOMB 0
#endif
#ifndef XRES
#define XRES 0
#endif
#ifndef XUQ
#define XUQ 0
#endif
#ifndef XPOOL
#define XPOOL 0
#endif
constexpr int LDS_BYTES = 147456, LDS_MISC = 131072;
#define XB_TMO      128
#define XB_XCNT(j)  (256  + 64 * (j))
#define XB_XSUB(j)  (1280 + 64 * (j))
#define XB_XGEN(j)  (2304 + 64 * (j))
#define XB_TOP      3328
#define XB_TOPGEN   3392
#define XCD_BAR_WORDS 3456
#define XB_SPIN_CAP (1u << 18)
constexpr int CW_BAR = 4096;
DI unsigned xb_ld(unsigned* p)              { return __hip_atomic_load(p, __ATOMIC_RELAXED, __HIP_MEMORY_SCOPE_AGENT); }
DI unsigned xb_add(unsigned* p, unsigned v) { return __hip_atomic_fetch_add(p, v, __ATOMIC_RELAXED, __HIP_MEMORY_SCOPE_AGENT); }
DI unsigned xb_xcc_id() { return (unsigned)__builtin_amdgcn_s_getreg((3 << 11) | 20) & 0xFu; }
#define XB_SPIN(cond, bar) do { unsigned _sp = 0; while (cond) { __builtin_amdgcn_s_sleep(1); \
    if ((++_sp & 255u) == 0u) { if (xb_ld(&(bar)[XB_TMO])) break; if (_sp > XB_SPIN_CAP) { atomicAdd(&(bar)[XB_TMO], 1u); break; } } } } while (0)
struct XcdBarrier { unsigned* bar; unsigned x; volatile LAS unsigned* st; };
DI XcdBarrier xcd_barrier_post(unsigned* bar, volatile LAS unsigned* st) {
    XcdBarrier b; b.bar = bar; b.x = xb_xcc_id(); b.st = st;
    if (threadIdx.x == 0) (void)xb_add(&bar[XB_XCNT(b.x)], 1u);
    return b;
}
DI void xcd_barrier_complete(unsigned* bar, unsigned x, unsigned& nloc, unsigned& nx) {
    const unsigned G = gridDim.x * gridDim.y * gridDim.z;
    unsigned sum, cnt, mine, sp = 0u;
    for (;;) {
        sum = 0u; cnt = 0u; mine = 0u;
#pragma unroll
        for (unsigned j = 0; j < 16; ++j) { const unsigned c = xb_ld(&bar[XB_XCNT(j)]); sum += c; cnt += (c > 0u) ? 1u : 0u; mine = (j == x) ? c : mine; }
        if (sum == G) break;
        __builtin_amdgcn_s_sleep(1);
        if ((++sp & 255u) == 0u) { if (xb_ld(&bar[XB_TMO])) break; if (sp > XB_SPIN_CAP) { atomicAdd(&bar[XB_TMO], 1u); break; } }
    }
    nloc = mine > 0u ? mine : 1u; nx = cnt > 0u ? cnt : 1u;
}
DI void xcd_barrier(const XcdBarrier& b) {
    asm volatile("s_waitcnt vmcnt(0)" ::: "memory");
    __syncthreads();
    if (threadIdx.x == 0) {
        unsigned* bar = b.bar;
        __builtin_amdgcn_s_waitcnt(0);
        unsigned nloc = b.st[0], nx = b.st[1];
        if (nloc == 0u) { xcd_barrier_complete(bar, b.x, nloc, nx); b.st[0] = nloc; b.st[1] = nx; }
        const unsigned old = xb_add(&bar[XB_XSUB(b.x)], 1u);
        const unsigned gen = old / nloc;
        if (old + 1u == (gen + 1u) * nloc) {
            __builtin_amdgcn_fence(__ATOMIC_RELEASE, "agent");
            asm volatile("s_waitcnt vmcnt(0)" ::: "memory");
            const unsigned og = xb_add(&bar[XB_TOP], 1u);
            const unsigned tg = og / nx;
            if (og + 1u == (tg + 1u) * nx) xb_add(&bar[XB_TOPGEN], 1u);
            else XB_SPIN(xb_ld(&bar[XB_TOPGEN]) == tg, bar);
            __builtin_amdgcn_fence(__ATOMIC_ACQUIRE, "agent");
            xb_add(&bar[XB_XGEN(b.x)], 1u);
            asm volatile("s_waitcnt vmcnt(0)" ::: "memory");
        } else {
            XB_SPIN(xb_ld(&bar[XB_XGEN(b.x)]) == gen, bar);
            __builtin_amdgcn_fence(__ATOMIC_ACQUIRE, "agent");
            asm volatile("s_waitcnt vmcnt(0)" ::: "memory");
        }
    }
    __syncthreads();
}

#define LDS_WAIT() asm volatile("s_waitcnt lgkmcnt(0)" ::: "memory")
DI void wt_item(const float* W, int K, int N, bf16_t* WT, const float* kgain, const float* ngain, float scale, int perm, int row_off, LAS float* scr, int item, int lane) {
    const int nblk = N >> 5, kb = item / nblk, nb = item - kb * nblk, k0 = kb * 64, n0 = nb * 32, kr = lane >> 3, n4 = (lane & 7) * 4;
    f32x4 ng = {scale, scale, scale, scale}; if (ngain) ng = *(const f32x4*)(ngain + n0 + n4) * scale;
    f32x4 v[8];
#pragma unroll
    for (int i = 0; i < 8; ++i) v[i] = *(const f32x4*)(W + (size_t)(k0 + 8 * i + kr) * N + n0 + n4);
#pragma unroll
    for (int i = 0; i < 8; ++i) { const int k = 8 * i + kr; f32x4 x = v[i] * ng; if (kgain) x = x * kgain[k0 + k];
        scr[(n4 + 0) * 65 + k] = x.x; scr[(n4 + 1) * 65 + k] = x.y; scr[(n4 + 2) * 65 + k] = x.z; scr[(n4 + 3) * 65 + k] = x.w; }
    LDS_WAIT();
    const int kc = lane & 7;
#pragma unroll
    for (int q = 0; q < 4; ++q) { const int n = (lane >> 3) + 8 * q; const LAS float* sp = scr + n * 65 + 8 * kc;
        u32x4 o; o.x = pk2(sp[0], sp[1]); o.y = pk2(sp[2], sp[3]); o.z = pk2(sp[4], sp[5]); o.w = pk2(sp[6], sp[7]);
        *(u32x4*)(WT + (size_t)(row_off + permrow(perm, n0 + n)) * K + k0 + 8 * kc) = o; }
    LDS_WAIT();
}
struct MArgs { const void* in[32]; float* out; unsigned char* ws; int ph_lo, ph_hi, bar_region, pad; };
#define INF(i) ((const float*)P.in[i])
#define WSB(off) ((bf16_t*)(P.ws + (off)))
#define WSF(off) ((float*)(P.ws + (off)))
constexpr float SC_MEM = 0.08838834764831845f  , SC_MLA = 0.07216878364870323f  ;
DI void conv_phase(const MArgs& P, LAS unsigned char* lds, int gw, int NGW, int wave, int lane) {
    LAS float* scr = (LAS float*)(lds + wave * 16384);
    constexpr int I_POOL = 8 * 128, I_MQ = 4 * 512, I_MO = 4 * 512, I_E = (JIT ? 0 : 128) * 512, I_DQ = 512, I_KR = 64, I_UQ = 2 * 512, I_QR = 2 * 256, I_O = 2 * 2048, I_UK = 512;
    constexpr int NITEMS = I_POOL + 3 * I_MQ + I_MO + 3 * I_E + 3 * I_DQ + I_KR + I_UQ + I_QR + I_O + 2 * I_UK;
    for (int it = gw; it < NITEMS; it += NGW) {
        int r = it;
        if (r < I_E) { const int m = r >> 9; wt_item(INF(28) + (size_t)m * D * EFF, D, EFF, WSB(WS_WGU) + (size_t)m * 1024 * D, INF(6) + (m >> 5) * D, nullptr, 1.f, 3, 0, scr, r & 511, lane); continue; } r -= I_E;
        if (r < I_E) { const int m = r >> 9; wt_item(INF(29) + (size_t)m * D * EFF, D, EFF, WSB(WS_WGU) + (size_t)m * 1024 * D, INF(6) + (m >> 5) * D, nullptr, 1.f, 4, 0, scr, r & 511, lane); continue; } r -= I_E;
        if (r < I_E) { const int m = r >> 9; wt_item(INF(30) + (size_t)m * EFF * D, EFF, D, WSB(WS_WD) + (size_t)m * D * EFF, nullptr, nullptr, 1.f, 0, 0, scr, r & 511, lane); continue; } r -= I_E;
        if (r < I_POOL) { const int m = r >> 7; wt_item(INF(7) + (size_t)m * PG * PG, PG, PG, WSB(WS_WPOOL) + (size_t)(m >> 2) * D * PG, nullptr, INF(8) + (m >> 2) * D + (m & 3) * PG, 1.f, 0, (m & 3) * PG, scr, r & 127, lane); continue; } r -= I_POOL;
        if (r < I_MQ) { const int m = r >> 9; wt_item(INF(20) + (size_t)m * D * MI, D, MI, WSB(WS_WMQ) + (size_t)m * MI * D, INF(4) + m * D, nullptr, SC_MEM, 0, 0, scr, r & 511, lane); continue; } r -= I_MQ;
        if (r < I_MQ) { const int m = r >> 9; wt_item(INF(21) + (size_t)m * D * MI, D, MI, WSB(WS_WMK) + (size_t)m * MI * D, INF(5) + m * D, nullptr, 1.f, 0, 0, scr, r & 511, lane); continue; } r -= I_MQ;
        if (r < I_MQ) { const int m = r >> 9; wt_item(INF(22) + (size_t)m * D * MI, D, MI, WSB(WS_WMV) + (size_t)m * MI * D, INF(5) + m * D, nullptr, 1.f, 0, 0, scr, r & 511, lane); continue; } r -= I_MQ;
        if (r < I_MO) { const int m = r >> 9; wt_item(INF(23) + (size_t)m * MI * D, MI, D, WSB(WS_WMO) + (size_t)m * D * MI, nullptr, nullptr, 1.f, 0, 0, scr, r & 511, lane); continue; } r -= I_MO;
        if (r < I_DQ) { wt_item(INF(15), D, QR, WSB(WS_WDQ0), INF(3) + 2 * D, nullptr, 1.f, 0, 0, scr, r, lane); continue; } r -= I_DQ;
        if (r < I_DQ) { wt_item(INF(10), D, KVR, WSB(WS_WDQ0), INF(9), nullptr, 1.f, 0, 512, scr, r, lane); continue; } r -= I_DQ;
        if (r < I_KR) { wt_item(INF(12), D, ROPE, WSB(WS_WDQ0), INF(9), nullptr, 1.f, 5, 1024, scr, r, lane); continue; } r -= I_KR;
        if (r < I_DQ) { wt_item(INF(15) + (size_t)D * QR, D, QR, WSB(WS_WDQ1), INF(3) + 3 * D, nullptr, 1.f, 0, 0, scr, r, lane); continue; } r -= I_DQ;
        if (r < I_UQ) { const int m = r >> 9; wt_item(INF(17) + (size_t)m * QR * D, QR, HEADS * NOPE, WSB(WS_WUQ) + (size_t)m * NQ * QR, INF(16) + m * QR, nullptr, SC_MLA, 1, 0, scr, r & 511, lane); continue; } r -= I_UQ;
        if (r < I_QR) { const int m = r >> 8; wt_item(INF(18) + (size_t)m * QR * HEADS * ROPE, QR, HEADS * ROPE, WSB(WS_WUQ) + (size_t)m * NQ * QR, INF(16) + m * QR, nullptr, SC_MLA, 2, 0, scr, r & 255, lane); continue; } r -= I_QR;
        if (r < I_O) { const int m = r >> 11; wt_item(INF(19) + (size_t)m * D * D, D, D, WSB(WS_WO) + (size_t)m * D * D, nullptr, nullptr, 1.f, 0, 0, scr, r & 2047, lane); continue; } r -= I_O;
        if (r < I_UK) { wt_item(INF(13), KVR, D, WSB(WS_WUKV), INF(11), nullptr, 1.f, 0, 0, scr, r, lane); continue; } r -= I_UK;
        wt_item(INF(14), KVR, D, WSB(WS_WUKV), INF(11), nullptr, 1.f, 0, 2048, scr, r, lane);
    }
}
DI void conv_experts(const MArgs& P, int l, LAS unsigned char* lds, LAS unsigned* ctr, int vcu, int G, int wave, int lane) {
    LAS float* scr = (LAS float*)(lds + 16384 + wave * 8448);
    for (;;) {
        unsigned i = 0; if (lane == 0) i = __hip_atomic_fetch_add(ctr, 1u, __ATOMIC_RELAXED, __HIP_MEMORY_SCOPE_WORKGROUP);
        i = __builtin_amdgcn_readfirstlane(i);
        const int it = vcu + (int)i * G; if (it >= 3 * NE * 512) break;
        const int fam = it >> 14, m = l * NE + ((it >> 9) & 31), r = it & 511;
        if (fam == 0) wt_item(INF(28) + (size_t)m * D * EFF, D, EFF, WSB(WS_WGU) + (size_t)m * 1024 * D, INF(6) + l * D, nullptr, 1.f, 3, 0, scr, r, lane);
        else if (fam == 1) wt_item(INF(29) + (size_t)m * D * EFF, D, EFF, WSB(WS_WGU) + (size_t)m * 1024 * D, INF(6) + l * D, nullptr, 1.f, 4, 0, scr, r, lane);
        else wt_item(INF(30) + (size_t)m * EFF * D, EFF, D, WSB(WS_WD) + (size_t)m * D * EFF, nullptr, nullptr, 1.f, 0, 0, scr, r, lane); }
}
DI void tables_phase(const MArgs& P, int gtid, int NT_) {
    for (int idx = gtid; idx < T * 32; idx += NT_) { const int t = idx >> 5, i = idx & 31;
        const float inv = (float)(1.0 / pow(10000.0, (double)i / 32.0)); const float ang = (float)((const int*)P.in[2])[t] * inv;
        const double rev = (double)ang * 0.15915494309189533577; const float fr = (float)(rev - rint(rev));
        WSF(WS_COS)[idx] = __builtin_amdgcn_cosf(fr); WSF(WS_SIN)[idx] = __builtin_amdgcn_sinf(fr); }
    for (int idx = gtid; idx < DEPTH * 48 * D; idx += NT_) { const int l = idx / (48 * D), n = (idx / D) % 48, k = idx % D;
        float w = 0.f; if (n < 36) w = (n < 4 ? INF(24)[((size_t)l * D + k) * 4 + n] : INF(26)[((size_t)l * D + k) * 32 + (n - 4)]) * INF(6)[l * D + k];
        const unsigned hi = f2bf(w), lo = f2bf(w - __uint_as_float(hi << 16));
        WSB(WS_RWH)[((size_t)(l * 2 + 0) * 48 + n) * D + k] = (bf16_t)hi; WSB(WS_RWH)[((size_t)(l * 2 + 1) * 48 + n) * D + k] = (bf16_t)lo; }
    unsigned* z = (unsigned*)(WSB(WS_WDQ0) + (size_t)1088 * D);
    for (int idx = gtid; idx < (NDQ0 - 1088) * D / 2; idx += NT_) z[idx] = 0u;
}
DI void memprep_phase(const MArgs& P, int gw, int NGW, int lane) {
    for (int r = gw; r < NB * MEMT; r += NGW) { const f32x4* x = (const f32x4*)(INF(1) + (size_t)r * D) + lane; float ss = 0.f;
#pragma unroll
        for (int j = 0; j < 8; ++j) { const f32x4 v = x[64 * j]; ss += (v.x * v.x + v.y * v.y) + (v.z * v.z + v.w * v.w);
            u32x2 o; o.x = pk2(v.x, v.y); o.y = pk2(v.z, v.w); *((u32x2*)(WSB(WS_MEMB) + (size_t)r * D) + lane + 64 * j) = o; }
        ss = wave_sum(ss); if (lane == 0) WSF(WS_MEMRS)[r] = rsqrtf(ss * (1.0f / D) + EPS); }
}
DI void combine_phase(const float* src, const bf16_t* src16, const bf16_t* Y, float* H, bf16_t* HB, float* RS0, const float* gain, bf16_t* HN, float* out, int gw, int NGW, int lane) {
    for (int t = gw; t < T; t += NGW) {
        const f32x4* x = (const f32x4*)(src + (size_t)t * D) + lane; f32x4 v[8]; float ss = 0.f;
#pragma unroll
        for (int j = 0; j < 8; ++j) {
            if (src16) { const u32x2 h = *((const u32x2*)(src16 + (size_t)t * D) + lane + 64 * j); v[j] = (f32x4){__uint_as_float(h.x << 16), __uint_as_float(h.x & 0xffff0000u), __uint_as_float(h.y << 16), __uint_as_float(h.y & 0xffff0000u)}; }
            else v[j] = x[64 * j];
            if (Y) { const u32x2 a = *((const u32x2*)(Y + (size_t)(2 * t) * D) + lane + 64 * j), b = *((const u32x2*)(Y + (size_t)(2 * t + 1) * D) + lane + 64 * j);
                v[j].x = (v[j].x + __uint_as_float(a.x << 16)) + __uint_as_float(b.x << 16); v[j].y = (v[j].y + __uint_as_float(a.x & 0xffff0000u)) + __uint_as_float(b.x & 0xffff0000u);
                v[j].z = (v[j].z + __uint_as_float(a.y << 16)) + __uint_as_float(b.y << 16); v[j].w = (v[j].w + __uint_as_float(a.y & 0xffff0000u)) + __uint_as_float(b.y & 0xffff0000u); }
            ss += (v[j].x * v[j].x + v[j].y * v[j].y) + (v[j].z * v[j].z + v[j].w * v[j].w); }
        ss = wave_sum(ss); const float rs = rsqrtf(ss * (1.0f / D) + EPS);
        if (lane == 0 && RS0) RS0[t] = rs;
#pragma unroll
        for (int j = 0; j < 8; ++j) {
            if (H) *((f32x4*)(H + (size_t)t * D) + lane + 64 * j) = v[j];
            if (HB) { u32x2 o; o.x = pk2(v[j].x, v[j].y); o.y = pk2(v[j].z, v[j].w); *((u32x2*)(HB + (size_t)t * D) + lane + 64 * j) = o; }
            if (gain) { const f32x4 g = *((const f32x4*)gain + lane + 64 * j); const f32x4 n = v[j] * g * rs;
                if (HN) { u32x2 o; o.x = pk2(n.x, n.y); o.y = pk2(n.z, n.w); *((u32x2*)(HN + (size_t)t * D) + lane + 64 * j) = o; }
                if (out) *((f32x4*)(out + (size_t)t * D) + lane + 64 * j) = n; } }
    }
}
DI void pool_phase(const bf16_t* HN, bf16_t* U, int vcu, int G, int tid) {
    if (vcu < 0) return;
    for (int t = vcu * 2 + (tid >> 8); t < T; t += 2 * G) { const int c = (tid & 255) * 8, s = t & (S - 1), w = 2 << (c >> 9), n = (s + 1 < w) ? s + 1 : w;
        float acc[8] = {0.f, 0.f, 0.f, 0.f, 0.f, 0.f, 0.f, 0.f}, self[8] = {0.f, 0.f, 0.f, 0.f, 0.f, 0.f, 0.f, 0.f};
        for (int i = 0; i < n; ++i) { const u32x4 v = *(const u32x4*)(HN + (size_t)(t - i) * D + c);
            const float f[8] = {__uint_as_float(v.x << 16), __uint_as_float(v.x & 0xffff0000u), __uint_as_float(v.y << 16), __uint_as_float(v.y & 0xffff0000u),
                                __uint_as_float(v.z << 16), __uint_as_float(v.z & 0xffff0000u), __uint_as_float(v.w << 16), __uint_as_float(v.w & 0xffff0000u)};
#pragma unroll
            for (int q = 0; q < 8; ++q) { acc[q] += f[q]; if (i == 0) self[q] = f[q]; } }
        const float inv = 1.0f / (float)n; u32x4 o;
        o.x = pk2(acc[0] * inv - self[0], acc[1] * inv - self[1]); o.y = pk2(acc[2] * inv - self[2], acc[3] * inv - self[3]);
        o.z = pk2(acc[4] * inv - self[4], acc[5] * inv - self[5]); o.w = pk2(acc[6] * inv - self[6], acc[7] * inv - self[7]);
        *(u32x4*)(U + (size_t)t * D + c) = o; }
}
typedef float f32x4r __attribute__((ext_vector_type(4)));
DI void router_phase(const float* H, const bf16_t* HBs, const bf16_t* RWH, const float* rg_b, const float* re_b, float* RS2, int* cnt, int* list, float* gwt, LAS unsigned char* lds, int vcu, int G, int wave, int lane, bool commit = true) {
    LAS float* tile = (LAS float*)(lds + wave * 4096);
    const bf16_t* RWL = RWH + (size_t)48 * D;
    for (int t16 = wave * G + vcu; t16 < T / 16; t16 += 8 * G) {
        const int r16 = lane & 15, kq = lane >> 4;
        const float* hp = H + (size_t)(t16 * 16 + r16) * D + kq * 8; const bf16_t* hb = HBs + (size_t)(t16 * 16 + r16) * D + kq * 8;
        const bf16_t* wh = RWH + (size_t)r16 * D + kq * 8; const bf16_t* wl = RWL + (size_t)r16 * D + kq * 8;
        f32x4 acc[3]; float ss = 0.f;
#pragma unroll
        for (int q = 0; q < 3; ++q) acc[q] = (f32x4){0.f, 0.f, 0.f, 0.f};
        for (int k0 = 0; k0 < D; k0 += 128) {
            f32x4 xa[4], xb[4];
#pragma unroll
            for (int u = 0; u < 4; ++u) {
                if (H16) { const u32x4 w = *(const u32x4*)(hb + k0 + u * 32);
                    xa[u] = (f32x4){__uint_as_float(w.x << 16), __uint_as_float(w.x & 0xffff0000u), __uint_as_float(w.y << 16), __uint_as_float(w.y & 0xffff0000u)};
                    xb[u] = (f32x4){__uint_as_float(w.z << 16), __uint_as_float(w.z & 0xffff0000u), __uint_as_float(w.w << 16), __uint_as_float(w.w & 0xffff0000u)}; }
                else { xa[u] = *(const f32x4*)(hp + k0 + u * 32); xb[u] = *(const f32x4*)(hp + k0 + u * 32 + 4); } }
#pragma unroll
            for (int u = 0; u < 4; ++u) {
                const f32x4 a = xa[u], b = xb[u];
                ss += ((a.x * a.x + a.y * a.y) + (a.z * a.z + a.w * a.w)) + ((b.x * b.x + b.y * b.y) + (b.z * b.z + b.w * b.w));
                u32x4 h; h.x = fg::cvt_pk_bf16(a.x, a.y); h.y = fg::cvt_pk_bf16(a.z, a.w); h.z = fg::cvt_pk_bf16(b.x, b.y); h.w = fg::cvt_pk_bf16(b.z, b.w);
                u32x4 lo; lo.x = fg::cvt_pk_bf16(a.x - __uint_as_float(h.x << 16), a.y - __uint_as_float(h.x & 0xffff0000u)); lo.y = fg::cvt_pk_bf16(a.z - __uint_as_float(h.y << 16), a.w - __uint_as_float(h.y & 0xffff0000u));
                lo.z = fg::cvt_pk_bf16(b.x - __uint_as_float(h.z << 16), b.y - __uint_as_float(h.z & 0xffff0000u)); lo.w = fg::cvt_pk_bf16(b.z - __uint_as_float(h.w << 16), b.w - __uint_as_float(h.w & 0xffff0000u));
                const bf16x8 ah = *reinterpret_cast<const bf16x8*>(&h), al_ = *reinterpret_cast<const bf16x8*>(&lo);
#pragma unroll
                for (int q = 0; q < 3; ++q) { const bf16x8 bh = *(const bf16x8*)(wh + (size_t)q * 16 * D + k0 + u * 32), bl = *(const bf16x8*)(wl + (size_t)q * 16 * D + k0 + u * 32);
                    acc[q] = __builtin_amdgcn_mfma_f32_16x16x32_bf16(ah, bh, acc[q], 0, 0, 0);
                    if (!H16) acc[q] = __builtin_amdgcn_mfma_f32_16x16x32_bf16(al_, bh, acc[q], 0, 0, 0);
                    acc[q] = __builtin_amdgcn_mfma_f32_16x16x32_bf16(ah, bl, acc[q], 0, 0, 0); }
            }
        }
        ss = fg::quad_sum(ss);
        const float rs = rsqrtf(ss * (1.0f / D) + EPS);
#pragma unroll
        for (int q = 0; q < 3; ++q)
#pragma unroll
            for (int i = 0; i < 4; ++i) tile[(kq * 4 + i) * 49 + q * 16 + r16] = acc[q][i];
        LDS_WAIT();
        if (lane < 16) {
            const LAS float* tr = tile + lane * 49; const int t = t16 * 16 + lane;
            const float g0 = tr[0] * rs + rg_b[0], g1 = tr[1] * rs + rg_b[1], g2 = tr[2] * rs + rg_b[2], g3 = tr[3] * rs + rg_b[3];
            int gs = 0; float gm = g0; if (g1 > gm) { gm = g1; gs = 1; } if (g2 > gm) { gm = g2; gs = 2; } if (g3 > gm) { gm = g3; gs = 3; }
            const float gp = 1.0f / (__expf(g0 - gm) + __expf(g1 - gm) + __expf(g2 - gm) + __expf(g3 - gm));
            float ev[8];
#pragma unroll
            for (int i = 0; i < 8; ++i) ev[i] = tr[4 + gs * 8 + i] * rs + re_b[gs * 8 + i];
            int i0 = 0; float m0 = ev[0];
#pragma unroll
            for (int i = 1; i < 8; ++i) if (ev[i] > m0) { m0 = ev[i]; i0 = i; }
            int i1 = -1; float m1 = -3.0e38f;
#pragma unroll
            for (int i = 0; i < 8; ++i) if (i != i0 && ev[i] > m1) { m1 = ev[i]; i1 = i; }
            const float e1 = __expf(m1 - m0), w0 = gp / (1.0f + e1), w1 = gp * e1 / (1.0f + e1);
            if (commit || w0 < -1.f) { RS2[t] = rs; const int ea = gs * 8 + i0, eb = gs * 8 + i1;
                const int pa = atomicAdd(&cnt[ea], 1); list[(size_t)ea * CAP + pa] = 2 * t; gwt[2 * t] = w0;
                const int pb = atomicAdd(&cnt[eb], 1); list[(size_t)eb * CAP + pb] = 2 * t + 1; gwt[2 * t + 1] = w1; }
        }
        LDS_WAIT();
    }
}
namespace fg {
struct EpiMemKV {
    bf16_t* O; const float* rs;
    DI void operator()(const Acc& acc, const Unit& u, int wr, int wc, int fr, int fq) const {
        float sc[2][4];
#pragma unroll
        for (int ai = 0; ai < 2; ++ai)
#pragma unroll
            for (int m = 0; m < 4; ++m) sc[ai][m] = rs[u.pm * BM + EPI_ROWS(ai, m)];
#pragma unroll
        for (int ai = 0; ai < 2; ++ai)
#pragma unroll
            for (int m = 0; m < 4; ++m) { const int r = u.pm * BM + EPI_ROWS(ai, m);
#pragma unroll
                for (int bj = 0; bj < 2; ++bj) { const int c0 = (u.pn & 1) * BM + bj * HALF + wc * 32 + 8 * fq;
                    *(u32x4*)(O + (size_t)(u.pn >> 1) * (NB * MEMT * MI) + (size_t)r * MI + c0) = pack8(acc[ai][bj][m][0] * sc[ai][m], acc[ai][bj][m][1] * sc[ai][m]); } }
    }
};
}
DI int scan32(int v, int lane) {
#pragma unroll
    for (int o = 1; o < 32; o <<= 1) { const int t = __builtin_amdgcn_ds_bpermute(((lane - o) & 63) << 2, v); if ((lane & 31) >= o) v += t; }
    return v;
}
DI void moe_prefix(LAS unsigned char* lds, const int* cnt) {
    LAS int* pref = (LAS int*)(lds + LDS_MISC + 1024); const int tid = opaque_tid();
    if (tid < 64) {
        const int e = tid & 31, c = cnt[e], nt = (c + 255) >> 8, st = scan32(nt, tid);
        if (tid < 32) { pref[64 + e] = c; pref[e] = st - nt; if (e == 31) pref[32] = st; }
    }
    __syncthreads();
    if (tid == 0) {
        const int G = gridDim.x, nx = (G & 7) ? 1 : 8, x = blockIdx.x % nx; int n = 0;
        for (int e = x; e < NE; e += nx) { const int nt = (pref[64 + e] + 255) >> 8, base = pref[e]; for (int t = 0; t < nt; ++t) pref[128 + n++] = e | (t << 8) | ((base + t) << 16); }
        pref[40] = n; }
    __syncthreads();
}

__global__ void __launch_bounds__(512, 2) mk_fwd(MArgs a) {
    extern __shared__ __attribute__((aligned(16))) unsigned char lds_raw[];
    LAS unsigned char* lds = (LAS unsigned char*)lds_raw;
    const int G = gridDim.x, bx = blockIdx.x, vcu = fa::vcu_of(bx, G), NGW = G * 8;
    volatile LAS unsigned* MISC = (volatile LAS unsigned*)(lds + LDS_MISC);
    if (threadIdx.x < 64) MISC[threadIdx.x] = 0u;
    __syncthreads();
    unsigned char* ws = a.ws;
    XcdBarrier bar = xcd_barrier_post((unsigned*)(ws + WS_CTL) + CW_BAR + a.bar_region * XCD_BAR_WORDS, MISC + 8);
    const MArgs& P = a;
    int pid = 0; const int lo = a.ph_lo, hi = a.ph_hi;
#define PH_IF if (pid >= lo && pid < hi)
#define TL const int tid = opaque_tid(), lane = tid & 63, wave = __builtin_amdgcn_readfirstlane(tid >> 6), gw = vcu * 8 + wave; (void)lane; (void)gw
#define PH_END do { if (pid >= lo && pid + 1 < hi) xcd_barrier(bar); ++pid; } while (0)
    PH_IF { TL; conv_phase(P, lds, gw, NGW, wave, lane); if (XCONV) conv_phase(P, lds, gw, NGW, wave, lane); tables_phase(P, vcu * 512 + tid, G * 512); memprep_phase(P, gw, NGW, lane);
            combine_phase(INF(0), nullptr, nullptr, H16 ? nullptr : WSF(WS_H), WSB(WS_HB), WSF(WS_RS0), INF(3), WSB(WS_HN), nullptr, gw, NGW, lane); }
    PH_END;
    for (int l = 0; l < DEPTH; ++l) {
        const bool isA = l < NA; const int j = l - NA;
        if (l > 0) { PH_IF { TL; if (XCOMB) combine_phase(WSF(WS_H), H16 ? WSB(WS_HB) : nullptr, WSB(WS_Y), WSF(WS_Q), nullptr, nullptr, nullptr, nullptr, nullptr, gw, NGW, lane);
            combine_phase(WSF(WS_H), H16 ? WSB(WS_HB) : nullptr, WSB(WS_Y), H16 ? nullptr : WSF(WS_H), WSB(WS_HB), WSF(WS_RS0), isA ? INF(3) + l * D : nullptr, isA ? WSB(WS_HN) : nullptr, nullptr, gw, NGW, lane); } PH_END; }
        if (isA) {
            PH_IF { if (l == 0) { fg::ProbDense pr{(const char*)WSB(WS_MEMB), (const char*)WSB(WS_WMK), (const char*)WSB(WS_MEMB), (const char*)WSB(WS_WMK), NB * MEMT / 256, 16, 16, D, D, 0, G, bx}; fg::EpiMemKV E{WSB(WS_MK), WSF(WS_MEMRS)}; fg::gemm_phase(lds, pr, E); }
                    { TL; const bool split = (l == 0 && G > 64); pool_phase(WSB(WS_HN), WSB(WS_U), split ? bx - 64 : vcu, split ? G - 64 : G, tid); if (XPOOL) pool_phase(WSB(WS_HN), WSB(WS_U), vcu, G, tid); } }
            PH_END;
        } else {
            PH_IF { const int n = j == 0 ? NDQ0 : QR; const char* B = (const char*)(j == 0 ? WSB(WS_WDQ0) : WSB(WS_WDQ1));
                    fg::ProbDense pr{(const char*)WSB(WS_HB), B, (const char*)WSB(WS_HB), B, T / 256, n / 256, n / 256, D, D, 0, G, bx};
                    fg::EpiDQ E{WSB(WS_CQ), WSB(WS_CKV), WSB(WS_KR), WSF(WS_RS0), WSF(WS_LSQ), WSF(WS_LSKV), WSF(WS_COS), WSF(WS_SIN)}; fg::gemm_phase(lds, pr, E); if (XDENSE) fg::gemm_phase(lds, pr, E); }
            PH_END;
            PH_IF { fg::ProbDense pr{(const char*)WSB(WS_CQ), (const char*)(WSB(WS_WUQ) + (size_t)j * NQ * QR), (const char*)WSB(WS_CKV), (const char*)WSB(WS_WUKV), T / 256, (j == 0 ? NQ + 4096 : NQ) / 256, NQ / 256, QR, QR, 0, G, bx};
                    fg::EpiUQ E{WSB(WS_Q), WSB(WS_KN), WSB(WS_V), WSF(WS_LSQ), WSF(WS_LSKV), WSF(WS_COS), WSF(WS_SIN)}; fg::gemm_phase(lds, pr, E); if (XUQ) fg::gemm_phase(lds, pr, E); }
            PH_END;
            PH_IF { fa::mla_phase((LAS char*)lds, WSB(WS_Q), WSB(WS_KN), WSB(WS_KR), WSB(WS_V), WSB(WS_AO), G, bx); if (XMLA) fa::mla_phase((LAS char*)lds, WSB(WS_Q), WSB(WS_KN), WSB(WS_KR), WSB(WS_V), WSB(WS_AO), G, bx); }
            PH_END;
        }
        PH_IF { const char* A = (const char*)(isA ? WSB(WS_U) : WSB(WS_AO)); const char* B = (const char*)(isA ? WSB(WS_WPOOL) + (size_t)l * D * PG : WSB(WS_WO) + (size_t)j * D * D);
                fg::ProbDense pr{A, B, A, B, T / 256, D / 256, D / 256, isA ? PG : D, D, isA ? 1 : 0, G, bx}; fg::EpiRes<true> E{WSB(WS_HB), WSF(WS_SSP)}; if (XRES) { fg::EpiRes<true> E2{WSB(WS_HB), WSF(WS_SSP), WSB(WS_Y)}; fg::gemm_phase(lds, pr, E2); } fg::gemm_phase(lds, pr, E); }
        PH_END;
        PH_IF { const char* B = (const char*)(WSB(WS_WMQ) + (size_t)l * MI * D); fg::ProbDense pr{(const char*)WSB(WS_HB), B, (const char*)WSB(WS_HB), B, T / 256, MI / 256, MI / 256, D, D, 0, G, bx};
                fg::EpiBf16RS<2> E{WSB(WS_MQ), MI, WSF(WS_SSP)}; fg::gemm_phase(lds, pr, E); if (XDENSE) fg::gemm_phase(lds, pr, E); }
        PH_END;
        PH_IF { fa::memattn_phase((LAS char*)lds, WSB(WS_MQ), WSB(WS_MK) + (size_t)l * NB * MEMT * MI, WSB(WS_MV) + (size_t)l * NB * MEMT * MI, WSB(WS_MO), G, bx); if (XMEMATT) fa::memattn_phase((LAS char*)lds, WSB(WS_MQ), WSB(WS_MK) + (size_t)l * NB * MEMT * MI, WSB(WS_MV) + (size_t)l * NB * MEMT * MI, WSB(WS_MO), G, bx); }
        PH_END;
        PH_IF { const char* B = (const char*)(WSB(WS_WMO) + (size_t)l * D * MI); fg::ProbDense pr{(const char*)WSB(WS_MO), B, (const char*)WSB(WS_MO), B, T / 256, D / 256, D / 256, MI, MI, 0, G, bx};
                fg::EpiRes<false> E{WSB(WS_HB), nullptr}; if (XRES) { fg::EpiRes<false> E2{WSB(WS_HB), nullptr, WSB(WS_Y)}; fg::gemm_phase(lds, pr, E2); } fg::gemm_phase(lds, pr, E); }
        PH_END;
        PH_IF { TL; if (JIT) { if (tid == 0) *(LAS unsigned*)(lds + LDS_MISC + 64) = 0u; __syncthreads(); }
                if (XROUTER) router_phase(WSF(WS_H), WSB(WS_HB), WSB(WS_RWH) + (size_t)l * 2 * 48 * D, INF(25) + l * NG, INF(27) + l * NE, WSF(WS_RS2), ((int*)(P.ws + WS_CTL + OFF_CNT)) + l * NE, ((int*)(P.ws + WS_LIST)), WSF(WS_GW), lds, vcu, G, wave, lane, false);
                router_phase(WSF(WS_H), WSB(WS_HB), WSB(WS_RWH) + (size_t)l * 2 * 48 * D, INF(25) + l * NG, INF(27) + l * NE, WSF(WS_RS2), ((int*)(P.ws + WS_CTL + OFF_CNT)) + l * NE, ((int*)(P.ws + WS_LIST)), WSF(WS_GW), lds, vcu, G, wave, lane);
                if (JIT) conv_experts(P, l, lds, (LAS unsigned*)(lds + LDS_MISC + 64), vcu, G, wave, lane); }
        PH_END;
        PH_IF { moe_prefix(lds, ((int*)(P.ws + WS_CTL + OFF_CNT)) + l * NE);
                fg::ProbMoe pr{(const char*)WSB(WS_HB), (const char*)(WSB(WS_WGU) + (size_t)l * NE * 1024 * D), ((int*)(P.ws + WS_LIST)), (const LAS int*)(lds + LDS_MISC + 1024), 4, D, D, 1, G, bx, (long)1024 * D * 2};
                fg::EpiMoe1 E{WSB(WS_HH), WSF(WS_RS2), ((int*)(P.ws + WS_LIST))}; fg::gemm_phase(lds, pr, E); if (XMOE == 1) fg::gemm_phase(lds, pr, E); if (XMOE == 2) fg::gemm_phase<decltype(E), decltype(pr), true>(lds, pr, E); }
        PH_END;
        PH_IF { moe_prefix(lds, ((int*)(P.ws + WS_CTL + OFF_CNT)) + l * NE);
                fg::ProbMoe pr{(const char*)WSB(WS_HH), (const char*)(WSB(WS_WD) + (size_t)l * NE * D * EFF), ((int*)(P.ws + WS_LIST)), (const LAS int*)(lds + LDS_MISC + 1024), 8, EFF, EFF, 0, G, bx, (long)D * EFF * 2};
                fg::EpiMoe2 E{WSB(WS_Y), WSF(WS_GW), ((int*)(P.ws + WS_LIST))}; fg::gemm_phase(lds, pr, E); if (XMOE == 1) fg::gemm_phase(lds, pr, E); if (XMOE == 2) fg::gemm_phase<decltype(E), decltype(pr), true>(lds, pr, E); }
        PH_END;
    }
    PH_IF { TL; combine_phase(WSF(WS_H), H16 ? WSB(WS_HB) : nullptr, WSB(WS_Y), nullptr, nullptr, nullptr, INF(31), nullptr, P.out, gw, NGW, lane); }
#undef PH_IF
#undef PH_END
}
constexpr int NPHASES = 1 + 8 + 9 + 11 + 11 + 1;

#ifndef MK_SPLIT
#define MK_SPLIT 0
#endif
extern "C" void kernel_launch(void* const* d_in, const int* in_sizes, int n_in, void* d_out, int out_size, void* d_ws, size_t ws_size, hipStream_t stream) {
    static int grid = 0;
    if (grid == 0) {
        if (n_in != 32 || in_sizes[0] != T * D || out_size != T * D || ws_size < WS_END) { fprintf(stderr, "kernel_launch: shape/ws mismatch (ws %zu need %zu)\n", ws_size, (size_t)WS_END); grid = -1; return; }
        int dev = 0, cus = 0;
        if (hipGetDevice(&dev) != hipSuccess || hipDeviceGetAttribute(&cus, hipDeviceAttributeMultiprocessorCount, dev) != hipSuccess || cus <= 0) { fprintf(stderr, "kernel_launch: device query failed\n"); grid = -1; return; }
        if (hipFuncSetAttribute((const void*)mk_fwd, hipFuncAttributeMaxDynamicSharedMemorySize, LDS_BYTES) != hipSuccess) { fprintf(stderr, "kernel_launch: hipFuncSetAttribute failed\n"); grid = -1; return; }
        int per_cu = 0;
        if (hipOccupancyMaxActiveBlocksPerMultiprocessor(&per_cu, (const void*)mk_fwd, 512, LDS_BYTES) != hipSuccess || per_cu < 1) fprintf(stderr, "kernel_launch: occupancy query says %d\n", per_cu);
        (void)hipGetLastError();
        grid = cus;
    }
    if (grid < 0) return;
    if (hipMemsetAsync((char*)d_ws + WS_CTL, 0, CTL_BYTES, stream) != hipSuccess) { fprintf(stderr, "kernel_launch: memset failed\n"); return; }
    MArgs a; memset(&a, 0, sizeof(a));
    for (int i = 0; i < 32; ++i) a.in[i] = d_in[i];
    a.out = (float*)d_out; a.ws = (unsigned char*)d_ws;
#if MK_SPLIT
    for (int p = 0; p < NPHASES; ++p) { a.ph_lo = p; a.ph_hi = p + 1; a.bar_region = 0; hipLaunchKernelGGL(mk_fwd, dim3(grid), dim3(512), LDS_BYTES, stream, a); }
#else
    a.ph_lo = 0; a.ph_hi = NPHASES; a.bar_region = 0; hipLaunchKernelGGL(mk_fwd, dim3(grid), dim3(512), LDS_BYTES, stream, a);
#endif
    const hipError_t le = hipPeekAtLastError();
    if (le != hipSuccess) fprintf(stderr, "kernel_launch: launch failed: %s\n", hipGetErrorName(le));
}
```

```cpp
#include <hip/hip_runtime.h>
#include <cstdio>
#include <cstdint>
#include <cstring>

typedef unsigned short bf16_t;
typedef float f32x4 __attribute__((ext_vector_type(4)));
typedef unsigned u32x4 __attribute__((ext_vector_type(4)));
typedef unsigned u32x2 __attribute__((ext_vector_type(2)));
#define DI __device__ __forceinline__

constexpr int D = 2048, NB = 4, S = 4096, T = NB * S, DEPTH = 4, NA = 2;
constexpr int CHUNK = 64;
constexpr int PG = 512;
constexpr int HEADS = 16, QR = 512, KVR = 512, NOPE = 128, ROPE = 64, VD = 128, QKD = NOPE + ROPE;
constexpr int MEMT = 256, MH = 4, MHD = 128, MI = 512;
constexpr int NG = 4, EPG = 8, NE = 32, EFF = 512;
constexpr float EPS = 1e-6f;
constexpr int CAP = T;
constexpr int MAXROWS = 2 * T + NE * 256;
constexpr int NQ = HEADS * QKD;
constexpr int NDQ0 = 1280;

constexpr size_t al(size_t x) { return (x + 255) & ~(size_t)255; }
constexpr size_t WS_CTL = 0, CTL_BYTES = 1u << 20;
constexpr size_t OFF_CNT = 65536;
constexpr size_t WS_WPOOL = WS_CTL + CTL_BYTES;
constexpr size_t WS_WMQ = WS_WPOOL + (size_t)NA * D * PG * 2;
constexpr size_t WS_WMK = WS_WMQ + (size_t)DEPTH * MI * D * 2;
constexpr size_t WS_WMV = WS_WMK + (size_t)DEPTH * MI * D * 2;
constexpr size_t WS_WMO = WS_WMV + (size_t)DEPTH * MI * D * 2;
constexpr size_t WS_WDQ0 = WS_WMO + (size_t)DEPTH * D * MI * 2;
constexpr size_t WS_WDQ1 = WS_WDQ0 + (size_t)NDQ0 * D * 2;
constexpr size_t WS_WUQ = WS_WDQ1 + (size_t)QR * D * 2;
constexpr size_t WS_WUKV = WS_WUQ + (size_t)2 * NQ * QR * 2;
constexpr size_t WS_WO = WS_WUKV + (size_t)4096 * KVR * 2;
constexpr size_t WS_RWT = WS_WO + (size_t)2 * D * D * 2;
constexpr size_t WS_WGU = al(WS_RWT + (size_t)DEPTH * 36 * D * 4);
constexpr size_t WS_WD = WS_WGU + (size_t)DEPTH * NE * 1024 * D * 2;
constexpr size_t WS_H = WS_WD + (size_t)DEPTH * NE * D * EFF * 2;
constexpr size_t WS_HB = WS_H + (size_t)T * D * 4;
constexpr size_t WS_Y = WS_HB + (size_t)T * D * 2;
constexpr size_t WS_HH = WS_Y + (size_t)2 * T * D * 2;
constexpr size_t WS_KN = WS_HH + (size_t)MAXROWS * EFF * 2;
constexpr size_t WS_V = WS_KN + (size_t)T * D * 2;
constexpr size_t WS_Q = WS_V + (size_t)T * D * 2;
constexpr size_t WS_HN = WS_Q;
constexpr size_t WS_U = WS_Q + (size_t)T * D * 2;
constexpr size_t WS_AO = WS_Q + (size_t)T * NQ * 2;
constexpr size_t WS_MQ = WS_AO + (size_t)T * D * 2;
constexpr size_t WS_MO = WS_MQ + (size_t)T * MI * 2;
constexpr size_t WS_CQ = WS_MO + (size_t)T * MI * 2;
constexpr size_t WS_CKV = WS_CQ + (size_t)T * QR * 2;
constexpr size_t WS_KR = WS_CKV + (size_t)T * KVR * 2;
constexpr size_t WS_MEMB = WS_KR + (size_t)T * ROPE * 2;
constexpr size_t WS_MK = WS_MEMB + (size_t)NB * MEMT * D * 2;
constexpr size_t WS_MV = WS_MK + (size_t)DEPTH * NB * MEMT * MI * 2;
constexpr size_t WS_SSP = WS_MV + (size_t)DEPTH * NB * MEMT * MI * 2;
constexpr size_t WS_LSQ = WS_SSP + (size_t)T * 32 * 4;
constexpr size_t WS_LSKV = WS_LSQ + (size_t)T * 8 * 4;
constexpr size_t WS_RS0 = WS_LSKV + (size_t)T * 8 * 4;
constexpr size_t WS_RS2 = WS_RS0 + (size_t)T * 4;
constexpr size_t WS_MEMRS = WS_RS2 + (size_t)T * 4;
constexpr size_t WS_COS = WS_MEMRS + 4096;
constexpr size_t WS_SIN = WS_COS + (size_t)T * 32 * 4;
constexpr size_t WS_GW = WS_SIN + (size_t)T * 32 * 4;
constexpr size_t WS_LIST = WS_GW + (size_t)2 * T * 4;
constexpr size_t WS_RWH = WS_LIST + (size_t)NE * CAP * 4;
constexpr size_t WS_END = WS_RWH + (size_t)DEPTH * 2 * 48 * D * 2;
static_assert(WS_U + (size_t)T * D * 2 <= WS_MQ, "U overlay inside Q|AO");

DI float bf2f(bf16_t b) { return __uint_as_float(((unsigned)b) << 16); }
DI unsigned f2bf(float f) { unsigned u = __float_as_uint(f); return (u + 0x7fffu + ((u >> 16) & 1u)) >> 16; }
DI unsigned pk2(float lo, float hi) { return f2bf(lo) | (f2bf(hi) << 16); }
#define SWZ_XOR(v, m) __int_as_float(__builtin_amdgcn_ds_swizzle(__float_as_int(v), (((m) << 10) | 0x1F)))
DI float half_sum(float s) { auto rr = __builtin_amdgcn_permlane32_swap(__float_as_uint(s), __float_as_uint(s), false, false); return __uint_as_float(rr[0]) + __uint_as_float(rr[1]); }
DI float wave_sum(float v) { v += SWZ_XOR(v, 1); v += SWZ_XOR(v, 2); v += SWZ_XOR(v, 4); v += SWZ_XOR(v, 8); v += SWZ_XOR(v, 16); return half_sum(v); }
DI int opaque_tid() { int t = threadIdx.x; asm volatile("" : "+v"(t)); return t; }
DI float silu(float x) { return x / (1.0f + __expf(-x)); }

DI int permrow(int perm, int n) {
    switch (perm) {
        case 1: return (n >> 7) * QKD + (n & 127);
        case 2: { const int h = n >> 6, r = n & 63; return h * QKD + NOPE + 2 * (r & 31) + (r >> 5); }
        case 3: return (n >> 7) * 256 + (n & 127);
        case 4: return (n >> 7) * 256 + 128 + (n & 127);
        case 5: return 2 * (n & 31) + (n >> 5);
        default: return n;
    }
}
#define LAS __attribute__((address_space(3)))
typedef short bf16x8 __attribute__((ext_vector_type(8)));
namespace fg {
constexpr int BM = 256, BK = 64, HALF = 128, HTB = HALF * BK * 2, STAGE_BYTES = 8 * HTB, NXCD = 8, WGM = 16;
DI int lds_byte(int r, int c) { const int st = (r >> 4) * 2 + (c >> 5), rr = r & 15, cc = c & 31, ob = rr * 64 + cc * 2; return st * 1024 + (ob ^ (((ob >> 9) & 1) << 5)); }
DI void stage_rc(int b, int& R, int& C) { const int st = b / 1024, sb = b % 1024, swz = sb ^ (((sb >> 9) & 1) << 5); R = (st >> 1) * 16 + swz / 64; C = (st & 1) * 32 + (swz % 64) / 2; }
DI int perm32(int rho) { const int n = rho >> 4, i = rho & 15; return 8 * (i >> 2) + 4 * n + (i & 3); }
DI unsigned cvt_pk_bf16(float lo, float hi) { unsigned r; asm volatile("v_cvt_pk_bf16_f32 %0, %1, %2" : "=v"(r) : "v"(lo), "v"(hi)); return r; }
struct Unit { int pm, pn, e, r0, cnt; };

struct ProbDense {
    const char* A0; const char* B0; const char* A1; const char* B1; int nM, nN, nN0, K, lda, pool, G, c;
    static constexpr bool GATHER = false;
    DI bool next(int i, Unit& u) const {
        const long L = (long)i * G + c; const int nwg = nM * nN; if (L >= nwg) return false;
        int wgid = (int)L; { const int q = nwg / NXCD, r = nwg % NXCD, xcd = wgid % NXCD, off = wgid / NXCD; wgid = (xcd < r ? xcd * (q + 1) : r * (q + 1) + (xcd - r) * q) + off; }
        const int nig = WGM * nN, gid = wgid / nig, fm = gid * WGM, gsz = (nM - fm) < WGM ? (nM - fm) : WGM;
        u.pm = fm + ((wgid % nig) % gsz); u.pn = (wgid % nig) / gsz; u.e = 0; u.r0 = 0; u.cnt = 256; return true; }
    DI const char* aptr(const Unit& u) const { return (u.pn < nN0 ? A0 : A1) + (size_t)u.pm * 256 * lda * 2 + (pool ? (size_t)(u.pn >> 1) * 1024 : 0); }
    DI const char* bptr(const Unit& u) const { return u.pn < nN0 ? B0 + (size_t)u.pn * 256 * K * 2 : B1 + (size_t)(u.pn - nN0) * 256 * K * 2; }
    DI void avoff(const Unit&, int tid, unsigned (&vo)[2][2]) const {
        int R[2], C[2]; stage_rc(tid * 16, R[0], C[0]); stage_rc(tid * 16 + 8192, R[1], C[1]);
#pragma unroll
        for (int h = 0; h < 2; ++h)
#pragma unroll
            for (int i = 0; i < 2; ++i) vo[h][i] = (unsigned)((h * 128 + R[i]) * lda + C[i]) * 2u; }
};
struct ProbMoe {
    const char* A; const char* Bt; const int* list; const LAS int* pref; int npn, K, lda, gather, G, c; long estride;
    static constexpr bool GATHER = true;
    DI bool next(int i, Unit& u) const {
        const int nx = (G & 7) ? 1 : 8, q = i * (G / nx) + c / nx, t = q / npn; if (t >= pref[40]) return false;
        const int ent = pref[128 + t], e = ent & 255;
        u.pm = ent >> 16; u.pn = q % npn; u.e = e; u.r0 = ((ent >> 8) & 255) * 256; u.cnt = pref[64 + e]; return true; }
    DI const char* aptr(const Unit& u) const { return gather ? A : A + (size_t)u.pm * 256 * lda * 2; }
    DI const char* bptr(const Unit& u) const { return Bt + (size_t)u.e * estride + (size_t)u.pn * 256 * K * 2; }
    DI void avoff(const Unit& u, int tid, unsigned (&vo)[2][2]) const {
        int R[2], C[2]; stage_rc(tid * 16, R[0], C[0]); stage_rc(tid * 16 + 8192, R[1], C[1]);
#pragma unroll
        for (int h = 0; h < 2; ++h)
#pragma unroll
            for (int i = 0; i < 2; ++i) { const int row = h * 128 + R[i];
                if (gather) { const int ri = u.r0 + row; const int tok = ri < u.cnt ? (list[(size_t)u.e * CAP + ri] >> 1) : 0; vo[h][i] = (unsigned)(tok * lda + C[i]) * 2u; }
                else vo[h][i] = (unsigned)(row * lda + C[i]) * 2u; } }
};

typedef f32x4 Acc[2][2][4][2];
DI float quad_sum(float s) { s += SWZ_XOR(s, 16); return half_sum(s); }
DI float sq8(const f32x4& a, const f32x4& b) { return ((a.x * a.x + a.y * a.y) + (a.z * a.z + a.w * a.w)) + ((b.x * b.x + b.y * b.y) + (b.z * b.z + b.w * b.w)); }
DI u32x4 pack8(const f32x4& a, const f32x4& b) { u32x4 w; w.x = cvt_pk_bf16(a.x, a.y); w.y = cvt_pk_bf16(a.z, a.w); w.z = cvt_pk_bf16(b.x, b.y); w.w = cvt_pk_bf16(b.z, b.w); return w; }
template <int NP> DI float rs_from_parts(const float* part, int r, int fq, float inv_n) {
    float s;
    if (NP == 32) { const f32x4 a = *(const f32x4*)(part + (size_t)r * 32 + fq * 8), b = *(const f32x4*)(part + (size_t)r * 32 + fq * 8 + 4); s = ((a.x + a.y) + (a.z + a.w)) + ((b.x + b.y) + (b.z + b.w)); }
    else { const float* p = part + (size_t)r * 8 + fq * 2; s = p[0] + p[1]; }
    s = quad_sum(s); return rsqrtf(s * inv_n + EPS);
}
DI void rope8(f32x4& a, f32x4& b, const float* COS, const float* SIN, int r, int i0) {
    const f32x4 c = *(const f32x4*)(COS + (size_t)r * 32 + i0), s = *(const f32x4*)(SIN + (size_t)r * 32 + i0);
    const f32x4 a2 = {a.x * c.x - a.y * s.x, a.y * c.x + a.x * s.x, a.z * c.y - a.w * s.y, a.w * c.y + a.z * s.y};
    const f32x4 b2 = {b.x * c.z - b.y * s.z, b.y * c.z + b.x * s.z, b.z * c.w - b.w * s.w, b.w * c.w + b.z * s.w};
    a = a2; b = b2;
}
#define EPI_ROWS(ai, m) (ai * HALF + wr * 64 + m * 16 + fr)
DI void unpack8(const u32x4& w, f32x4& a, f32x4& b) {
    a = (f32x4){__uint_as_float(w.x << 16), __uint_as_float(w.x & 0xffff0000u), __uint_as_float(w.y << 16), __uint_as_float(w.y & 0xffff0000u)};
    b = (f32x4){__uint_as_float(w.z << 16), __uint_as_float(w.z & 0xffff0000u), __uint_as_float(w.w << 16), __uint_as_float(w.w & 0xffff0000u)}; }
DI void rope8r(f32x4& a, f32x4& b, const f32x4& c, const f32x4& s) {
    const f32x4 a2 = {a.x * c.x - a.y * s.x, a.y * c.x + a.x * s.x, a.z * c.y - a.w * s.y, a.w * c.y + a.z * s.y};
    const f32x4 b2 = {b.x * c.z - b.y * s.z, b.y * c.z + b.x * s.z, b.z * c.w - b.w * s.w, b.w * c.w + b.z * s.w};
    a = a2; b = b2;
}
template <bool STATS> struct EpiRes {
    bf16_t* HB; float* SSP; bf16_t* HBout = nullptr;
    DI void operator()(const Acc& acc, const Unit& u, int wr, int wc, int fr, int fq) const {
        const int cb = u.pn * BM + wc * 32 + 8 * fq;
#pragma unroll
        for (int ai = 0; ai < 2; ++ai) {
            u32x4 w[4][2];
#pragma unroll
            for (int m = 0; m < 4; ++m)
#pragma unroll
                for (int bj = 0; bj < 2; ++bj) w[m][bj] = *(const u32x4*)(HB + (size_t)(u.pm * BM + EPI_ROWS(ai, m)) * D + cb + bj * HALF);
#pragma unroll
            for (int m = 0; m < 4; ++m) { const int r = u.pm * BM + EPI_ROWS(ai, m); float ss = 0.f;
#pragma unroll
                for (int bj = 0; bj < 2; ++bj) { f32x4 h0, h1; unpack8(w[m][bj], h0, h1); h0 += acc[ai][bj][m][0]; h1 += acc[ai][bj][m][1];
                    *(u32x4*)((HBout ? HBout : HB) + (size_t)r * D + cb + bj * HALF) = pack8(h0, h1); if (STATS) ss += sq8(h0, h1); }
                if (STATS) { ss = quad_sum(ss); if (fq == 0) SSP[(size_t)r * 32 + u.pn * 4 + wc] = ss; } }
        }
    }
};
template <int MODE  > struct EpiBf16RS {
    bf16_t* O; int ldo; const float* rs;
    DI void operator()(const Acc& acc, const Unit& u, int wr, int wc, int fr, int fq) const {
        float sc[2][4];
#pragma unroll
        for (int ai = 0; ai < 2; ++ai)
#pragma unroll
            for (int m = 0; m < 4; ++m) { const int r = u.pm * BM + EPI_ROWS(ai, m); sc[ai][m] = MODE == 1 ? rs[r] : rs_from_parts<32>(rs, r, fq, 1.0f / D); }
#pragma unroll
        for (int ai = 0; ai < 2; ++ai)
#pragma unroll
            for (int m = 0; m < 4; ++m) { const int r = u.pm * BM + EPI_ROWS(ai, m);
#pragma unroll
                for (int bj = 0; bj < 2; ++bj) { const int c0 = u.pn * BM + bj * HALF + wc * 32 + 8 * fq;
                    *(u32x4*)(O + (size_t)r * ldo + c0) = pack8(acc[ai][bj][m][0] * sc[ai][m], acc[ai][bj][m][1] * sc[ai][m]); } }
    }
};
struct EpiDQ {
    bf16_t* CQ; bf16_t* CKV; bf16_t* KR; const float* RS0; float* LSQ; float* LSKV; const float* COS; const float* SIN;
    DI void operator()(const Acc& acc, const Unit& u, int wr, int wc, int fr, int fq) const {
        float sc[2][4];
#pragma unroll
        for (int ai = 0; ai < 2; ++ai)
#pragma unroll
            for (int m = 0; m < 4; ++m) sc[ai][m] = RS0[u.pm * BM + EPI_ROWS(ai, m)];
        if (u.pn < 4) {
#pragma unroll
            for (int ai = 0; ai < 2; ++ai)
#pragma unroll
                for (int m = 0; m < 4; ++m) { const int r = u.pm * BM + EPI_ROWS(ai, m); float ss = 0.f;
#pragma unroll
                    for (int bj = 0; bj < 2; ++bj) { const int cl = bj * HALF + wc * 32 + 8 * fq; const f32x4 v0 = acc[ai][bj][m][0] * sc[ai][m], v1 = acc[ai][bj][m][1] * sc[ai][m];
                        ss += sq8(v0, v1); *(u32x4*)((u.pn < 2 ? CQ : CKV) + (size_t)r * 512 + (u.pn & 1) * 256 + cl) = pack8(v0, v1); }
                    ss = quad_sum(ss); if (fq == 0) (u.pn < 2 ? LSQ : LSKV)[(size_t)r * 8 + (u.pn & 1) * 4 + wc] = ss; }
        } else if (wc < 2) {
            const int cl = wc * 32 + 8 * fq; f32x4 cs[2][4], sn[2][4];
#pragma unroll
            for (int ai = 0; ai < 2; ++ai)
#pragma unroll
                for (int m = 0; m < 4; ++m) { const int r = u.pm * BM + EPI_ROWS(ai, m); cs[ai][m] = *(const f32x4*)(COS + (unsigned)(r * 32 + (cl >> 1))); sn[ai][m] = *(const f32x4*)(SIN + (unsigned)(r * 32 + (cl >> 1))); }
#pragma unroll
            for (int ai = 0; ai < 2; ++ai)
#pragma unroll
                for (int m = 0; m < 4; ++m) { const int r = u.pm * BM + EPI_ROWS(ai, m); f32x4 v0 = acc[ai][0][m][0] * sc[ai][m], v1 = acc[ai][0][m][1] * sc[ai][m];
                    rope8r(v0, v1, cs[ai][m], sn[ai][m]); *(u32x4*)(KR + (size_t)r * 64 + cl) = pack8(v0, v1); }
        }
    }
};
struct EpiUQ {
    bf16_t* Q; bf16_t* KN; bf16_t* V; const float* LSQ; const float* LSKV; const float* COS; const float* SIN;
    DI void operator()(const Acc& acc, const Unit& u, int wr, int wc, int fr, int fq) const {
        const bool isq = u.pn < 12; float sc[2][4];
#pragma unroll
        for (int ai = 0; ai < 2; ++ai)
#pragma unroll
            for (int m = 0; m < 4; ++m) sc[ai][m] = rs_from_parts<8>(isq ? LSQ : LSKV, u.pm * BM + EPI_ROWS(ai, m), fq, 1.0f / 512.0f);
#pragma unroll
        for (int bj = 0; bj < 2; ++bj) {
            const int c0 = (isq ? u.pn : u.pn - 12) * BM + bj * HALF + wc * 32 + 8 * fq, hc = c0 % QKD; const bool rot = isq && hc >= NOPE;
#pragma unroll
            for (int ai = 0; ai < 2; ++ai) {
                f32x4 cs[4], sn[4];
                if (rot) {
#pragma unroll
                    for (int m = 0; m < 4; ++m) { const int r = u.pm * BM + EPI_ROWS(ai, m); cs[m] = *(const f32x4*)(COS + (unsigned)(r * 32 + ((hc - NOPE) >> 1))); sn[m] = *(const f32x4*)(SIN + (unsigned)(r * 32 + ((hc - NOPE) >> 1))); } }
#pragma unroll
                for (int m = 0; m < 4; ++m) { const int r = u.pm * BM + EPI_ROWS(ai, m); f32x4 v0 = acc[ai][bj][m][0] * sc[ai][m], v1 = acc[ai][bj][m][1] * sc[ai][m];
                    if (rot) rope8r(v0, v1, cs[m], sn[m]);
                    bf16_t* o = isq ? Q + (size_t)r * NQ + c0 : (c0 < 2048 ? KN + c0 : V + (c0 - 2048)) + (size_t)r * D;
                    *(u32x4*)o = pack8(v0, v1); }
            }
        }
    }
};
struct EpiMoe1 {
    bf16_t* HH; const float* RS2; const int* list;
    DI void operator()(const Acc& acc, const Unit& u, int wr, int wc, int fr, int fq) const {
        int tok[2][4]; float sc[2][4];
#pragma unroll
        for (int ai = 0; ai < 2; ++ai)
#pragma unroll
            for (int m = 0; m < 4; ++m) { const int ri = u.r0 + EPI_ROWS(ai, m); tok[ai][m] = ri < u.cnt ? (list[(size_t)u.e * CAP + ri] >> 1) : 0; }
#pragma unroll
        for (int ai = 0; ai < 2; ++ai)
#pragma unroll
            for (int m = 0; m < 4; ++m) sc[ai][m] = RS2[tok[ai][m]];
#pragma unroll
        for (int ai = 0; ai < 2; ++ai)
#pragma unroll
            for (int m = 0; m < 4; ++m) { const int lr = EPI_ROWS(ai, m);
                if (u.r0 + lr < u.cnt) { const float s_ = sc[ai][m];
                    const f32x4 g0 = acc[ai][0][m][0] * s_, g1 = acc[ai][0][m][1] * s_, u0 = acc[ai][1][m][0] * s_, u1 = acc[ai][1][m][1] * s_;
                    const f32x4 h0 = {silu(g0.x) * u0.x, silu(g0.y) * u0.y, silu(g0.z) * u0.z, silu(g0.w) * u0.w}, h1 = {silu(g1.x) * u1.x, silu(g1.y) * u1.y, silu(g1.z) * u1.z, silu(g1.w) * u1.w};
                    *(u32x4*)(HH + (size_t)(u.pm * BM + lr) * EFF + u.pn * 128 + wc * 32 + 8 * fq) = pack8(h0, h1); } }
    }
};
struct EpiMoe2 {
    bf16_t* Y; const float* GW; const int* list;
    DI void operator()(const Acc& acc, const Unit& u, int wr, int wc, int fr, int fq) const {
        int as[2][4]; float sc[2][4];
#pragma unroll
        for (int ai = 0; ai < 2; ++ai)
#pragma unroll
            for (int m = 0; m < 4; ++m) { const int ri = u.r0 + EPI_ROWS(ai, m); as[ai][m] = ri < u.cnt ? list[(size_t)u.e * CAP + ri] : 0; }
#pragma unroll
        for (int ai = 0; ai < 2; ++ai)
#pragma unroll
            for (int m = 0; m < 4; ++m) sc[ai][m] = GW[as[ai][m]];
#pragma unroll
        for (int ai = 0; ai < 2; ++ai)
#pragma unroll
            for (int m = 0; m < 4; ++m) { if (u.r0 + EPI_ROWS(ai, m) < u.cnt) {
#pragma unroll
                    for (int bj = 0; bj < 2; ++bj) { const int c0 = u.pn * BM + bj * HALF + wc * 32 + 8 * fq;
                        *(u32x4*)(Y + (size_t)as[ai][m] * D + c0) = pack8(acc[ai][bj][m][0] * sc[ai][m], acc[ai][bj][m][1] * sc[ai][m]); } } }
    }
};

template <class Epi, class Prob, bool DRY = false>
DI void gemm_phase(LAS unsigned char* lds, const Prob& P, const Epi& E) {
    const int tid = opaque_tid(), wid = __builtin_amdgcn_readfirstlane(tid >> 6), lane = tid & 63, wr = wid >> 2, wc = wid & 3, fr = lane & 15, fq = lane >> 4;
    const int K = P.K, nt = K / BK;
    int sR[2], sC[2]; unsigned voffB[2];
#pragma unroll
    for (int i = 0; i < 2; ++i) { stage_rc(tid * 16 + i * 8192, sR[i], sC[i]); const int Rb = (sR[i] & ~31) + perm32(sR[i] & 31); voffB[i] = (unsigned)(Rb * K + sC[i]) * 2u; }
    const size_t kstep = (size_t)(BK * 2), hstepB = (size_t)HALF * K * 2;
    const unsigned ldsw = (unsigned)wid * 1024u;
    const int aoff = lds_byte(wr * 64 + fr, fq * 8), boff = lds_byte(wc * 32 + fr, fq * 8);
#define PG8_SA(b, h) (((b) * 2 + (h)) * HTB)
#define PG8_SB(b, h) ((4 + (b) * 2 + (h)) * HTB)
#define PG8_STAGE(bufoff, gbase, voff) do { _Pragma("unroll") for (int _i = 0; _i < 2; ++_i) \
        __builtin_amdgcn_global_load_lds((const unsigned*)((const char*)(gbase) + (voff)[_i]), (LAS unsigned*)(lds + (bufoff) + ldsw + _i * 8192), 16, 0, 0); } while (0)
#define PG8_LDA(dst, b, h) do { _Pragma("unroll") for (int m = 0; m < 4; ++m) _Pragma("unroll") for (int k = 0; k < 2; ++k) dst[m][k] = *(const LAS bf16x8*)(lds + PG8_SA(b, h) + aoff + m * 2048 + k * 1024); } while (0)
#define PG8_LDB(dst, b, h) do { _Pragma("unroll") for (int n = 0; n < 2; ++n) _Pragma("unroll") for (int k = 0; k < 2; ++k) dst[n][k] = *(const LAS bf16x8*)(lds + PG8_SB(b, h) + boff + n * 2048 + k * 1024); } while (0)
#define PG8_MMA(ai, bj, At, Bt) do { __builtin_amdgcn_s_setprio(1); _Pragma("unroll") for (int m = 0; m < 4; ++m) _Pragma("unroll") for (int n = 0; n < 2; ++n) _Pragma("unroll") for (int k = 0; k < 2; ++k) \
        acc[ai][bj][m][n] = __builtin_amdgcn_mfma_f32_16x16x32_bf16(Bt[n][k], At[m][k], acc[ai][bj][m][n], 0, 0, 0); __builtin_amdgcn_s_setprio(0); } while (0)
#define PG8_WAIT_V(n) asm volatile("s_waitcnt vmcnt(" #n ")" ::: "memory")
#define PG8_WAIT_L(n) asm volatile("s_waitcnt lgkmcnt(" #n ")" ::: "memory")
#define PG8_BAR __builtin_amdgcn_s_barrier()
#define PG8_SCHED __builtin_amdgcn_sched_barrier(0)
    Unit cur, nxt; int ui = 0;
    if (!P.next(0, cur)) return;
    bool do0 = true, do1 = true;
    if constexpr (Prob::GATHER) { const int nv = cur.cnt - cur.r0; do0 = wr * 64 < nv; do1 = 128 + wr * 64 < nv; }
    if constexpr (DRY) { do0 = false; do1 = false; }
    f32x4 acc[2][2][4][2];
#pragma unroll
    for (int a = 0; a < 2; ++a)
#pragma unroll
        for (int b = 0; b < 2; ++b)
#pragma unroll
            for (int m = 0; m < 4; ++m)
#pragma unroll
                for (int n = 0; n < 2; ++n) acc[a][b][m][n] = (f32x4){0.f, 0.f, 0.f, 0.f};
    bf16x8 At[4][2], B0[2][2], B1[2][2];
    const char* cA = P.aptr(cur); const char* cB = P.bptr(cur);
    unsigned voA[2][2], vnA[2][2];
    P.avoff(cur, tid, voA);
    if constexpr (Prob::GATHER) asm volatile("s_waitcnt vmcnt(0)" ::: "memory");
    PG8_STAGE(PG8_SB(0, 0), cB, voffB); PG8_STAGE(PG8_SB(0, 1), cB + hstepB, voffB); PG8_STAGE(PG8_SA(0, 0), cA, voA[0]); PG8_STAGE(PG8_SA(0, 1), cA, voA[1]);
    if (wr == 1) PG8_BAR;
    PG8_WAIT_V(2); PG8_BAR;
    PG8_STAGE(PG8_SB(1, 0), cB + kstep, voffB); PG8_STAGE(PG8_SA(1, 0), cA + kstep, voA[0]); PG8_STAGE(PG8_SB(1, 1), cB + hstepB + kstep, voffB);
    PG8_WAIT_V(6); PG8_BAR;
    for (;;) {
        const bool has_next = P.next(ui + 1, nxt);
        const char* nA = has_next ? P.aptr(nxt) : cA; const char* nB = has_next ? P.bptr(nxt) : cB;
#pragma unroll
        for (int h = 0; h < 2; ++h)
#pragma unroll
            for (int i = 0; i < 2; ++i) vnA[h][i] = voA[h][i];
        for (int t = 0; t < nt; t += 2) {
            const bool last = (t == nt - 2);
            if constexpr (Prob::GATHER) { if (last && has_next) P.avoff(nxt, opaque_tid(), vnA); }
            const char* a1 = cA + (size_t)(t + 1) * kstep;
            const char* a2 = last ? nA : cA + (size_t)(t + 2) * kstep; const char* b2 = last ? nB : cB + (size_t)(t + 2) * kstep;
            const char* a3 = a2 + kstep; const char* b3 = b2 + kstep;
            unsigned w0[2], w1[2];
#pragma unroll
            for (int i = 0; i < 2; ++i) { w0[i] = last ? vnA[0][i] : voA[0][i]; w1[i] = last ? vnA[1][i] : voA[1][i]; }
            PG8_LDB(B0, 0, 0); PG8_LDB(B1, 0, 1); PG8_SCHED; PG8_LDA(At, 0, 0); PG8_STAGE(PG8_SA(1, 1), a1, voA[1]);
            PG8_WAIT_V(8); PG8_WAIT_L(0); PG8_BAR; if (do0) { PG8_MMA(0, 0, At, B0); PG8_MMA(0, 1, At, B1); } PG8_BAR; PG8_SCHED;
            PG8_LDA(At, 0, 1); PG8_STAGE(PG8_SB(0, 0), b2, voffB); PG8_STAGE(PG8_SB(0, 1), b2 + hstepB, voffB); PG8_STAGE(PG8_SA(0, 0), a2, w0);
            PG8_WAIT_V(8); PG8_WAIT_L(0); PG8_BAR; if (do1) { PG8_MMA(1, 0, At, B0); PG8_MMA(1, 1, At, B1); } PG8_BAR; PG8_SCHED;
            PG8_LDB(B0, 1, 0); PG8_LDB(B1, 1, 1); PG8_SCHED; PG8_LDA(At, 1, 0); PG8_STAGE(PG8_SA(0, 1), a2, w1);
            PG8_WAIT_V(8); PG8_WAIT_L(0); PG8_BAR; if (do0) { PG8_MMA(0, 0, At, B0); PG8_MMA(0, 1, At, B1); } PG8_BAR; PG8_SCHED;
            PG8_LDA(At, 1, 1); PG8_STAGE(PG8_SB(1, 0), b3, voffB); PG8_STAGE(PG8_SB(1, 1), b3 + hstepB, voffB); PG8_STAGE(PG8_SA(1, 0), a3, w0);
            PG8_WAIT_V(8); PG8_WAIT_L(0); PG8_BAR; if (do1) { PG8_MMA(1, 0, At, B0); PG8_MMA(1, 1, At, B1); } PG8_BAR; PG8_SCHED;
        }
        if (wr == 0) PG8_BAR;
        if constexpr (!DRY) { const int lz = opaque_tid() & 63; E(acc, cur, wr, wc, lz & 15, lz >> 4); }
        if (!has_next) break;
#pragma unroll
        for (int a = 0; a < 2; ++a)
#pragma unroll
            for (int b = 0; b < 2; ++b)
#pragma unroll
                for (int m = 0; m < 4; ++m)
#pragma unroll
                    for (int n = 0; n < 2; ++n) acc[a][b][m][n] = (f32x4){0.f, 0.f, 0.f, 0.f};
        cur = nxt; cA = nA; cB = nB; ++ui;
        if constexpr (Prob::GATHER) { const int nv = cur.cnt - cur.r0; do0 = wr * 64 < nv; do1 = 128 + wr * 64 < nv; }
        if constexpr (DRY) { do0 = false; do1 = false; }
#pragma unroll
        for (int h = 0; h < 2; ++h)
#pragma unroll
            for (int i = 0; i < 2; ++i) voA[h][i] = vnA[h][i];
        if (wr == 1) PG8_BAR;
    }
    PG8_WAIT_V(0);
    PG8_BAR;
#undef PG8_SA
#undef PG8_SB
#undef PG8_STAGE
#undef PG8_LDA
#undef PG8_LDB
#undef PG8_MMA
#undef PG8_WAIT_V
#undef PG8_WAIT_L
#undef PG8_BAR
#undef PG8_SCHED
}
}


namespace fa {
typedef float f32x16 __attribute__((ext_vector_type(16)));
typedef short s16x4 __attribute__((ext_vector_type(4)));
#define SBAR() __builtin_amdgcn_sched_barrier(0)
constexpr float THR = 8.f, LOG2E = 1.4426950408889634f;
DI int crow(int r, int hi) { return (r & 3) + 8 * (r >> 2) + 4 * hi; }
DI unsigned cvtpk(float lo, float hi) { unsigned r; asm volatile("v_cvt_pk_bf16_f32 %0, %1, %2" : "=v"(r) : "v"(lo), "v"(hi)); return r; }
DI void partialSM(f32x16& p0, f32x16& p1, float& m_reg, float& mn, float& alpha) {
    float pmax = p0[0];
#pragma unroll
    for (int r = 1; r < 16; ++r) pmax = fmaxf(pmax, p0[r]);
#pragma unroll
    for (int r = 0; r < 16; ++r) pmax = fmaxf(pmax, p1[r]);
    { auto rr = __builtin_amdgcn_permlane32_swap(__float_as_uint(pmax), __float_as_uint(pmax), false, false); pmax = fmaxf(__uint_as_float(rr[0]), __uint_as_float(rr[1])); }
    if (__builtin_expect(__all(pmax - m_reg <= THR), 1)) { mn = m_reg; alpha = 1.f; }
    else { mn = fmaxf(m_reg, pmax); alpha = __builtin_amdgcn_exp2f((m_reg - mn) * LOG2E); m_reg = mn; }
    const float mnC = -mn * LOG2E;
#pragma unroll
    for (int r = 0; r < 16; ++r) p0[r] = fmaf(p0[r], LOG2E, mnC);
#pragma unroll
    for (int r = 0; r < 16; ++r) p1[r] = fmaf(p1[r], LOG2E, mnC);
#pragma unroll
    for (int r = 0; r < 16; ++r) p0[r] = __builtin_amdgcn_exp2f(p0[r]);
}
DI void finishSM(f32x16& p0, f32x16& p1, float alpha, float& l_reg, bf16x8& pa0, bf16x8& pa1, bf16x8& pa2, bf16x8& pa3) {
#pragma unroll
    for (int r = 0; r < 16; ++r) p1[r] = __builtin_amdgcn_exp2f(p1[r]);
    float ps = 0;
#pragma unroll
    for (int r = 0; r < 16; ++r) ps += p0[r];
#pragma unroll
    for (int r = 0; r < 16; ++r) ps += p1[r];
    { auto rr = __builtin_amdgcn_permlane32_swap(__float_as_uint(ps), __float_as_uint(ps), false, false); ps = __uint_as_float(rr[0]) + __uint_as_float(rr[1]); }
    l_reg = l_reg * alpha + ps;
#define PK4(P, BASE, OUT) do { unsigned a0 = cvtpk(P[BASE + 0], P[BASE + 1]), a1 = cvtpk(P[BASE + 2], P[BASE + 3]);   \
    unsigned b0 = cvtpk(P[BASE + 4], P[BASE + 5]), b1 = cvtpk(P[BASE + 6], P[BASE + 7]);                              \
    auto r0 = __builtin_amdgcn_permlane32_swap(a0, b0, false, false); auto r1 = __builtin_amdgcn_permlane32_swap(a1, b1, false, false); \
    u32x4 w = {r0[0], r1[0], r0[1], r1[1]}; OUT = *reinterpret_cast<bf16x8*>(&w); } while (0)
    PK4(p0, 0, pa0); PK4(p0, 8, pa1); PK4(p1, 0, pa2); PK4(p1, 8, pa3);
#undef PK4
}
template <int DQK> DI void qkt(f32x16& p0, f32x16& p1, LAS const char* Ks, const int (&kb)[4], const bf16x8* qr) {
    constexpr int KROW = DQK * 2;
#pragma unroll
    for (int r = 0; r < 16; ++r) { p0[r] = 0.f; p1[r] = 0.f; }
    __builtin_amdgcn_s_setprio(1);
#pragma unroll
    for (int d0 = 0; d0 < DQK / 16; ++d0) {
        const bf16x8 b0 = *(LAS const bf16x8*)(Ks + kb[d0 & 3] + (d0 >> 2) * 128);
        const bf16x8 b1 = *(LAS const bf16x8*)(Ks + kb[d0 & 3] + (d0 >> 2) * 128 + 32 * KROW);
        p0 = __builtin_amdgcn_mfma_f32_32x32x16_bf16(b0, qr[d0], p0, 0, 0, 0);
        p1 = __builtin_amdgcn_mfma_f32_32x32x16_bf16(b1, qr[d0], p1, 0, 0, 0); }
    __builtin_amdgcn_s_setprio(0);
}
DI int v_rd_base(int lane) { return ((lane & 3) << 3) | (((lane >> 2) & 3) << 6) | (((lane >> 4) & 1) << 5) | (((lane >> 5) & 1) << 8); }
constexpr int v_rd_off(int d0, int ks, int half) { return d0 * 512 + ks * 4096 + half * 2048; }
template <int OFF> DI s16x4 tr_read(int vb) { s16x4 r; asm volatile("ds_read_b64_tr_b16 %0, %1 offset:%2" : "=&v"(r) : "v"(vb), "i"(OFF) : "memory"); return r; }
template <int D0> DI void pv_one(f32x16& od, int vb, bf16x8 pa0, bf16x8 pa1, bf16x8 pa2, bf16x8 pa3) {
    const s16x4 l0 = tr_read<v_rd_off(D0, 0, 0)>(vb), h0 = tr_read<v_rd_off(D0, 0, 1)>(vb), l1 = tr_read<v_rd_off(D0, 1, 0)>(vb), h1 = tr_read<v_rd_off(D0, 1, 1)>(vb);
    const s16x4 l2 = tr_read<v_rd_off(D0, 2, 0)>(vb), h2 = tr_read<v_rd_off(D0, 2, 1)>(vb), l3 = tr_read<v_rd_off(D0, 3, 0)>(vb), h3 = tr_read<v_rd_off(D0, 3, 1)>(vb);
    asm volatile("s_waitcnt lgkmcnt(0)" ::: "memory"); SBAR();
#define PK(L, H) (bf16x8){L[0], L[1], L[2], L[3], H[0], H[1], H[2], H[3]}
    __builtin_amdgcn_s_setprio(1);
    od = __builtin_amdgcn_mfma_f32_32x32x16_bf16(pa0, PK(l0, h0), od, 0, 0, 0);
    od = __builtin_amdgcn_mfma_f32_32x32x16_bf16(pa1, PK(l1, h1), od, 0, 0, 0);
    od = __builtin_amdgcn_mfma_f32_32x32x16_bf16(pa2, PK(l2, h2), od, 0, 0, 0);
    od = __builtin_amdgcn_mfma_f32_32x32x16_bf16(pa3, PK(l3, h3), od, 0, 0, 0);
    __builtin_amdgcn_s_setprio(0);
#undef PK
}
DI void pv_d0(f32x16* o, int vb, bf16x8 pa0, bf16x8 pa1, bf16x8 pa2, bf16x8 pa3) {
    pv_one<0>(o[0], vb, pa0, pa1, pa2, pa3); pv_one<1>(o[1], vb, pa0, pa1, pa2, pa3); pv_one<2>(o[2], vb, pa0, pa1, pa2, pa3); pv_one<3>(o[3], vb, pa0, pa1, pa2, pa3);
}
template <int DQK, bool CAUSAL>
DI void attn_unit(LAS char* lds, const bf16_t* Qb, int ldq, const bf16_t* K1, int ldk1, const bf16_t* K2, int ldk2, const bf16_t* Vb, int ldv, bf16_t* Ob, int ldo, int NT, int qtile0) {
    constexpr int KROW = DQK * 2, KT = 64 * KROW, BUF = KT + 16384, NKP = DQK / 64, ND0 = DQK / 16;
    const int tid = opaque_tid(), wid = __builtin_amdgcn_readfirstlane(tid >> 6), lane = tid & 63, r32 = lane & 31, hi = lane >> 5;
    LAS float* wsf = (LAS float*)(lds + 3 * BUF) + wid * 64; LAS float* li_l = wsf; LAS float* al_l = wsf + 32;
    const char* kp[NKP]; int kst[NKP]; const char* vp[2];
#pragma unroll
    for (int i = 0; i < NKP; ++i) { const int p = (wid * NKP + i) * 1024 + lane * 16, row = p / KROW, cbs = p % KROW, cb = cbs ^ ((row & 7) << 4);
        if (DQK == 128 || cb < 256) { kp[i] = (const char*)K1 + (size_t)row * ldk1 * 2 + cb; kst[i] = 64 * ldk1 * 2; }
        else { kp[i] = (const char*)K2 + (size_t)row * ldk2 * 2 + (cb - 256); kst[i] = 64 * ldk2 * 2; } }
#pragma unroll
    for (int i = 0; i < 2; ++i) { const int p = (wid * 2 + i) * 1024 + lane * 16, sub = p >> 9, q = (p & 511) >> 1, kk = (sub >> 2) * 8 + (q >> 5), k = (kk & ~0xC) | ((kk & 4) << 1) | ((kk & 8) >> 1), c = (sub & 3) * 32 + (q & 31);
        vp[i] = (const char*)Vb + ((size_t)k * ldv + c) * 2; }
    const int vstep = 64 * ldv * 2;
#define FA_DMA(bo) do { _Pragma("unroll") for (int _i = 0; _i < NKP; ++_i) { __builtin_amdgcn_global_load_lds((const unsigned*)kp[_i], (LAS unsigned*)(lds + (bo) + (wid * NKP + _i) * 1024), 16, 0, 0); kp[_i] += kst[_i]; } \
        _Pragma("unroll") for (int _i = 0; _i < 2; ++_i) { __builtin_amdgcn_global_load_lds((const unsigned*)vp[_i], (LAS unsigned*)(lds + (bo) + KT + (wid * 2 + _i) * 1024), 16, 0, 0); vp[_i] += vstep; } } while (0)
#define FA_SYNC() do { asm volatile("s_waitcnt vmcnt(0)" ::: "memory"); __builtin_amdgcn_s_barrier(); asm volatile("" ::: "memory"); } while (0)
    int bm1 = 0, bc = BUF, bp1 = 2 * BUF;
    FA_DMA(bm1); FA_DMA(bc);
    bf16x8 qr[ND0];
    { const bf16_t* Qw = Qb + (size_t)(wid * 32 + r32) * ldq + hi * 8;
#pragma unroll
      for (int d0 = 0; d0 < ND0; ++d0) qr[d0] = *(const bf16x8*)(Qw + d0 * 16); }
    int kb[4];
#pragma unroll
    for (int q = 0; q < 4; ++q) kb[q] = r32 * KROW + ((q * 32 + hi * 16) ^ ((r32 & 7) << 4));
    const int vb0 = (int)(uintptr_t)lds + KT + v_rd_base(lane);
    const int lim = CAUSAL ? qtile0 + (wid >> 1) : 0x7fffffff;
    float m_reg = -1e30f, l_reg = 0; f32x16 o[4];
#pragma unroll
    for (int d = 0; d < 4; ++d)
#pragma unroll
        for (int r = 0; r < 16; ++r) o[d][r] = 0.f;
    f32x16 pA0, pA1, pB0, pB1; float mnA, mnB, alA, alB; bf16x8 pa0, pa1, pa2, pa3;
#define FA_VIS(j) (!CAUSAL || (j) <= lim)
#define FA_MASK(P0, P1, j) do { if (CAUSAL && (j) > lim) { _Pragma("unroll") for (int _r = 0; _r < 16; ++_r) { P0[_r] = -1e30f; P1[_r] = -1e30f; } } } while (0)
#define FA_RESC(a) do { if (__any((a) < 1.f)) { if (hi == 0) al_l[r32] = (a); asm volatile("s_waitcnt lgkmcnt(0)" ::: "memory"); \
        _Pragma("unroll") for (int _d = 0; _d < 4; ++_d) _Pragma("unroll") for (int _r = 0; _r < 16; ++_r) o[_d][_r] *= al_l[crow(_r, hi)]; } } while (0)
#define FA_ROT() do { const int _t = bm1; bm1 = bc; bc = bp1; bp1 = _t; } while (0)
    FA_SYNC();
    FA_DMA(bp1);
    qkt<DQK>(pA0, pA1, lds + bm1, kb, qr); partialSM(pA0, pA1, m_reg, mnA, alA);
    for (int j = 1; j + 1 < NT; j += 2) {
        SBAR(); if (FA_VIS(j)) qkt<DQK>(pB0, pB1, lds + bc, kb, qr);
        finishSM(pA0, pA1, alA, l_reg, pa0, pa1, pa2, pa3); SBAR();
        if (FA_VIS(j - 1)) pv_d0(o, vb0 + bm1, pa0, pa1, pa2, pa3); FA_MASK(pB0, pB1, j); partialSM(pB0, pB1, m_reg, mnB, alB);
        FA_SYNC(); if (j + 2 < NT) FA_DMA(bm1);
        FA_RESC(alB); FA_ROT();
        SBAR(); if (FA_VIS(j + 1)) qkt<DQK>(pA0, pA1, lds + bc, kb, qr);
        finishSM(pB0, pB1, alB, l_reg, pa0, pa1, pa2, pa3); SBAR();
        if (FA_VIS(j)) pv_d0(o, vb0 + bm1, pa0, pa1, pa2, pa3); FA_MASK(pA0, pA1, j + 1); partialSM(pA0, pA1, m_reg, mnA, alA);
        FA_SYNC(); if (j + 3 < NT) FA_DMA(bm1);
        FA_RESC(alA); FA_ROT();
    }
    SBAR(); if (FA_VIS(NT - 1)) qkt<DQK>(pB0, pB1, lds + bc, kb, qr);
    finishSM(pA0, pA1, alA, l_reg, pa0, pa1, pa2, pa3); SBAR();
    if (FA_VIS(NT - 2)) pv_d0(o, vb0 + bm1, pa0, pa1, pa2, pa3); FA_MASK(pB0, pB1, NT - 1); partialSM(pB0, pB1, m_reg, mnB, alB);
    FA_RESC(alB);
    finishSM(pB0, pB1, alB, l_reg, pa0, pa1, pa2, pa3); SBAR();
    if (FA_VIS(NT - 1)) pv_d0(o, vb0 + bc, pa0, pa1, pa2, pa3);
    if (hi == 0) li_l[r32] = l_reg; asm volatile("s_waitcnt lgkmcnt(0)" ::: "memory");
    float rli[16];
#pragma unroll
    for (int r = 0; r < 16; ++r) rli[r] = __builtin_amdgcn_rcpf(li_l[crow(r, hi)]);
    FA_SYNC();
    LAS char* Ot = lds + wid * 8704;
#pragma unroll
    for (int r = 0; r < 16; ++r)
#pragma unroll
        for (int d0 = 0; d0 < 4; ++d0) *(LAS bf16_t*)(Ot + crow(r, hi) * 272 + (d0 * 32 + r32) * 2) = (bf16_t)f2bf(o[d0][r] * rli[r]);
    asm volatile("s_waitcnt lgkmcnt(0)" ::: "memory");
#pragma unroll
    for (int i = 0; i < 8; ++i) { const int idx = i * 64 + lane, row = idx >> 4, c16 = idx & 15;
        const u32x4 v = *(LAS const u32x4*)(Ot + row * 272 + c16 * 16); *(u32x4*)(Ob + (size_t)(wid * 32 + row) * ldo + c16 * 8) = v; }
    asm volatile("s_waitcnt lgkmcnt(0)" ::: "memory"); __builtin_amdgcn_s_barrier(); asm volatile("" ::: "memory");
#undef FA_DMA
#undef FA_SYNC
#undef FA_MASK
#undef FA_VIS
#undef FA_RESC
#undef FA_ROT
}
DI int vcu_of(int bx, int G) { return (G % 8 == 0) ? (bx % 8) * (G / 8) + bx / 8 : bx; }
DI void mla_phase(LAS char* lds, const bf16_t* Q, const bf16_t* KN, const bf16_t* KR, const bf16_t* V, bf16_t* AO, int G, int bx) {
    const int v = vcu_of(bx, G);
    for (int p = v; p < NB * HEADS * 8; p += G) { const int bh = p >> 3, i = p & 7, b = bh / HEADS, h = bh % HEADS;
#pragma unroll 1
        for (int s = 0; s < 2; ++s) { const int qb = s ? 15 - i : i; const size_t row0 = (size_t)b * S + qb * 256, key0 = (size_t)b * S;
            attn_unit<192, true>(lds, Q + row0 * NQ + h * QKD, NQ, KN + key0 * D + h * NOPE, D, KR + key0 * ROPE, ROPE, V + key0 * D + h * VD, D, AO + row0 * D + h * VD, D, 4 * qb + 4, 4 * qb); } }
}
DI void memattn_phase(LAS char* lds, const bf16_t* MQ, const bf16_t* MK, const bf16_t* MV, bf16_t* MO, int G, int bx) {
    for (int u = bx; u < NB * MH * (S / 256); u += G) { const int qb = u % (S / 256), h = (u / (S / 256)) % MH, b = u / (S / 256 * MH); const size_t row0 = (size_t)b * S + qb * 256, key0 = (size_t)b * MEMT;
        attn_unit<128, false>(lds, MQ + row0 * MI + h * MHD, MI, MK + key0 * MI + h * MHD, MI, nullptr, 0, MV + key0 * MI + h * MHD, MI, MO + row0 * MI + h * MHD, MI, MEMT / 64, 0); }
}
}

#ifndef H16
#define H16 1
#endif
#ifndef JIT
#define JIT 1
#endif
#ifndef XCONV
#define XCONV 0
#endif
#ifndef XMLA
#define XMLA 0
#endif
#ifndef XMOE
#define XMOE 0
#endif
#ifndef XROUTER
#define XROUTER 0
#endif
#ifndef XDENSE
#define XDENSE 0
#endif
#ifndef XMEMATT
#define XMEMATT 0
#endif
#ifndef XCOMB
#define XCOMB 0
#endif
#ifndef XRES
#define XRES 0
#endif
#ifndef XUQ
#define XUQ 0
#endif
#ifndef XPOOL
#define XPOOL 0
#endif
constexpr int LDS_BYTES = 147456, LDS_MISC = 131072;
#define XB_TMO      128
#define XB_XCNT(j)  (256  + 64 * (j))
#define XB_XSUB(j)  (1280 + 64 * (j))
#define XB_XGEN(j)  (2304 + 64 * (j))
#define XB_TOP      3328
#define XB_TOPGEN   3392
#define XCD_BAR_WORDS 3456
#define XB_SPIN_CAP (1u << 18)
constexpr int CW_BAR = 4096;
DI unsigned xb_ld(unsigned* p)              { return __hip_atomic_load(p, __ATOMIC_RELAXED, __HIP_MEMORY_SCOPE_AGENT); }
DI unsigned xb_add(unsigned* p, unsigned v) { return __hip_atomic_fetch_add(p, v, __ATOMIC_RELAXED, __HIP_MEMORY_SCOPE_AGENT); }
DI unsigned xb_xcc_id() { return (unsigned)__builtin_amdgcn_s_getreg((3 << 11) | 20) & 0xFu; }
#define XB_SPIN(cond, bar) do { unsigned _sp = 0; while (cond) { __builtin_amdgcn_s_sleep(1); \
    if ((++_sp & 255u) == 0u) { if (xb_ld(&(bar)[XB_TMO])) break; if (_sp > XB_SPIN_CAP) { atomicAdd(&(bar)[XB_TMO], 1u); break; } } } } while (0)
struct XcdBarrier { unsigned* bar; unsigned x; volatile LAS unsigned* st; };
DI XcdBarrier xcd_barrier_post(unsigned* bar, volatile LAS unsigned* st) {
    XcdBarrier b; b.bar = bar; b.x = xb_xcc_id(); b.st = st;
    if (threadIdx.x == 0) (void)xb_add(&bar[XB_XCNT(b.x)], 1u);
    return b;
}
DI void xcd_barrier_complete(unsigned* bar, unsigned x, unsigned& nloc, unsigned& nx) {
    const unsigned G = gridDim.x * gridDim.y * gridDim.z;
    unsigned sum, cnt, mine, sp = 0u;
    for (;;) {
        sum = 0u; cnt = 0u; mine = 0u;
#pragma unroll
        for (unsigned j = 0; j < 16; ++j) { const unsigned c = xb_ld(&bar[XB_XCNT(j)]); sum += c; cnt += (c > 0u) ? 1u : 0u; mine = (j == x) ? c : mine; }
        if (sum == G) break;
        __builtin_amdgcn_s_sleep(1);
        if ((++sp & 255u) == 0u) { if (xb_ld(&bar[XB_TMO])) break; if (sp > XB_SPIN_CAP) { atomicAdd(&bar[XB_TMO], 1u); break; } }
    }
    nloc = mine > 0u ? mine : 1u; nx = cnt > 0u ? cnt : 1u;
}
DI void xcd_barrier(const XcdBarrier& b) {
    asm volatile("s_waitcnt vmcnt(0)" ::: "memory");
    __syncthreads();
    if (threadIdx.x == 0) {
        unsigned* bar = b.bar;
        __builtin_amdgcn_s_waitcnt(0);
        unsigned nloc = b.st[0], nx = b.st[1];
        if (nloc == 0u) { xcd_barrier_complete(bar, b.x, nloc, nx); b.st[0] = nloc; b.st[1] = nx; }
        const unsigned old = xb_add(&bar[XB_XSUB(b.x)], 1u);
        const unsigned gen = old / nloc;
        if (old + 1u == (gen + 1u) * nloc) {
            __builtin_amdgcn_fence(__ATOMIC_RELEASE, "agent");
            asm volatile("s_waitcnt vmcnt(0)" ::: "memory");
            const unsigned og = xb_add(&bar[XB_TOP], 1u);
            const unsigned tg = og / nx;
            if (og + 1u == (tg + 1u) * nx) xb_add(&bar[XB_TOPGEN], 1u);
            else XB_SPIN(xb_ld(&bar[XB_TOPGEN]) == tg, bar);
            __builtin_amdgcn_fence(__ATOMIC_ACQUIRE, "agent");
            xb_add(&bar[XB_XGEN(b.x)], 1u);
            asm volatile("s_waitcnt vmcnt(0)" ::: "memory");
        } else {
            XB_SPIN(xb_ld(&bar[XB_XGEN(b.x)]) == gen, bar);
            __builtin_amdgcn_fence(__ATOMIC_ACQUIRE, "agent");
            asm volatile("s_waitcnt vmcnt(0)" ::: "memory");
        }
    }
    __syncthreads();
}

#define LDS_WAIT() asm volatile("s_waitcnt lgkmcnt(0)" ::: "memory")
DI void wt_item(const float* W, int K, int N, bf16_t* WT, const float* kgain, const float* ngain, float scale, int perm, int row_off, LAS float* scr, int item, int lane) {
    const int nblk = N >> 5, kb = item / nblk, nb = item - kb * nblk, k0 = kb * 64, n0 = nb * 32, kr = lane >> 3, n4 = (lane & 7) * 4;
    f32x4 ng = {scale, scale, scale, scale}; if (ngain) ng = *(const f32x4*)(ngain + n0 + n4) * scale;
    f32x4 v[8];
#pragma unroll
    for (int i = 0; i < 8; ++i) v[i] = *(const f32x4*)(W + (size_t)(k0 + 8 * i + kr) * N + n0 + n4);
#pragma unroll
    for (int i = 0; i < 8; ++i) { const int k = 8 * i + kr; f32x4 x = v[i] * ng; if (kgain) x = x * kgain[k0 + k];
        scr[(n4 + 0) * 65 + k] = x.x; scr[(n4 + 1) * 65 + k] = x.y; scr[(n4 + 2) * 65 + k] = x.z; scr[(n4 + 3) * 65 + k] = x.w; }
    LDS_WAIT();
    const int kc = lane & 7;
#pragma unroll
    for (int q = 0; q < 4; ++q) { const int n = (lane >> 3) + 8 * q; const LAS float* sp = scr + n * 65 + 8 * kc;
        u32x4 o; o.x = pk2(sp[0], sp[1]); o.y = pk2(sp[2], sp[3]); o.z = pk2(sp[4], sp[5]); o.w = pk2(sp[6], sp[7]);
        *(u32x4*)(WT + (size_t)(row_off + permrow(perm, n0 + n)) * K + k0 + 8 * kc) = o; }
    LDS_WAIT();
}
struct MArgs { const void* in[32]; float* out; unsigned char* ws; int ph_lo, ph_hi, bar_region, pad; };
#define INF(i) ((const float*)P.in[i])
#define WSB(off) ((bf16_t*)(P.ws + (off)))
#define WSF(off) ((float*)(P.ws + (off)))
constexpr int CVA = 7680;
constexpr float SC_MEM = 0.08838834764831845f  , SC_MLA = 0.07216878364870323f  ;
DI void conv_phase(const MArgs& P, LAS unsigned char* lds, int gw, int NGW, int wave, int lane) {
    LAS float* scr = (LAS float*)(lds + wave * 16384);
    constexpr int I_POOL = 8 * 128, I_MQ = 4 * 512, I_MO = 4 * 512, I_E = (JIT ? 0 : 128) * 512, I_DQ = 512, I_KR = 64, I_UQ = 2 * 512, I_QR = 2 * 256, I_O = 2 * 2048, I_UK = 512;
    constexpr int NITEMS = I_POOL + 3 * I_MQ + I_MO + 3 * I_E + 3 * I_DQ + I_KR + I_UQ + I_QR + I_O + 2 * I_UK;
    for (int it = gw; it < NITEMS; it += NGW) {
        int r = it;
        if (r < I_E) { const int m = r >> 9; wt_item(INF(28) + (size_t)m * D * EFF, D, EFF, WSB(WS_WGU) + (size_t)m * 1024 * D, INF(6) + (m >> 5) * D, nullptr, 1.f, 3, 0, scr, r & 511, lane); continue; } r -= I_E;
        if (r < I_E) { const int m = r >> 9; wt_item(INF(29) + (size_t)m * D * EFF, D, EFF, WSB(WS_WGU) + (size_t)m * 1024 * D, INF(6) + (m >> 5) * D, nullptr, 1.f, 4, 0, scr, r & 511, lane); continue; } r -= I_E;
        if (r < I_E) { const int m = r >> 9; wt_item(INF(30) + (size_t)m * EFF * D, EFF, D, WSB(WS_WD) + (size_t)m * D * EFF, nullptr, nullptr, 1.f, 0, 0, scr, r & 511, lane); continue; } r -= I_E;
        if (r < I_POOL) { const int m = r >> 7; wt_item(INF(7) + (size_t)m * PG * PG, PG, PG, WSB(WS_WPOOL) + (size_t)(m >> 2) * D * PG, nullptr, INF(8) + (m >> 2) * D + (m & 3) * PG, 1.f, 0, (m & 3) * PG, scr, r & 127, lane); continue; } r -= I_POOL;
        if (r < I_MQ) { const int m = r >> 9; wt_item(INF(20) + (size_t)m * D * MI, D, MI, WSB(WS_WMQ) + (size_t)m * MI * D, INF(4) + m * D, nullptr, SC_MEM, 0, 0, scr, r & 511, lane); continue; } r -= I_MQ;
        if (r < I_MQ) { const int m = r >> 9; wt_item(INF(21) + (size_t)m * D * MI, D, MI, WSB(WS_WMK) + (size_t)m * MI * D, INF(5) + m * D, nullptr, 1.f, 0, 0, scr, r & 511, lane); continue; } r -= I_MQ;
        if (r < I_MQ) { const int m = r >> 9; wt_item(INF(22) + (size_t)m * D * MI, D, MI, WSB(WS_WMV) + (size_t)m * MI * D, INF(5) + m * D, nullptr, 1.f, 0, 0, scr, r & 511, lane); continue; } r -= I_MQ;
        if (r < I_MO) { const int m = r >> 9; wt_item(INF(23) + (size_t)m * MI * D, MI, D, WSB(WS_WMO) + (size_t)m * D * MI, nullptr, nullptr, 1.f, 0, 0, scr, r & 511, lane); continue; } r -= I_MO;
        if (r < I_DQ) { wt_item(INF(15), D, QR, WSB(WS_WDQ0), INF(3) + 2 * D, nullptr, 1.f, 0, 0, scr, r, lane); continue; } r -= I_DQ;
        if (r < I_DQ) { wt_item(INF(10), D, KVR, WSB(WS_WDQ0), INF(9), nullptr, 1.f, 0, 512, scr, r, lane); continue; } r -= I_DQ;
        if (r < I_KR) { wt_item(INF(12), D, ROPE, WSB(WS_WDQ0), INF(9), nullptr, 1.f, 5, 1024, scr, r, lane); continue; } r -= I_KR;
        if (r < I_DQ) { wt_item(INF(15) + (size_t)D * QR, D, QR, WSB(WS_WDQ1), INF(3) + 3 * D, nullptr, 1.f, 0, 0, scr, r, lane); continue; } r -= I_DQ;
        if (r < I_UQ) { const int m = r >> 9; wt_item(INF(17) + (size_t)m * QR * D, QR, HEADS * NOPE, WSB(WS_WUQ) + (size_t)m * NQ * QR, INF(16) + m * QR, nullptr, SC_MLA, 1, 0, scr, r & 511, lane); continue; } r -= I_UQ;
        if (r < I_QR) { const int m = r >> 8; wt_item(INF(18) + (size_t)m * QR * HEADS * ROPE, QR, HEADS * ROPE, WSB(WS_WUQ) + (size_t)m * NQ * QR, INF(16) + m * QR, nullptr, SC_MLA, 2, 0, scr, r & 255, lane); continue; } r -= I_QR;
        if (r < I_O) { const int m = r >> 11; wt_item(INF(19) + (size_t)m * D * D, D, D, WSB(WS_WO) + (size_t)m * D * D, nullptr, nullptr, 1.f, 0, 0, scr, r & 2047, lane); continue; } r -= I_O;
        if (r < I_UK) { wt_item(INF(13), KVR, D, WSB(WS_WUKV), INF(11), nullptr, 1.f, 0, 0, scr, r, lane); continue; } r -= I_UK;
        wt_item(INF(14), KVR, D, WSB(WS_WUKV), INF(11), nullptr, 1.f, 0, 2048, scr, r, lane);
    }
}
DI void conv_experts(const MArgs& P, int l, LAS unsigned char* lds, LAS unsigned* ctr, int first, int stride, int limit, int wave, int lane) {
    LAS float* scr = (LAS float*)(lds + 16384 + wave * 8448);
    for (;;) {
        unsigned i = 0; if (lane == 0) i = __hip_atomic_fetch_add(ctr, 1u, __ATOMIC_RELAXED, __HIP_MEMORY_SCOPE_WORKGROUP);
        i = __builtin_amdgcn_readfirstlane(i);
        const int it = first + (int)i * stride; if (it >= limit) break;
        const int fam = it >> 14, m = l * NE + ((it >> 9) & 31), r = it & 511;
        if (fam == 0) wt_item(INF(28) + (size_t)m * D * EFF, D, EFF, WSB(WS_WGU) + (size_t)m * 1024 * D, INF(6) + l * D, nullptr, 1.f, 3, 0, scr, r, lane);
        else if (fam == 1) wt_item(INF(29) + (size_t)m * D * EFF, D, EFF, WSB(WS_WGU) + (size_t)m * 1024 * D, INF(6) + l * D, nullptr, 1.f, 4, 0, scr, r, lane);
        else wt_item(INF(30) + (size_t)m * EFF * D, EFF, D, WSB(WS_WD) + (size_t)m * D * EFF, nullptr, nullptr, 1.f, 0, 0, scr, r, lane); }
}
DI void tables_phase(const MArgs& P, int gtid, int NT_) {
    for (int idx = gtid; idx < T * 32; idx += NT_) { const int t = idx >> 5, i = idx & 31;
        const float inv = (float)(1.0 / pow(10000.0, (double)i / 32.0)); const float ang = (float)((const int*)P.in[2])[t] * inv;
        const double rev = (double)ang * 0.15915494309189533577; const float fr = (float)(rev - rint(rev));
        WSF(WS_COS)[idx] = __builtin_amdgcn_cosf(fr); WSF(WS_SIN)[idx] = __builtin_amdgcn_sinf(fr); }
    for (int idx = gtid; idx < DEPTH * 48 * D; idx += NT_) { const int l = idx / (48 * D), n = (idx / D) % 48, k = idx % D;
        float w = 0.f; if (n < 36) w = (n < 4 ? INF(24)[((size_t)l * D + k) * 4 + n] : INF(26)[((size_t)l * D + k) * 32 + (n - 4)]) * INF(6)[l * D + k];
        const unsigned hi = f2bf(w), lo = f2bf(w - __uint_as_float(hi << 16));
        WSB(WS_RWH)[((size_t)(l * 2 + 0) * 48 + n) * D + k] = (bf16_t)hi; WSB(WS_RWH)[((size_t)(l * 2 + 1) * 48 + n) * D + k] = (bf16_t)lo; }
    unsigned* z = (unsigned*)(WSB(WS_WDQ0) + (size_t)1088 * D);
    for (int idx = gtid; idx < (NDQ0 - 1088) * D / 2; idx += NT_) z[idx] = 0u;
}
DI void memprep_phase(const MArgs& P, int gw, int NGW, int lane) {
    for (int r = gw; r < NB * MEMT; r += NGW) { const f32x4* x = (const f32x4*)(INF(1) + (size_t)r * D) + lane; float ss = 0.f;
#pragma unroll
        for (int j = 0; j < 8; ++j) { const f32x4 v = x[64 * j]; ss += (v.x * v.x + v.y * v.y) + (v.z * v.z + v.w * v.w);
            u32x2 o; o.x = pk2(v.x, v.y); o.y = pk2(v.z, v.w); *((u32x2*)(WSB(WS_MEMB) + (size_t)r * D) + lane + 64 * j) = o; }
        ss = wave_sum(ss); if (lane == 0) WSF(WS_MEMRS)[r] = rsqrtf(ss * (1.0f / D) + EPS); }
}
DI void combine_phase(const float* src, const bf16_t* src16, const bf16_t* Y, float* H, bf16_t* HB, float* RS0, const float* gain, bf16_t* HN, float* out, int gw, int NGW, int lane) {
    for (int t = gw; t < T; t += NGW) {
        const f32x4* x = (const f32x4*)(src + (size_t)t * D) + lane; f32x4 v[8]; float ss = 0.f;
#pragma unroll
        for (int j = 0; j < 8; ++j) {
            if (src16) { const u32x2 h = *((const u32x2*)(src16 + (size_t)t * D) + lane + 64 * j); v[j] = (f32x4){__uint_as_float(h.x << 16), __uint_as_float(h.x & 0xffff0000u), __uint_as_float(h.y << 16), __uint_as_float(h.y & 0xffff0000u)}; }
            else v[j] = x[64 * j];
            if (Y) { const u32x2 a = *((const u32x2*)(Y + (size_t)(2 * t) * D) + lane + 64 * j), b = *((const u32x2*)(Y + (size_t)(2 * t + 1) * D) + lane + 64 * j);
                v[j].x = (v[j].x + __uint_as_float(a.x << 16)) + __uint_as_float(b.x << 16); v[j].y = (v[j].y + __uint_as_float(a.x & 0xffff0000u)) + __uint_as_float(b.x & 0xffff0000u);
                v[j].z = (v[j].z + __uint_as_float(a.y << 16)) + __uint_as_float(b.y << 16); v[j].w = (v[j].w + __uint_as_float(a.y & 0xffff0000u)) + __uint_as_float(b.y & 0xffff0000u); }
            ss += (v[j].x * v[j].x + v[j].y * v[j].y) + (v[j].z * v[j].z + v[j].w * v[j].w); }
        ss = wave_sum(ss); const float rs = rsqrtf(ss * (1.0f / D) + EPS);
        if (lane == 0 && RS0) RS0[t] = rs;
#pragma unroll
        for (int j = 0; j < 8; ++j) {
            if (H) *((f32x4*)(H + (size_t)t * D) + lane + 64 * j) = v[j];
            if (HB) { u32x2 o; o.x = pk2(v[j].x, v[j].y); o.y = pk2(v[j].z, v[j].w); *((u32x2*)(HB + (size_t)t * D) + lane + 64 * j) = o; }
            if (gain) { const f32x4 g = *((const f32x4*)gain + lane + 64 * j); const f32x4 n = v[j] * g * rs;
                if (HN) { u32x2 o; o.x = pk2(n.x, n.y); o.y = pk2(n.z, n.w); *((u32x2*)(HN + (size_t)t * D) + lane + 64 * j) = o; }
                if (out) *((f32x4*)(out + (size_t)t * D) + lane + 64 * j) = n; } }
    }
}
DI void pool_phase(const bf16_t* HN, bf16_t* U, int vcu, int G, int tid) {
    if (vcu < 0) return;
    for (int t = vcu * 2 + (tid >> 8); t < T; t += 2 * G) { const int c = (tid & 255) * 8, s = t & (S - 1), w = 2 << (c >> 9), n = (s + 1 < w) ? s + 1 : w;
        float acc[8] = {0.f, 0.f, 0.f, 0.f, 0.f, 0.f, 0.f, 0.f}, self[8] = {0.f, 0.f, 0.f, 0.f, 0.f, 0.f, 0.f, 0.f};
        for (int i = 0; i < n; ++i) { const u32x4 v = *(const u32x4*)(HN + (size_t)(t - i) * D + c);
            const float f[8] = {__uint_as_float(v.x << 16), __uint_as_float(v.x & 0xffff0000u), __uint_as_float(v.y << 16), __uint_as_float(v.y & 0xffff0000u),
                                __uint_as_float(v.z << 16), __uint_as_float(v.z & 0xffff0000u), __uint_as_float(v.w << 16), __uint_as_float(v.w & 0xffff0000u)};
#pragma unroll
            for (int q = 0; q < 8; ++q) { acc[q] += f[q]; if (i == 0) self[q] = f[q]; } }
        const float inv = 1.0f / (float)n; u32x4 o;
        o.x = pk2(acc[0] * inv - self[0], acc[1] * inv - self[1]); o.y = pk2(acc[2] * inv - self[2], acc[3] * inv - self[3]);
        o.z = pk2(acc[4] * inv - self[4], acc[5] * inv - self[5]); o.w = pk2(acc[6] * inv - self[6], acc[7] * inv - self[7]);
        *(u32x4*)(U + (size_t)t * D + c) = o; }
}
typedef float f32x4r __attribute__((ext_vector_type(4)));
DI void router_phase(const float* H, const bf16_t* HBs, const bf16_t* RWH, const float* rg_b, const float* re_b, float* RS2, int* cnt, int* list, float* gwt, LAS unsigned char* lds, int vcu, int G, int wave, int lane, bool commit = true) {
    LAS float* tile = (LAS float*)(lds + wave * 4096);
    const bf16_t* RWL = RWH + (size_t)48 * D;
    for (int t16 = wave * G + vcu; t16 < T / 16; t16 += 8 * G) {
        const int r16 = lane & 15, kq = lane >> 4;
        const float* hp = H + (size_t)(t16 * 16 + r16) * D + kq * 8; const bf16_t* hb = HBs + (size_t)(t16 * 16 + r16) * D + kq * 8;
        const bf16_t* wh = RWH + (size_t)r16 * D + kq * 8; const bf16_t* wl = RWL + (size_t)r16 * D + kq * 8;
        f32x4 acc[3]; float ss = 0.f;
#pragma unroll
        for (int q = 0; q < 3; ++q) acc[q] = (f32x4){0.f, 0.f, 0.f, 0.f};
        for (int k0 = 0; k0 < D; k0 += 128) {
            f32x4 xa[4], xb[4];
#pragma unroll
            for (int u = 0; u < 4; ++u) {
                if (H16) { const u32x4 w = *(const u32x4*)(hb + k0 + u * 32);
                    xa[u] = (f32x4){__uint_as_float(w.x << 16), __uint_as_float(w.x & 0xffff0000u), __uint_as_float(w.y << 16), __uint_as_float(w.y & 0xffff0000u)};
                    xb[u] = (f32x4){__uint_as_float(w.z << 16), __uint_as_float(w.z & 0xffff0000u), __uint_as_float(w.w << 16), __uint_as_float(w.w & 0xffff0000u)}; }
                else { xa[u] = *(const f32x4*)(hp + k0 + u * 32); xb[u] = *(const f32x4*)(hp + k0 + u * 32 + 4); } }
#pragma unroll
            for (int u = 0; u < 4; ++u) {
                const f32x4 a = xa[u], b = xb[u];
                ss += ((a.x * a.x + a.y * a.y) + (a.z * a.z + a.w * a.w)) + ((b.x * b.x + b.y * b.y) + (b.z * b.z + b.w * b.w));
                u32x4 h; h.x = fg::cvt_pk_bf16(a.x, a.y); h.y = fg::cvt_pk_bf16(a.z, a.w); h.z = fg::cvt_pk_bf16(b.x, b.y); h.w = fg::cvt_pk_bf16(b.z, b.w);
                u32x4 lo; lo.x = fg::cvt_pk_bf16(a.x - __uint_as_float(h.x << 16), a.y - __uint_as_float(h.x & 0xffff0000u)); lo.y = fg::cvt_pk_bf16(a.z - __uint_as_float(h.y << 16), a.w - __uint_as_float(h.y & 0xffff0000u));
                lo.z = fg::cvt_pk_bf16(b.x - __uint_as_float(h.z << 16), b.y - __uint_as_float(h.z & 0xffff0000u)); lo.w = fg::cvt_pk_bf16(b.z - __uint_as_float(h.w << 16), b.w - __uint_as_float(h.w & 0xffff0000u));
                const bf16x8 ah = *reinterpret_cast<const bf16x8*>(&h), al_ = *reinterpret_cast<const bf16x8*>(&lo);
#pragma unroll
                for (int q = 0; q < 3; ++q) { const bf16x8 bh = *(const bf16x8*)(wh + (size_t)q * 16 * D + k0 + u * 32), bl = *(const bf16x8*)(wl + (size_t)q * 16 * D + k0 + u * 32);
                    acc[q] = __builtin_amdgcn_mfma_f32_16x16x32_bf16(ah, bh, acc[q], 0, 0, 0);
                    if (!H16) acc[q] = __builtin_amdgcn_mfma_f32_16x16x32_bf16(al_, bh, acc[q], 0, 0, 0);
                    acc[q] = __builtin_amdgcn_mfma_f32_16x16x32_bf16(ah, bl, acc[q], 0, 0, 0); }
            }
        }
        ss = fg::quad_sum(ss);
        const float rs = rsqrtf(ss * (1.0f / D) + EPS);
#pragma unroll
        for (int q = 0; q < 3; ++q)
#pragma unroll
            for (int i = 0; i < 4; ++i) tile[(kq * 4 + i) * 49 + q * 16 + r16] = acc[q][i];
        LDS_WAIT();
        if (lane < 16) {
            const LAS float* tr = tile + lane * 49; const int t = t16 * 16 + lane;
            const float g0 = tr[0] * rs + rg_b[0], g1 = tr[1] * rs + rg_b[1], g2 = tr[2] * rs + rg_b[2], g3 = tr[3] * rs + rg_b[3];
            int gs = 0; float gm = g0; if (g1 > gm) { gm = g1; gs = 1; } if (g2 > gm) { gm = g2; gs = 2; } if (g3 > gm) { gm = g3; gs = 3; }
            const float gp = 1.0f / (__expf(g0 - gm) + __expf(g1 - gm) + __expf(g2 - gm) + __expf(g3 - gm));
            float ev[8];
#pragma unroll
            for (int i = 0; i < 8; ++i) ev[i] = tr[4 + gs * 8 + i] * rs + re_b[gs * 8 + i];
            int i0 = 0; float m0 = ev[0];
#pragma unroll
            for (int i = 1; i < 8; ++i) if (ev[i] > m0) { m0 = ev[i]; i0 = i; }
            int i1 = -1; float m1 = -3.0e38f;
#pragma unroll
            for (int i = 0; i < 8; ++i) if (i != i0 && ev[i] > m1) { m1 = ev[i]; i1 = i; }
            const float e1 = __expf(m1 - m0), w0 = gp / (1.0f + e1), w1 = gp * e1 / (1.0f + e1);
            if (commit || w0 < -1.f) { RS2[t] = rs; const int ea = gs * 8 + i0, eb = gs * 8 + i1;
                const int pa = atomicAdd(&cnt[ea], 1); list[(size_t)ea * CAP + pa] = 2 * t; gwt[2 * t] = w0;
                const int pb = atomicAdd(&cnt[eb], 1); list[(size_t)eb * CAP + pb] = 2 * t + 1; gwt[2 * t + 1] = w1; }
        }
        LDS_WAIT();
    }
}
namespace fg {
struct EpiMemKV {
    bf16_t* O; const float* rs;
    DI void operator()(const Acc& acc, const Unit& u, int wr, int wc, int fr, int fq) const {
        float sc[2][4];
#pragma unroll
        for (int ai = 0; ai < 2; ++ai)
#pragma unroll
            for (int m = 0; m < 4; ++m) sc[ai][m] = rs[u.pm * BM + EPI_ROWS(ai, m)];
#pragma unroll
        for (int ai = 0; ai < 2; ++ai)
#pragma unroll
            for (int m = 0; m < 4; ++m) { const int r = u.pm * BM + EPI_ROWS(ai, m);
#pragma unroll
                for (int bj = 0; bj < 2; ++bj) { const int c0 = (u.pn & 1) * BM + bj * HALF + wc * 32 + 8 * fq;
                    *(u32x4*)(O + (size_t)(u.pn >> 1) * (NB * MEMT * MI) + (size_t)r * MI + c0) = pack8(acc[ai][bj][m][0] * sc[ai][m], acc[ai][bj][m][1] * sc[ai][m]); } }
    }
};
}
DI int scan32(int v, int lane) {
#pragma unroll
    for (int o = 1; o < 32; o <<= 1) { const int t = __builtin_amdgcn_ds_bpermute(((lane - o) & 63) << 2, v); if ((lane & 31) >= o) v += t; }
    return v;
}
DI void moe_prefix(LAS unsigned char* lds, const int* cnt) {
    LAS int* pref = (LAS int*)(lds + LDS_MISC + 1024); const int tid = opaque_tid();
    if (tid < 64) {
        const int e = tid & 31, c = cnt[e], nt = (c + 255) >> 8, st = scan32(nt, tid);
        if (tid < 32) { pref[64 + e] = c; pref[e] = st - nt; if (e == 31) pref[32] = st; }
    }
    __syncthreads();
    if (tid == 0) {
        const int G = gridDim.x, nx = (G & 7) ? 1 : 8, x = blockIdx.x % nx; int n = 0;
        for (int e = x; e < NE; e += nx) { const int nt = (pref[64 + e] + 255) >> 8, base = pref[e]; for (int t = 0; t < nt; ++t) pref[128 + n++] = e | (t << 8) | ((base + t) << 16); }
        pref[40] = n; }
    __syncthreads();
}

__global__ void __launch_bounds__(512, 2) mk_fwd(MArgs a) {
    extern __shared__ __attribute__((aligned(16))) unsigned char lds_raw[];
    LAS unsigned char* lds = (LAS unsigned char*)lds_raw;
    const int G = gridDim.x, bx = blockIdx.x, vcu = fa::vcu_of(bx, G), NGW = G * 8;
    volatile LAS unsigned* MISC = (volatile LAS unsigned*)(lds + LDS_MISC);
    if (threadIdx.x < 64) MISC[threadIdx.x] = 0u;
    __syncthreads();
    unsigned char* ws = a.ws;
    XcdBarrier bar = xcd_barrier_post((unsigned*)(ws + WS_CTL) + CW_BAR + a.bar_region * XCD_BAR_WORDS, MISC + 8);
    const MArgs& P = a;
    int pid = 0; const int lo = a.ph_lo, hi = a.ph_hi;
#define PH_IF if (pid >= lo && pid < hi)
#define TL const int tid = opaque_tid(), lane = tid & 63, wave = __builtin_amdgcn_readfirstlane(tid >> 6), gw = vcu * 8 + wave; (void)lane; (void)gw
#define PH_END do { if (pid >= lo && pid + 1 < hi) xcd_barrier(bar); ++pid; } while (0)
    PH_IF { TL; conv_phase(P, lds, gw, NGW, wave, lane); if (XCONV) conv_phase(P, lds, gw, NGW, wave, lane); tables_phase(P, vcu * 512 + tid, G * 512); memprep_phase(P, gw, NGW, lane);
            combine_phase(INF(0), nullptr, nullptr, H16 ? nullptr : WSF(WS_H), WSB(WS_HB), WSF(WS_RS0), INF(3), WSB(WS_HN), nullptr, gw, NGW, lane); }
    PH_END;
    for (int l = 0; l < DEPTH; ++l) {
        const bool isA = l < NA; const int j = l - NA;
        if (l > 0) { PH_IF { TL; if (XCOMB) combine_phase(WSF(WS_H), H16 ? WSB(WS_HB) : nullptr, WSB(WS_Y), WSF(WS_Q), nullptr, nullptr, nullptr, nullptr, nullptr, gw, NGW, lane);
            combine_phase(WSF(WS_H), H16 ? WSB(WS_HB) : nullptr, WSB(WS_Y), H16 ? nullptr : WSF(WS_H), WSB(WS_HB), WSF(WS_RS0), isA ? INF(3) + l * D : nullptr, isA ? WSB(WS_HN) : nullptr, nullptr, gw, NGW, lane); } PH_END; }
        if (isA) {
            PH_IF { if (l == 0) { fg::ProbDense pr{(const char*)WSB(WS_MEMB), (const char*)WSB(WS_WMK), (const char*)WSB(WS_MEMB), (const char*)WSB(WS_WMK), NB * MEMT / 256, 16, 16, D, D, 0, G, bx}; fg::EpiMemKV E{WSB(WS_MK), WSF(WS_MEMRS)}; fg::gemm_phase(lds, pr, E); }
                    { TL; const bool split = (l == 0 && G > 64); pool_phase(WSB(WS_HN), WSB(WS_U), split ? bx - 64 : vcu, split ? G - 64 : G, tid); if (XPOOL) pool_phase(WSB(WS_HN), WSB(WS_U), vcu, G, tid); } }
            PH_END;
        } else {
            PH_IF { const int n = j == 0 ? NDQ0 : QR; const char* B = (const char*)(j == 0 ? WSB(WS_WDQ0) : WSB(WS_WDQ1));
                    fg::ProbDense pr{(const char*)WSB(WS_HB), B, (const char*)WSB(WS_HB), B, T / 256, n / 256, n / 256, D, D, 0, G, bx};
                    fg::EpiDQ E{WSB(WS_CQ), WSB(WS_CKV), WSB(WS_KR), WSF(WS_RS0), WSF(WS_LSQ), WSF(WS_LSKV), WSF(WS_COS), WSF(WS_SIN)}; fg::gemm_phase(lds, pr, E); if (XDENSE) fg::gemm_phase(lds, pr, E); }
            PH_END;
            PH_IF { fg::ProbDense pr{(const char*)WSB(WS_CQ), (const char*)(WSB(WS_WUQ) + (size_t)j * NQ * QR), (const char*)WSB(WS_CKV), (const char*)WSB(WS_WUKV), T / 256, (j == 0 ? NQ + 4096 : NQ) / 256, NQ / 256, QR, QR, 0, G, bx};
                    fg::EpiUQ E{WSB(WS_Q), WSB(WS_KN), WSB(WS_V), WSF(WS_LSQ), WSF(WS_LSKV), WSF(WS_COS), WSF(WS_SIN)}; fg::gemm_phase(lds, pr, E); if (XUQ) fg::gemm_phase(lds, pr, E); }
            PH_END;
            PH_IF { fa::mla_phase((LAS char*)lds, WSB(WS_Q), WSB(WS_KN), WSB(WS_KR), WSB(WS_V), WSB(WS_AO), G, bx); if (XMLA) fa::mla_phase((LAS char*)lds, WSB(WS_Q), WSB(WS_KN), WSB(WS_KR), WSB(WS_V), WSB(WS_AO), G, bx); }
            PH_END;
        }
        PH_IF { const char* A = (const char*)(isA ? WSB(WS_U) : WSB(WS_AO)); const char* B = (const char*)(isA ? WSB(WS_WPOOL) + (size_t)l * D * PG : WSB(WS_WO) + (size_t)j * D * D);
                fg::ProbDense pr{A, B, A, B, T / 256, D / 256, D / 256, isA ? PG : D, D, isA ? 1 : 0, G, bx}; fg::EpiRes<true> E{WSB(WS_HB), WSF(WS_SSP)}; if (XRES) { fg::EpiRes<true> E2{WSB(WS_HB), WSF(WS_SSP), WSB(WS_Y)}; fg::gemm_phase(lds, pr, E2); } fg::gemm_phase(lds, pr, E); }
        PH_END;
        PH_IF { if (JIT && G == 256 && bx >= 128) { const int _t = opaque_tid(); if (_t == 0) *(LAS unsigned*)(lds + LDS_MISC + 64) = 0u; __syncthreads();
                    conv_experts(P, l, lds, (LAS unsigned*)(lds + LDS_MISC + 64), bx - 128, 128, CVA, __builtin_amdgcn_readfirstlane(_t >> 6), _t & 63); }
                const char* B = (const char*)(WSB(WS_WMQ) + (size_t)l * MI * D); fg::ProbDense pr{(const char*)WSB(WS_HB), B, (const char*)WSB(WS_HB), B, T / 256, MI / 256, MI / 256, D, D, 0, G, bx};
                fg::EpiBf16RS<2> E{WSB(WS_MQ), MI, WSF(WS_SSP)}; fg::gemm_phase(lds, pr, E); if (XDENSE) fg::gemm_phase(lds, pr, E); }
        PH_END;
        PH_IF { fa::memattn_phase((LAS char*)lds, WSB(WS_MQ), WSB(WS_MK) + (size_t)l * NB * MEMT * MI, WSB(WS_MV) + (size_t)l * NB * MEMT * MI, WSB(WS_MO), G, bx); if (XMEMATT) fa::memattn_phase((LAS char*)lds, WSB(WS_MQ), WSB(WS_MK) + (size_t)l * NB * MEMT * MI, WSB(WS_MV) + (size_t)l * NB * MEMT * MI, WSB(WS_MO), G, bx); }
        PH_END;
        PH_IF { const char* B = (const char*)(WSB(WS_WMO) + (size_t)l * D * MI); fg::ProbDense pr{(const char*)WSB(WS_MO), B, (const char*)WSB(WS_MO), B, T / 256, D / 256, D / 256, MI, MI, 0, G, bx};
                fg::EpiRes<false> E{WSB(WS_HB), nullptr}; if (XRES) { fg::EpiRes<false> E2{WSB(WS_HB), nullptr, WSB(WS_Y)}; fg::gemm_phase(lds, pr, E2); } fg::gemm_phase(lds, pr, E); }
        PH_END;
        PH_IF { TL; if (JIT) { if (tid == 0) *(LAS unsigned*)(lds + LDS_MISC + 64) = 0u; __syncthreads(); }
                if (XROUTER) router_phase(WSF(WS_H), WSB(WS_HB), WSB(WS_RWH) + (size_t)l * 2 * 48 * D, INF(25) + l * NG, INF(27) + l * NE, WSF(WS_RS2), ((int*)(P.ws + WS_CTL + OFF_CNT)) + l * NE, ((int*)(P.ws + WS_LIST)), WSF(WS_GW), lds, vcu, G, wave, lane, false);
                router_phase(WSF(WS_H), WSB(WS_HB), WSB(WS_RWH) + (size_t)l * 2 * 48 * D, INF(25) + l * NG, INF(27) + l * NE, WSF(WS_RS2), ((int*)(P.ws + WS_CTL + OFF_CNT)) + l * NE, ((int*)(P.ws + WS_LIST)), WSF(WS_GW), lds, vcu, G, wave, lane);
                if (JIT) { const int cva = (G == 256) ? CVA : 0; conv_experts(P, l, lds, (LAS unsigned*)(lds + LDS_MISC + 64), cva + vcu, G, 3 * NE * 512, wave, lane); } }
        PH_END;
        PH_IF { moe_prefix(lds, ((int*)(P.ws + WS_CTL + OFF_CNT)) + l * NE);
                fg::ProbMoe pr{(const char*)WSB(WS_HB), (const char*)(WSB(WS_WGU) + (size_t)l * NE * 1024 * D), ((int*)(P.ws + WS_LIST)), (const LAS int*)(lds + LDS_MISC + 1024), 4, D, D, 1, G, bx, (long)1024 * D * 2};
                fg::EpiMoe1 E{WSB(WS_HH), WSF(WS_RS2), ((int*)(P.ws + WS_LIST))}; fg::gemm_phase(lds, pr, E); if (XMOE == 1) fg::gemm_phase(lds, pr, E); if (XMOE == 2) fg::gemm_phase<decltype(E), decltype(pr), true>(lds, pr, E); }
        PH_END;
        PH_IF { moe_prefix(lds, ((int*)(P.ws + WS_CTL + OFF_CNT)) + l * NE);
                fg::ProbMoe pr{(const char*)WSB(WS_HH), (const char*)(WSB(WS_WD) + (size_t)l * NE * D * EFF), ((int*)(P.ws + WS_LIST)), (const LAS int*)(lds + LDS_MISC + 1024), 8, EFF, EFF, 0, G, bx, (long)D * EFF * 2};
                fg::EpiMoe2 E{WSB(WS_Y), WSF(WS_GW), ((int*)(P.ws + WS_LIST))}; fg::gemm_phase(lds, pr, E); if (XMOE == 1) fg::gemm_phase(lds, pr, E); if (XMOE == 2) fg::gemm_phase<decltype(E), decltype(pr), true>(lds, pr, E); }
        PH_END;
    }
    PH_IF { TL; combine_phase(WSF(WS_H), H16 ? WSB(WS_HB) : nullptr, WSB(WS_Y), nullptr, nullptr, nullptr, INF(31), nullptr, P.out, gw, NGW, lane); }
#undef PH_IF
#undef PH_END
}
constexpr int NPHASES = 1 + 8 + 9 + 11 + 11 + 1;

#ifndef MK_SPLIT
#define MK_SPLIT 0
#endif
extern "C" void kernel_launch(void* const* d_in, const int* in_sizes, int n_in, void* d_out, int out_size, void* d_ws, size_t ws_size, hipStream_t stream) {
    static int grid = 0;
    if (grid == 0) {
        if (n_in != 32 || in_sizes[0] != T * D || out_size != T * D || ws_size < WS_END) { fprintf(stderr, "kernel_launch: shape/ws mismatch (ws %zu need %zu)\n", ws_size, (size_t)WS_END); grid = -1; return; }
        int dev = 0, cus = 0;
        if (hipGetDevice(&dev) != hipSuccess || hipDeviceGetAttribute(&cus, hipDeviceAttributeMultiprocessorCount, dev) != hipSuccess || cus <= 0) { fprintf(stderr, "kernel_launch: device query failed\n"); grid = -1; return; }
        if (hipFuncSetAttribute((const void*)mk_fwd, hipFuncAttributeMaxDynamicSharedMemorySize, LDS_BYTES) != hipSuccess) { fprintf(stderr, "kernel_launch: hipFuncSetAttribute failed\n"); grid = -1; return; }
        int per_cu = 0;
        if (hipOccupancyMaxActiveBlocksPerMultiprocessor(&per_cu, (const void*)mk_fwd, 512, LDS_BYTES) != hipSuccess || per_cu < 1) fprintf(stderr, "kernel_launch: occupancy query says %d\n", per_cu);
        (void)hipGetLastError();
        grid = cus;
    }
    if (grid < 0) return;
    if (hipMemsetAsync((char*)d_ws + WS_CTL, 0, CTL_BYTES, stream) != hipSuccess) { fprintf(stderr, "kernel_launch: memset failed\n"); return; }
    MArgs a; memset(&a, 0, sizeof(a));
    for (int i = 0; i < 32; ++i) a.in[i] = d_in[i];
    a.out = (float*)d_out; a.ws = (unsigned char*)d_ws;
#if MK_SPLIT
    for (int p = 0; p < NPHASES; ++p) { a.ph_lo = p; a.ph_hi = p + 1; a.bar_region = 0; hipLaunchKernelGGL(mk_fwd, dim3(grid), dim3(512), LDS_BYTES, stream, a); }
#else
    a.ph_lo = 0; a.ph_hi = NPHASES; a.bar_region = 0; hipLaunchKernelGGL(mk_fwd, dim3(grid), dim3(512), LDS_BYTES, stream, a);
#endif
    const hipError_t le = hipPeekAtLastError();
    if (le != hipSuccess) fprintf(stderr, "kernel_launch: launch failed: %s\n", hipGetErrorName(le));
}
```
